# Optimizing an MI355X kernel written in HIP

```python
import math
import jax, jax.numpy as jnp
from jax import lax
import numpy as np

D_MODEL = 1024
BATCH = 8
SEQ = 4096
DEPTH = 2
DEC_BATCH = 16
DEC_SEQ = 2048
PAST_LEN = 128

PLE_DIM = 256
N_MIXERS = 2
N_S5_LAYERS = (DEPTH + 1) // 2
N_RG_LAYERS = DEPTH // 2
S5_WIDTH = D_MODEL
S5_GROUP = 16
S5_GROUPS = S5_WIDTH // S5_GROUP
S5_STATE = 64
S5_DT_MIN = 1e-3
S5_DT_MAX = 1e-1
RG_WIDTH = D_MODEL
RG_BLOCKS = 4
RG_BLOCK = RG_WIDTH // RG_BLOCKS
RG_CONV = 4
RG_CONV_LEFT = 1
RG_C = 8.0
PEER_HEADS = 8
PEER_NKEYS = 128
PEER_EXPERTS = PEER_NKEYS * PEER_NKEYS
PEER_QDIM = 256
PEER_HALF = PEER_QDIM // 2
PEER_TOPK = 16
PEER_CHUNK = 512
ALPHA = (2 * DEPTH) ** 0.25
BETA = (8 * DEPTH) ** -0.25
LN_EPS = 1e-5

kernel_name = 'hybrid_s5_rglru_peer_encoder'

F32 = jnp.float32


def _layernorm(x, g, b):
    xf = x.astype(F32)
    mu = jnp.mean(xf, axis=-1, keepdims=True)
    var = jnp.mean(jnp.square(xf - mu), axis=-1, keepdims=True)
    return ((xf - mu) * lax.rsqrt(var + LN_EPS) * g.astype(F32) + b.astype(F32)).astype(x.dtype)


def _cplx_combine(left, right):
    a1r, a1i, b1r, b1i = left
    a2r, a2i, b2r, b2i = right
    return (a1r * a2r - a1i * a2i,
            a1r * a2i + a1i * a2r,
            a2r * b1r - a2i * b1i + b2r,
            a2r * b1i + a2i * b1r + b2i)


def _real_combine(left, right):
    a1, b1 = left
    a2, b2 = right
    return (a1 * a2, a2 * b1 + b2)


def _s5_direction(ug, lam_re, lam_im, log_step, b_re, b_im, c_re, c_im, reverse):
    L = ug.shape[1]
    step = jnp.exp(log_step.astype(F32))[:, None]
    lr = lam_re.astype(F32)
    li = lam_im.astype(F32)
    mag = jnp.exp(lr * step)
    ang = li * step
    ar = mag * jnp.cos(ang)
    ai = mag * jnp.sin(ang)
    den = lr * lr + li * li
    zr = ar - 1.0
    qr = (zr * lr + ai * li) / den
    qi = (ai * lr - zr * li) / den
    br = b_re.astype(F32)
    bi = b_im.astype(F32)
    bbr = qr[..., None] * br - qi[..., None] * bi
    bbi = qr[..., None] * bi + qi[..., None] * br
    bu_r = jnp.einsum('blgc,gpc->blgp', ug, bbr)
    bu_i = jnp.einsum('blgc,gpc->blgp', ug, bbi)
    a_r = jnp.broadcast_to(ar, (1, L) + ar.shape)
    a_i = jnp.broadcast_to(ai, (1, L) + ai.shape)
    _, _, h_r, h_i = lax.associative_scan(_cplx_combine, (a_r, a_i, bu_r, bu_i), reverse=reverse, axis=1)
    return (jnp.einsum('blgp,gcp->blgc', h_r, c_re.astype(F32))
            - jnp.einsum('blgp,gcp->blgc', h_i, c_im.astype(F32)))


def _s5_mixer(x, w_in, lam_re, lam_im, log_step, b_re, b_im, c_re, c_im, d_skip, w_glu):
    bsz, L, _ = x.shape
    u = (x @ w_in).astype(F32)
    ug = u.reshape(bsz, L, S5_GROUPS, S5_GROUP)
    y = (_s5_direction(ug, lam_re[0], lam_im[0], log_step[0], b_re[0], b_im[0], c_re[0], c_im[0], False)
         + _s5_direction(ug, lam_re[1], lam_im[1], log_step[1], b_re[1], b_im[1], c_re[1], c_im[1], True))
    y = y.reshape(bsz, L, S5_WIDTH) + d_skip.astype(F32) * u
    h = jax.nn.gelu(y).astype(x.dtype)
    val, gate = jnp.split(h @ w_glu, 2, axis=-1)
    return val * jax.nn.sigmoid(gate)


def _rg_direction(cf, cb, w_a, b_a, w_x, b_x, lam, reverse):
    shape = cf.shape
    r_gate = jax.nn.sigmoid(jnp.einsum('blhi,hij->blhj', cb, w_a.astype(F32)).reshape(shape) + b_a.astype(F32))
    i_gate = jax.nn.sigmoid(jnp.einsum('blhi,hij->blhj', cb, w_x.astype(F32)).reshape(shape) + b_x.astype(F32))
    log_a = -RG_C * r_gate * jax.nn.softplus(-lam.astype(F32))
    a = jnp.exp(log_a)
    b = jnp.sqrt(-jnp.expm1(2.0 * log_a)) * (i_gate * cf)
    _, h = lax.associative_scan(_real_combine, (a, b), reverse=reverse, axis=1)
    return h


def _rg_mixer(x, w_in, conv_w, conv_b, w_ga, b_ga, w_gx, b_gx, lam, w_out):
    bsz, L, _ = x.shape
    g, r = jnp.split(x @ w_in, 2, axis=-1)
    rp = jnp.pad(r, ((0, 0), (RG_CONV_LEFT, RG_CONV - 1 - RG_CONV_LEFT), (0, 0)))
    c = conv_b + sum(rp[:, k:k + L] * conv_w[k] for k in range(RG_CONV))
    cf = c.astype(F32)
    cb = cf.reshape(bsz, L, RG_BLOCKS, RG_BLOCK)
    h = (_rg_direction(cf, cb, w_ga[0], b_ga[0], w_gx[0], b_gx[0], lam[0], False)
         + _rg_direction(cf, cb, w_ga[1], b_ga[1], w_gx[1], b_gx[1], lam[1], True))
    y = h.astype(x.dtype) * jax.nn.gelu(g)
    return y @ w_out


def _peer(x, w_q, subkeys, u_tab, v_tab):
    bsz, L, D = x.shape
    T = bsz * L
    xt = x.reshape(T, D)
    q = (xt @ w_q).astype(F32).reshape(T, PEER_HEADS, 2, PEER_HALF)
    s = jnp.einsum('thcd,cnd->thcn', q, subkeys.astype(F32))
    sv, si = lax.top_k(s, PEER_TOPK)
    cand_s = (sv[:, :, 0, :, None] + sv[:, :, 1, None, :]).reshape(T, PEER_HEADS, PEER_TOPK * PEER_TOPK)
    cand_e = (si[:, :, 0, :, None] * PEER_NKEYS + si[:, :, 1, None, :]).reshape(T, PEER_HEADS, PEER_TOPK * PEER_TOPK)
    top_s, top_p = lax.top_k(cand_s, PEER_TOPK)
    experts = jnp.take_along_axis(cand_e, top_p, axis=-1).reshape(T, PEER_HEADS * PEER_TOPK)
    gates = jax.nn.softmax(top_s, axis=-1).reshape(T, PEER_HEADS * PEER_TOPK)
    chunk = math.gcd(T, PEER_CHUNK)
    n_blocks = T // chunk

    def expert_block(args):
        xc, ec, gc = args
        act = jax.nn.gelu(jnp.einsum('ckd,cd->ck', u_tab[ec], xc).astype(F32))
        return jnp.einsum('ck,ckd->cd', (gc * act).astype(xc.dtype), v_tab[ec])

    out = lax.map(expert_block, (xt.reshape(n_blocks, chunk, D),
                                 experts.reshape(n_blocks, chunk, PEER_HEADS * PEER_TOPK),
                                 gates.reshape(n_blocks, chunk, PEER_HEADS * PEER_TOPK)))
    return out.reshape(bsz, L, D)


def _trunk(x, p, s5, rg, ln, peer, ple):
    ln1_g, ln1_b, ln2_g, ln2_b = ln
    peer_w_q, peer_subkeys, peer_u, peer_v = peer
    ple_w_proj, ple_w_gate = ple
    for i in range(DEPTH):
        j = i // N_MIXERS
        if i % N_MIXERS == 0:
            mix = _s5_mixer(x, *(w[j] for w in s5))
        else:
            mix = _rg_mixer(x, *(w[j] for w in rg))
        x = _layernorm(ALPHA * x + mix, ln1_g[i], ln1_b[i])
        x = _layernorm(ALPHA * x + _peer(x, peer_w_q[i], peer_subkeys[i], peer_u[i], peer_v[i]), ln2_g[i], ln2_b[i])
        x = x + (p[i] @ ple_w_proj[i]) * jax.nn.sigmoid(x @ ple_w_gate[i])
    return x


def setup_inputs(seed: int = 0) -> dict:
    key = jax.random.key(seed)
    ks = jax.random.split(key, 40)

    def nrm(k, shape, scale):
        return jax.random.normal(k, shape, F32) * scale

    NA, NB, D = N_S5_LAYERS, N_RG_LAYERS, D_MODEL
    G, P, GC = S5_GROUPS, S5_STATE, S5_GROUP
    lam_im_base = math.pi * jnp.arange(P, dtype=F32)
    u_rg = jax.random.uniform(ks[10], (NB, 2, RG_WIDTH), F32, 0.9, 0.999)
    a_rg = u_rg ** (1.0 / RG_C)
    inputs = {
        'x_prompt': nrm(ks[0], (BATCH, SEQ, D), 1.0),
        'x_sample': nrm(ks[1], (DEC_BATCH, DEC_SEQ, D), 1.0),
        'p_prompt': nrm(ks[2], (DEPTH, BATCH, SEQ, PLE_DIM), 1.0),
        'p_sample': nrm(ks[3], (DEPTH, DEC_BATCH, DEC_SEQ, PLE_DIM), 1.0),
        's5_w_in': nrm(ks[4], (NA, D, S5_WIDTH), D ** -0.5),
        's5_lam_re': -0.5 + nrm(ks[5], (NA, 2, G, P), 0.01),
        's5_lam_im': lam_im_base + nrm(ks[6], (NA, 2, G, P), 0.01),
        's5_log_step': jax.random.uniform(ks[7], (NA, 2, G), F32, math.log(S5_DT_MIN), math.log(S5_DT_MAX)),
        's5_b_re': nrm(ks[8], (NA, 2, G, P, GC), (2 * GC) ** -0.5),
        's5_b_im': nrm(ks[9], (NA, 2, G, P, GC), (2 * GC) ** -0.5),
        's5_c_re': nrm(ks[11], (NA, 2, G, GC, P), (2 * P) ** -0.5),
        's5_c_im': nrm(ks[12], (NA, 2, G, GC, P), (2 * P) ** -0.5),
        's5_d': nrm(ks[13], (NA, S5_WIDTH), 1.0),
        's5_w_glu': jnp.concatenate([nrm(ks[14], (NA, S5_WIDTH, D), BETA * S5_WIDTH ** -0.5),
                                     nrm(ks[15], (NA, S5_WIDTH, D), S5_WIDTH ** -0.5)], axis=-1),
        'rg_w_in': nrm(ks[16], (NB, D, 2 * RG_WIDTH), D ** -0.5),
        'rg_conv_w': nrm(ks[17], (NB, RG_CONV, RG_WIDTH), RG_CONV ** -0.5),
        'rg_conv_b': nrm(ks[18], (NB, RG_WIDTH), 0.01),
        'rg_w_gate_a': nrm(ks[19], (NB, 2, RG_BLOCKS, RG_BLOCK, RG_BLOCK), RG_BLOCK ** -0.5),
        'rg_b_gate_a': nrm(ks[20], (NB, 2, RG_WIDTH), 0.01),
        'rg_w_gate_x': nrm(ks[21], (NB, 2, RG_BLOCKS, RG_BLOCK, RG_BLOCK), RG_BLOCK ** -0.5),
        'rg_b_gate_x': nrm(ks[22], (NB, 2, RG_WIDTH), 0.01),
        'rg_lambda': jnp.log(a_rg) - jnp.log1p(-a_rg),
        'rg_w_out': nrm(ks[23], (NB, RG_WIDTH, D), BETA * RG_WIDTH ** -0.5),
        'ln1_g': 1.0 + nrm(ks[24], (DEPTH, D), 0.01),
        'ln1_b': nrm(ks[25], (DEPTH, D), 0.01),
        'ln2_g': 1.0 + nrm(ks[26], (DEPTH, D), 0.01),
        'ln2_b': nrm(ks[27], (DEPTH, D), 0.01),
        'peer_w_q': nrm(ks[28], (DEPTH, D, PEER_HEADS * PEER_QDIM), D ** -0.5),
        'peer_subkeys': nrm(ks[29], (DEPTH, 2, PEER_NKEYS, PEER_HALF), PEER_HALF ** -0.5),
        'peer_u': nrm(ks[30], (DEPTH, PEER_EXPERTS, D), D ** -0.5),
        'peer_v': nrm(ks[31], (DEPTH, PEER_EXPERTS, D), BETA * PEER_HEADS ** -0.5),
        'ple_w_proj': nrm(ks[32], (DEPTH, PLE_DIM, D), PLE_DIM ** -0.5),
        'ple_w_gate': nrm(ks[33], (DEPTH, D, D), D ** -0.5),
    }
    return inputs


def reference(x_prompt, x_sample, p_prompt, p_sample,
              s5_w_in, s5_lam_re, s5_lam_im, s5_log_step, s5_b_re, s5_b_im, s5_c_re, s5_c_im, s5_d, s5_w_glu,
              rg_w_in, rg_conv_w, rg_conv_b, rg_w_gate_a, rg_b_gate_a, rg_w_gate_x, rg_b_gate_x, rg_lambda, rg_w_out,
              ln1_g, ln1_b, ln2_g, ln2_b,
              peer_w_q, peer_subkeys, peer_u, peer_v,
              ple_w_proj, ple_w_gate):
    s5 = (s5_w_in, s5_lam_re, s5_lam_im, s5_log_step, s5_b_re, s5_b_im, s5_c_re, s5_c_im, s5_d, s5_w_glu)
    rg = (rg_w_in, rg_conv_w, rg_conv_b, rg_w_gate_a, rg_b_gate_a, rg_w_gate_x, rg_b_gate_x, rg_lambda, rg_w_out)
    ln = (ln1_g, ln1_b, ln2_g, ln2_b)
    peer = (peer_w_q, peer_subkeys, peer_u, peer_v)
    ple = (ple_w_proj, ple_w_gate)
    y_prompt = _trunk(x_prompt, p_prompt, s5, rg, ln, peer, ple)
    y_sample = _trunk(x_sample, p_sample, s5, rg, ln, peer, ple)
    return (y_prompt, y_sample)
```

```cpp
#include <hip/hip_runtime.h>
#include <hip/hip_cooperative_groups.h>
#include <cstdio>
namespace cg = cooperative_groups;

#ifndef COOP
#define COOP 1
#endif

typedef unsigned short u16;
typedef unsigned int u32;
using bf16x8 = __attribute__((ext_vector_type(8))) short;
using f32x4 = __attribute__((ext_vector_type(4))) float;

#define DEVI __device__ __forceinline__

constexpr int TS = 32768;
constexpr float ALPHA = 1.41421356237309515f;
constexpr float LN_EPS = 1e-5f;
constexpr size_t MBy = 1ull << 20;

constexpr size_t OFF_WS5IN = 0;
constexpr size_t OFF_WGLU = 2 * MBy;
constexpr size_t OFF_WRGIN = 6 * MBy;
constexpr size_t OFF_WGATES = 10 * MBy;
constexpr size_t OFF_WRGOUT = 12 * MBy;
constexpr size_t OFF_WQ = 14 * MBy;
constexpr size_t OFF_SK = 22 * MBy;
constexpr size_t OFF_WPROJ = 23 * MBy;
constexpr size_t OFF_WPG = 24 * MBy;
constexpr size_t OFF_UB = 28 * MBy;
constexpr size_t OFF_VB = 60 * MBy;
constexpr size_t OFF_ACT = 92 * MBy;
constexpr size_t OFF_XB = OFF_ACT;
constexpr size_t OFF_KEYS = OFF_ACT + 64 * MBy;
constexpr size_t OFF_IDX = OFF_ACT + 96 * MBy;
constexpr size_t OFF_GATE = OFF_ACT + 112 * MBy;
constexpr size_t OFF_U = OFF_ACT;
constexpr size_t OFF_YF = OFF_ACT + 64 * MBy;
constexpr size_t OFF_YB = OFF_ACT + 128 * MBy;
constexpr size_t OFF_HB = OFF_ACT + 192 * MBy;
constexpr size_t OFF_GG = OFF_ACT;
constexpr size_t OFF_R = OFF_ACT + 64 * MBy;
constexpr size_t OFF_C = OFF_ACT + 128 * MBy;
constexpr size_t OFF_AB = OFF_ACT + 192 * MBy;
constexpr size_t OFF_AGG = OFF_ACT + 448 * MBy;
constexpr size_t OFF_CAR = OFF_ACT + 464 * MBy;
constexpr size_t WS_END = OFF_ACT + 472 * MBy;

constexpr int LDS_BYTES = 36864 + 32768;

struct Params {
  const float* in[33];
  float* out;
  unsigned char* ws;
};

DEVI u16 f2bf(float f) {
  u32 u = __float_as_uint(f);
  u += 0x7FFFu + ((u >> 16) & 1u);
  return (u16)(u >> 16);
}
DEVI float bf2f(u16 h) { return __uint_as_float(((u32)h) << 16); }
DEVI u32 pack2(float lo, float hi) { return (u32)f2bf(lo) | ((u32)f2bf(hi) << 16); }
DEVI float bflo(u32 w) { return __uint_as_float(w << 16); }
DEVI float bfhi(u32 w) { return __uint_as_float(w & 0xffff0000u); }
DEVI float sigmoid_(float x) { return 1.f / (1.f + __expf(-x)); }
DEVI float gelu_(float x) {
  float z = 0.7978845608028654f * (x + 0.044715f * x * x * x);
  return x / (1.f + __expf(-2.f * z));
}
DEVI float softplus_(float x) { return fmaxf(x, 0.f) + log1pf(__expf(-fabsf(x))); }
DEVI void unpack8(const uint4& w, float* f) {
  f[0] = bflo(w.x); f[1] = bfhi(w.x); f[2] = bflo(w.y); f[3] = bfhi(w.y);
  f[4] = bflo(w.z); f[5] = bfhi(w.z); f[6] = bflo(w.w); f[7] = bfhi(w.w);
}
DEVI uint4 pack8(const float* f) {
  uint4 o; o.x = pack2(f[0], f[1]); o.y = pack2(f[2], f[3]); o.z = pack2(f[4], f[5]); o.w = pack2(f[6], f[7]);
  return o;
}

struct LdBF {
  const u16* base; int ld;
  typedef uint4 Raw;
  DEVI Raw load(int row, int k) const { return *reinterpret_cast<const uint4*>(base + (size_t)row * ld + k); }
  DEVI static uint4 cvt(const Raw& r) { return r; }
};
struct RawF { float4 a, b; };
struct LdF32 {
  const float* base; int ld;
  typedef RawF Raw;
  DEVI Raw load(int row, int k) const {
    const float4* q = reinterpret_cast<const float4*>(base + (size_t)row * ld + k);
    RawF r; r.a = q[0]; r.b = q[1]; return r;
  }
  DEVI static uint4 cvt(const Raw& r) {
    uint4 o; o.x = pack2(r.a.x, r.a.y); o.y = pack2(r.a.z, r.a.w); o.z = pack2(r.b.x, r.b.y); o.w = pack2(r.b.z, r.b.w);
    return o;
  }
};

template <class AL, class BL, class EP>
DEVI void gemm_tile(const AL al, const BL bl, const int K, unsigned char* smem, EP ep) {
  u16* As = reinterpret_cast<u16*>(smem);
  u16* Bs = As + 128 * 72;
  const int tid = threadIdx.x, lane = tid & 63, wave = tid >> 6, wm = wave >> 1, wn = wave & 1;
  const int lr = lane & 15, lq = lane >> 4;
  f32x4 acc[4][4];
#pragma unroll
  for (int i = 0; i < 4; ++i)
#pragma unroll
    for (int j = 0; j < 4; ++j) acc[i][j] = f32x4{0.f, 0.f, 0.f, 0.f};
  typename AL::Raw ra[4];
  typename BL::Raw rb[4];
  const int prow = tid >> 3, pk = (tid & 7) * 8;
#pragma unroll
  for (int i = 0; i < 4; ++i) { ra[i] = al.load(prow + i * 32, pk); rb[i] = bl.load(prow + i * 32, pk); }
  for (int kt = 0; kt < K; kt += 64) {
    __syncthreads();
#pragma unroll
    for (int i = 0; i < 4; ++i) {
      *reinterpret_cast<uint4*>(As + (prow + i * 32) * 72 + pk) = AL::cvt(ra[i]);
      *reinterpret_cast<uint4*>(Bs + (prow + i * 32) * 72 + pk) = BL::cvt(rb[i]);
    }
    __syncthreads();
    if (kt + 64 < K) {
#pragma unroll
      for (int i = 0; i < 4; ++i) { ra[i] = al.load(prow + i * 32, kt + 64 + pk); rb[i] = bl.load(prow + i * 32, kt + 64 + pk); }
    }
#pragma unroll
    for (int ks = 0; ks < 2; ++ks) {
      bf16x8 af[4], bfr[4];
#pragma unroll
      for (int i = 0; i < 4; ++i) af[i] = *reinterpret_cast<const bf16x8*>(As + (wm * 64 + i * 16 + lr) * 72 + ks * 32 + lq * 8);
#pragma unroll
      for (int j = 0; j < 4; ++j) bfr[j] = *reinterpret_cast<const bf16x8*>(Bs + (wn * 64 + j * 16 + lr) * 72 + ks * 32 + lq * 8);
#pragma unroll
      for (int i = 0; i < 4; ++i)
#pragma unroll
        for (int j = 0; j < 4; ++j) acc[i][j] = __builtin_amdgcn_mfma_f32_16x16x32_bf16(af[i], bfr[j], acc[i][j], 0, 0, 0);
    }
  }
  __syncthreads();
  ep(acc);
}

template <int PERM>
DEVI void cvt_wt(const float* W, int K, int N, u16* out, int a0, int a1) {
  const int gsz = gridDim.x * 256, gtid = blockIdx.x * 256 + threadIdx.x;
  const int total = N * (K >> 3);
  for (int i = gtid; i < total; i += gsz) {
    const int n = i % N, kv = i / N;
    float v[8];
#pragma unroll
    for (int j = 0; j < 8; ++j) v[j] = W[(size_t)(kv * 8 + j) * N + n];
    int np = n;
    if (PERM == 1) { const int g = n >> 10, o = n & 1023; np = (o >> 4) * 32 + g * 16 + (o & 15); }
    if (PERM == 2) { np = a0 * 512 + (n >> 4) * 32 + a1 * 16 + (n & 15); }
    *reinterpret_cast<uint4*>(out + (size_t)np * K + kv * 8) = pack8(v);
  }
}

DEVI void cvt_plain(const float* src, u16* dst, size_t n8) {
  const size_t gsz = (size_t)gridDim.x * 256, gtid = (size_t)blockIdx.x * 256 + threadIdx.x;
  for (size_t i = gtid; i < n8; i += gsz) {
    const float4* q = reinterpret_cast<const float4*>(src + i * 8);
    float4 a = q[0], b = q[1];
    uint4 o; o.x = pack2(a.x, a.y); o.y = pack2(a.z, a.w); o.z = pack2(b.x, b.y); o.w = pack2(b.z, b.w);
    *reinterpret_cast<uint4*>(dst + i * 8) = o;
  }
}

DEVI void phase_setup(const Params& p) {
  unsigned char* ws = p.ws;
  cvt_wt<0>(p.in[4], 1024, 1024, (u16*)(ws + OFF_WS5IN), 0, 0);
  cvt_wt<1>(p.in[13], 1024, 2048, (u16*)(ws + OFF_WGLU), 0, 0);
  cvt_wt<0>(p.in[14], 1024, 2048, (u16*)(ws + OFF_WRGIN), 0, 0);
  for (int d = 0; d < 2; ++d)
    for (int gate = 0; gate < 2; ++gate)
      for (int h = 0; h < 4; ++h)
        cvt_wt<2>((gate ? p.in[19] : p.in[17]) + (size_t)(d * 4 + h) * 65536, 256, 256,
                  (u16*)(ws + OFF_WGATES) + (size_t)h * 1024 * 256, d, gate);
  cvt_wt<0>(p.in[22], 1024, 1024, (u16*)(ws + OFF_WRGOUT), 0, 0);
  for (int l = 0; l < 2; ++l) {
    cvt_wt<0>(p.in[27] + (size_t)l * 1024 * 2048, 1024, 2048, (u16*)(ws + OFF_WQ) + (size_t)l * 2048 * 1024, 0, 0);
    cvt_wt<0>(p.in[31] + (size_t)l * 256 * 1024, 256, 1024, (u16*)(ws + OFF_WPROJ) + (size_t)l * 1024 * 256, 0, 0);
    cvt_wt<0>(p.in[32] + (size_t)l * 1024 * 1024, 1024, 1024, (u16*)(ws + OFF_WPG) + (size_t)l * 1024 * 1024, 0, 0);
  }
  cvt_plain(p.in[28], (u16*)(ws + OFF_SK), 65536 / 8);
}

DEVI void phase_s5_in(const Params& p, int s, unsigned char* smem) {
  const float* X = p.in[s];
  const u16* Wt = (const u16*)(p.ws + OFF_WS5IN);
  u16* U = (u16*)(p.ws + OFF_U);
  const int lane = threadIdx.x & 63, wave = threadIdx.x >> 6, wm = wave >> 1, wn = wave & 1;
  for (int tile = blockIdx.x; tile < 256 * 8; tile += gridDim.x) {
    const int m0 = (tile >> 3) * 128, n0 = (tile & 7) * 128;
    LdF32 al{X + (size_t)m0 * 1024, 1024};
    LdBF bl{Wt + (size_t)n0 * 1024, 1024};
    gemm_tile(al, bl, 1024, smem, [&](f32x4 (&acc)[4][4]) {
#pragma unroll
      for (int i = 0; i < 4; ++i)
#pragma unroll
        for (int j = 0; j < 4; ++j)
#pragma unroll
          for (int r = 0; r < 4; ++r) {
            const int row = m0 + wm * 64 + i * 16 + (lane >> 4) * 4 + r;
            const int col = n0 + wn * 64 + j * 16 + (lane & 15);
            U[(size_t)row * 1024 + col] = f2bf(acc[i][j][r]);
          }
    });
  }
}

DEVI void phase_s5_scan(const Params& p, int s) {
  const int L = s ? 2048 : 4096;
  const int nseq = TS / L;
  const int ntask = nseq * 128;
  const int lane = threadIdx.x & 63, wave = threadIdx.x >> 6;
  const u16* U = (const u16*)(p.ws + OFF_U);
  for (int task = wave * gridDim.x + blockIdx.x; task < ntask; task += gridDim.x * 4) {
    const int dir = task & 1, g = (task >> 1) & 63, seq = task >> 7;
    const int pg = dir * 64 + g;
    const float step = expf(p.in[7][pg]);
    const float lr_ = p.in[5][pg * 64 + lane], li_ = p.in[6][pg * 64 + lane];
    const float mag = expf(lr_ * step), ang = li_ * step;
    const float ar = mag * cosf(ang), ai = mag * sinf(ang);
    const float den = lr_ * lr_ + li_ * li_;
    const float zr = ar - 1.f;
    const float qr = (zr * lr_ + ai * li_) / den, qi = (ai * lr_ - zr * li_) / den;
    float bbr[16], bbi[16], cr[16], ci[16];
    {
      const float4* brp = reinterpret_cast<const float4*>(p.in[8] + ((size_t)pg * 64 + lane) * 16);
      const float4* bip = reinterpret_cast<const float4*>(p.in[9] + ((size_t)pg * 64 + lane) * 16);
#pragma unroll
      for (int c4 = 0; c4 < 4; ++c4) {
        const float4 br = brp[c4], bi = bip[c4];
        bbr[c4 * 4 + 0] = qr * br.x - qi * bi.x; bbi[c4 * 4 + 0] = qr * bi.x + qi * br.x;
        bbr[c4 * 4 + 1] = qr * br.y - qi * bi.y; bbi[c4 * 4 + 1] = qr * bi.y + qi * br.y;
        bbr[c4 * 4 + 2] = qr * br.z - qi * bi.z; bbi[c4 * 4 + 2] = qr * bi.z + qi * br.z;
        bbr[c4 * 4 + 3] = qr * br.w - qi * bi.w; bbi[c4 * 4 + 3] = qr * bi.w + qi * br.w;
      }
#pragma unroll
      for (int c = 0; c < 16; ++c) {
        cr[c] = p.in[10][((size_t)pg * 16 + c) * 64 + lane];
        ci[c] = p.in[11][((size_t)pg * 16 + c) * 64 + lane];
      }
    }
    float hr = 0.f, hi = 0.f;
    u16* Yd = (u16*)(p.ws + (dir ? OFF_YB : OFF_YF));
    const size_t base = (size_t)seq * L;
    const int cidx = ((lane >> 5) & 1) * 8 + ((lane >> 4) & 1) * 4 + ((lane >> 3) & 1) * 2 + ((lane >> 2) & 1);
    const bool b5 = lane & 32, b4 = lane & 16, b3 = lane & 8, b2 = lane & 4;
#pragma unroll 2
    for (int i = 0; i < L; ++i) {
      const int t = dir ? (L - 1 - i) : i;
      const uint4* up = reinterpret_cast<const uint4*>(U + (base + t) * 1024 + g * 16);
      const uint4 u0 = up[0], u1 = up[1];
      float u[16];
      unpack8(u0, u); unpack8(u1, u + 8);
      float bur = 0.f, bui = 0.f;
#pragma unroll
      for (int c = 0; c < 16; ++c) { bur = fmaf(bbr[c], u[c], bur); bui = fmaf(bbi[c], u[c], bui); }
      const float nhr = ar * hr - ai * hi + bur;
      const float nhi = ar * hi + ai * hr + bui;
      hr = nhr; hi = nhi;
      float y[16];
#pragma unroll
      for (int c = 0; c < 16; ++c) y[c] = cr[c] * hr - ci[c] * hi;
      float y8[8], y4[4], y2[2];
#pragma unroll
      for (int c = 0; c < 8; ++c) {
        const float keep = b5 ? y[c + 8] : y[c], send = b5 ? y[c] : y[c + 8];
        y8[c] = keep + __shfl_xor(send, 32);
      }
#pragma unroll
      for (int c = 0; c < 4; ++c) {
        const float keep = b4 ? y8[c + 4] : y8[c], send = b4 ? y8[c] : y8[c + 4];
        y4[c] = keep + __shfl_xor(send, 16);
      }
#pragma unroll
      for (int c = 0; c < 2; ++c) {
        const float keep = b3 ? y4[c + 2] : y4[c], send = b3 ? y4[c] : y4[c + 2];
        y2[c] = keep + __shfl_xor(send, 8);
      }
      float y1;
      {
        const float keep = b2 ? y2[1] : y2[0], send = b2 ? y2[0] : y2[1];
        y1 = keep + __shfl_xor(send, 4);
      }
      y1 += __shfl_xor(y1, 2);
      y1 += __shfl_xor(y1, 1);
      if ((lane & 3) == 0) Yd[(base + t) * 1024 + g * 16 + cidx] = f2bf(y1);
    }
  }
}

DEVI void phase_s5_combine(const Params& p) {
  const u16* U = (const u16*)(p.ws + OFF_U);
  const u16* YF = (const u16*)(p.ws + OFF_YF);
  const u16* YB = (const u16*)(p.ws + OFF_YB);
  u16* HB = (u16*)(p.ws + OFF_HB);
  const float* dsk = p.in[12];
  const int gsz = gridDim.x * 256, gtid = blockIdx.x * 256 + threadIdx.x;
  for (int i = gtid; i < TS * 128; i += gsz) {
    const int cv = (i & 127) * 8;
    const size_t off = (size_t)i * 8;
    float a[8], b[8], u[8], h[8];
    unpack8(*reinterpret_cast<const uint4*>(YF + off), a);
    unpack8(*reinterpret_cast<const uint4*>(YB + off), b);
    unpack8(*reinterpret_cast<const uint4*>(U + off), u);
#pragma unroll
    for (int j = 0; j < 8; ++j) h[j] = gelu_(a[j] + b[j] + dsk[cv + j] * u[j]);
    *reinterpret_cast<uint4*>(HB + off) = pack8(h);
  }
}

DEVI void phase_s5_glu(const Params& p, int s, unsigned char* smem) {
  const u16* HB = (const u16*)(p.ws + OFF_HB);
  const u16* Wt = (const u16*)(p.ws + OFF_WGLU);
  const float* Xin = p.in[s];
  float* Xo = p.out + (size_t)s * TS * 1024;
  const int lane = threadIdx.x & 63, wave = threadIdx.x >> 6, wm = wave >> 1, wn = wave & 1;
  for (int tile = blockIdx.x; tile < 256 * 16; tile += gridDim.x) {
    const int m0 = (tile >> 4) * 128, n0 = (tile & 15) * 128;
    LdBF al{HB + (size_t)m0 * 1024, 1024};
    LdBF bl{Wt + (size_t)n0 * 1024, 1024};
    gemm_tile(al, bl, 1024, smem, [&](f32x4 (&acc)[4][4]) {
#pragma unroll
      for (int i = 0; i < 4; ++i)
#pragma unroll
        for (int jj = 0; jj < 4; jj += 2)
#pragma unroll
          for (int r = 0; r < 4; ++r) {
            const int row = m0 + wm * 64 + i * 16 + (lane >> 4) * 4 + r;
            const int nb = n0 + wn * 64 + jj * 16;
            const int o = (nb >> 5) * 16 + (lane & 15);
            const float mix = acc[i][jj][r] * sigmoid_(acc[i][jj + 1][r]);
            const size_t idx = (size_t)row * 1024 + o;
            Xo[idx] = ALPHA * Xin[idx] + mix;
          }
    });
  }
}

DEVI void phase_ln1_tables(const Params& p, int s, int layer) {
  float* X = p.out + (size_t)s * TS * 1024;
  u16* XB = (u16*)(p.ws + OFF_XB);
  const float* gam = p.in[23] + layer * 1024;
  const float* bet = p.in[24] + layer * 1024;
  const int lane = threadIdx.x & 63, wave = threadIdx.x >> 6;
  for (int t = blockIdx.x * 4 + wave; t < TS; t += gridDim.x * 4) {
    float4 v[4];
#pragma unroll
    for (int i = 0; i < 4; ++i) v[i] = *reinterpret_cast<const float4*>(X + (size_t)t * 1024 + i * 256 + lane * 4);
    float sm = 0.f;
#pragma unroll
    for (int i = 0; i < 4; ++i) sm += v[i].x + v[i].y + v[i].z + v[i].w;
#pragma unroll
    for (int m = 32; m >= 1; m >>= 1) sm += __shfl_xor(sm, m);
    const float mu = sm * (1.f / 1024.f);
    float sq = 0.f;
#pragma unroll
    for (int i = 0; i < 4; ++i) {
      const float a = v[i].x - mu, b = v[i].y - mu, c = v[i].z - mu, d = v[i].w - mu;
      sq += a * a + b * b + c * c + d * d;
    }
#pragma unroll
    for (int m = 32; m >= 1; m >>= 1) sq += __shfl_xor(sq, m);
    const float rs = rsqrtf(sq * (1.f / 1024.f) + LN_EPS);
#pragma unroll
    for (int i = 0; i < 4; ++i) {
      const int c0 = i * 256 + lane * 4;
      const float4 g4 = *reinterpret_cast<const float4*>(gam + c0);
      const float4 b4 = *reinterpret_cast<const float4*>(bet + c0);
      float4 o;
      o.x = (v[i].x - mu) * rs * g4.x + b4.x; o.y = (v[i].y - mu) * rs * g4.y + b4.y;
      o.z = (v[i].z - mu) * rs * g4.z + b4.z; o.w = (v[i].w - mu) * rs * g4.w + b4.w;
      *reinterpret_cast<float4*>(X + (size_t)t * 1024 + c0) = o;
      uint2 pk; pk.x = pack2(o.x, o.y); pk.y = pack2(o.z, o.w);
      *reinterpret_cast<uint2*>(XB + (size_t)t * 1024 + c0) = pk;
    }
  }
  cvt_plain(p.in[29] + (size_t)layer * 16384 * 1024, (u16*)(p.ws + OFF_UB), (size_t)16384 * 1024 / 8);
  cvt_plain(p.in[30] + (size_t)layer * 16384 * 1024, (u16*)(p.ws + OFF_VB), (size_t)16384 * 1024 / 8);
}

DEVI u32 enc_key(float s, int n) {
  u32 b = __float_as_uint(s);
  u32 srt = (b & 0x80000000u) ? ~b : (b | 0x80000000u);
  return (srt & ~127u) | (u32)(127 - n);
}
DEVI float dec_key(u32 key, int& n) {
  n = 127 - (int)(key & 127u);
  u32 srt = key & ~127u;
  u32 b = (srt & 0x80000000u) ? (srt & 0x7fffffffu) : ~srt;
  return __uint_as_float(b);
}

DEVI void phase_peer_q(const Params& p, int layer, unsigned char* smem) {
  const u16* XB = (const u16*)(p.ws + OFF_XB);
  const u16* Wt = (const u16*)(p.ws + OFF_WQ) + (size_t)layer * 2048 * 1024;
  const u16* SK = (const u16*)(p.ws + OFF_SK) + (size_t)layer * 2 * 128 * 128;
  u32* KEYS = (u32*)(p.ws + OFF_KEYS);
  const int tid = threadIdx.x, lane = tid & 63, wave = tid >> 6, wm = wave >> 1, wn = wave & 1;
  const int lr = lane & 15, lq = lane >> 4;
  u16* Qs = reinterpret_cast<u16*>(smem);
  u32* Sk = reinterpret_cast<u32*>(smem);
  for (int tile = blockIdx.x; tile < 256 * 16; tile += gridDim.x) {
    const int m0 = (tile >> 4) * 128, hc = tile & 15, n0 = hc * 128;
    const int c = hc & 1;
    LdBF al{XB + (size_t)m0 * 1024, 1024};
    LdBF bl{Wt + (size_t)n0 * 1024, 1024};
    gemm_tile(al, bl, 1024, smem, [&](f32x4 (&acc)[4][4]) {
#pragma unroll
      for (int i = 0; i < 4; ++i)
#pragma unroll
        for (int j = 0; j < 4; ++j)
#pragma unroll
          for (int r = 0; r < 4; ++r)
            Qs[(wm * 64 + i * 16 + lq * 4 + r) * 136 + wn * 64 + j * 16 + lr] = f2bf(acc[i][j][r]);
      __syncthreads();
      f32x4 sc[4][4];
#pragma unroll
      for (int i = 0; i < 4; ++i)
#pragma unroll
        for (int j = 0; j < 4; ++j) sc[i][j] = f32x4{0.f, 0.f, 0.f, 0.f};
      const u16* skc = SK + (size_t)c * 128 * 128;
#pragma unroll
      for (int ks = 0; ks < 4; ++ks) {
        bf16x8 af[4], bfr[4];
#pragma unroll
        for (int i = 0; i < 4; ++i) af[i] = *reinterpret_cast<const bf16x8*>(Qs + (wm * 64 + i * 16 + lr) * 136 + ks * 32 + lq * 8);
#pragma unroll
        for (int j = 0; j < 4; ++j) bfr[j] = *reinterpret_cast<const bf16x8*>(skc + (size_t)(wn * 64 + j * 16 + lr) * 128 + ks * 32 + lq * 8);
#pragma unroll
        for (int i = 0; i < 4; ++i)
#pragma unroll
          for (int j = 0; j < 4; ++j) sc[i][j] = __builtin_amdgcn_mfma_f32_16x16x32_bf16(af[i], bfr[j], sc[i][j], 0, 0, 0);
      }
      __syncthreads();
#pragma unroll
      for (int i = 0; i < 4; ++i)
#pragma unroll
        for (int j = 0; j < 4; ++j)
#pragma unroll
          for (int r = 0; r < 4; ++r) {
            const int n = wn * 64 + j * 16 + lr;
            Sk[(wm * 64 + i * 16 + lq * 4 + r) * 129 + n] = enc_key(sc[i][j][r], n);
          }
      __syncthreads();
      if (tid < 128) {
        u32 top[16];
#pragma unroll
        for (int k = 0; k < 16; ++k) top[k] = 0u;
#pragma unroll 4
        for (int n = 0; n < 128; ++n) {
          u32 v = Sk[tid * 129 + n];
#pragma unroll
          for (int k = 0; k < 16; ++k) {
            const u32 hi = max(top[k], v);
            v = min(top[k], v);
            top[k] = hi;
          }
        }
        uint4* dst = reinterpret_cast<uint4*>(KEYS + ((size_t)(m0 + tid) * 16 + hc) * 16);
        dst[0] = uint4{top[0], top[1], top[2], top[3]};
        dst[1] = uint4{top[4], top[5], top[6], top[7]};
        dst[2] = uint4{top[8], top[9], top[10], top[11]};
        dst[3] = uint4{top[12], top[13], top[14], top[15]};
      }
    });
  }
}

DEVI void phase_peer_route(const Params& p) {
  const u32* KEYS = (const u32*)(p.ws + OFF_KEYS);
  int* IDX = (int*)(p.ws + OFF_IDX);
  float* GATE = (float*)(p.ws + OFF_GATE);
  const int gsz = gridDim.x * 256, gtid = blockIdx.x * 256 + threadIdx.x;
  for (int i = gtid; i < TS * 8; i += gsz) {
    const uint4* src = reinterpret_cast<const uint4*>(KEYS + (size_t)i * 32);
    u32 kk[32];
#pragma unroll
    for (int q = 0; q < 8; ++q) { const uint4 w = src[q]; kk[q * 4] = w.x; kk[q * 4 + 1] = w.y; kk[q * 4 + 2] = w.z; kk[q * 4 + 3] = w.w; }
    float s0[16], s1[16]; int i0[16], i1[16];
#pragma unroll
    for (int k = 0; k < 16; ++k) { s0[k] = dec_key(kk[k], i0[k]); s1[k] = dec_key(kk[16 + k], i1[k]); }
    float top[16];
#pragma unroll
    for (int k = 0; k < 16; ++k) top[k] = -3.0e38f;
#pragma unroll
    for (int k1 = 0; k1 < 16; ++k1)
#pragma unroll
      for (int k2 = 0; k2 < 16; ++k2)
        if ((k1 + 1) * (k2 + 1) <= 16) {
          float v = s0[k1] + s1[k2];
#pragma unroll
          for (int k = 0; k < 16; ++k) {
            const float hi = fmaxf(top[k], v);
            v = fminf(top[k], v);
            top[k] = hi;
          }
        }
    const float thr = top[15], mx = top[0];
    float den = 0.f;
#pragma unroll
    for (int k = 0; k < 16; ++k) den += __expf(top[k] - mx);
    const float inv = 1.f / den;
    int cnt = 0;
    int* idst = IDX + (size_t)i * 16;
    float* gdst = GATE + (size_t)i * 16;
#pragma unroll
    for (int k1 = 0; k1 < 16; ++k1)
#pragma unroll
      for (int k2 = 0; k2 < 16; ++k2)
        if ((k1 + 1) * (k2 + 1) <= 16) {
          const float v = s0[k1] + s1[k2];
          if (v >= thr && cnt < 16) {
            idst[cnt] = i0[k1] * 128 + i1[k2];
            gdst[cnt] = __expf(v - mx) * inv;
            ++cnt;
          }
        }
  }
}

DEVI void phase_peer_gather(const Params& p, int s, int layer) {
  float* X = p.out + (size_t)s * TS * 1024;
  u16* XB = (u16*)(p.ws + OFF_XB);
  const uint4* Ub = (const uint4*)(p.ws + OFF_UB);
  const uint4* Vb = (const uint4*)(p.ws + OFF_VB);
  const int* IDX = (const int*)(p.ws + OFF_IDX);
  const float* GATE = (const float*)(p.ws + OFF_GATE);
  const float* gam = p.in[25] + layer * 1024;
  const float* bet = p.in[26] + layer * 1024;
  const int lane = threadIdx.x & 63, wave = threadIdx.x >> 6;
  for (int t = blockIdx.x * 4 + wave; t < TS; t += gridDim.x * 4) {
    float x[16], o[16];
    {
      const float4* xp = reinterpret_cast<const float4*>(X + (size_t)t * 1024 + lane * 8);
      const float4 a = xp[0], b = xp[1];
      const float4* xq = reinterpret_cast<const float4*>(X + (size_t)t * 1024 + 512 + lane * 8);
      const float4 c = xq[0], d = xq[1];
      x[0] = a.x; x[1] = a.y; x[2] = a.z; x[3] = a.w; x[4] = b.x; x[5] = b.y; x[6] = b.z; x[7] = b.w;
      x[8] = c.x; x[9] = c.y; x[10] = c.z; x[11] = c.w; x[12] = d.x; x[13] = d.y; x[14] = d.z; x[15] = d.w;
    }
#pragma unroll
    for (int k = 0; k < 16; ++k) o[k] = 0.f;
    const int iv0 = IDX[(size_t)t * 128 + lane], iv1 = IDX[(size_t)t * 128 + 64 + lane];
    const float gv0 = GATE[(size_t)t * 128 + lane], gv1 = GATE[(size_t)t * 128 + 64 + lane];
    for (int e0 = 0; e0 < 128; e0 += 4) {
      const int ivs = (e0 < 64) ? iv0 : iv1;
      const int gvs = __float_as_int((e0 < 64) ? gv0 : gv1);
      uint4 uu[4][2], vv[4][2];
      float ge[4];
#pragma unroll
      for (int q = 0; q < 4; ++q) {
        const int ln = (e0 + q) & 63;
        const int ei = __builtin_amdgcn_readlane(ivs, ln);
        ge[q] = __int_as_float(__builtin_amdgcn_readlane(gvs, ln));
        const uint4* ur = Ub + (size_t)ei * 128;
        const uint4* vr = Vb + (size_t)ei * 128;
        uu[q][0] = ur[lane]; uu[q][1] = ur[64 + lane];
        vv[q][0] = vr[lane]; vv[q][1] = vr[64 + lane];
      }
#pragma unroll
      for (int q = 0; q < 4; ++q) {
        float uf[16];
        unpack8(uu[q][0], uf); unpack8(uu[q][1], uf + 8);
        float d = 0.f;
#pragma unroll
        for (int k = 0; k < 16; ++k) d = fmaf(uf[k], x[k], d);
#pragma unroll
        for (int m = 32; m >= 1; m >>= 1) d += __shfl_xor(d, m);
        const float w = ge[q] * gelu_(d);
        float vf[16];
        unpack8(vv[q][0], vf); unpack8(vv[q][1], vf + 8);
#pragma unroll
        for (int k = 0; k < 16; ++k) o[k] = fmaf(w, vf[k], o[k]);
      }
    }
    float sm = 0.f;
#pragma unroll
    for (int k = 0; k < 16; ++k) { o[k] = ALPHA * x[k] + o[k]; sm += o[k]; }
#pragma unroll
    for (int m = 32; m >= 1; m >>= 1) sm += __shfl_xor(sm, m);
    const float mu = sm * (1.f / 1024.f);
    float sq = 0.f;
#pragma unroll
    for (int k = 0; k < 16; ++k) { const float dd = o[k] - mu; sq += dd * dd; }
#pragma unroll
    for (int m = 32; m >= 1; m >>= 1) sq += __shfl_xor(sq, m);
    const float rs = rsqrtf(sq * (1.f / 1024.f) + LN_EPS);
#pragma unroll
    for (int hf = 0; hf < 2; ++hf) {
      const int c0 = hf * 512 + lane * 8;
      float r[8];
#pragma unroll
      for (int k = 0; k < 8; ++k) r[k] = (o[hf * 8 + k] - mu) * rs * gam[c0 + k] + bet[c0 + k];
      float4* dp = reinterpret_cast<float4*>(X + (size_t)t * 1024 + c0);
      dp[0] = float4{r[0], r[1], r[2], r[3]};
      dp[1] = float4{r[4], r[5], r[6], r[7]};
      *reinterpret_cast<uint4*>(XB + (size_t)t * 1024 + c0) = pack8(r);
    }
  }
}

DEVI void phase_ple(const Params& p, int s, int layer, unsigned char* smem) {
  float* X = p.out + (size_t)s * TS * 1024;
  const u16* XB = (const u16*)(p.ws + OFF_XB);
  const float* P = p.in[2 + s] + (size_t)layer * TS * 256;
  const u16* Wp = (const u16*)(p.ws + OFF_WPROJ) + (size_t)layer * 1024 * 256;
  const u16* Wg = (const u16*)(p.ws + OFF_WPG) + (size_t)layer * 1024 * 1024;
  const int lane = threadIdx.x & 63, wave = threadIdx.x >> 6, wm = wave >> 1, wn = wave & 1;
  for (int tile = blockIdx.x; tile < 256 * 8; tile += gridDim.x) {
    const int m0 = (tile >> 3) * 128, n0 = (tile & 7) * 128;
    u32* pkl = reinterpret_cast<u32*>(smem + 36864) + threadIdx.x;
    {
      LdF32 al{P + (size_t)m0 * 256, 256};
      LdBF bl{Wp + (size_t)n0 * 256, 256};
      gemm_tile(al, bl, 256, smem, [&](f32x4 (&acc)[4][4]) {
#pragma unroll
        for (int i = 0; i < 4; ++i)
#pragma unroll
          for (int j = 0; j < 4; ++j) {
            pkl[((i * 4 + j) * 2 + 0) * 256] = pack2(acc[i][j][0], acc[i][j][1]);
            pkl[((i * 4 + j) * 2 + 1) * 256] = pack2(acc[i][j][2], acc[i][j][3]);
          }
      });
    }
    {
      LdBF al{XB + (size_t)m0 * 1024, 1024};
      LdBF bl{Wg + (size_t)n0 * 1024, 1024};
      gemm_tile(al, bl, 1024, smem, [&](f32x4 (&acc)[4][4]) {
#pragma unroll
        for (int i = 0; i < 4; ++i)
#pragma unroll
          for (int j = 0; j < 4; ++j)
#pragma unroll
            for (int r = 0; r < 4; ++r) {
              const int row = m0 + wm * 64 + i * 16 + (lane >> 4) * 4 + r;
              const int col = n0 + wn * 64 + j * 16 + (lane & 15);
              const u32 w = pkl[((i * 4 + j) * 2 + (r >> 1)) * 256];
              const float pv = (r & 1) ? bfhi(w) : bflo(w);
              const size_t idx = (size_t)row * 1024 + col;
              X[idx] = X[idx] + pv * sigmoid_(acc[i][j][r]);
            }
      });
    }
  }
}

DEVI void phase_rg_in(const Params& p, int s, unsigned char* smem) {
  const float* X = p.out + (size_t)s * TS * 1024;
  const u16* Wt = (const u16*)(p.ws + OFF_WRGIN);
  u16* GG = (u16*)(p.ws + OFF_GG);
  u16* R = (u16*)(p.ws + OFF_R);
  const int lane = threadIdx.x & 63, wave = threadIdx.x >> 6, wm = wave >> 1, wn = wave & 1;
  for (int tile = blockIdx.x; tile < 256 * 16; tile += gridDim.x) {
    const int m0 = (tile >> 4) * 128, n0 = (tile & 15) * 128;
    LdF32 al{X + (size_t)m0 * 1024, 1024};
    LdBF bl{Wt + (size_t)n0 * 1024, 1024};
    gemm_tile(al, bl, 1024, smem, [&](f32x4 (&acc)[4][4]) {
#pragma unroll
      for (int i = 0; i < 4; ++i)
#pragma unroll
        for (int j = 0; j < 4; ++j)
#pragma unroll
          for (int r = 0; r < 4; ++r) {
            const int row = m0 + wm * 64 + i * 16 + (lane >> 4) * 4 + r;
            const int col = n0 + wn * 64 + j * 16 + (lane & 15);
            if (n0 < 1024) GG[(size_t)row * 1024 + col] = f2bf(gelu_(acc[i][j][r]));
            else R[(size_t)row * 1024 + col - 1024] = f2bf(acc[i][j][r]);
          }
    });
  }
}

DEVI void phase_rg_conv(const Params& p, int s) {
  const int L = s ? 2048 : 4096;
  const u16* R = (const u16*)(p.ws + OFF_R);
  u16* C = (u16*)(p.ws + OFF_C);
  const float* cw = p.in[15];
  const float* cb = p.in[16];
  const int gsz = gridDim.x * 256, gtid = blockIdx.x * 256 + threadIdx.x;
  for (int i = gtid; i < TS * 128; i += gsz) {
    const int t = i >> 7, cv = (i & 127) * 8;
    const int pos = t & (L - 1);
    float acc[8];
#pragma unroll
    for (int j = 0; j < 8; ++j) acc[j] = cb[cv + j];
#pragma unroll
    for (int k = 0; k < 4; ++k) {
      const int pp = pos + k - 1;
      if (pp >= 0 && pp < L) {
        float rv[8];
        unpack8(*reinterpret_cast<const uint4*>(R + (size_t)(t + k - 1) * 1024 + cv), rv);
#pragma unroll
        for (int j = 0; j < 8; ++j) acc[j] = fmaf(rv[j], cw[k * 1024 + cv + j], acc[j]);
      }
    }
    *reinterpret_cast<uint4*>(C + (size_t)i * 8) = pack8(acc);
  }
}

DEVI void phase_rg_gates(const Params& p, unsigned char* smem) {
  const u16* C = (const u16*)(p.ws + OFF_C);
  const u16* Wt = (const u16*)(p.ws + OFF_WGATES);
  u32* AB = (u32*)(p.ws + OFF_AB);
  const float* ba = p.in[18];
  const float* bx = p.in[20];
  const float* lam = p.in[21];
  const int lane = threadIdx.x & 63, wave = threadIdx.x >> 6, wm = wave >> 1, wn = wave & 1;
  for (int tile = blockIdx.x; tile < 256 * 32; tile += gridDim.x) {
    const int m0 = (tile >> 5) * 128, h = (tile >> 3) & 3, nt = tile & 7, n0 = nt * 128;
    LdBF al{C + (size_t)m0 * 1024 + h * 256, 1024};
    LdBF bl{Wt + ((size_t)h * 1024 + n0) * 256, 256};
    gemm_tile(al, bl, 256, smem, [&](f32x4 (&acc)[4][4]) {
#pragma unroll
      for (int jj = 0; jj < 4; jj += 2) {
        const int nb = n0 + wn * 64 + jj * 16;
        const int d = nb >> 9;
        const int ch = h * 256 + ((nb & 511) >> 5) * 16 + (lane & 15);
        const float bav = ba[d * 1024 + ch], bxv = bx[d * 1024 + ch];
        const float sp8 = -8.f * softplus_(-lam[d * 1024 + ch]);
#pragma unroll
        for (int i = 0; i < 4; ++i)
#pragma unroll
          for (int r = 0; r < 4; ++r) {
            const int row = m0 + wm * 64 + i * 16 + (lane >> 4) * 4 + r;
            const float rg = sigmoid_(acc[i][jj][r] + bav);
            const float ig = sigmoid_(acc[i][jj + 1][r] + bxv);
            const float la = sp8 * rg;
            const float cval = bf2f(C[(size_t)row * 1024 + ch]);
            const float b = sqrtf(-expm1f(2.f * la)) * ig * cval;
            AB[((size_t)row * 2 + d) * 1024 + ch] = pack2(la, b);
          }
      }
    });
  }
}

DEVI void phase_rg_agg(const Params& p) {
  const u32* AB = (const u32*)(p.ws + OFF_AB);
  float2* AGG = (float2*)(p.ws + OFF_AGG);
  const int gsz = gridDim.x * 256, gtid = blockIdx.x * 256 + threadIdx.x;
  for (int i = gtid; i < 1024 * 2 * 1024; i += gsz) {
    const int ch = i & 1023, d = (i >> 10) & 1, chunk = i >> 11;
    const int c0 = chunk * 32;
    float h = 0.f, LA = 0.f;
#pragma unroll 8
    for (int k = 0; k < 32; ++k) {
      const int t = d ? (c0 + 31 - k) : (c0 + k);
      const u32 w = AB[((size_t)t * 2 + d) * 1024 + ch];
      const float la = bflo(w), b = bfhi(w);
      h = __expf(la) * h + b;
      LA += la;
    }
    AGG[((size_t)d * 1024 + chunk) * 1024 + ch] = float2{LA, h};
  }
}

DEVI void phase_rg_carry(const Params& p, int s) {
  const int L = s ? 2048 : 4096;
  const int nseq = TS / L, nch = L / 32;
  const float2* AGG = (const float2*)(p.ws + OFF_AGG);
  float* CAR = (float*)(p.ws + OFF_CAR);
  const int gsz = gridDim.x * 256, gtid = blockIdx.x * 256 + threadIdx.x;
  for (int i = gtid; i < nseq * 2 * 1024; i += gsz) {
    const int ch = i & 1023, d = (i >> 10) & 1, seq = i >> 11;
    float H = 0.f;
    for (int k = 0; k < nch; ++k) {
      const int chunk = seq * nch + (d ? (nch - 1 - k) : k);
      const size_t idx = ((size_t)d * 1024 + chunk) * 1024 + ch;
      CAR[idx] = H;
      const float2 ag = AGG[idx];
      H = __expf(ag.x) * H + ag.y;
    }
  }
}

DEVI void phase_rg_final(const Params& p) {
  const u32* AB = (const u32*)(p.ws + OFF_AB);
  const float* CAR = (const float*)(p.ws + OFF_CAR);
  const u16* GG = (const u16*)(p.ws + OFF_GG);
  u16* Y = (u16*)(p.ws + OFF_R);
  const int gsz = gridDim.x * 256, gtid = blockIdx.x * 256 + threadIdx.x;
  for (int i = gtid; i < 1024 * 1024; i += gsz) {
    const int ch = i & 1023, chunk = i >> 10;
    const int c0 = chunk * 32;
    float hf[32];
    float h = CAR[((size_t)chunk) * 1024 + ch];
#pragma unroll
    for (int k = 0; k < 32; ++k) {
      const u32 w = AB[((size_t)(c0 + k) * 2 + 0) * 1024 + ch];
      h = __expf(bflo(w)) * h + bfhi(w);
      hf[k] = h;
    }
    h = CAR[((size_t)1024 + chunk) * 1024 + ch];
#pragma unroll
    for (int k = 31; k >= 0; --k) {
      const u32 w = AB[((size_t)(c0 + k) * 2 + 1) * 1024 + ch];
      h = __expf(bflo(w)) * h + bfhi(w);
      const size_t idx = (size_t)(c0 + k) * 1024 + ch;
      Y[idx] = f2bf((hf[k] + h) * bf2f(GG[idx]));
    }
  }
}

DEVI void phase_rg_out(const Params& p, int s, unsigned char* smem) {
  float* X = p.out + (size_t)s * TS * 1024;
  const u16* Y = (const u16*)(p.ws + OFF_R);
  const u16* Wt = (const u16*)(p.ws + OFF_WRGOUT);
  const int lane = threadIdx.x & 63, wave = threadIdx.x >> 6, wm = wave >> 1, wn = wave & 1;
  for (int tile = blockIdx.x; tile < 256 * 8; tile += gridDim.x) {
    const int m0 = (tile >> 3) * 128, n0 = (tile & 7) * 128;
    LdBF al{Y + (size_t)m0 * 1024, 1024};
    LdBF bl{Wt + (size_t)n0 * 1024, 1024};
    gemm_tile(al, bl, 1024, smem, [&](f32x4 (&acc)[4][4]) {
#pragma unroll
      for (int i = 0; i < 4; ++i)
#pragma unroll
        for (int j = 0; j < 4; ++j)
#pragma unroll
          for (int r = 0; r < 4; ++r) {
            const int row = m0 + wm * 64 + i * 16 + (lane >> 4) * 4 + r;
            const int col = n0 + wn * 64 + j * 16 + (lane & 15);
            const size_t idx = (size_t)row * 1024 + col;
            X[idx] = ALPHA * X[idx] + acc[i][j][r];
          }
    });
  }
}

constexpr int NPS = 21;
constexpr int NPHASE = 1 + 2 * NPS;

template <int PH>
DEVI void run_phase(const Params& p, unsigned char* smem) {
  if constexpr (PH == 0) {
    phase_setup(p);
  } else {
    constexpr int s = (PH - 1) / NPS, q = (PH - 1) % NPS;
    if constexpr (q == 0) phase_s5_in(p, s, smem);
    else if constexpr (q == 1) phase_s5_scan(p, s);
    else if constexpr (q == 2) phase_s5_combine(p);
    else if constexpr (q == 3) phase_s5_glu(p, s, smem);
    else if constexpr (q == 4) phase_ln1_tables(p, s, 0);
    else if constexpr (q == 5) phase_peer_q(p, 0, smem);
    else if constexpr (q == 6) phase_peer_route(p);
    else if constexpr (q == 7) phase_peer_gather(p, s, 0);
    else if constexpr (q == 8) phase_ple(p, s, 0, smem);
    else if constexpr (q == 9) phase_rg_in(p, s, smem);
    else if constexpr (q == 10) phase_rg_conv(p, s);
    else if constexpr (q == 11) phase_rg_gates(p, smem);
    else if constexpr (q == 12) phase_rg_agg(p);
    else if constexpr (q == 13) phase_rg_carry(p, s);
    else if constexpr (q == 14) phase_rg_final(p);
    else if constexpr (q == 15) phase_rg_out(p, s, smem);
    else if constexpr (q == 16) phase_ln1_tables(p, s, 1);
    else if constexpr (q == 17) phase_peer_q(p, 1, smem);
    else if constexpr (q == 18) phase_peer_route(p);
    else if constexpr (q == 19) phase_peer_gather(p, s, 1);
    else if constexpr (q == 20) phase_ple(p, s, 1, smem);
  }
}

template <int PH>
DEVI void run_steps(const Params& p, int lo, int hi, unsigned char* smem) {
  if constexpr (PH < NPHASE) {
    if (PH >= lo && PH < hi) {
      run_phase<PH>(p, smem);
      if (PH + 1 < hi) cg::this_grid().sync();
    }
    run_steps<PH + 1>(p, lo, hi, smem);
  }
}

__global__ void __launch_bounds__(256, 2) mega(Params p, int ph_lo, int ph_hi) {
  extern __shared__ __attribute__((aligned(16))) unsigned char smem[];
  run_steps<0>(p, ph_lo, ph_hi, smem);
}

extern "C" void kernel_launch(void* const* d_in, const int* in_sizes, int n_in, void* d_out, int out_size, void* d_ws,
                              size_t ws_size, hipStream_t stream) {
  static int grid = 0;
  if (grid == 0) {
    if (n_in != 33 || ws_size < WS_END) {
      fprintf(stderr, "kernel_launch: need 33 inputs and %zu bytes ws; got %d, %zu\n", (size_t)WS_END, n_in, ws_size);
      grid = -1;
      return;
    }
    int dev = 0, cus = 0, per_cu = 0;
    hipGetDevice(&dev);
    hipDeviceGetAttribute(&cus, hipDeviceAttributeMultiprocessorCount, dev);
    if (hipFuncSetAttribute((const void*)mega, hipFuncAttributeMaxDynamicSharedMemorySize, LDS_BYTES) != hipSuccess) {
      fprintf(stderr, "kernel_launch: hipFuncSetAttribute failed\n");
      grid = -1;
      return;
    }
    hipOccupancyMaxActiveBlocksPerMultiprocessor(&per_cu, (const void*)mega, 256, LDS_BYTES);
    if (per_cu < 1) per_cu = 1;
    if (per_cu > 2) per_cu = 2;
    grid = cus * per_cu;
    fprintf(stderr, "kernel_launch: cus %d per_cu %d grid %d\n", cus, per_cu, grid);
  }
  if (grid < 0) return;
  Params p{};
  for (int i = 0; i < 33; ++i) p.in[i] = (const float*)d_in[i];
  p.out = (float*)d_out;
  p.ws = (unsigned char*)d_ws;
#if COOP
  int lo = 0, hi = NPHASE;
  void* args[] = {&p, &lo, &hi};
  hipError_t e = hipLaunchCooperativeKernel((const void*)mega, dim3(grid), dim3(256), args, LDS_BYTES, stream);
  if (e != hipSuccess) fprintf(stderr, "cooperative launch failed: %s (grid %d)\n", hipGetErrorString(e), grid);
#else
  for (int ph = 0; ph < NPHASE; ++ph) {
    hipLaunchKernelGGL(mega, dim3(grid), dim3(256), LDS_BYTES, stream, p, ph, ph + 1);
  }
#endif
}
```

```cpp
#include <hip/hip_runtime.h>
#include <hip/hip_cooperative_groups.h>
#include <cstdio>
namespace cg = cooperative_groups;

#ifndef COOP
#define COOP 1
#endif

typedef unsigned short u16;
typedef unsigned int u32;
using bf16x8 = __attribute__((ext_vector_type(8))) short;
using f32x4 = __attribute__((ext_vector_type(4))) float;
typedef float f2 __attribute__((ext_vector_type(2)));

#define DEVI __device__ __forceinline__

constexpr int TS = 32768;
constexpr float ALPHA = 1.41421356237309515f;
constexpr float LN_EPS = 1e-5f;
constexpr size_t MBy = 1ull << 20;

constexpr size_t OFF_WS5IN = 0;
constexpr size_t OFF_WGLU = 2 * MBy;
constexpr size_t OFF_WRGIN = 6 * MBy;
constexpr size_t OFF_WGATES = 10 * MBy;
constexpr size_t OFF_WRGOUT = 12 * MBy;
constexpr size_t OFF_WQ = 14 * MBy;
constexpr size_t OFF_SK = 22 * MBy;
constexpr size_t OFF_WPROJ = 23 * MBy;
constexpr size_t OFF_WPG = 24 * MBy;
constexpr size_t OFF_UB = 28 * MBy;
constexpr size_t OFF_VB = 60 * MBy;
constexpr size_t OFF_UB8 = OFF_UB;
constexpr size_t OFF_VB8 = OFF_UB + 16 * MBy;
constexpr size_t OFF_SCL = OFF_UB + 32 * MBy;
constexpr size_t OFF_ACT = 92 * MBy;
constexpr size_t OFF_XB = OFF_ACT;
constexpr size_t OFF_KEYS = OFF_ACT + 64 * MBy;
constexpr size_t OFF_IDX = OFF_ACT + 96 * MBy;
constexpr size_t OFF_GATE = OFF_ACT + 112 * MBy;
constexpr size_t OFF_SU = OFF_ACT + 128 * MBy;
constexpr size_t OFF_U = OFF_ACT;
constexpr size_t OFF_YF = OFF_ACT + 64 * MBy;
constexpr size_t OFF_YB = OFF_ACT + 128 * MBy;
constexpr size_t OFF_HB = OFF_ACT + 192 * MBy;
constexpr size_t OFF_GG = OFF_ACT;
constexpr size_t OFF_R = OFF_ACT + 64 * MBy;
constexpr size_t OFF_C = OFF_ACT + 128 * MBy;
constexpr size_t OFF_AB = OFF_ACT + 192 * MBy;
constexpr size_t OFF_AGG = OFF_ACT + 448 * MBy;
constexpr size_t OFF_CAR = OFF_ACT + 464 * MBy;
constexpr size_t WS_END = OFF_ACT + 472 * MBy;

constexpr int LDS_BYTES = 36864 + 32768;

struct Params {
  const float* in[33];
  float* out;
  unsigned char* ws;
};

DEVI u16 f2bf(float f) {
  u32 u = __float_as_uint(f);
  u += 0x7FFFu + ((u >> 16) & 1u);
  return (u16)(u >> 16);
}
DEVI float bf2f(u16 h) { return __uint_as_float(((u32)h) << 16); }
DEVI u32 pack2(float lo, float hi) { return (u32)f2bf(lo) | ((u32)f2bf(hi) << 16); }
DEVI float bflo(u32 w) { return __uint_as_float(w << 16); }
DEVI float bfhi(u32 w) { return __uint_as_float(w & 0xffff0000u); }
DEVI float sigmoid_(float x) { return 1.f / (1.f + __expf(-x)); }
DEVI float gelu_(float x) {
  float z = 0.7978845608028654f * (x + 0.044715f * x * x * x);
  return x / (1.f + __expf(-2.f * z));
}
DEVI float softplus_(float x) { return fmaxf(x, 0.f) + log1pf(__expf(-fabsf(x))); }
DEVI void unpack8(const uint4& w, float* f) {
  f[0] = bflo(w.x); f[1] = bfhi(w.x); f[2] = bflo(w.y); f[3] = bfhi(w.y);
  f[4] = bflo(w.z); f[5] = bfhi(w.z); f[6] = bflo(w.w); f[7] = bfhi(w.w);
}
DEVI uint4 pack8(const float* f) {
  uint4 o; o.x = pack2(f[0], f[1]); o.y = pack2(f[2], f[3]); o.z = pack2(f[4], f[5]); o.w = pack2(f[6], f[7]);
  return o;
}

struct LdBF {
  const u16* base; int ld;
  typedef uint4 Raw;
  DEVI Raw load(int row, int k) const { return *reinterpret_cast<const uint4*>(base + (size_t)row * ld + k); }
  DEVI static uint4 cvt(const Raw& r) { return r; }
};
struct RawF { float4 a, b; };
struct LdF32 {
  const float* base; int ld;
  typedef RawF Raw;
  DEVI Raw load(int row, int k) const {
    const float4* q = reinterpret_cast<const float4*>(base + (size_t)row * ld + k);
    RawF r; r.a = q[0]; r.b = q[1]; return r;
  }
  DEVI static uint4 cvt(const Raw& r) {
    uint4 o; o.x = pack2(r.a.x, r.a.y); o.y = pack2(r.a.z, r.a.w); o.z = pack2(r.b.x, r.b.y); o.w = pack2(r.b.z, r.b.w);
    return o;
  }
};

template <class AL, class BL, class EP>
DEVI void gemm_tile(const AL al, const BL bl, const int K, unsigned char* smem, EP ep) {
  u16* As = reinterpret_cast<u16*>(smem);
  u16* Bs = As + 128 * 72;
  const int tid = threadIdx.x, lane = tid & 63, wave = tid >> 6, wm = wave >> 1, wn = wave & 1;
  const int lr = lane & 15, lq = lane >> 4;
  f32x4 acc[4][4];
#pragma unroll
  for (int i = 0; i < 4; ++i)
#pragma unroll
    for (int j = 0; j < 4; ++j) acc[i][j] = f32x4{0.f, 0.f, 0.f, 0.f};
  typename AL::Raw ra[4];
  typename BL::Raw rb[4];
  const int prow = tid >> 3, pk = (tid & 7) * 8;
#pragma unroll
  for (int i = 0; i < 4; ++i) { ra[i] = al.load(prow + i * 32, pk); rb[i] = bl.load(prow + i * 32, pk); }
  for (int kt = 0; kt < K; kt += 64) {
    __syncthreads();
#pragma unroll
    for (int i = 0; i < 4; ++i) {
      *reinterpret_cast<uint4*>(As + (prow + i * 32) * 72 + pk) = AL::cvt(ra[i]);
      *reinterpret_cast<uint4*>(Bs + (prow + i * 32) * 72 + pk) = BL::cvt(rb[i]);
    }
    __syncthreads();
    if (kt + 64 < K) {
#pragma unroll
      for (int i = 0; i < 4; ++i) { ra[i] = al.load(prow + i * 32, kt + 64 + pk); rb[i] = bl.load(prow + i * 32, kt + 64 + pk); }
    }
#pragma unroll
    for (int ks = 0; ks < 2; ++ks) {
      bf16x8 af[4], bfr[4];
#pragma unroll
      for (int i = 0; i < 4; ++i) af[i] = *reinterpret_cast<const bf16x8*>(As + (wm * 64 + i * 16 + lr) * 72 + ks * 32 + lq * 8);
#pragma unroll
      for (int j = 0; j < 4; ++j) bfr[j] = *reinterpret_cast<const bf16x8*>(Bs + (wn * 64 + j * 16 + lr) * 72 + ks * 32 + lq * 8);
#pragma unroll
      for (int i = 0; i < 4; ++i)
#pragma unroll
        for (int j = 0; j < 4; ++j) acc[i][j] = __builtin_amdgcn_mfma_f32_16x16x32_bf16(af[i], bfr[j], acc[i][j], 0, 0, 0);
    }
  }
  __syncthreads();
  ep(acc);
}

template <int PERM>
DEVI void cvt_wt(const float* W, int K, int N, u16* out, int a0, int a1) {
  const int gsz = gridDim.x * 256, gtid = blockIdx.x * 256 + threadIdx.x;
  const int total = N * (K >> 3);
  for (int i = gtid; i < total; i += gsz) {
    const int n = i % N, kv = i / N;
    float v[8];
#pragma unroll
    for (int j = 0; j < 8; ++j) v[j] = W[(size_t)(kv * 8 + j) * N + n];
    int np = n;
    if (PERM == 1) { const int g = n >> 10, o = n & 1023; np = (o >> 4) * 32 + g * 16 + (o & 15); }
    if (PERM == 2) { np = a0 * 512 + (n >> 4) * 32 + a1 * 16 + (n & 15); }
    *reinterpret_cast<uint4*>(out + (size_t)np * K + kv * 8) = pack8(v);
  }
}

DEVI void cvt_plain(const float* src, u16* dst, size_t n8) {
  const size_t gsz = (size_t)gridDim.x * 256, gtid = (size_t)blockIdx.x * 256 + threadIdx.x;
  for (size_t i = gtid; i < n8; i += gsz) {
    const float4* q = reinterpret_cast<const float4*>(src + i * 8);
    float4 a = q[0], b = q[1];
    uint4 o; o.x = pack2(a.x, a.y); o.y = pack2(a.z, a.w); o.z = pack2(b.x, b.y); o.w = pack2(b.z, b.w);
    *reinterpret_cast<uint4*>(dst + i * 8) = o;
  }
}

DEVI void phase_setup(const Params& p) {
  unsigned char* ws = p.ws;
  cvt_wt<0>(p.in[4], 1024, 1024, (u16*)(ws + OFF_WS5IN), 0, 0);
  cvt_wt<1>(p.in[13], 1024, 2048, (u16*)(ws + OFF_WGLU), 0, 0);
  cvt_wt<0>(p.in[14], 1024, 2048, (u16*)(ws + OFF_WRGIN), 0, 0);
  for (int d = 0; d < 2; ++d)
    for (int gate = 0; gate < 2; ++gate)
      for (int h = 0; h < 4; ++h)
        cvt_wt<2>((gate ? p.in[19] : p.in[17]) + (size_t)(d * 4 + h) * 65536, 256, 256,
                  (u16*)(ws + OFF_WGATES) + (size_t)h * 1024 * 256, d, gate);
  cvt_wt<0>(p.in[22], 1024, 1024, (u16*)(ws + OFF_WRGOUT), 0, 0);
  for (int l = 0; l < 2; ++l) {
    cvt_wt<0>(p.in[27] + (size_t)l * 1024 * 2048, 1024, 2048, (u16*)(ws + OFF_WQ) + (size_t)l * 2048 * 1024, 0, 0);
    cvt_wt<0>(p.in[31] + (size_t)l * 256 * 1024, 256, 1024, (u16*)(ws + OFF_WPROJ) + (size_t)l * 1024 * 256, 0, 0);
    cvt_wt<0>(p.in[32] + (size_t)l * 1024 * 1024, 1024, 1024, (u16*)(ws + OFF_WPG) + (size_t)l * 1024 * 1024, 0, 0);
  }
  cvt_plain(p.in[28], (u16*)(ws + OFF_SK), 65536 / 8);
}

DEVI void phase_s5_in(const Params& p, int s, unsigned char* smem) {
  const float* X = p.in[s];
  const u16* Wt = (const u16*)(p.ws + OFF_WS5IN);
  u16* U = (u16*)(p.ws + OFF_U);
  const int lane = threadIdx.x & 63, wave = threadIdx.x >> 6, wm = wave >> 1, wn = wave & 1;
  for (int tile = blockIdx.x; tile < 256 * 8; tile += gridDim.x) {
    const int m0 = (tile >> 3) * 128, n0 = (tile & 7) * 128;
    LdF32 al{X + (size_t)m0 * 1024, 1024};
    LdBF bl{Wt + (size_t)n0 * 1024, 1024};
    gemm_tile(al, bl, 1024, smem, [&](f32x4 (&acc)[4][4]) {
#pragma unroll
      for (int i = 0; i < 4; ++i)
#pragma unroll
        for (int j = 0; j < 4; ++j)
#pragma unroll
          for (int r = 0; r < 4; ++r) {
            const int row = m0 + wm * 64 + i * 16 + (lane >> 4) * 4 + r;
            const int col = n0 + wn * 64 + j * 16 + (lane & 15);
            U[(size_t)row * 1024 + col] = f2bf(acc[i][j][r]);
          }
    });
  }
}

DEVI void phase_s5_scan(const Params& p, int s) {
  const int L = s ? 2048 : 4096;
  const int nseq = TS / L;
  const int ntask = nseq * 128;
  const int lane = threadIdx.x & 63, wave = threadIdx.x >> 6;
  const u16* U = (const u16*)(p.ws + OFF_U);
  for (int task = wave * gridDim.x + blockIdx.x; task < ntask; task += gridDim.x * 4) {
    const int dir = task & 1, g = (task >> 1) & 63, seq = task >> 7;
    const int pg = dir * 64 + g;
    const float step = expf(p.in[7][pg]);
    const float lr_ = p.in[5][pg * 64 + lane], li_ = p.in[6][pg * 64 + lane];
    const float mag = expf(lr_ * step), ang = li_ * step;
    const float ar = mag * cosf(ang), ai = mag * sinf(ang);
    const float den = lr_ * lr_ + li_ * li_;
    const float zr = ar - 1.f;
    const float qr = (zr * lr_ + ai * li_) / den, qi = (ai * lr_ - zr * li_) / den;
    float bbr[16], bbi[16], cr[16], ci[16];
    {
      const float4* brp = reinterpret_cast<const float4*>(p.in[8] + ((size_t)pg * 64 + lane) * 16);
      const float4* bip = reinterpret_cast<const float4*>(p.in[9] + ((size_t)pg * 64 + lane) * 16);
#pragma unroll
      for (int c4 = 0; c4 < 4; ++c4) {
        const float4 br = brp[c4], bi = bip[c4];
        bbr[c4 * 4 + 0] = qr * br.x - qi * bi.x; bbi[c4 * 4 + 0] = qr * bi.x + qi * br.x;
        bbr[c4 * 4 + 1] = qr * br.y - qi * bi.y; bbi[c4 * 4 + 1] = qr * bi.y + qi * br.y;
        bbr[c4 * 4 + 2] = qr * br.z - qi * bi.z; bbi[c4 * 4 + 2] = qr * bi.z + qi * br.z;
        bbr[c4 * 4 + 3] = qr * br.w - qi * bi.w; bbi[c4 * 4 + 3] = qr * bi.w + qi * br.w;
      }
#pragma unroll
      for (int c = 0; c < 16; ++c) {
        cr[c] = p.in[10][((size_t)pg * 16 + c) * 64 + lane];
        ci[c] = p.in[11][((size_t)pg * 16 + c) * 64 + lane];
      }
    }
    float hr = 0.f, hi = 0.f;
    u16* Yd = (u16*)(p.ws + (dir ? OFF_YB : OFF_YF));
    const size_t base = (size_t)seq * L;
    const int cidx = ((lane >> 5) & 1) * 8 + ((lane >> 4) & 1) * 4 + ((lane >> 3) & 1) * 2 + ((lane >> 2) & 1);
    const bool b5 = lane & 32, b4 = lane & 16, b3 = lane & 8, b2 = lane & 4;
#pragma unroll 2
    for (int i = 0; i < L; ++i) {
      const int t = dir ? (L - 1 - i) : i;
      const uint4* up = reinterpret_cast<const uint4*>(U + (base + t) * 1024 + g * 16);
      const uint4 u0 = up[0], u1 = up[1];
      float u[16];
      unpack8(u0, u); unpack8(u1, u + 8);
      float bur = 0.f, bui = 0.f;
#pragma unroll
      for (int c = 0; c < 16; ++c) { bur = fmaf(bbr[c], u[c], bur); bui = fmaf(bbi[c], u[c], bui); }
      const float nhr = ar * hr - ai * hi + bur;
      const float nhi = ar * hi + ai * hr + bui;
      hr = nhr; hi = nhi;
      float y[16];
#pragma unroll
      for (int c = 0; c < 16; ++c) y[c] = cr[c] * hr - ci[c] * hi;
      float y8[8], y4[4], y2[2];
#pragma unroll
      for (int c = 0; c < 8; ++c) {
        const float keep = b5 ? y[c + 8] : y[c], send = b5 ? y[c] : y[c + 8];
        y8[c] = keep + __shfl_xor(send, 32);
      }
#pragma unroll
      for (int c = 0; c < 4; ++c) {
        const float keep = b4 ? y8[c + 4] : y8[c], send = b4 ? y8[c] : y8[c + 4];
        y4[c] = keep + __shfl_xor(send, 16);
      }
#pragma unroll
      for (int c = 0; c < 2; ++c) {
        const float keep = b3 ? y4[c + 2] : y4[c], send = b3 ? y4[c] : y4[c + 2];
        y2[c] = keep + __shfl_xor(send, 8);
      }
      float y1;
      {
        const float keep = b2 ? y2[1] : y2[0], send = b2 ? y2[0] : y2[1];
        y1 = keep + __shfl_xor(send, 4);
      }
      y1 += __shfl_xor(y1, 2);
      y1 += __shfl_xor(y1, 1);
      if ((lane & 3) == 0) Yd[(base + t) * 1024 + g * 16 + cidx] = f2bf(y1);
    }
  }
}

DEVI void phase_s5_combine(const Params& p) {
  const u16* U = (const u16*)(p.ws + OFF_U);
  const u16* YF = (const u16*)(p.ws + OFF_YF);
  const u16* YB = (const u16*)(p.ws + OFF_YB);
  u16* HB = (u16*)(p.ws + OFF_HB);
  const float* dsk = p.in[12];
  const int gsz = gridDim.x * 256, gtid = blockIdx.x * 256 + threadIdx.x;
  for (int i = gtid; i < TS * 128; i += gsz) {
    const int cv = (i & 127) * 8;
    const size_t off = (size_t)i * 8;
    float a[8], b[8], u[8], h[8];
    unpack8(*reinterpret_cast<const uint4*>(YF + off), a);
    unpack8(*reinterpret_cast<const uint4*>(YB + off), b);
    unpack8(*reinterpret_cast<const uint4*>(U + off), u);
#pragma unroll
    for (int j = 0; j < 8; ++j) h[j] = gelu_(a[j] + b[j] + dsk[cv + j] * u[j]);
    *reinterpret_cast<uint4*>(HB + off) = pack8(h);
  }
}

DEVI void phase_s5_glu(const Params& p, int s, unsigned char* smem) {
  const u16* HB = (const u16*)(p.ws + OFF_HB);
  const u16* Wt = (const u16*)(p.ws + OFF_WGLU);
  const float* Xin = p.in[s];
  float* Xo = p.out + (size_t)s * TS * 1024;
  const int lane = threadIdx.x & 63, wave = threadIdx.x >> 6, wm = wave >> 1, wn = wave & 1;
  for (int tile = blockIdx.x; tile < 256 * 16; tile += gridDim.x) {
    const int m0 = (tile >> 4) * 128, n0 = (tile & 15) * 128;
    LdBF al{HB + (size_t)m0 * 1024, 1024};
    LdBF bl{Wt + (size_t)n0 * 1024, 1024};
    gemm_tile(al, bl, 1024, smem, [&](f32x4 (&acc)[4][4]) {
#pragma unroll
      for (int i = 0; i < 4; ++i)
#pragma unroll
        for (int jj = 0; jj < 4; jj += 2)
#pragma unroll
          for (int r = 0; r < 4; ++r) {
            const int row = m0 + wm * 64 + i * 16 + (lane >> 4) * 4 + r;
            const int nb = n0 + wn * 64 + jj * 16;
            const int o = (nb >> 5) * 16 + (lane & 15);
            const float mix = acc[i][jj][r] * sigmoid_(acc[i][jj + 1][r]);
            const size_t idx = (size_t)row * 1024 + o;
            Xo[idx] = ALPHA * Xin[idx] + mix;
          }
    });
  }
}

DEVI void phase_ln1_tables(const Params& p, int s, int layer) {
  float* X = p.out + (size_t)s * TS * 1024;
  u16* XB = (u16*)(p.ws + OFF_XB);
  const float* gam = p.in[23] + layer * 1024;
  const float* bet = p.in[24] + layer * 1024;
  const int lane = threadIdx.x & 63, wave = threadIdx.x >> 6;
  for (int t = blockIdx.x * 4 + wave; t < TS; t += gridDim.x * 4) {
    float4 v[4];
#pragma unroll
    for (int i = 0; i < 4; ++i) v[i] = *reinterpret_cast<const float4*>(X + (size_t)t * 1024 + i * 256 + lane * 4);
    float sm = 0.f;
#pragma unroll
    for (int i = 0; i < 4; ++i) sm += v[i].x + v[i].y + v[i].z + v[i].w;
#pragma unroll
    for (int m = 32; m >= 1; m >>= 1) sm += __shfl_xor(sm, m);
    const float mu = sm * (1.f / 1024.f);
    float sq = 0.f;
#pragma unroll
    for (int i = 0; i < 4; ++i) {
      const float a = v[i].x - mu, b = v[i].y - mu, c = v[i].z - mu, d = v[i].w - mu;
      sq += a * a + b * b + c * c + d * d;
    }
#pragma unroll
    for (int m = 32; m >= 1; m >>= 1) sq += __shfl_xor(sq, m);
    const float rs = rsqrtf(sq * (1.f / 1024.f) + LN_EPS);
#pragma unroll
    for (int i = 0; i < 4; ++i) {
      const int c0 = i * 256 + lane * 4;
      const float4 g4 = *reinterpret_cast<const float4*>(gam + c0);
      const float4 b4 = *reinterpret_cast<const float4*>(bet + c0);
      float4 o;
      o.x = (v[i].x - mu) * rs * g4.x + b4.x; o.y = (v[i].y - mu) * rs * g4.y + b4.y;
      o.z = (v[i].z - mu) * rs * g4.z + b4.z; o.w = (v[i].w - mu) * rs * g4.w + b4.w;
      *reinterpret_cast<float4*>(X + (size_t)t * 1024 + c0) = o;
      uint2 pk; pk.x = pack2(o.x, o.y); pk.y = pack2(o.z, o.w);
      *reinterpret_cast<uint2*>(XB + (size_t)t * 1024 + c0) = pk;
    }
  }
  float* SCL = (float*)(p.ws + OFF_SCL);
  for (int r = blockIdx.x * 4 + wave; r < 32768; r += gridDim.x * 4) {
    const int tab = r >> 14, row = r & 16383;
    const float4* sp = reinterpret_cast<const float4*>(p.in[29 + tab] + ((size_t)layer * 16384 + row) * 1024 + lane * 16);
    const float4 a = sp[0], b = sp[1], c = sp[2], d = sp[3];
    float am = fmaxf(fmaxf(fmaxf(fabsf(a.x), fabsf(a.y)), fmaxf(fabsf(a.z), fabsf(a.w))),
                     fmaxf(fmaxf(fabsf(b.x), fabsf(b.y)), fmaxf(fabsf(b.z), fabsf(b.w))));
    am = fmaxf(am, fmaxf(fmaxf(fmaxf(fabsf(c.x), fabsf(c.y)), fmaxf(fabsf(c.z), fabsf(c.w))),
                         fmaxf(fmaxf(fabsf(d.x), fabsf(d.y)), fmaxf(fabsf(d.z), fabsf(d.w)))));
#pragma unroll
    for (int m = 32; m >= 1; m >>= 1) am = fmaxf(am, __shfl_xor(am, m));
    const float sc = am > 0.f ? 224.f / am : 1.f;
    const float inv = am > 0.f ? am * (1.f / 224.f) : 1.f;
    uint4 o;
    int w = 0;
    w = __builtin_amdgcn_cvt_pk_fp8_f32(a.x * sc, a.y * sc, w, false); w = __builtin_amdgcn_cvt_pk_fp8_f32(a.z * sc, a.w * sc, w, true); o.x = (u32)w;
    w = __builtin_amdgcn_cvt_pk_fp8_f32(b.x * sc, b.y * sc, w, false); w = __builtin_amdgcn_cvt_pk_fp8_f32(b.z * sc, b.w * sc, w, true); o.y = (u32)w;
    w = __builtin_amdgcn_cvt_pk_fp8_f32(c.x * sc, c.y * sc, w, false); w = __builtin_amdgcn_cvt_pk_fp8_f32(c.z * sc, c.w * sc, w, true); o.z = (u32)w;
    w = __builtin_amdgcn_cvt_pk_fp8_f32(d.x * sc, d.y * sc, w, false); w = __builtin_amdgcn_cvt_pk_fp8_f32(d.z * sc, d.w * sc, w, true); o.w = (u32)w;
    *reinterpret_cast<uint4*>(p.ws + (tab ? OFF_VB8 : OFF_UB8) + (size_t)row * 1024 + lane * 16) = o;
    if (lane == 0) SCL[tab * 16384 + row] = inv;
  }
}

DEVI u32 enc_key(float s, int n) {
  u32 b = __float_as_uint(s);
  u32 srt = (b & 0x80000000u) ? ~b : (b | 0x80000000u);
  return (srt & ~127u) | (u32)(127 - n);
}
DEVI float dec_key(u32 key, int& n) {
  n = 127 - (int)(key & 127u);
  u32 srt = key & ~127u;
  u32 b = (srt & 0x80000000u) ? (srt & 0x7fffffffu) : ~srt;
  return __uint_as_float(b);
}

DEVI void phase_peer_q(const Params& p, int layer, unsigned char* smem) {
  const u16* XB = (const u16*)(p.ws + OFF_XB);
  const u16* Wt = (const u16*)(p.ws + OFF_WQ) + (size_t)layer * 2048 * 1024;
  const u16* SK = (const u16*)(p.ws + OFF_SK) + (size_t)layer * 2 * 128 * 128;
  u32* KEYS = (u32*)(p.ws + OFF_KEYS);
  const int tid = threadIdx.x, lane = tid & 63, wave = tid >> 6, wm = wave >> 1, wn = wave & 1;
  const int lr = lane & 15, lq = lane >> 4;
  u16* Qs = reinterpret_cast<u16*>(smem);
  u32* Sk = reinterpret_cast<u32*>(smem);
  for (int tile = blockIdx.x; tile < 256 * 16; tile += gridDim.x) {
    const int m0 = (tile >> 4) * 128, hc = tile & 15, n0 = hc * 128;
    const int c = hc & 1;
    LdBF al{XB + (size_t)m0 * 1024, 1024};
    LdBF bl{Wt + (size_t)n0 * 1024, 1024};
    gemm_tile(al, bl, 1024, smem, [&](f32x4 (&acc)[4][4]) {
#pragma unroll
      for (int i = 0; i < 4; ++i)
#pragma unroll
        for (int j = 0; j < 4; ++j)
#pragma unroll
          for (int r = 0; r < 4; ++r)
            Qs[(wm * 64 + i * 16 + lq * 4 + r) * 136 + wn * 64 + j * 16 + lr] = f2bf(acc[i][j][r]);
      __syncthreads();
      f32x4 sc[4][4];
#pragma unroll
      for (int i = 0; i < 4; ++i)
#pragma unroll
        for (int j = 0; j < 4; ++j) sc[i][j] = f32x4{0.f, 0.f, 0.f, 0.f};
      const u16* skc = SK + (size_t)c * 128 * 128;
#pragma unroll
      for (int ks = 0; ks < 4; ++ks) {
        bf16x8 af[4], bfr[4];
#pragma unroll
        for (int i = 0; i < 4; ++i) af[i] = *reinterpret_cast<const bf16x8*>(Qs + (wm * 64 + i * 16 + lr) * 136 + ks * 32 + lq * 8);
#pragma unroll
        for (int j = 0; j < 4; ++j) bfr[j] = *reinterpret_cast<const bf16x8*>(skc + (size_t)(wn * 64 + j * 16 + lr) * 128 + ks * 32 + lq * 8);
#pragma unroll
        for (int i = 0; i < 4; ++i)
#pragma unroll
          for (int j = 0; j < 4; ++j) sc[i][j] = __builtin_amdgcn_mfma_f32_16x16x32_bf16(af[i], bfr[j], sc[i][j], 0, 0, 0);
      }
      __syncthreads();
#pragma unroll
      for (int i = 0; i < 4; ++i)
#pragma unroll
        for (int j = 0; j < 4; ++j)
#pragma unroll
          for (int r = 0; r < 4; ++r) {
            const int n = wn * 64 + j * 16 + lr;
            Sk[(wm * 64 + i * 16 + lq * 4 + r) * 129 + n] = enc_key(sc[i][j][r], n);
          }
      __syncthreads();
      if (tid < 128) {
        u32 top[16];
#pragma unroll
        for (int k = 0; k < 16; ++k) top[k] = 0u;
#pragma unroll 4
        for (int n = 0; n < 128; ++n) {
          u32 v = Sk[tid * 129 + n];
#pragma unroll
          for (int k = 0; k < 16; ++k) {
            const u32 hi = max(top[k], v);
            v = min(top[k], v);
            top[k] = hi;
          }
        }
        uint4* dst = reinterpret_cast<uint4*>(KEYS + ((size_t)(m0 + tid) * 16 + hc) * 16);
        dst[0] = uint4{top[0], top[1], top[2], top[3]};
        dst[1] = uint4{top[4], top[5], top[6], top[7]};
        dst[2] = uint4{top[8], top[9], top[10], top[11]};
        dst[3] = uint4{top[12], top[13], top[14], top[15]};
      }
    });
  }
}

DEVI void phase_peer_route(const Params& p) {
  const u32* KEYS = (const u32*)(p.ws + OFF_KEYS);
  int* IDX = (int*)(p.ws + OFF_IDX);
  float* GATE = (float*)(p.ws + OFF_GATE);
  float* SU = (float*)(p.ws + OFF_SU);
  const float* SCL = (const float*)(p.ws + OFF_SCL);
  const int gsz = gridDim.x * 256, gtid = blockIdx.x * 256 + threadIdx.x;
  for (int i = gtid; i < TS * 8; i += gsz) {
    const uint4* src = reinterpret_cast<const uint4*>(KEYS + (size_t)i * 32);
    u32 kk[32];
#pragma unroll
    for (int q = 0; q < 8; ++q) { const uint4 w = src[q]; kk[q * 4] = w.x; kk[q * 4 + 1] = w.y; kk[q * 4 + 2] = w.z; kk[q * 4 + 3] = w.w; }
    float s0[16], s1[16]; int i0[16], i1[16];
#pragma unroll
    for (int k = 0; k < 16; ++k) { s0[k] = dec_key(kk[k], i0[k]); s1[k] = dec_key(kk[16 + k], i1[k]); }
    float top[16];
#pragma unroll
    for (int k = 0; k < 16; ++k) top[k] = -3.0e38f;
#pragma unroll
    for (int k1 = 0; k1 < 16; ++k1)
#pragma unroll
      for (int k2 = 0; k2 < 16; ++k2)
        if ((k1 + 1) * (k2 + 1) <= 16) {
          float v = s0[k1] + s1[k2];
#pragma unroll
          for (int k = 0; k < 16; ++k) {
            const float hi = fmaxf(top[k], v);
            v = fminf(top[k], v);
            top[k] = hi;
          }
        }
    const float thr = top[15], mx = top[0];
    float den = 0.f;
#pragma unroll
    for (int k = 0; k < 16; ++k) den += __expf(top[k] - mx);
    const float inv = 1.f / den;
    int cnt = 0;
    int* idst = IDX + (size_t)i * 16;
    float* gdst = GATE + (size_t)i * 16;
    float* sdst = SU + (size_t)i * 16;
#pragma unroll
    for (int k1 = 0; k1 < 16; ++k1)
#pragma unroll
      for (int k2 = 0; k2 < 16; ++k2)
        if ((k1 + 1) * (k2 + 1) <= 16) {
          const float v = s0[k1] + s1[k2];
          if (v >= thr && cnt < 16) {
            const int e = i0[k1] * 128 + i1[k2];
            idst[cnt] = e;
            gdst[cnt] = __expf(v - mx) * inv * SCL[16384 + e];
            sdst[cnt] = SCL[e];
            ++cnt;
          }
        }
  }
}

DEVI f2 cvt8(u32 w, bool hi) { return hi ? __builtin_amdgcn_cvt_pk_f32_fp8((int)w, true) : __builtin_amdgcn_cvt_pk_f32_fp8((int)w, false); }

DEVI void phase_peer_gather(const Params& p, int s, int layer) {
  float* X = p.out + (size_t)s * TS * 1024;
  u16* XB = (u16*)(p.ws + OFF_XB);
  const unsigned char* Ub8 = p.ws + OFF_UB8;
  const unsigned char* Vb8 = p.ws + OFF_VB8;
  const int* IDX = (const int*)(p.ws + OFF_IDX);
  const float* GATE = (const float*)(p.ws + OFF_GATE);
  const float* SU = (const float*)(p.ws + OFF_SU);
  const float* gam = p.in[25] + layer * 1024;
  const float* bet = p.in[26] + layer * 1024;
  const int lane = threadIdx.x & 63, wave = threadIdx.x >> 6;
  const bool b5 = lane & 32, b4 = lane & 16, b3 = lane & 8;
  for (int t = blockIdx.x * 4 + wave; t < TS; t += gridDim.x * 4) {
    f2 x[8], o[8];
    {
      const float4* xp = reinterpret_cast<const float4*>(X + (size_t)t * 1024 + lane * 16);
      const float4 a = xp[0], b = xp[1], c = xp[2], d = xp[3];
      x[0] = f2{a.x, a.y}; x[1] = f2{a.z, a.w}; x[2] = f2{b.x, b.y}; x[3] = f2{b.z, b.w};
      x[4] = f2{c.x, c.y}; x[5] = f2{c.z, c.w}; x[6] = f2{d.x, d.y}; x[7] = f2{d.z, d.w};
    }
#pragma unroll
    for (int k = 0; k < 8; ++k) o[k] = f2{0.f, 0.f};
    const int iv0 = IDX[(size_t)t * 128 + lane], iv1 = IDX[(size_t)t * 128 + 64 + lane];
    const float gv0 = GATE[(size_t)t * 128 + lane], gv1 = GATE[(size_t)t * 128 + 64 + lane];
    const float su0 = SU[(size_t)t * 128 + lane], su1 = SU[(size_t)t * 128 + 64 + lane];
    for (int e0 = 0; e0 < 128; e0 += 8) {
      const bool lo = e0 < 64;
      const int ivs = lo ? iv0 : iv1;
      const float gvs = lo ? gv0 : gv1;
      const float sus = lo ? su0 : su1;
      uint4 uu[8], vv[8];
#pragma unroll
      for (int k = 0; k < 8; ++k) {
        const int ei = __builtin_amdgcn_readlane(ivs, (e0 & 63) + k);
        uu[k] = *reinterpret_cast<const uint4*>(Ub8 + (size_t)ei * 1024 + lane * 16);
        vv[k] = *reinterpret_cast<const uint4*>(Vb8 + (size_t)ei * 1024 + lane * 16);
      }
      float dk[8];
#pragma unroll
      for (int k = 0; k < 8; ++k) {
        f2 acc = cvt8(uu[k].x, false) * x[0];
        acc = cvt8(uu[k].x, true) * x[1] + acc;
        acc = cvt8(uu[k].y, false) * x[2] + acc;
        acc = cvt8(uu[k].y, true) * x[3] + acc;
        acc = cvt8(uu[k].z, false) * x[4] + acc;
        acc = cvt8(uu[k].z, true) * x[5] + acc;
        acc = cvt8(uu[k].w, false) * x[6] + acc;
        acc = cvt8(uu[k].w, true) * x[7] + acc;
        dk[k] = acc.x + acc.y;
      }
      float d4[4], d2[2], d1;
#pragma unroll
      for (int k = 0; k < 4; ++k) {
        const float keep = b5 ? dk[k + 4] : dk[k], send = b5 ? dk[k] : dk[k + 4];
        d4[k] = keep + __shfl_xor(send, 32);
      }
#pragma unroll
      for (int k = 0; k < 2; ++k) {
        const float keep = b4 ? d4[k + 2] : d4[k], send = b4 ? d4[k] : d4[k + 2];
        d2[k] = keep + __shfl_xor(send, 16);
      }
      {
        const float keep = b3 ? d2[1] : d2[0], send = b3 ? d2[0] : d2[1];
        d1 = keep + __shfl_xor(send, 8);
      }
      d1 += __shfl_xor(d1, 4);
      d1 += __shfl_xor(d1, 2);
      d1 += __shfl_xor(d1, 1);
      const int srcl = (e0 & 63) + (lane >> 3);
      const float suv = __shfl(sus, srcl), gvv = __shfl(gvs, srcl);
      const float w = gvv * gelu_(d1 * suv);
      const int wi = __float_as_int(w);
#pragma unroll
      for (int k = 0; k < 8; ++k) {
        const float wk = __int_as_float(__builtin_amdgcn_readlane(wi, k * 8));
        const f2 w2 = f2{wk, wk};
        o[0] = w2 * cvt8(vv[k].x, false) + o[0];
        o[1] = w2 * cvt8(vv[k].x, true) + o[1];
        o[2] = w2 * cvt8(vv[k].y, false) + o[2];
        o[3] = w2 * cvt8(vv[k].y, true) + o[3];
        o[4] = w2 * cvt8(vv[k].z, false) + o[4];
        o[5] = w2 * cvt8(vv[k].z, true) + o[5];
        o[6] = w2 * cvt8(vv[k].w, false) + o[6];
        o[7] = w2 * cvt8(vv[k].w, true) + o[7];
      }
    }
    float sm = 0.f;
#pragma unroll
    for (int k = 0; k < 8; ++k) { o[k] = ALPHA * x[k] + o[k]; sm += o[k].x + o[k].y; }
#pragma unroll
    for (int m = 32; m >= 1; m >>= 1) sm += __shfl_xor(sm, m);
    const float mu = sm * (1.f / 1024.f);
    float sq = 0.f;
#pragma unroll
    for (int k = 0; k < 8; ++k) { const float da = o[k].x - mu, db = o[k].y - mu; sq += da * da + db * db; }
#pragma unroll
    for (int m = 32; m >= 1; m >>= 1) sq += __shfl_xor(sq, m);
    const float rs = rsqrtf(sq * (1.f / 1024.f) + LN_EPS);
    const int c0 = lane * 16;
    float r[16];
#pragma unroll
    for (int k = 0; k < 8; ++k) {
      r[2 * k] = (o[k].x - mu) * rs * gam[c0 + 2 * k] + bet[c0 + 2 * k];
      r[2 * k + 1] = (o[k].y - mu) * rs * gam[c0 + 2 * k + 1] + bet[c0 + 2 * k + 1];
    }
    float4* dp = reinterpret_cast<float4*>(X + (size_t)t * 1024 + c0);
    dp[0] = float4{r[0], r[1], r[2], r[3]};
    dp[1] = float4{r[4], r[5], r[6], r[7]};
    dp[2] = float4{r[8], r[9], r[10], r[11]};
    dp[3] = float4{r[12], r[13], r[14], r[15]};
    uint4* bp = reinterpret_cast<uint4*>(XB + (size_t)t * 1024 + c0);
    bp[0] = pack8(r);
    bp[1] = pack8(r + 8);
  }
}

DEVI void phase_ple(const Params& p, int s, int layer, unsigned char* smem) {
  float* X = p.out + (size_t)s * TS * 1024;
  const u16* XB = (const u16*)(p.ws + OFF_XB);
  const float* P = p.in[2 + s] + (size_t)layer * TS * 256;
  const u16* Wp = (const u16*)(p.ws + OFF_WPROJ) + (size_t)layer * 1024 * 256;
  const u16* Wg = (const u16*)(p.ws + OFF_WPG) + (size_t)layer * 1024 * 1024;
  const int lane = threadIdx.x & 63, wave = threadIdx.x >> 6, wm = wave >> 1, wn = wave & 1;
  for (int tile = blockIdx.x; tile < 256 * 8; tile += gridDim.x) {
    const int m0 = (tile >> 3) * 128, n0 = (tile & 7) * 128;
    u32* pkl = reinterpret_cast<u32*>(smem + 36864) + threadIdx.x;
    {
      LdF32 al{P + (size_t)m0 * 256, 256};
      LdBF bl{Wp + (size_t)n0 * 256, 256};
      gemm_tile(al, bl, 256, smem, [&](f32x4 (&acc)[4][4]) {
#pragma unroll
        for (int i = 0; i < 4; ++i)
#pragma unroll
          for (int j = 0; j < 4; ++j) {
            pkl[((i * 4 + j) * 2 + 0) * 256] = pack2(acc[i][j][0], acc[i][j][1]);
            pkl[((i * 4 + j) * 2 + 1) * 256] = pack2(acc[i][j][2], acc[i][j][3]);
          }
      });
    }
    {
      LdBF al{XB + (size_t)m0 * 1024, 1024};
      LdBF bl{Wg + (size_t)n0 * 1024, 1024};
      gemm_tile(al, bl, 1024, smem, [&](f32x4 (&acc)[4][4]) {
#pragma unroll
        for (int i = 0; i < 4; ++i)
#pragma unroll
          for (int j = 0; j < 4; ++j)
#pragma unroll
            for (int r = 0; r < 4; ++r) {
              const int row = m0 + wm * 64 + i * 16 + (lane >> 4) * 4 + r;
              const int col = n0 + wn * 64 + j * 16 + (lane & 15);
              const u32 w = pkl[((i * 4 + j) * 2 + (r >> 1)) * 256];
              const float pv = (r & 1) ? bfhi(w) : bflo(w);
              const size_t idx = (size_t)row * 1024 + col;
              X[idx] = X[idx] + pv * sigmoid_(acc[i][j][r]);
            }
      });
    }
  }
}

DEVI void phase_rg_in(const Params& p, int s, unsigned char* smem) {
  const float* X = p.out + (size_t)s * TS * 1024;
  const u16* Wt = (const u16*)(p.ws + OFF_WRGIN);
  u16* GG = (u16*)(p.ws + OFF_GG);
  u16* R = (u16*)(p.ws + OFF_R);
  const int lane = threadIdx.x & 63, wave = threadIdx.x >> 6, wm = wave >> 1, wn = wave & 1;
  for (int tile = blockIdx.x; tile < 256 * 16; tile += gridDim.x) {
    const int m0 = (tile >> 4) * 128, n0 = (tile & 15) * 128;
    LdF32 al{X + (size_t)m0 * 1024, 1024};
    LdBF bl{Wt + (size_t)n0 * 1024, 1024};
    gemm_tile(al, bl, 1024, smem, [&](f32x4 (&acc)[4][4]) {
#pragma unroll
      for (int i = 0; i < 4; ++i)
#pragma unroll
        for (int j = 0; j < 4; ++j)
#pragma unroll
          for (int r = 0; r < 4; ++r) {
            const int row = m0 + wm * 64 + i * 16 + (lane >> 4) * 4 + r;
            const int col = n0 + wn * 64 + j * 16 + (lane & 15);
            if (n0 < 1024) GG[(size_t)row * 1024 + col] = f2bf(gelu_(acc[i][j][r]));
            else R[(size_t)row * 1024 + col - 1024] = f2bf(acc[i][j][r]);
          }
    });
  }
}

DEVI void phase_rg_conv(const Params& p, int s) {
  const int L = s ? 2048 : 4096;
  const u16* R = (const u16*)(p.ws + OFF_R);
  u16* C = (u16*)(p.ws + OFF_C);
  const float* cw = p.in[15];
  const float* cb = p.in[16];
  const int gsz = gridDim.x * 256, gtid = blockIdx.x * 256 + threadIdx.x;
  for (int i = gtid; i < TS * 128; i += gsz) {
    const int t = i >> 7, cv = (i & 127) * 8;
    const int pos = t & (L - 1);
    float acc[8];
#pragma unroll
    for (int j = 0; j < 8; ++j) acc[j] = cb[cv + j];
#pragma unroll
    for (int k = 0; k < 4; ++k) {
      const int pp = pos + k - 1;
      if (pp >= 0 && pp < L) {
        float rv[8];
        unpack8(*reinterpret_cast<const uint4*>(R + (size_t)(t + k - 1) * 1024 + cv), rv);
#pragma unroll
        for (int j = 0; j < 8; ++j) acc[j] = fmaf(rv[j], cw[k * 1024 + cv + j], acc[j]);
      }
    }
    *reinterpret_cast<uint4*>(C + (size_t)i * 8) = pack8(acc);
  }
}

DEVI void phase_rg_gates(const Params& p, unsigned char* smem) {
  const u16* C = (const u16*)(p.ws + OFF_C);
  const u16* Wt = (const u16*)(p.ws + OFF_WGATES);
  u32* AB = (u32*)(p.ws + OFF_AB);
  const float* ba = p.in[18];
  const float* bx = p.in[20];
  const float* lam = p.in[21];
  const int lane = threadIdx.x & 63, wave = threadIdx.x >> 6, wm = wave >> 1, wn = wave & 1;
  for (int tile = blockIdx.x; tile < 256 * 32; tile += gridDim.x) {
    const int m0 = (tile >> 5) * 128, h = (tile >> 3) & 3, nt = tile & 7, n0 = nt * 128;
    LdBF al{C + (size_t)m0 * 1024 + h * 256, 1024};
    LdBF bl{Wt + ((size_t)h * 1024 + n0) * 256, 256};
    gemm_tile(al, bl, 256, smem, [&](f32x4 (&acc)[4][4]) {
#pragma unroll
      for (int jj = 0; jj < 4; jj += 2) {
        const int nb = n0 + wn * 64 + jj * 16;
        const int d = nb >> 9;
        const int ch = h * 256 + ((nb & 511) >> 5) * 16 + (lane & 15);
        const float bav = ba[d * 1024 + ch], bxv = bx[d * 1024 + ch];
        const float sp8 = -8.f * softplus_(-lam[d * 1024 + ch]);
#pragma unroll
        for (int i = 0; i < 4; ++i)
#pragma unroll
          for (int r = 0; r < 4; ++r) {
            const int row = m0 + wm * 64 + i * 16 + (lane >> 4) * 4 + r;
            const float rg = sigmoid_(acc[i][jj][r] + bav);
            const float ig = sigmoid_(acc[i][jj + 1][r] + bxv);
            const float la = sp8 * rg;
            const float cval = bf2f(C[(size_t)row * 1024 + ch]);
            const float b = sqrtf(-expm1f(2.f * la)) * ig * cval;
            AB[((size_t)row * 2 + d) * 1024 + ch] = pack2(la, b);
          }
      }
    });
  }
}

DEVI void phase_rg_agg(const Params& p) {
  const u32* AB = (const u32*)(p.ws + OFF_AB);
  float2* AGG = (float2*)(p.ws + OFF_AGG);
  const int gsz = gridDim.x * 256, gtid = blockIdx.x * 256 + threadIdx.x;
  for (int i = gtid; i < 1024 * 2 * 1024; i += gsz) {
    const int ch = i & 1023, d = (i >> 10) & 1, chunk = i >> 11;
    const int c0 = chunk * 32;
    float h = 0.f, LA = 0.f;
#pragma unroll 8
    for (int k = 0; k < 32; ++k) {
      const int t = d ? (c0 + 31 - k) : (c0 + k);
      const u32 w = AB[((size_t)t * 2 + d) * 1024 + ch];
      const float la = bflo(w), b = bfhi(w);
      h = __expf(la) * h + b;
      LA += la;
    }
    AGG[((size_t)d * 1024 + chunk) * 1024 + ch] = float2{LA, h};
  }
}

DEVI void phase_rg_carry(const Params& p, int s) {
  const int L = s ? 2048 : 4096;
  const int nseq = TS / L, nch = L / 32;
  const float2* AGG = (const float2*)(p.ws + OFF_AGG);
  float* CAR = (float*)(p.ws + OFF_CAR);
  const int gsz = gridDim.x * 256, gtid = blockIdx.x * 256 + threadIdx.x;
  for (int i = gtid; i < nseq * 2 * 1024; i += gsz) {
    const int ch = i & 1023, d = (i >> 10) & 1, seq = i >> 11;
    float H = 0.f;
    for (int k = 0; k < nch; ++k) {
      const int chunk = seq * nch + (d ? (nch - 1 - k) : k);
      const size_t idx = ((size_t)d * 1024 + chunk) * 1024 + ch;
      CAR[idx] = H;
      const float2 ag = AGG[idx];
      H = __expf(ag.x) * H + ag.y;
    }
  }
}

DEVI void phase_rg_final(const Params& p) {
  const u32* AB = (const u32*)(p.ws + OFF_AB);
  const float* CAR = (const float*)(p.ws + OFF_CAR);
  const u16* GG = (const u16*)(p.ws + OFF_GG);
  u16* Y = (u16*)(p.ws + OFF_R);
  const int gsz = gridDim.x * 256, gtid = blockIdx.x * 256 + threadIdx.x;
  for (int i = gtid; i < 1024 * 1024; i += gsz) {
    const int ch = i & 1023, chunk = i >> 10;
    const int c0 = chunk * 32;
    float hf[32];
    float h = CAR[((size_t)chunk) * 1024 + ch];
#pragma unroll
    for (int k = 0; k < 32; ++k) {
      const u32 w = AB[((size_t)(c0 + k) * 2 + 0) * 1024 + ch];
      h = __expf(bflo(w)) * h + bfhi(w);
      hf[k] = h;
    }
    h = CAR[((size_t)1024 + chunk) * 1024 + ch];
#pragma unroll
    for (int k = 31; k >= 0; --k) {
      const u32 w = AB[((size_t)(c0 + k) * 2 + 1) * 1024 + ch];
      h = __expf(bflo(w)) * h + bfhi(w);
      const size_t idx = (size_t)(c0 + k) * 1024 + ch;
      Y[idx] = f2bf((hf[k] + h) * bf2f(GG[idx]));
    }
  }
}

DEVI void phase_rg_out(const Params& p, int s, unsigned char* smem) {
  float* X = p.out + (size_t)s * TS * 1024;
  const u16* Y = (const u16*)(p.ws + OFF_R);
  const u16* Wt = (const u16*)(p.ws + OFF_WRGOUT);
  const int lane = threadIdx.x & 63, wave = threadIdx.x >> 6, wm = wave >> 1, wn = wave & 1;
  for (int tile = blockIdx.x; tile < 256 * 8; tile += gridDim.x) {
    const int m0 = (tile >> 3) * 128, n0 = (tile & 7) * 128;
    LdBF al{Y + (size_t)m0 * 1024, 1024};
    LdBF bl{Wt + (size_t)n0 * 1024, 1024};
    gemm_tile(al, bl, 1024, smem, [&](f32x4 (&acc)[4][4]) {
#pragma unroll
      for (int i = 0; i < 4; ++i)
#pragma unroll
        for (int j = 0; j < 4; ++j)
#pragma unroll
          for (int r = 0; r < 4; ++r) {
            const int row = m0 + wm * 64 + i * 16 + (lane >> 4) * 4 + r;
            const int col = n0 + wn * 64 + j * 16 + (lane & 15);
            const size_t idx = (size_t)row * 1024 + col;
            X[idx] = ALPHA * X[idx] + acc[i][j][r];
          }
    });
  }
}

constexpr int NPS = 21;
constexpr int NPHASE = 1 + 2 * NPS;

template <int PH>
DEVI void run_phase(const Params& p, unsigned char* smem) {
  if constexpr (PH == 0) {
    phase_setup(p);
  } else {
    constexpr int s = (PH - 1) / NPS, q = (PH - 1) % NPS;
    if constexpr (q == 0) phase_s5_in(p, s, smem);
    else if constexpr (q == 1) phase_s5_scan(p, s);
    else if constexpr (q == 2) phase_s5_combine(p);
    else if constexpr (q == 3) phase_s5_glu(p, s, smem);
    else if constexpr (q == 4) phase_ln1_tables(p, s, 0);
    else if constexpr (q == 5) phase_peer_q(p, 0, smem);
    else if constexpr (q == 6) phase_peer_route(p);
    else if constexpr (q == 7) phase_peer_gather(p, s, 0);
    else if constexpr (q == 8) phase_ple(p, s, 0, smem);
    else if constexpr (q == 9) phase_rg_in(p, s, smem);
    else if constexpr (q == 10) phase_rg_conv(p, s);
    else if constexpr (q == 11) phase_rg_gates(p, smem);
    else if constexpr (q == 12) phase_rg_agg(p);
    else if constexpr (q == 13) phase_rg_carry(p, s);
    else if constexpr (q == 14) phase_rg_final(p);
    else if constexpr (q == 15) phase_rg_out(p, s, smem);
    else if constexpr (q == 16) phase_ln1_tables(p, s, 1);
    else if constexpr (q == 17) phase_peer_q(p, 1, smem);
    else if constexpr (q == 18) phase_peer_route(p);
    else if constexpr (q == 19) phase_peer_gather(p, s, 1);
    else if constexpr (q == 20) phase_ple(p, s, 1, smem);
  }
}

template <int PH>
DEVI void run_steps(const Params& p, int lo, int hi, unsigned char* smem) {
  if constexpr (PH < NPHASE) {
    if (PH >= lo && PH < hi) {
      run_phase<PH>(p, smem);
#ifdef DBL_MASK
      if (PH > 0 && ((DBL_MASK >> ((PH - 1) % NPS)) & 1)) { __syncthreads(); run_phase<PH>(p, smem); }
#endif
      if (PH + 1 < hi) cg::this_grid().sync();
    }
    run_steps<PH + 1>(p, lo, hi, smem);
  }
}

__global__ void __launch_bounds__(256, 2) mega(Params p, int ph_lo, int ph_hi) {
  extern __shared__ __attribute__((aligned(16))) unsigned char smem[];
  run_steps<0>(p, ph_lo, ph_hi, smem);
}

extern "C" void kernel_launch(void* const* d_in, const int* in_sizes, int n_in, void* d_out, int out_size, void* d_ws,
                              size_t ws_size, hipStream_t stream) {
  static int grid = 0;
  if (grid == 0) {
    if (n_in != 33 || ws_size < WS_END) {
      fprintf(stderr, "kernel_launch: need 33 inputs and %zu bytes ws; got %d, %zu\n", (size_t)WS_END, n_in, ws_size);
      grid = -1;
      return;
    }
    int dev = 0, cus = 0, per_cu = 0;
    hipGetDevice(&dev);
    hipDeviceGetAttribute(&cus, hipDeviceAttributeMultiprocessorCount, dev);
    if (hipFuncSetAttribute((const void*)mega, hipFuncAttributeMaxDynamicSharedMemorySize, LDS_BYTES) != hipSuccess) {
      fprintf(stderr, "kernel_launch: hipFuncSetAttribute failed\n");
      grid = -1;
      return;
    }
    hipOccupancyMaxActiveBlocksPerMultiprocessor(&per_cu, (const void*)mega, 256, LDS_BYTES);
    if (per_cu < 1) per_cu = 1;
    if (per_cu > 2) per_cu = 2;
    grid = cus * per_cu;
    fprintf(stderr, "kernel_launch: cus %d per_cu %d grid %d\n", cus, per_cu, grid);
  }
  if (grid < 0) return;
  Params p{};
  for (int i = 0; i < 33; ++i) p.in[i] = (const float*)d_in[i];
  p.out = (float*)d_out;
  p.ws = (unsigned char*)d_ws;
#if COOP
  int lo = 0, hi = NPHASE;
  void* args[] = {&p, &lo, &hi};
  hipError_t e = hipLaunchCooperativeKernel((const void*)mega, dim3(grid), dim3(256), args, LDS_BYTES, stream);
  if (e != hipSuccess) fprintf(stderr, "cooperative launch failed: %s (grid %d)\n", hipGetErrorString(e), grid);
#else
  for (int ph = 0; ph < NPHASE; ++ph) {
    hipLaunchKernelGGL(mega, dim3(grid), dim3(256), LDS_BYTES, stream, p, ph, ph + 1);
  }
#endif
}
```

```cpp
#include <hip/hip_runtime.h>
#include <hip/hip_cooperative_groups.h>
#include <cstdio>
namespace cg = cooperative_groups;

#ifndef COOP
#define COOP 1
#endif

typedef unsigned short u16;
typedef unsigned int u32;
using bf16x8 = __attribute__((ext_vector_type(8))) short;
using f32x4 = __attribute__((ext_vector_type(4))) float;
typedef float f2 __attribute__((ext_vector_type(2)));

#define DEVI __device__ __forceinline__

constexpr int TS = 32768;
constexpr float ALPHA = 1.41421356237309515f;
constexpr float LN_EPS = 1e-5f;
constexpr size_t MBy = 1ull << 20;

constexpr size_t OFF_WS5IN = 0;
constexpr size_t OFF_WGLU = 2 * MBy;
constexpr size_t OFF_WRGIN = 6 * MBy;
constexpr size_t OFF_WGATES = 10 * MBy;
constexpr size_t OFF_WRGOUT = 12 * MBy;
constexpr size_t OFF_WQ = 14 * MBy;
constexpr size_t OFF_SK = 22 * MBy;
constexpr size_t OFF_WPROJ = 23 * MBy;
constexpr size_t OFF_WPG = 24 * MBy;
constexpr size_t OFF_UB = 28 * MBy;
constexpr size_t OFF_VB = 60 * MBy;
constexpr size_t OFF_UB8 = OFF_UB;
constexpr size_t OFF_VB8 = OFF_UB + 16 * MBy;
constexpr size_t OFF_SCL = OFF_UB + 32 * MBy;
constexpr size_t OFF_ACT = 92 * MBy;
constexpr size_t OFF_XB = OFF_ACT;
constexpr size_t OFF_KEYS = OFF_ACT + 64 * MBy;
constexpr size_t OFF_IDX = OFF_ACT + 96 * MBy;
constexpr size_t OFF_GATE = OFF_ACT + 112 * MBy;
constexpr size_t OFF_SU = OFF_ACT + 128 * MBy;
constexpr size_t OFF_AP = OFF_ACT;
constexpr size_t OFF_HLOC = OFF_ACT + 104 * MBy;
constexpr size_t OFF_HB = OFF_ACT + 192 * MBy;
constexpr size_t OFF_GG = OFF_ACT;
constexpr size_t OFF_R = OFF_ACT + 64 * MBy;
constexpr size_t OFF_C = OFF_ACT + 128 * MBy;
constexpr size_t OFF_AB = OFF_ACT + 192 * MBy;
constexpr size_t OFF_AGG = OFF_ACT + 448 * MBy;
constexpr size_t OFF_CAR = OFF_ACT + 464 * MBy;
constexpr size_t OFF_BT1 = OFF_ACT + 472 * MBy;
constexpr size_t OFF_WST = OFF_BT1 + 48 * MBy;
constexpr size_t OFF_KTAB = OFF_WST + 16 * MBy;
constexpr size_t OFF_POW = OFF_KTAB + 4 * MBy;
constexpr size_t OFF_BBAR = OFF_POW + 3 * MBy;
constexpr size_t WS_END = OFF_BBAR + 1 * MBy;

constexpr int LDS_BYTES = 36864 + 32768;

struct Params {
  const float* in[33];
  float* out;
  unsigned char* ws;
};

DEVI u16 f2bf(float f) {
  u32 u = __float_as_uint(f);
  u += 0x7FFFu + ((u >> 16) & 1u);
  return (u16)(u >> 16);
}
DEVI float bf2f(u16 h) { return __uint_as_float(((u32)h) << 16); }
DEVI u32 pack2(float lo, float hi) { return (u32)f2bf(lo) | ((u32)f2bf(hi) << 16); }
DEVI float bflo(u32 w) { return __uint_as_float(w << 16); }
DEVI float bfhi(u32 w) { return __uint_as_float(w & 0xffff0000u); }
DEVI float sigmoid_(float x) { return 1.f / (1.f + __expf(-x)); }
DEVI float gelu_(float x) {
  float z = 0.7978845608028654f * (x + 0.044715f * x * x * x);
  return x / (1.f + __expf(-2.f * z));
}
DEVI float softplus_(float x) { return fmaxf(x, 0.f) + log1pf(__expf(-fabsf(x))); }
DEVI void unpack8(const uint4& w, float* f) {
  f[0] = bflo(w.x); f[1] = bfhi(w.x); f[2] = bflo(w.y); f[3] = bfhi(w.y);
  f[4] = bflo(w.z); f[5] = bfhi(w.z); f[6] = bflo(w.w); f[7] = bfhi(w.w);
}
DEVI uint4 pack8(const float* f) {
  uint4 o; o.x = pack2(f[0], f[1]); o.y = pack2(f[2], f[3]); o.z = pack2(f[4], f[5]); o.w = pack2(f[6], f[7]);
  return o;
}

struct LdBF {
  const u16* base; int ld;
  typedef uint4 Raw;
  DEVI Raw load(int row, int k) const { return *reinterpret_cast<const uint4*>(base + (size_t)row * ld + k); }
  DEVI static uint4 cvt(const Raw& r) { return r; }
};
struct RawF { float4 a, b; };
struct LdF32 {
  const float* base; int ld;
  typedef RawF Raw;
  DEVI Raw load(int row, int k) const {
    const float4* q = reinterpret_cast<const float4*>(base + (size_t)row * ld + k);
    RawF r; r.a = q[0]; r.b = q[1]; return r;
  }
  DEVI static uint4 cvt(const Raw& r) {
    uint4 o; o.x = pack2(r.a.x, r.a.y); o.y = pack2(r.a.z, r.a.w); o.z = pack2(r.b.x, r.b.y); o.w = pack2(r.b.z, r.b.w);
    return o;
  }
};

template <class AL, class BL, class EP>
DEVI void gemm_tile(const AL al, const BL bl, const int K, unsigned char* smem, EP ep) {
  u16* As = reinterpret_cast<u16*>(smem);
  u16* Bs = As + 128 * 72;
  const int tid = threadIdx.x, lane = tid & 63, wave = tid >> 6, wm = wave >> 1, wn = wave & 1;
  const int lr = lane & 15, lq = lane >> 4;
  f32x4 acc[4][4];
#pragma unroll
  for (int i = 0; i < 4; ++i)
#pragma unroll
    for (int j = 0; j < 4; ++j) acc[i][j] = f32x4{0.f, 0.f, 0.f, 0.f};
  typename AL::Raw ra[4];
  typename BL::Raw rb[4];
  const int prow = tid >> 3, pk = (tid & 7) * 8;
#pragma unroll
  for (int i = 0; i < 4; ++i) { ra[i] = al.load(prow + i * 32, pk); rb[i] = bl.load(prow + i * 32, pk); }
  for (int kt = 0; kt < K; kt += 64) {
    __syncthreads();
#pragma unroll
    for (int i = 0; i < 4; ++i) {
      *reinterpret_cast<uint4*>(As + (prow + i * 32) * 72 + pk) = AL::cvt(ra[i]);
      *reinterpret_cast<uint4*>(Bs + (prow + i * 32) * 72 + pk) = BL::cvt(rb[i]);
    }
    __syncthreads();
    if (kt + 64 < K) {
#pragma unroll
      for (int i = 0; i < 4; ++i) { ra[i] = al.load(prow + i * 32, kt + 64 + pk); rb[i] = bl.load(prow + i * 32, kt + 64 + pk); }
    }
#pragma unroll
    for (int ks = 0; ks < 2; ++ks) {
      bf16x8 af[4], bfr[4];
#pragma unroll
      for (int i = 0; i < 4; ++i) af[i] = *reinterpret_cast<const bf16x8*>(As + (wm * 64 + i * 16 + lr) * 72 + ks * 32 + lq * 8);
#pragma unroll
      for (int j = 0; j < 4; ++j) bfr[j] = *reinterpret_cast<const bf16x8*>(Bs + (wn * 64 + j * 16 + lr) * 72 + ks * 32 + lq * 8);
#pragma unroll
      for (int i = 0; i < 4; ++i)
#pragma unroll
        for (int j = 0; j < 4; ++j) acc[i][j] = __builtin_amdgcn_mfma_f32_16x16x32_bf16(af[i], bfr[j], acc[i][j], 0, 0, 0);
    }
  }
  __syncthreads();
  ep(acc);
}

template <int PERM>
DEVI void cvt_wt(const float* W, int K, int N, u16* out, int a0, int a1) {
  const int gsz = gridDim.x * 256, gtid = blockIdx.x * 256 + threadIdx.x;
  const int total = N * (K >> 3);
  for (int i = gtid; i < total; i += gsz) {
    const int n = i % N, kv = i / N;
    float v[8];
#pragma unroll
    for (int j = 0; j < 8; ++j) v[j] = W[(size_t)(kv * 8 + j) * N + n];
    int np = n;
    if (PERM == 1) { const int g = n >> 10, o = n & 1023; np = (o >> 4) * 32 + g * 16 + (o & 15); }
    if (PERM == 2) { np = a0 * 512 + (n >> 4) * 32 + a1 * 16 + (n & 15); }
    *reinterpret_cast<uint4*>(out + (size_t)np * K + kv * 8) = pack8(v);
  }
}

DEVI void cvt_plain(const float* src, u16* dst, size_t n8) {
  const size_t gsz = (size_t)gridDim.x * 256, gtid = (size_t)blockIdx.x * 256 + threadIdx.x;
  for (size_t i = gtid; i < n8; i += gsz) {
    const float4* q = reinterpret_cast<const float4*>(src + i * 8);
    float4 a = q[0], b = q[1];
    uint4 o; o.x = pack2(a.x, a.y); o.y = pack2(a.z, a.w); o.z = pack2(b.x, b.y); o.w = pack2(b.z, b.w);
    *reinterpret_cast<uint4*>(dst + i * 8) = o;
  }
}

DEVI void phase_setup(const Params& p) {
  unsigned char* ws = p.ws;
  cvt_wt<0>(p.in[4], 1024, 1024, (u16*)(ws + OFF_WS5IN), 0, 0);
  cvt_wt<1>(p.in[13], 1024, 2048, (u16*)(ws + OFF_WGLU), 0, 0);
  cvt_wt<0>(p.in[14], 1024, 2048, (u16*)(ws + OFF_WRGIN), 0, 0);
  for (int d = 0; d < 2; ++d)
    for (int gate = 0; gate < 2; ++gate)
      for (int h = 0; h < 4; ++h)
        cvt_wt<2>((gate ? p.in[19] : p.in[17]) + (size_t)(d * 4 + h) * 65536, 256, 256,
                  (u16*)(ws + OFF_WGATES) + (size_t)h * 1024 * 256, d, gate);
  cvt_wt<0>(p.in[22], 1024, 1024, (u16*)(ws + OFF_WRGOUT), 0, 0);
  for (int l = 0; l < 2; ++l) {
    cvt_wt<0>(p.in[27] + (size_t)l * 1024 * 2048, 1024, 2048, (u16*)(ws + OFF_WQ) + (size_t)l * 2048 * 1024, 0, 0);
    cvt_wt<0>(p.in[31] + (size_t)l * 256 * 1024, 256, 1024, (u16*)(ws + OFF_WPROJ) + (size_t)l * 1024 * 256, 0, 0);
    cvt_wt<0>(p.in[32] + (size_t)l * 1024 * 1024, 1024, 1024, (u16*)(ws + OFF_WPG) + (size_t)l * 1024 * 1024, 0, 0);
  }
  cvt_plain(p.in[28], (u16*)(ws + OFF_SK), 65536 / 8);
  const int gsz = gridDim.x * 256, gtid = blockIdx.x * 256 + threadIdx.x;
  float2* POW = (float2*)(ws + OFF_POW);
  float2* BBAR = (float2*)(ws + OFF_BBAR);
  for (int i = gtid; i < 2 * 64 * 33 * 64; i += gsz) {
    const int pp = i & 63, n = (i >> 6) % 33, dg = i / (64 * 33);
    const float step = expf(p.in[7][dg]);
    const float lr_ = p.in[5][dg * 64 + pp], li_ = p.in[6][dg * 64 + pp];
    const float mag = expf((float)n * (lr_ * step)), ang = (float)n * (li_ * step);
    POW[i] = float2{mag * cosf(ang), mag * sinf(ang)};
  }
  for (int i = gtid; i < 2 * 64 * 64; i += gsz) {
    const int dg = i >> 6;
    const float step = expf(p.in[7][dg]);
    const float lr_ = p.in[5][i], li_ = p.in[6][i];
    const float mag = expf(lr_ * step), ang = li_ * step;
    const float ar = mag * cosf(ang), ai = mag * sinf(ang);
    const float den = lr_ * lr_ + li_ * li_;
    const float zr = ar - 1.f;
    const float qr = (zr * lr_ + ai * li_) / den, qi = (ai * lr_ - zr * li_) / den;
#pragma unroll
    for (int c = 0; c < 16; ++c) {
      const float br = p.in[8][(size_t)i * 16 + c], bi = p.in[9][(size_t)i * 16 + c];
      BBAR[(size_t)i * 16 + c] = float2{qr * br - qi * bi, qr * bi + qi * br};
    }
  }
}

DEVI float s5_kterm(const Params& p, const float2* POW, const float2* BBAR, int d, int g, int n, int c, int cp) {
  const int dg = d * 64 + g;
  const float* cr = p.in[10] + ((size_t)dg * 16 + c) * 64;
  const float* ci = p.in[11] + ((size_t)dg * 16 + c) * 64;
  const float2* E = POW + ((size_t)dg * 33 + n) * 64;
  const float2* BB = BBAR + (size_t)dg * 64 * 16 + cp;
  float s = 0.f;
#pragma unroll 8
  for (int pp = 0; pp < 64; ++pp) {
    const float2 e = E[pp], bb = BB[pp * 16];
    const float Cr = cr[pp], Ci = ci[pp];
    const float cer = Cr * e.x - Ci * e.y, cei = Cr * e.y + Ci * e.x;
    s += cer * bb.x - cei * bb.y;
  }
  return s;
}

DEVI void phase_setup2(const Params& p) {
  unsigned char* ws = p.ws;
  const int gsz = gridDim.x * 256, gtid = blockIdx.x * 256 + threadIdx.x;
  const float2* POW = (const float2*)(ws + OFF_POW);
  const float2* BBAR = (const float2*)(ws + OFF_BBAR);
  float* KTAB = (float*)(ws + OFF_KTAB);
  u16* WST = (u16*)(ws + OFF_WST);
  u16* BT1 = (u16*)(ws + OFF_BT1);
  for (int i = gtid; i < 64 * 63 * 256; i += gsz) {
    const int cp = i & 15, c = (i >> 4) & 15, ti = (i >> 8) % 63, g = i / (63 * 256);
    const int tau = ti - 31;
    float s = 0.f;
    if (tau >= 0) s += s5_kterm(p, POW, BBAR, 0, g, tau, c, cp);
    if (tau <= 0) s += s5_kterm(p, POW, BBAR, 1, g, -tau, c, cp);
    KTAB[i] = s;
  }
  for (int i = gtid; i < 64 * 256 * 64; i += gsz) {
    const int kv = i & 63, np = (i >> 6) & 255, g = i >> 14;
    const int d = np >> 7, ri = (np >> 6) & 1, pp = np & 63, s = kv >> 1, c0 = (kv & 1) * 8;
    const int npow = d ? s : 31 - s;
    const float2 e = POW[((size_t)(d * 64 + g) * 33 + npow) * 64 + pp];
    float v[8];
#pragma unroll
    for (int j = 0; j < 8; ++j) {
      const float2 bb = BBAR[((size_t)(d * 64 + g) * 64 + pp) * 16 + c0 + j];
      v[j] = ri ? (e.x * bb.y + e.y * bb.x) : (e.x * bb.x - e.y * bb.y);
    }
    *reinterpret_cast<uint4*>(WST + ((size_t)g * 256 + np) * 512 + kv * 8) = pack8(v);
  }
  for (int i = gtid; i < 64 * 512 * 32; i += gsz) {
    const int kv = i & 31, n = (i >> 5) & 511, g = i >> 14;
    const int t = n >> 4, c = n & 15, kk0 = kv * 8;
    const int d = kk0 >> 7, ri = (kk0 >> 6) & 1, p0 = kk0 & 63;
    const int npow = d ? 32 - t : t + 1;
    const int dg = d * 64 + g;
    float v[8];
#pragma unroll
    for (int j = 0; j < 8; ++j) {
      const int pp = p0 + j;
      const float Cr = p.in[10][((size_t)dg * 16 + c) * 64 + pp], Ci = p.in[11][((size_t)dg * 16 + c) * 64 + pp];
      const float2 e = POW[((size_t)dg * 33 + npow) * 64 + pp];
      v[j] = ri ? -(Cr * e.y + Ci * e.x) : (Cr * e.x - Ci * e.y);
    }
    *reinterpret_cast<uint4*>(BT1 + ((size_t)g * 512 + n) * 768 + 512 + kv * 8) = pack8(v);
  }
}

DEVI void phase_setup3(const Params& p) {
  const int gsz = gridDim.x * 256, gtid = blockIdx.x * 256 + threadIdx.x;
  const float* KTAB = (const float*)(p.ws + OFF_KTAB);
  u16* BT1 = (u16*)(p.ws + OFF_BT1);
  for (int i = gtid; i < 64 * 512 * 64; i += gsz) {
    const int kv = i & 63, n = (i >> 6) & 511, g = i >> 15;
    const int t = n >> 4, c = n & 15, s = kv >> 1, c0 = (kv & 1) * 8;
    const float* src = KTAB + (((size_t)g * 63 + (t - s + 31)) * 16 + c) * 16 + c0;
    float v[8];
#pragma unroll
    for (int j = 0; j < 8; ++j) v[j] = src[j];
    *reinterpret_cast<uint4*>(BT1 + ((size_t)g * 512 + n) * 768 + kv * 8) = pack8(v);
  }
}

DEVI void phase_s5_in(const Params& p, int s, unsigned char* smem) {
  const float* X = p.in[s];
  const u16* Wt = (const u16*)(p.ws + OFF_WS5IN);
  u16* AP = (u16*)(p.ws + OFF_AP);
  const int lane = threadIdx.x & 63, wave = threadIdx.x >> 6, wm = wave >> 1, wn = wave & 1;
  for (int tile = blockIdx.x; tile < 256 * 8; tile += gridDim.x) {
    const int m0 = (tile >> 3) * 128, n0 = (tile & 7) * 128;
    LdF32 al{X + (size_t)m0 * 1024, 1024};
    LdBF bl{Wt + (size_t)n0 * 1024, 1024};
    gemm_tile(al, bl, 1024, smem, [&](f32x4 (&acc)[4][4]) {
#pragma unroll
      for (int i = 0; i < 4; ++i)
#pragma unroll
        for (int j = 0; j < 4; ++j)
#pragma unroll
          for (int r = 0; r < 4; ++r) {
            const int row = m0 + wm * 64 + i * 16 + (lane >> 4) * 4 + r;
            const int col = n0 + wn * 64 + j * 16 + (lane & 15);
            AP[((size_t)(col >> 4) * 1024 + (row >> 5)) * 768 + (row & 31) * 16 + (col & 15)] = f2bf(acc[i][j][r]);
          }
    });
  }
}

DEVI void phase_s5_state(const Params& p, unsigned char* smem) {
  const u16* AP = (const u16*)(p.ws + OFF_AP);
  const u16* WST = (const u16*)(p.ws + OFF_WST);
  float* HLOC = (float*)(p.ws + OFF_HLOC);
  const int lane = threadIdx.x & 63, wave = threadIdx.x >> 6, wm = wave >> 1, wn = wave & 1;
  for (int tile = blockIdx.x; tile < 64 * 16; tile += gridDim.x) {
    const int g = tile >> 4, m0 = ((tile >> 1) & 7) * 128, n0 = (tile & 1) * 128;
    LdBF al{AP + ((size_t)g * 1024 + m0) * 768, 768};
    LdBF bl{WST + ((size_t)g * 256 + n0) * 512, 512};
    gemm_tile(al, bl, 512, smem, [&](f32x4 (&acc)[4][4]) {
#pragma unroll
      for (int i = 0; i < 4; ++i)
#pragma unroll
        for (int j = 0; j < 4; ++j)
#pragma unroll
          for (int r = 0; r < 4; ++r) {
            const int row = m0 + wm * 64 + i * 16 + (lane >> 4) * 4 + r;
            const int col = n0 + wn * 64 + j * 16 + (lane & 15);
            HLOC[((size_t)g * 1024 + row) * 256 + col] = acc[i][j][r];
          }
    });
  }
}

DEVI void phase_s5_cscan(const Params& p, int s) {
  const int L = s ? 2048 : 4096;
  const int nseq = TS / L, nch = L / 32;
  u16* AP = (u16*)(p.ws + OFF_AP);
  const float* HLOC = (const float*)(p.ws + OFF_HLOC);
  const float2* POW = (const float2*)(p.ws + OFF_POW);
  const int gsz = gridDim.x * 256, gtid = blockIdx.x * 256 + threadIdx.x;
  for (int i = gtid; i < 64 * nseq * 128; i += gsz) {
    const int pp = i & 63, d = (i >> 6) & 1, g = (i >> 7) & 63, seq = i >> 13;
    const float2 e = POW[((size_t)(d * 64 + g) * 33 + 32) * 64 + pp];
    float Hr = 0.f, Hi = 0.f;
#pragma unroll 4
    for (int j = 0; j < nch; ++j) {
      const int chunk = seq * nch + (d ? (nch - 1 - j) : j);
      u16* ap = AP + ((size_t)g * 1024 + chunk) * 768 + 512 + d * 128 + pp;
      ap[0] = f2bf(Hr);
      ap[64] = f2bf(Hi);
      const float* hl = HLOC + ((size_t)g * 1024 + chunk) * 256 + d * 128 + pp;
      const float a = hl[0], b = hl[64];
      const float nHr = e.x * Hr - e.y * Hi + a;
      const float nHi = e.x * Hi + e.y * Hr + b;
      Hr = nHr; Hi = nHi;
    }
  }
}

DEVI void phase_s5_main(const Params& p, unsigned char* smem) {
  const u16* AP = (const u16*)(p.ws + OFF_AP);
  const u16* BT1 = (const u16*)(p.ws + OFF_BT1);
  u16* HB = (u16*)(p.ws + OFF_HB);
  const float* dsk = p.in[12];
  const int lane = threadIdx.x & 63, wave = threadIdx.x >> 6, wm = wave >> 1, wn = wave & 1;
  for (int tile = blockIdx.x; tile < 64 * 32; tile += gridDim.x) {
    const int g = tile >> 5, m0 = ((tile >> 2) & 7) * 128, n0 = (tile & 3) * 128;
    LdBF al{AP + ((size_t)g * 1024 + m0) * 768, 768};
    LdBF bl{BT1 + ((size_t)g * 512 + n0) * 768, 768};
    gemm_tile(al, bl, 768, smem, [&](f32x4 (&acc)[4][4]) {
      const float dv = dsk[g * 16 + (lane & 15)];
#pragma unroll
      for (int i = 0; i < 4; ++i)
#pragma unroll
        for (int j = 0; j < 4; ++j)
#pragma unroll
          for (int r = 0; r < 4; ++r) {
            const int chunk = m0 + wm * 64 + i * 16 + (lane >> 4) * 4 + r;
            const int n = n0 + wn * 64 + j * 16 + (lane & 15);
            const float u = bf2f(AP[((size_t)g * 1024 + chunk) * 768 + n]);
            const float y = acc[i][j][r] + dv * u;
            HB[((size_t)chunk * 32 + (n >> 4)) * 1024 + g * 16 + (lane & 15)] = f2bf(gelu_(y));
          }
    });
  }
}

DEVI void phase_s5_glu(const Params& p, int s, unsigned char* smem) {
  const u16* HB = (const u16*)(p.ws + OFF_HB);
  const u16* Wt = (const u16*)(p.ws + OFF_WGLU);
  const float* Xin = p.in[s];
  float* Xo = p.out + (size_t)s * TS * 1024;
  const int lane = threadIdx.x & 63, wave = threadIdx.x >> 6, wm = wave >> 1, wn = wave & 1;
  for (int tile = blockIdx.x; tile < 256 * 16; tile += gridDim.x) {
    const int m0 = (tile >> 4) * 128, n0 = (tile & 15) * 128;
    LdBF al{HB + (size_t)m0 * 1024, 1024};
    LdBF bl{Wt + (size_t)n0 * 1024, 1024};
    gemm_tile(al, bl, 1024, smem, [&](f32x4 (&acc)[4][4]) {
#pragma unroll
      for (int i = 0; i < 4; ++i)
#pragma unroll
        for (int jj = 0; jj < 4; jj += 2)
#pragma unroll
          for (int r = 0; r < 4; ++r) {
            const int row = m0 + wm * 64 + i * 16 + (lane >> 4) * 4 + r;
            const int nb = n0 + wn * 64 + jj * 16;
            const int o = (nb >> 5) * 16 + (lane & 15);
            const float mix = acc[i][jj][r] * sigmoid_(acc[i][jj + 1][r]);
            const size_t idx = (size_t)row * 1024 + o;
            Xo[idx] = ALPHA * Xin[idx] + mix;
          }
    });
  }
}

DEVI void phase_ln1_tables(const Params& p, int s, int layer) {
  float* X = p.out + (size_t)s * TS * 1024;
  u16* XB = (u16*)(p.ws + OFF_XB);
  const float* gam = p.in[23] + layer * 1024;
  const float* bet = p.in[24] + layer * 1024;
  const int lane = threadIdx.x & 63, wave = threadIdx.x >> 6;
  for (int t = blockIdx.x * 4 + wave; t < TS; t += gridDim.x * 4) {
    float4 v[4];
#pragma unroll
    for (int i = 0; i < 4; ++i) v[i] = *reinterpret_cast<const float4*>(X + (size_t)t * 1024 + i * 256 + lane * 4);
    float sm = 0.f;
#pragma unroll
    for (int i = 0; i < 4; ++i) sm += v[i].x + v[i].y + v[i].z + v[i].w;
#pragma unroll
    for (int m = 32; m >= 1; m >>= 1) sm += __shfl_xor(sm, m);
    const float mu = sm * (1.f / 1024.f);
    float sq = 0.f;
#pragma unroll
    for (int i = 0; i < 4; ++i) {
      const float a = v[i].x - mu, b = v[i].y - mu, c = v[i].z - mu, d = v[i].w - mu;
      sq += a * a + b * b + c * c + d * d;
    }
#pragma unroll
    for (int m = 32; m >= 1; m >>= 1) sq += __shfl_xor(sq, m);
    const float rs = rsqrtf(sq * (1.f / 1024.f) + LN_EPS);
#pragma unroll
    for (int i = 0; i < 4; ++i) {
      const int c0 = i * 256 + lane * 4;
      const float4 g4 = *reinterpret_cast<const float4*>(gam + c0);
      const float4 b4 = *reinterpret_cast<const float4*>(bet + c0);
      float4 o;
      o.x = (v[i].x - mu) * rs * g4.x + b4.x; o.y = (v[i].y - mu) * rs * g4.y + b4.y;
      o.z = (v[i].z - mu) * rs * g4.z + b4.z; o.w = (v[i].w - mu) * rs * g4.w + b4.w;
      *reinterpret_cast<float4*>(X + (size_t)t * 1024 + c0) = o;
      uint2 pk; pk.x = pack2(o.x, o.y); pk.y = pack2(o.z, o.w);
      *reinterpret_cast<uint2*>(XB + (size_t)t * 1024 + c0) = pk;
    }
  }
  float* SCL = (float*)(p.ws + OFF_SCL);
  for (int r = blockIdx.x * 4 + wave; r < 32768; r += gridDim.x * 4) {
    const int tab = r >> 14, row = r & 16383;
    const float4* sp = reinterpret_cast<const float4*>(p.in[29 + tab] + ((size_t)layer * 16384 + row) * 1024 + lane * 16);
    const float4 a = sp[0], b = sp[1], c = sp[2], d = sp[3];
    float am = fmaxf(fmaxf(fmaxf(fabsf(a.x), fabsf(a.y)), fmaxf(fabsf(a.z), fabsf(a.w))),
                     fmaxf(fmaxf(fabsf(b.x), fabsf(b.y)), fmaxf(fabsf(b.z), fabsf(b.w))));
    am = fmaxf(am, fmaxf(fmaxf(fmaxf(fabsf(c.x), fabsf(c.y)), fmaxf(fabsf(c.z), fabsf(c.w))),
                         fmaxf(fmaxf(fabsf(d.x), fabsf(d.y)), fmaxf(fabsf(d.z), fabsf(d.w)))));
#pragma unroll
    for (int m = 32; m >= 1; m >>= 1) am = fmaxf(am, __shfl_xor(am, m));
    const float sc = am > 0.f ? 224.f / am : 1.f;
    const float inv = am > 0.f ? am * (1.f / 224.f) : 1.f;
    uint4 o;
    int w = 0;
    w = __builtin_amdgcn_cvt_pk_fp8_f32(a.x * sc, a.y * sc, w, false); w = __builtin_amdgcn_cvt_pk_fp8_f32(a.z * sc, a.w * sc, w, true); o.x = (u32)w;
    w = __builtin_amdgcn_cvt_pk_fp8_f32(b.x * sc, b.y * sc, w, false); w = __builtin_amdgcn_cvt_pk_fp8_f32(b.z * sc, b.w * sc, w, true); o.y = (u32)w;
    w = __builtin_amdgcn_cvt_pk_fp8_f32(c.x * sc, c.y * sc, w, false); w = __builtin_amdgcn_cvt_pk_fp8_f32(c.z * sc, c.w * sc, w, true); o.z = (u32)w;
    w = __builtin_amdgcn_cvt_pk_fp8_f32(d.x * sc, d.y * sc, w, false); w = __builtin_amdgcn_cvt_pk_fp8_f32(d.z * sc, d.w * sc, w, true); o.w = (u32)w;
    *reinterpret_cast<uint4*>(p.ws + (tab ? OFF_VB8 : OFF_UB8) + (size_t)row * 1024 + lane * 16) = o;
    if (lane == 0) SCL[tab * 16384 + row] = inv;
  }
}

DEVI u32 enc_key(float s, int n) {
  u32 b = __float_as_uint(s);
  u32 srt = (b & 0x80000000u) ? ~b : (b | 0x80000000u);
  return (srt & ~127u) | (u32)(127 - n);
}
DEVI float dec_key(u32 key, int& n) {
  n = 127 - (int)(key & 127u);
  u32 srt = key & ~127u;
  u32 b = (srt & 0x80000000u) ? (srt & 0x7fffffffu) : ~srt;
  return __uint_as_float(b);
}

DEVI void phase_peer_q(const Params& p, int layer, unsigned char* smem) {
  const u16* XB = (const u16*)(p.ws + OFF_XB);
  const u16* Wt = (const u16*)(p.ws + OFF_WQ) + (size_t)layer * 2048 * 1024;
  const u16* SK = (const u16*)(p.ws + OFF_SK) + (size_t)layer * 2 * 128 * 128;
  u32* KEYS = (u32*)(p.ws + OFF_KEYS);
  const int tid = threadIdx.x, lane = tid & 63, wave = tid >> 6, wm = wave >> 1, wn = wave & 1;
  const int lr = lane & 15, lq = lane >> 4;
  u16* Qs = reinterpret_cast<u16*>(smem);
  u32* Sk = reinterpret_cast<u32*>(smem);
  for (int tile = blockIdx.x; tile < 256 * 16; tile += gridDim.x) {
    const int m0 = (tile >> 4) * 128, hc = tile & 15, n0 = hc * 128;
    const int c = hc & 1;
    LdBF al{XB + (size_t)m0 * 1024, 1024};
    LdBF bl{Wt + (size_t)n0 * 1024, 1024};
    gemm_tile(al, bl, 1024, smem, [&](f32x4 (&acc)[4][4]) {
#pragma unroll
      for (int i = 0; i < 4; ++i)
#pragma unroll
        for (int j = 0; j < 4; ++j)
#pragma unroll
          for (int r = 0; r < 4; ++r)
            Qs[(wm * 64 + i * 16 + lq * 4 + r) * 136 + wn * 64 + j * 16 + lr] = f2bf(acc[i][j][r]);
      __syncthreads();
      f32x4 sc[4][4];
#pragma unroll
      for (int i = 0; i < 4; ++i)
#pragma unroll
        for (int j = 0; j < 4; ++j) sc[i][j] = f32x4{0.f, 0.f, 0.f, 0.f};
      const u16* skc = SK + (size_t)c * 128 * 128;
#pragma unroll
      for (int ks = 0; ks < 4; ++ks) {
        bf16x8 af[4], bfr[4];
#pragma unroll
        for (int i = 0; i < 4; ++i) af[i] = *reinterpret_cast<const bf16x8*>(Qs + (wm * 64 + i * 16 + lr) * 136 + ks * 32 + lq * 8);
#pragma unroll
        for (int j = 0; j < 4; ++j) bfr[j] = *reinterpret_cast<const bf16x8*>(skc + (size_t)(wn * 64 + j * 16 + lr) * 128 + ks * 32 + lq * 8);
#pragma unroll
        for (int i = 0; i < 4; ++i)
#pragma unroll
          for (int j = 0; j < 4; ++j) sc[i][j] = __builtin_amdgcn_mfma_f32_16x16x32_bf16(af[i], bfr[j], sc[i][j], 0, 0, 0);
      }
      __syncthreads();
#pragma unroll
      for (int i = 0; i < 4; ++i)
#pragma unroll
        for (int j = 0; j < 4; ++j)
#pragma unroll
          for (int r = 0; r < 4; ++r) {
            const int n = wn * 64 + j * 16 + lr;
            Sk[(wm * 64 + i * 16 + lq * 4 + r) * 129 + n] = enc_key(sc[i][j][r], n);
          }
      __syncthreads();
      if (tid < 128) {
        u32 top[16];
#pragma unroll
        for (int k = 0; k < 16; ++k) top[k] = 0u;
#pragma unroll 4
        for (int n = 0; n < 128; ++n) {
          u32 v = Sk[tid * 129 + n];
#pragma unroll
          for (int k = 0; k < 16; ++k) {
            const u32 hi = max(top[k], v);
            v = min(top[k], v);
            top[k] = hi;
          }
        }
        uint4* dst = reinterpret_cast<uint4*>(KEYS + ((size_t)(m0 + tid) * 16 + hc) * 16);
        dst[0] = uint4{top[0], top[1], top[2], top[3]};
        dst[1] = uint4{top[4], top[5], top[6], top[7]};
        dst[2] = uint4{top[8], top[9], top[10], top[11]};
        dst[3] = uint4{top[12], top[13], top[14], top[15]};
      }
    });
  }
}

DEVI void phase_peer_route(const Params& p) {
  const u32* KEYS = (const u32*)(p.ws + OFF_KEYS);
  int* IDX = (int*)(p.ws + OFF_IDX);
  float* GATE = (float*)(p.ws + OFF_GATE);
  float* SU = (float*)(p.ws + OFF_SU);
  const float* SCL = (const float*)(p.ws + OFF_SCL);
  const int gsz = gridDim.x * 256, gtid = blockIdx.x * 256 + threadIdx.x;
  for (int i = gtid; i < TS * 8; i += gsz) {
    const uint4* src = reinterpret_cast<const uint4*>(KEYS + (size_t)i * 32);
    u32 kk[32];
#pragma unroll
    for (int q = 0; q < 8; ++q) { const uint4 w = src[q]; kk[q * 4] = w.x; kk[q * 4 + 1] = w.y; kk[q * 4 + 2] = w.z; kk[q * 4 + 3] = w.w; }
    float s0[16], s1[16]; int i0[16], i1[16];
#pragma unroll
    for (int k = 0; k < 16; ++k) { s0[k] = dec_key(kk[k], i0[k]); s1[k] = dec_key(kk[16 + k], i1[k]); }
    float top[16];
#pragma unroll
    for (int k = 0; k < 16; ++k) top[k] = -3.0e38f;
#pragma unroll
    for (int k1 = 0; k1 < 16; ++k1)
#pragma unroll
      for (int k2 = 0; k2 < 16; ++k2)
        if ((k1 + 1) * (k2 + 1) <= 16) {
          float v = s0[k1] + s1[k2];
#pragma unroll
          for (int k = 0; k < 16; ++k) {
            const float hi = fmaxf(top[k], v);
            v = fminf(top[k], v);
            top[k] = hi;
          }
        }
    const float thr = top[15], mx = top[0];
    float den = 0.f;
#pragma unroll
    for (int k = 0; k < 16; ++k) den += __expf(top[k] - mx);
    const float inv = 1.f / den;
    int cnt = 0;
    int* idst = IDX + (size_t)i * 16;
    float* gdst = GATE + (size_t)i * 16;
    float* sdst = SU + (size_t)i * 16;
#pragma unroll
    for (int k1 = 0; k1 < 16; ++k1)
#pragma unroll
      for (int k2 = 0; k2 < 16; ++k2)
        if ((k1 + 1) * (k2 + 1) <= 16) {
          const float v = s0[k1] + s1[k2];
          if (v >= thr && cnt < 16) {
            const int e = i0[k1] * 128 + i1[k2];
            idst[cnt] = e;
            gdst[cnt] = __expf(v - mx) * inv * SCL[16384 + e];
            sdst[cnt] = SCL[e];
            ++cnt;
          }
        }
  }
}

DEVI f2 cvt8(u32 w, bool hi) { return hi ? __builtin_amdgcn_cvt_pk_f32_fp8((int)w, true) : __builtin_amdgcn_cvt_pk_f32_fp8((int)w, false); }

DEVI void phase_peer_gather(const Params& p, int s, int layer) {
  float* X = p.out + (size_t)s * TS * 1024;
  u16* XB = (u16*)(p.ws + OFF_XB);
  const unsigned char* Ub8 = p.ws + OFF_UB8;
  const unsigned char* Vb8 = p.ws + OFF_VB8;
  const int* IDX = (const int*)(p.ws + OFF_IDX);
  const float* GATE = (const float*)(p.ws + OFF_GATE);
  const float* SU = (const float*)(p.ws + OFF_SU);
  const float* gam = p.in[25] + layer * 1024;
  const float* bet = p.in[26] + layer * 1024;
  const int lane = threadIdx.x & 63, wave = threadIdx.x >> 6;
  const bool b5 = lane & 32, b4 = lane & 16, b3 = lane & 8;
  for (int t = blockIdx.x * 4 + wave; t < TS; t += gridDim.x * 4) {
    f2 x[8], o[8];
    {
      const float4* xp = reinterpret_cast<const float4*>(X + (size_t)t * 1024 + lane * 16);
      const float4 a = xp[0], b = xp[1], c = xp[2], d = xp[3];
      x[0] = f2{a.x, a.y}; x[1] = f2{a.z, a.w}; x[2] = f2{b.x, b.y}; x[3] = f2{b.z, b.w};
      x[4] = f2{c.x, c.y}; x[5] = f2{c.z, c.w}; x[6] = f2{d.x, d.y}; x[7] = f2{d.z, d.w};
    }
#pragma unroll
    for (int k = 0; k < 8; ++k) o[k] = f2{0.f, 0.f};
    const int iv0 = IDX[(size_t)t * 128 + lane], iv1 = IDX[(size_t)t * 128 + 64 + lane];
    const float gv0 = GATE[(size_t)t * 128 + lane], gv1 = GATE[(size_t)t * 128 + 64 + lane];
    const float su0 = SU[(size_t)t * 128 + lane], su1 = SU[(size_t)t * 128 + 64 + lane];
    for (int e0 = 0; e0 < 128; e0 += 8) {
      const bool lo = e0 < 64;
      const int ivs = lo ? iv0 : iv1;
      const float gvs = lo ? gv0 : gv1;
      const float sus = lo ? su0 : su1;
      uint4 uu[8], vv[8];
#pragma unroll
      for (int k = 0; k < 8; ++k) {
        const int ei = __builtin_amdgcn_readlane(ivs, (e0 & 63) + k);
        uu[k] = *reinterpret_cast<const uint4*>(Ub8 + (size_t)ei * 1024 + lane * 16);
        vv[k] = *reinterpret_cast<const uint4*>(Vb8 + (size_t)ei * 1024 + lane * 16);
      }
      float dk[8];
#pragma unroll
      for (int k = 0; k < 8; ++k) {
        f2 acc = cvt8(uu[k].x, false) * x[0];
        acc = cvt8(uu[k].x, true) * x[1] + acc;
        acc = cvt8(uu[k].y, false) * x[2] + acc;
        acc = cvt8(uu[k].y, true) * x[3] + acc;
        acc = cvt8(uu[k].z, false) * x[4] + acc;
        acc = cvt8(uu[k].z, true) * x[5] + acc;
        acc = cvt8(uu[k].w, false) * x[6] + acc;
        acc = cvt8(uu[k].w, true) * x[7] + acc;
        dk[k] = acc.x + acc.y;
      }
      float d4[4], d2[2], d1;
#pragma unroll
      for (int k = 0; k < 4; ++k) {
        const float keep = b5 ? dk[k + 4] : dk[k], send = b5 ? dk[k] : dk[k + 4];
        d4[k] = keep + __shfl_xor(send, 32);
      }
#pragma unroll
      for (int k = 0; k < 2; ++k) {
        const float keep = b4 ? d4[k + 2] : d4[k], send = b4 ? d4[k] : d4[k + 2];
        d2[k] = keep + __shfl_xor(send, 16);
      }
      {
        const float keep = b3 ? d2[1] : d2[0], send = b3 ? d2[0] : d2[1];
        d1 = keep + __shfl_xor(send, 8);
      }
      d1 += __shfl_xor(d1, 4);
      d1 += __shfl_xor(d1, 2);
      d1 += __shfl_xor(d1, 1);
      const int srcl = (e0 & 63) + (lane >> 3);
      const float suv = __shfl(sus, srcl), gvv = __shfl(gvs, srcl);
      const float w = gvv * gelu_(d1 * suv);
      const int wi = __float_as_int(w);
#pragma unroll
      for (int k = 0; k < 8; ++k) {
        const float wk = __int_as_float(__builtin_amdgcn_readlane(wi, k * 8));
        const f2 w2 = f2{wk, wk};
        o[0] = w2 * cvt8(vv[k].x, false) + o[0];
        o[1] = w2 * cvt8(vv[k].x, true) + o[1];
        o[2] = w2 * cvt8(vv[k].y, false) + o[2];
        o[3] = w2 * cvt8(vv[k].y, true) + o[3];
        o[4] = w2 * cvt8(vv[k].z, false) + o[4];
        o[5] = w2 * cvt8(vv[k].z, true) + o[5];
        o[6] = w2 * cvt8(vv[k].w, false) + o[6];
        o[7] = w2 * cvt8(vv[k].w, true) + o[7];
      }
    }
    float sm = 0.f;
#pragma unroll
    for (int k = 0; k < 8; ++k) { o[k] = ALPHA * x[k] + o[k]; sm += o[k].x + o[k].y; }
#pragma unroll
    for (int m = 32; m >= 1; m >>= 1) sm += __shfl_xor(sm, m);
    const float mu = sm * (1.f / 1024.f);
    float sq = 0.f;
#pragma unroll
    for (int k = 0; k < 8; ++k) { const float da = o[k].x - mu, db = o[k].y - mu; sq += da * da + db * db; }
#pragma unroll
    for (int m = 32; m >= 1; m >>= 1) sq += __shfl_xor(sq, m);
    const float rs = rsqrtf(sq * (1.f / 1024.f) + LN_EPS);
    const int c0 = lane * 16;
    float r[16];
#pragma unroll
    for (int k = 0; k < 8; ++k) {
      r[2 * k] = (o[k].x - mu) * rs * gam[c0 + 2 * k] + bet[c0 + 2 * k];
      r[2 * k + 1] = (o[k].y - mu) * rs * gam[c0 + 2 * k + 1] + bet[c0 + 2 * k + 1];
    }
    float4* dp = reinterpret_cast<float4*>(X + (size_t)t * 1024 + c0);
    dp[0] = float4{r[0], r[1], r[2], r[3]};
    dp[1] = float4{r[4], r[5], r[6], r[7]};
    dp[2] = float4{r[8], r[9], r[10], r[11]};
    dp[3] = float4{r[12], r[13], r[14], r[15]};
    uint4* bp = reinterpret_cast<uint4*>(XB + (size_t)t * 1024 + c0);
    bp[0] = pack8(r);
    bp[1] = pack8(r + 8);
  }
}

DEVI void phase_ple(const Params& p, int s, int layer, unsigned char* smem) {
  float* X = p.out + (size_t)s * TS * 1024;
  const u16* XB = (const u16*)(p.ws + OFF_XB);
  const float* P = p.in[2 + s] + (size_t)layer * TS * 256;
  const u16* Wp = (const u16*)(p.ws + OFF_WPROJ) + (size_t)layer * 1024 * 256;
  const u16* Wg = (const u16*)(p.ws + OFF_WPG) + (size_t)layer * 1024 * 1024;
  const int lane = threadIdx.x & 63, wave = threadIdx.x >> 6, wm = wave >> 1, wn = wave & 1;
  for (int tile = blockIdx.x; tile < 256 * 8; tile += gridDim.x) {
    const int m0 = (tile >> 3) * 128, n0 = (tile & 7) * 128;
    u32* pkl = reinterpret_cast<u32*>(smem + 36864) + threadIdx.x;
    {
      LdF32 al{P + (size_t)m0 * 256, 256};
      LdBF bl{Wp + (size_t)n0 * 256, 256};
      gemm_tile(al, bl, 256, smem, [&](f32x4 (&acc)[4][4]) {
#pragma unroll
        for (int i = 0; i < 4; ++i)
#pragma unroll
          for (int j = 0; j < 4; ++j) {
            pkl[((i * 4 + j) * 2 + 0) * 256] = pack2(acc[i][j][0], acc[i][j][1]);
            pkl[((i * 4 + j) * 2 + 1) * 256] = pack2(acc[i][j][2], acc[i][j][3]);
          }
      });
    }
    {
      LdBF al{XB + (size_t)m0 * 1024, 1024};
      LdBF bl{Wg + (size_t)n0 * 1024, 1024};
      gemm_tile(al, bl, 1024, smem, [&](f32x4 (&acc)[4][4]) {
#pragma unroll
        for (int i = 0; i < 4; ++i)
#pragma unroll
          for (int j = 0; j < 4; ++j)
#pragma unroll
            for (int r = 0; r < 4; ++r) {
              const int row = m0 + wm * 64 + i * 16 + (lane >> 4) * 4 + r;
              const int col = n0 + wn * 64 + j * 16 + (lane & 15);
              const u32 w = pkl[((i * 4 + j) * 2 + (r >> 1)) * 256];
              const float pv = (r & 1) ? bfhi(w) : bflo(w);
              const size_t idx = (size_t)row * 1024 + col;
              X[idx] = X[idx] + pv * sigmoid_(acc[i][j][r]);
            }
      });
    }
  }
}

DEVI void phase_rg_in(const Params& p, int s, unsigned char* smem) {
  const float* X = p.out + (size_t)s * TS * 1024;
  const u16* Wt = (const u16*)(p.ws + OFF_WRGIN);
  u16* GG = (u16*)(p.ws + OFF_GG);
  u16* R = (u16*)(p.ws + OFF_R);
  const int lane = threadIdx.x & 63, wave = threadIdx.x >> 6, wm = wave >> 1, wn = wave & 1;
  for (int tile = blockIdx.x; tile < 256 * 16; tile += gridDim.x) {
    const int m0 = (tile >> 4) * 128, n0 = (tile & 15) * 128;
    LdF32 al{X + (size_t)m0 * 1024, 1024};
    LdBF bl{Wt + (size_t)n0 * 1024, 1024};
    gemm_tile(al, bl, 1024, smem, [&](f32x4 (&acc)[4][4]) {
#pragma unroll
      for (int i = 0; i < 4; ++i)
#pragma unroll
        for (int j = 0; j < 4; ++j)
#pragma unroll
          for (int r = 0; r < 4; ++r) {
            const int row = m0 + wm * 64 + i * 16 + (lane >> 4) * 4 + r;
            const int col = n0 + wn * 64 + j * 16 + (lane & 15);
            if (n0 < 1024) GG[(size_t)row * 1024 + col] = f2bf(gelu_(acc[i][j][r]));
            else R[(size_t)row * 1024 + col - 1024] = f2bf(acc[i][j][r]);
          }
    });
  }
}

DEVI void phase_rg_conv(const Params& p, int s) {
  const int L = s ? 2048 : 4096;
  const u16* R = (const u16*)(p.ws + OFF_R);
  u16* C = (u16*)(p.ws + OFF_C);
  const float* cw = p.in[15];
  const float* cb = p.in[16];
  const int gsz = gridDim.x * 256, gtid = blockIdx.x * 256 + threadIdx.x;
  for (int i = gtid; i < TS * 128; i += gsz) {
    const int t = i >> 7, cv = (i & 127) * 8;
    const int pos = t & (L - 1);
    float acc[8];
#pragma unroll
    for (int j = 0; j < 8; ++j) acc[j] = cb[cv + j];
#pragma unroll
    for (int k = 0; k < 4; ++k) {
      const int pp = pos + k - 1;
      if (pp >= 0 && pp < L) {
        float rv[8];
        unpack8(*reinterpret_cast<const uint4*>(R + (size_t)(t + k - 1) * 1024 + cv), rv);
#pragma unroll
        for (int j = 0; j < 8; ++j) acc[j] = fmaf(rv[j], cw[k * 1024 + cv + j], acc[j]);
      }
    }
    *reinterpret_cast<uint4*>(C + (size_t)i * 8) = pack8(acc);
  }
}

DEVI void phase_rg_gates(const Params& p, unsigned char* smem) {
  const u16* C = (const u16*)(p.ws + OFF_C);
  const u16* Wt = (const u16*)(p.ws + OFF_WGATES);
  u32* AB = (u32*)(p.ws + OFF_AB);
  const float* ba = p.in[18];
  const float* bx = p.in[20];
  const float* lam = p.in[21];
  const int lane = threadIdx.x & 63, wave = threadIdx.x >> 6, wm = wave >> 1, wn = wave & 1;
  for (int tile = blockIdx.x; tile < 256 * 32; tile += gridDim.x) {
    const int m0 = (tile >> 5) * 128, h = (tile >> 3) & 3, nt = tile & 7, n0 = nt * 128;
    LdBF al{C + (size_t)m0 * 1024 + h * 256, 1024};
    LdBF bl{Wt + ((size_t)h * 1024 + n0) * 256, 256};
    gemm_tile(al, bl, 256, smem, [&](f32x4 (&acc)[4][4]) {
#pragma unroll
      for (int jj = 0; jj < 4; jj += 2) {
        const int nb = n0 + wn * 64 + jj * 16;
        const int d = nb >> 9;
        const int ch = h * 256 + ((nb & 511) >> 5) * 16 + (lane & 15);
        const float bav = ba[d * 1024 + ch], bxv = bx[d * 1024 + ch];
        const float sp8 = -8.f * softplus_(-lam[d * 1024 + ch]);
#pragma unroll
        for (int i = 0; i < 4; ++i)
#pragma unroll
          for (int r = 0; r < 4; ++r) {
            const int row = m0 + wm * 64 + i * 16 + (lane >> 4) * 4 + r;
            const float rg = sigmoid_(acc[i][jj][r] + bav);
            const float ig = sigmoid_(acc[i][jj + 1][r] + bxv);
            const float la = sp8 * rg;
            const float cval = bf2f(C[(size_t)row * 1024 + ch]);
            const float b = sqrtf(-expm1f(2.f * la)) * ig * cval;
            AB[((size_t)row * 2 + d) * 1024 + ch] = pack2(la, b);
          }
      }
    });
  }
}

DEVI void phase_rg_agg(const Params& p) {
  const u32* AB = (const u32*)(p.ws + OFF_AB);
  float2* AGG = (float2*)(p.ws + OFF_AGG);
  const int gsz = gridDim.x * 256, gtid = blockIdx.x * 256 + threadIdx.x;
  for (int i = gtid; i < 1024 * 2 * 1024; i += gsz) {
    const int ch = i & 1023, d = (i >> 10) & 1, chunk = i >> 11;
    const int c0 = chunk * 32;
    float h = 0.f, LA = 0.f;
#pragma unroll 8
    for (int k = 0; k < 32; ++k) {
      const int t = d ? (c0 + 31 - k) : (c0 + k);
      const u32 w = AB[((size_t)t * 2 + d) * 1024 + ch];
      const float la = bflo(w), b = bfhi(w);
      h = __expf(la) * h + b;
      LA += la;
    }
    AGG[((size_t)d * 1024 + chunk) * 1024 + ch] = float2{LA, h};
  }
}

DEVI void phase_rg_carry(const Params& p, int s) {
  const int L = s ? 2048 : 4096;
  const int nseq = TS / L, nch = L / 32;
  const float2* AGG = (const float2*)(p.ws + OFF_AGG);
  float* CAR = (float*)(p.ws + OFF_CAR);
  const int gsz = gridDim.x * 256, gtid = blockIdx.x * 256 + threadIdx.x;
  for (int i = gtid; i < nseq * 2 * 1024; i += gsz) {
    const int ch = i & 1023, d = (i >> 10) & 1, seq = i >> 11;
    float H = 0.f;
    for (int k = 0; k < nch; ++k) {
      const int chunk = seq * nch + (d ? (nch - 1 - k) : k);
      const size_t idx = ((size_t)d * 1024 + chunk) * 1024 + ch;
      CAR[idx] = H;
      const float2 ag = AGG[idx];
      H = __expf(ag.x) * H + ag.y;
    }
  }
}

DEVI void phase_rg_final(const Params& p) {
  const u32* AB = (const u32*)(p.ws + OFF_AB);
  const float* CAR = (const float*)(p.ws + OFF_CAR);
  const u16* GG = (const u16*)(p.ws + OFF_GG);
  u16* Y = (u16*)(p.ws + OFF_R);
  const int gsz = gridDim.x * 256, gtid = blockIdx.x * 256 + threadIdx.x;
  for (int i = gtid; i < 1024 * 1024; i += gsz) {
    const int ch = i & 1023, chunk = i >> 10;
    const int c0 = chunk * 32;
    float hf[32];
    float h = CAR[((size_t)chunk) * 1024 + ch];
#pragma unroll
    for (int k = 0; k < 32; ++k) {
      const u32 w = AB[((size_t)(c0 + k) * 2 + 0) * 1024 + ch];
      h = __expf(bflo(w)) * h + bfhi(w);
      hf[k] = h;
    }
    h = CAR[((size_t)1024 + chunk) * 1024 + ch];
#pragma unroll
    for (int k = 31; k >= 0; --k) {
      const u32 w = AB[((size_t)(c0 + k) * 2 + 1) * 1024 + ch];
      h = __expf(bflo(w)) * h + bfhi(w);
      const size_t idx = (size_t)(c0 + k) * 1024 + ch;
      Y[idx] = f2bf((hf[k] + h) * bf2f(GG[idx]));
    }
  }
}

DEVI void phase_rg_out(const Params& p, int s, unsigned char* smem) {
  float* X = p.out + (size_t)s * TS * 1024;
  const u16* Y = (const u16*)(p.ws + OFF_R);
  const u16* Wt = (const u16*)(p.ws + OFF_WRGOUT);
  const int lane = threadIdx.x & 63, wave = threadIdx.x >> 6, wm = wave >> 1, wn = wave & 1;
  for (int tile = blockIdx.x; tile < 256 * 8; tile += gridDim.x) {
    const int m0 = (tile >> 3) * 128, n0 = (tile & 7) * 128;
    LdBF al{Y + (size_t)m0 * 1024, 1024};
    LdBF bl{Wt + (size_t)n0 * 1024, 1024};
    gemm_tile(al, bl, 1024, smem, [&](f32x4 (&acc)[4][4]) {
#pragma unroll
      for (int i = 0; i < 4; ++i)
#pragma unroll
        for (int j = 0; j < 4; ++j)
#pragma unroll
          for (int r = 0; r < 4; ++r) {
            const int row = m0 + wm * 64 + i * 16 + (lane >> 4) * 4 + r;
            const int col = n0 + wn * 64 + j * 16 + (lane & 15);
            const size_t idx = (size_t)row * 1024 + col;
            X[idx] = ALPHA * X[idx] + acc[i][j][r];
          }
    });
  }
}

constexpr int NPS = 22;
constexpr int NSETUP = 3;
constexpr int NPHASE = NSETUP + 2 * NPS;

template <int PH>
DEVI void run_phase(const Params& p, unsigned char* smem) {
  if constexpr (PH == 0) {
    phase_setup(p);
  } else if constexpr (PH == 1) {
    phase_setup2(p);
  } else if constexpr (PH == 2) {
    phase_setup3(p);
  } else {
    constexpr int s = (PH - NSETUP) / NPS, q = (PH - NSETUP) % NPS;
    if constexpr (q == 0) phase_s5_in(p, s, smem);
    else if constexpr (q == 1) phase_s5_state(p, smem);
    else if constexpr (q == 2) phase_s5_cscan(p, s);
    else if constexpr (q == 3) phase_s5_main(p, smem);
    else if constexpr (q == 4) phase_s5_glu(p, s, smem);
    else if constexpr (q == 5) phase_ln1_tables(p, s, 0);
    else if constexpr (q == 6) phase_peer_q(p, 0, smem);
    else if constexpr (q == 7) phase_peer_route(p);
    else if constexpr (q == 8) phase_peer_gather(p, s, 0);
    else if constexpr (q == 9) phase_ple(p, s, 0, smem);
    else if constexpr (q == 10) phase_rg_in(p, s, smem);
    else if constexpr (q == 11) phase_rg_conv(p, s);
    else if constexpr (q == 12) phase_rg_gates(p, smem);
    else if constexpr (q == 13) phase_rg_agg(p);
    else if constexpr (q == 14) phase_rg_carry(p, s);
    else if constexpr (q == 15) phase_rg_final(p);
    else if constexpr (q == 16) phase_rg_out(p, s, smem);
    else if constexpr (q == 17) phase_ln1_tables(p, s, 1);
    else if constexpr (q == 18) phase_peer_q(p, 1, smem);
    else if constexpr (q == 19) phase_peer_route(p);
    else if constexpr (q == 20) phase_peer_gather(p, s, 1);
    else if constexpr (q == 21) phase_ple(p, s, 1, smem);
  }
}

template <int PH>
DEVI void run_steps(const Params& p, int lo, int hi, unsigned char* smem) {
  if constexpr (PH < NPHASE) {
    if (PH >= lo && PH < hi) {
      run_phase<PH>(p, smem);
#ifdef DBL_MASK
      if (PH >= NSETUP && ((DBL_MASK >> ((PH - NSETUP) % NPS)) & 1)) { __syncthreads(); run_phase<PH>(p, smem); }
#endif
      if (PH + 1 < hi) cg::this_grid().sync();
    }
    run_steps<PH + 1>(p, lo, hi, smem);
  }
}

__global__ void __launch_bounds__(256, 2) mega(Params p, int ph_lo, int ph_hi) {
  extern __shared__ __attribute__((aligned(16))) unsigned char smem[];
  run_steps<0>(p, ph_lo, ph_hi, smem);
}

extern "C" void kernel_launch(void* const* d_in, const int* in_sizes, int n_in, void* d_out, int out_size, void* d_ws,
                              size_t ws_size, hipStream_t stream) {
  static int grid = 0;
  if (grid == 0) {
    if (n_in != 33 || ws_size < WS_END) {
      fprintf(stderr, "kernel_launch: need 33 inputs and %zu bytes ws; got %d, %zu\n", (size_t)WS_END, n_in, ws_size);
      grid = -1;
      return;
    }
    int dev = 0, cus = 0, per_cu = 0;
    hipGetDevice(&dev);
    hipDeviceGetAttribute(&cus, hipDeviceAttributeMultiprocessorCount, dev);
    if (hipFuncSetAttribute((const void*)mega, hipFuncAttributeMaxDynamicSharedMemorySize, LDS_BYTES) != hipSuccess) {
      fprintf(stderr, "kernel_launch: hipFuncSetAttribute failed\n");
      grid = -1;
      return;
    }
    hipOccupancyMaxActiveBlocksPerMultiprocessor(&per_cu, (const void*)mega, 256, LDS_BYTES);
    if (per_cu < 1) per_cu = 1;
    if (per_cu > 2) per_cu = 2;
    grid = cus * per_cu;
    fprintf(stderr, "kernel_launch: cus %d per_cu %d grid %d\n", cus, per_cu, grid);
  }
  if (grid < 0) return;
  Params p{};
  for (int i = 0; i < 33; ++i) p.in[i] = (const float*)d_in[i];
  p.out = (float*)d_out;
  p.ws = (unsigned char*)d_ws;
#if COOP
  int lo = 0, hi = NPHASE;
  void* args[] = {&p, &lo, &hi};
  hipError_t e = hipLaunchCooperativeKernel((const void*)mega, dim3(grid), dim3(256), args, LDS_BYTES, stream);
  if (e != hipSuccess) fprintf(stderr, "cooperative launch failed: %s (grid %d)\n", hipGetErrorString(e), grid);
#else
  for (int ph = 0; ph < NPHASE; ++ph) {
    hipLaunchKernelGGL(mega, dim3(grid), dim3(256), LDS_BYTES, stream, p, ph, ph + 1);
  }
#endif
}
```

```cpp
#include <hip/hip_runtime.h>
#include <hip/hip_cooperative_groups.h>
#include <cstdio>
namespace cg = cooperative_groups;

#ifndef COOP
#define COOP 1
#endif

typedef unsigned short u16;
typedef unsigned int u32;
using bf16x8 = __attribute__((ext_vector_type(8))) short;
using f32x4 = __attribute__((ext_vector_type(4))) float;
typedef float f2 __attribute__((ext_vector_type(2)));

#define DEVI __device__ __forceinline__

constexpr int TS = 32768;
constexpr float ALPHA = 1.41421356237309515f;
constexpr float LN_EPS = 1e-5f;
constexpr size_t MBy = 1ull << 20;

constexpr size_t OFF_WS5IN = 0;
constexpr size_t OFF_WGLU = 2 * MBy;
constexpr size_t OFF_WRGIN = 6 * MBy;
constexpr size_t OFF_WGATES = 10 * MBy;
constexpr size_t OFF_WRGOUT = 12 * MBy;
constexpr size_t OFF_WQ = 14 * MBy;
constexpr size_t OFF_SK = 22 * MBy;
constexpr size_t OFF_WPROJ = 23 * MBy;
constexpr size_t OFF_WPG = 24 * MBy;
constexpr size_t OFF_UB = 28 * MBy;
constexpr size_t OFF_VB = 60 * MBy;
constexpr size_t OFF_UB8 = OFF_UB;
constexpr size_t OFF_VB8 = OFF_UB + 16 * MBy;
constexpr size_t OFF_SCL = OFF_UB + 32 * MBy;
constexpr size_t OFF_ACT = 92 * MBy;
constexpr size_t OFF_XB = OFF_ACT;
constexpr size_t OFF_KEYS = OFF_ACT + 64 * MBy;
constexpr size_t OFF_IDX = OFF_ACT + 96 * MBy;
constexpr size_t OFF_GATE = OFF_ACT + 112 * MBy;
constexpr size_t OFF_SU = OFF_ACT + 128 * MBy;
constexpr size_t OFF_AP = OFF_ACT;
constexpr size_t OFF_HLOC = OFF_ACT + 104 * MBy;
constexpr size_t OFF_HB = OFF_ACT + 192 * MBy;
constexpr size_t OFF_GG = OFF_ACT;
constexpr size_t OFF_R = OFF_ACT + 64 * MBy;
constexpr size_t OFF_C = OFF_ACT + 128 * MBy;
constexpr size_t OFF_AB = OFF_ACT + 192 * MBy;
constexpr size_t OFF_AGG = OFF_ACT + 448 * MBy;
constexpr size_t OFF_CAR = OFF_ACT + 464 * MBy;
constexpr size_t OFF_BT1 = OFF_ACT + 472 * MBy;
constexpr size_t OFF_WST = OFF_BT1 + 48 * MBy;
constexpr size_t OFF_KTAB = OFF_WST + 16 * MBy;
constexpr size_t OFF_POW = OFF_KTAB + 4 * MBy;
constexpr size_t OFF_BBAR = OFF_POW + 3 * MBy;
constexpr size_t OFF_BAR = OFF_BBAR + 1 * MBy;
constexpr size_t WS_END = OFF_BAR + 1 * MBy;

constexpr int LDS_BYTES = 36864 + 32768;

struct Params {
  const float* in[33];
  float* out;
  unsigned char* ws;
};

DEVI u16 f2bf(float f) {
  u32 u = __float_as_uint(f);
  u += 0x7FFFu + ((u >> 16) & 1u);
  return (u16)(u >> 16);
}
DEVI float bf2f(u16 h) { return __uint_as_float(((u32)h) << 16); }
DEVI u32 pack2(float lo, float hi) { return (u32)f2bf(lo) | ((u32)f2bf(hi) << 16); }
DEVI float bflo(u32 w) { return __uint_as_float(w << 16); }
DEVI float bfhi(u32 w) { return __uint_as_float(w & 0xffff0000u); }
DEVI float sigmoid_(float x) { return __builtin_amdgcn_rcpf(1.f + __expf(-x)); }
DEVI float gelu_(float x) {
  float z = 0.7978845608028654f * (x + 0.044715f * x * x * x);
  return x * __builtin_amdgcn_rcpf(1.f + __expf(-2.f * z));
}
DEVI float softplus_(float x) { return fmaxf(x, 0.f) + log1pf(__expf(-fabsf(x))); }
DEVI void unpack8(const uint4& w, float* f) {
  f[0] = bflo(w.x); f[1] = bfhi(w.x); f[2] = bflo(w.y); f[3] = bfhi(w.y);
  f[4] = bflo(w.z); f[5] = bfhi(w.z); f[6] = bflo(w.w); f[7] = bfhi(w.w);
}
DEVI uint4 pack8(const float* f) {
  uint4 o; o.x = pack2(f[0], f[1]); o.y = pack2(f[2], f[3]); o.z = pack2(f[4], f[5]); o.w = pack2(f[6], f[7]);
  return o;
}

struct LdBF {
  const u16* base; int ld;
  typedef uint4 Raw;
  DEVI Raw load(int row, int k) const { return *reinterpret_cast<const uint4*>(base + (size_t)row * ld + k); }
  DEVI static uint4 cvt(const Raw& r) { return r; }
};
struct RawF { float4 a, b; };
struct LdF32 {
  const float* base; int ld;
  typedef RawF Raw;
  DEVI Raw load(int row, int k) const {
    const float4* q = reinterpret_cast<const float4*>(base + (size_t)row * ld + k);
    RawF r; r.a = q[0]; r.b = q[1]; return r;
  }
  DEVI static uint4 cvt(const Raw& r) {
    uint4 o; o.x = pack2(r.a.x, r.a.y); o.y = pack2(r.a.z, r.a.w); o.z = pack2(r.b.x, r.b.y); o.w = pack2(r.b.z, r.b.w);
    return o;
  }
};

template <class AL, class BL, class EP>
DEVI void gemm_tile(const AL al, const BL bl, const int K, unsigned char* smem, EP ep) {
  u16* As = reinterpret_cast<u16*>(smem);
  u16* Bs = As + 128 * 72;
  const int tid = threadIdx.x, lane = tid & 63, wave = tid >> 6, wm = wave >> 1, wn = wave & 1;
  const int lr = lane & 15, lq = lane >> 4;
  f32x4 acc[4][4];
#pragma unroll
  for (int i = 0; i < 4; ++i)
#pragma unroll
    for (int j = 0; j < 4; ++j) acc[i][j] = f32x4{0.f, 0.f, 0.f, 0.f};
  typename AL::Raw ra[4];
  typename BL::Raw rb[4];
  const int prow = tid >> 3, pk = (tid & 7) * 8;
#pragma unroll
  for (int i = 0; i < 4; ++i) { ra[i] = al.load(prow + i * 32, pk); rb[i] = bl.load(prow + i * 32, pk); }
  for (int kt = 0; kt < K; kt += 64) {
    __syncthreads();
#pragma unroll
    for (int i = 0; i < 4; ++i) {
      *reinterpret_cast<uint4*>(As + (prow + i * 32) * 72 + pk) = AL::cvt(ra[i]);
      *reinterpret_cast<uint4*>(Bs + (prow + i * 32) * 72 + pk) = BL::cvt(rb[i]);
    }
    __syncthreads();
    if (kt + 64 < K) {
#pragma unroll
      for (int i = 0; i < 4; ++i) { ra[i] = al.load(prow + i * 32, kt + 64 + pk); rb[i] = bl.load(prow + i * 32, kt + 64 + pk); }
    }
#pragma unroll
    for (int ks = 0; ks < 2; ++ks) {
      bf16x8 af[4], bfr[4];
#pragma unroll
      for (int i = 0; i < 4; ++i) af[i] = *reinterpret_cast<const bf16x8*>(As + (wm * 64 + i * 16 + lr) * 72 + ks * 32 + lq * 8);
#pragma unroll
      for (int j = 0; j < 4; ++j) bfr[j] = *reinterpret_cast<const bf16x8*>(Bs + (wn * 64 + j * 16 + lr) * 72 + ks * 32 + lq * 8);
#pragma unroll
      for (int i = 0; i < 4; ++i)
#pragma unroll
        for (int j = 0; j < 4; ++j) acc[i][j] = __builtin_amdgcn_mfma_f32_16x16x32_bf16(af[i], bfr[j], acc[i][j], 0, 0, 0);
    }
  }
  __syncthreads();
  ep(acc);
}

typedef __attribute__((address_space(3))) unsigned lds_u32;
template <class EP>
DEVI void gemm_tile_dma(const u16* A, const int lda, const u16* Bt, const int ldb, const int K, unsigned char* smem, EP ep) {
  const int tid = threadIdx.x, lane = tid & 63, wave = tid >> 6, wm = wave >> 1, wn = wave & 1;
  const int lr = lane & 15, lq = lane >> 4;
  f32x4 acc[4][4];
#pragma unroll
  for (int i = 0; i < 4; ++i)
#pragma unroll
    for (int j = 0; j < 4; ++j) acc[i][j] = f32x4{0.f, 0.f, 0.f, 0.f};
  const int rr = lane >> 3, qq = (lane & 7) ^ rr;
  const u16* ag = A + (size_t)(wave * 32 + rr) * lda + qq * 8;
  const u16* bg = Bt + (size_t)(wave * 32 + rr) * ldb + qq * 8;
  unsigned char* wbase = smem + wave * 4096;
#define GT_ISSUE(stage, kt)                                                                                              \
  do {                                                                                                                   \
    _Pragma("unroll") for (int j = 0; j < 4; ++j) {                                                                      \
      __builtin_amdgcn_global_load_lds((const unsigned*)(ag + (size_t)j * 8 * lda + (kt)),                               \
                                       (lds_u32*)(wbase + (stage) * 32768 + j * 1024), 16, 0, 0);                        \
      __builtin_amdgcn_global_load_lds((const unsigned*)(bg + (size_t)j * 8 * ldb + (kt)),                               \
                                       (lds_u32*)(wbase + (stage) * 32768 + 16384 + j * 1024), 16, 0, 0);                \
    }                                                                                                                    \
  } while (0)
  __syncthreads();
  GT_ISSUE(0, 0);
  const int sw = lr & 7;
  int it = 0;
  for (int kt = 0; kt < K; kt += 64, ++it) {
    asm volatile("s_waitcnt vmcnt(0)" ::: "memory");
    __syncthreads();
    if (kt + 64 < K) GT_ISSUE((it + 1) & 1, kt + 64);
    const unsigned char* As = smem + (it & 1) * 32768;
    const unsigned char* Bs = As + 16384;
#pragma unroll
    for (int ks = 0; ks < 2; ++ks) {
      bf16x8 af[4], bfr[4];
      const int ch = ((ks * 4 + lq) ^ sw) * 16;
#pragma unroll
      for (int i = 0; i < 4; ++i) af[i] = *reinterpret_cast<const bf16x8*>(As + (wm * 64 + i * 16 + lr) * 128 + ch);
#pragma unroll
      for (int j = 0; j < 4; ++j) bfr[j] = *reinterpret_cast<const bf16x8*>(Bs + (wn * 64 + j * 16 + lr) * 128 + ch);
#pragma unroll
      for (int i = 0; i < 4; ++i)
#pragma unroll
        for (int j = 0; j < 4; ++j) acc[i][j] = __builtin_amdgcn_mfma_f32_16x16x32_bf16(af[i], bfr[j], acc[i][j], 0, 0, 0);
    }
  }
#undef GT_ISSUE
  __syncthreads();
  ep(acc);
}

DEVI bool tile_map(int it, int nmt, int nnt, int& mt, int& nt) {
  const int xcd = blockIdx.x & 7, j = blockIdx.x >> 3;
  const int per = gridDim.x >> 3;
  const int slot = it * per + j;
  const int S = (slot >> 6) * 8 + xcd;
  const int nsn = nnt >> 3, nsm = nmt >> 3;
  if (S >= nsn * nsm) return false;
  const int sm = S / nsn, sn = S - sm * nsn;
  const int w = slot & 63;
  mt = sm * 8 + (w >> 3);
  nt = sn * 8 + (w & 7);
  return true;
}

template <int PERM>
DEVI void cvt_wt(const float* W, int K, int N, u16* out, int a0, int a1) {
  const int gsz = gridDim.x * 256, gtid = blockIdx.x * 256 + threadIdx.x;
  const int total = N * (K >> 3);
  for (int i = gtid; i < total; i += gsz) {
    const int n = i % N, kv = i / N;
    float v[8];
#pragma unroll
    for (int j = 0; j < 8; ++j) v[j] = W[(size_t)(kv * 8 + j) * N + n];
    int np = n;
    if (PERM == 1) { const int g = n >> 10, o = n & 1023; np = (o >> 4) * 32 + g * 16 + (o & 15); }
    if (PERM == 2) { np = a0 * 512 + (n >> 4) * 32 + a1 * 16 + (n & 15); }
    *reinterpret_cast<uint4*>(out + (size_t)np * K + kv * 8) = pack8(v);
  }
}

DEVI void cvt_plain(const float* src, u16* dst, size_t n8) {
  const size_t gsz = (size_t)gridDim.x * 256, gtid = (size_t)blockIdx.x * 256 + threadIdx.x;
  for (size_t i = gtid; i < n8; i += gsz) {
    const float4* q = reinterpret_cast<const float4*>(src + i * 8);
    float4 a = q[0], b = q[1];
    uint4 o; o.x = pack2(a.x, a.y); o.y = pack2(a.z, a.w); o.z = pack2(b.x, b.y); o.w = pack2(b.z, b.w);
    *reinterpret_cast<uint4*>(dst + i * 8) = o;
  }
}

DEVI void phase_setup(const Params& p) {
  unsigned char* ws = p.ws;
  cvt_wt<0>(p.in[4], 1024, 1024, (u16*)(ws + OFF_WS5IN), 0, 0);
  cvt_wt<1>(p.in[13], 1024, 2048, (u16*)(ws + OFF_WGLU), 0, 0);
  cvt_wt<0>(p.in[14], 1024, 2048, (u16*)(ws + OFF_WRGIN), 0, 0);
  for (int d = 0; d < 2; ++d)
    for (int gate = 0; gate < 2; ++gate)
      for (int h = 0; h < 4; ++h)
        cvt_wt<2>((gate ? p.in[19] : p.in[17]) + (size_t)(d * 4 + h) * 65536, 256, 256,
                  (u16*)(ws + OFF_WGATES) + (size_t)h * 1024 * 256, d, gate);
  cvt_wt<0>(p.in[22], 1024, 1024, (u16*)(ws + OFF_WRGOUT), 0, 0);
  for (int l = 0; l < 2; ++l) {
    cvt_wt<0>(p.in[27] + (size_t)l * 1024 * 2048, 1024, 2048, (u16*)(ws + OFF_WQ) + (size_t)l * 2048 * 1024, 0, 0);
    cvt_wt<0>(p.in[31] + (size_t)l * 256 * 1024, 256, 1024, (u16*)(ws + OFF_WPROJ) + (size_t)l * 1024 * 256, 0, 0);
    cvt_wt<0>(p.in[32] + (size_t)l * 1024 * 1024, 1024, 1024, (u16*)(ws + OFF_WPG) + (size_t)l * 1024 * 1024, 0, 0);
  }
  cvt_plain(p.in[28], (u16*)(ws + OFF_SK), 65536 / 8);
  const int gsz = gridDim.x * 256, gtid = blockIdx.x * 256 + threadIdx.x;
  float2* POW = (float2*)(ws + OFF_POW);
  float2* BBAR = (float2*)(ws + OFF_BBAR);
  for (int i = gtid; i < 2 * 64 * 33 * 64; i += gsz) {
    const int pp = i & 63, n = (i >> 6) % 33, dg = i / (64 * 33);
    const float step = expf(p.in[7][dg]);
    const float lr_ = p.in[5][dg * 64 + pp], li_ = p.in[6][dg * 64 + pp];
    const float mag = expf((float)n * (lr_ * step)), ang = (float)n * (li_ * step);
    POW[i] = float2{mag * cosf(ang), mag * sinf(ang)};
  }
  for (int i = gtid; i < 2 * 64 * 64; i += gsz) {
    const int dg = i >> 6;
    const float step = expf(p.in[7][dg]);
    const float lr_ = p.in[5][i], li_ = p.in[6][i];
    const float mag = expf(lr_ * step), ang = li_ * step;
    const float ar = mag * cosf(ang), ai = mag * sinf(ang);
    const float den = lr_ * lr_ + li_ * li_;
    const float zr = ar - 1.f;
    const float qr = (zr * lr_ + ai * li_) / den, qi = (ai * lr_ - zr * li_) / den;
#pragma unroll
    for (int c = 0; c < 16; ++c) {
      const float br = p.in[8][(size_t)i * 16 + c], bi = p.in[9][(size_t)i * 16 + c];
      BBAR[(size_t)i * 16 + c] = float2{qr * br - qi * bi, qr * bi + qi * br};
    }
  }
}

DEVI float s5_kterm(const Params& p, const float2* POW, const float2* BBAR, int d, int g, int n, int c, int cp) {
  const int dg = d * 64 + g;
  const float* cr = p.in[10] + ((size_t)dg * 16 + c) * 64;
  const float* ci = p.in[11] + ((size_t)dg * 16 + c) * 64;
  const float2* E = POW + ((size_t)dg * 33 + n) * 64;
  const float2* BB = BBAR + (size_t)dg * 64 * 16 + cp;
  float s = 0.f;
#pragma unroll 8
  for (int pp = 0; pp < 64; ++pp) {
    const float2 e = E[pp], bb = BB[pp * 16];
    const float Cr = cr[pp], Ci = ci[pp];
    const float cer = Cr * e.x - Ci * e.y, cei = Cr * e.y + Ci * e.x;
    s += cer * bb.x - cei * bb.y;
  }
  return s;
}

DEVI void phase_setup2(const Params& p) {
  unsigned char* ws = p.ws;
  const int gsz = gridDim.x * 256, gtid = blockIdx.x * 256 + threadIdx.x;
  const float2* POW = (const float2*)(ws + OFF_POW);
  const float2* BBAR = (const float2*)(ws + OFF_BBAR);
  float* KTAB = (float*)(ws + OFF_KTAB);
  u16* WST = (u16*)(ws + OFF_WST);
  u16* BT1 = (u16*)(ws + OFF_BT1);
  for (int i = gtid; i < 64 * 63 * 256; i += gsz) {
    const int cp = i & 15, c = (i >> 4) & 15, ti = (i >> 8) % 63, g = i / (63 * 256);
    const int tau = ti - 31;
    float s = 0.f;
    if (tau >= 0) s += s5_kterm(p, POW, BBAR, 0, g, tau, c, cp);
    if (tau <= 0) s += s5_kterm(p, POW, BBAR, 1, g, -tau, c, cp);
    KTAB[i] = s;
  }
  for (int i = gtid; i < 64 * 256 * 64; i += gsz) {
    const int kv = i & 63, np = (i >> 6) & 255, g = i >> 14;
    const int d = np >> 7, ri = (np >> 6) & 1, pp = np & 63, s = kv >> 1, c0 = (kv & 1) * 8;
    const int npow = d ? s : 31 - s;
    const float2 e = POW[((size_t)(d * 64 + g) * 33 + npow) * 64 + pp];
    float v[8];
#pragma unroll
    for (int j = 0; j < 8; ++j) {
      const float2 bb = BBAR[((size_t)(d * 64 + g) * 64 + pp) * 16 + c0 + j];
      v[j] = ri ? (e.x * bb.y + e.y * bb.x) : (e.x * bb.x - e.y * bb.y);
    }
    *reinterpret_cast<uint4*>(WST + ((size_t)g * 256 + np) * 512 + kv * 8) = pack8(v);
  }
  for (int i = gtid; i < 64 * 512 * 32; i += gsz) {
    const int kv = i & 31, n = (i >> 5) & 511, g = i >> 14;
    const int t = n >> 4, c = n & 15, kk0 = kv * 8;
    const int d = kk0 >> 7, ri = (kk0 >> 6) & 1, p0 = kk0 & 63;
    const int npow = d ? 32 - t : t + 1;
    const int dg = d * 64 + g;
    float v[8];
#pragma unroll
    for (int j = 0; j < 8; ++j) {
      const int pp = p0 + j;
      const float Cr = p.in[10][((size_t)dg * 16 + c) * 64 + pp], Ci = p.in[11][((size_t)dg * 16 + c) * 64 + pp];
      const float2 e = POW[((size_t)dg * 33 + npow) * 64 + pp];
      v[j] = ri ? -(Cr * e.y + Ci * e.x) : (Cr * e.x - Ci * e.y);
    }
    *reinterpret_cast<uint4*>(BT1 + ((size_t)g * 512 + n) * 768 + 512 + kv * 8) = pack8(v);
  }
}

DEVI void phase_setup3(const Params& p) {
  const int gsz = gridDim.x * 256, gtid = blockIdx.x * 256 + threadIdx.x;
  const float* KTAB = (const float*)(p.ws + OFF_KTAB);
  u16* BT1 = (u16*)(p.ws + OFF_BT1);
  for (int i = gtid; i < 64 * 512 * 64; i += gsz) {
    const int kv = i & 63, n = (i >> 6) & 511, g = i >> 15;
    const int t = n >> 4, c = n & 15, s = kv >> 1, c0 = (kv & 1) * 8;
    const float* src = KTAB + (((size_t)g * 63 + (t - s + 31)) * 16 + c) * 16 + c0;
    float v[8];
#pragma unroll
    for (int j = 0; j < 8; ++j) v[j] = src[j];
    *reinterpret_cast<uint4*>(BT1 + ((size_t)g * 512 + n) * 768 + kv * 8) = pack8(v);
  }
}

DEVI void phase_s5_in(const Params& p, int s, unsigned char* smem) {
  const float* X = p.in[s];
  const u16* Wt = (const u16*)(p.ws + OFF_WS5IN);
  u16* AP = (u16*)(p.ws + OFF_AP);
  const int lane = threadIdx.x & 63, wave = threadIdx.x >> 6, wm = wave >> 1, wn = wave & 1;
  for (int it = 0, mt, nt; tile_map(it, 256, 8, mt, nt); ++it) {
    const int m0 = mt * 128, n0 = nt * 128;
    LdF32 al{X + (size_t)m0 * 1024, 1024};
    LdBF bl{Wt + (size_t)n0 * 1024, 1024};
    gemm_tile(al, bl, 1024, smem, [&](f32x4 (&acc)[4][4]) {
#pragma unroll
      for (int i = 0; i < 4; ++i)
#pragma unroll
        for (int j = 0; j < 4; ++j)
#pragma unroll
          for (int r = 0; r < 4; ++r) {
            const int row = m0 + wm * 64 + i * 16 + (lane >> 4) * 4 + r;
            const int col = n0 + wn * 64 + j * 16 + (lane & 15);
            AP[((size_t)(col >> 4) * 1024 + (row >> 5)) * 768 + (row & 31) * 16 + (col & 15)] = f2bf(acc[i][j][r]);
          }
    });
  }
}

DEVI void phase_s5_state(const Params& p, unsigned char* smem) {
  const u16* AP = (const u16*)(p.ws + OFF_AP);
  const u16* WST = (const u16*)(p.ws + OFF_WST);
  float* HLOC = (float*)(p.ws + OFF_HLOC);
  const int lane = threadIdx.x & 63, wave = threadIdx.x >> 6, wm = wave >> 1, wn = wave & 1;
  for (int tile = blockIdx.x; tile < 64 * 16; tile += gridDim.x) {
    const int g = tile >> 4, m0 = ((tile >> 1) & 7) * 128, n0 = (tile & 1) * 128;
    gemm_tile_dma(AP + ((size_t)g * 1024 + m0) * 768, 768, WST + ((size_t)g * 256 + n0) * 512, 512, 512, smem, [&](f32x4 (&acc)[4][4]) {
#pragma unroll
      for (int i = 0; i < 4; ++i)
#pragma unroll
        for (int j = 0; j < 4; ++j)
#pragma unroll
          for (int r = 0; r < 4; ++r) {
            const int row = m0 + wm * 64 + i * 16 + (lane >> 4) * 4 + r;
            const int col = n0 + wn * 64 + j * 16 + (lane & 15);
            HLOC[((size_t)g * 1024 + row) * 256 + col] = acc[i][j][r];
          }
    });
  }
}

DEVI void phase_s5_cscan(const Params& p, int s) {
  const int L = s ? 2048 : 4096;
  const int nseq = TS / L, nch = L / 32;
  u16* AP = (u16*)(p.ws + OFF_AP);
  const float* HLOC = (const float*)(p.ws + OFF_HLOC);
  const float2* POW = (const float2*)(p.ws + OFF_POW);
  const int gsz = gridDim.x * 256, gtid = blockIdx.x * 256 + threadIdx.x;
  for (int i = gtid; i < 64 * nseq * 128; i += gsz) {
    const int pp = i & 63, d = (i >> 6) & 1, g = (i >> 7) & 63, seq = i >> 13;
    const float2 e = POW[((size_t)(d * 64 + g) * 33 + 32) * 64 + pp];
    float Hr = 0.f, Hi = 0.f;
#pragma unroll 4
    for (int j = 0; j < nch; ++j) {
      const int chunk = seq * nch + (d ? (nch - 1 - j) : j);
      u16* ap = AP + ((size_t)g * 1024 + chunk) * 768 + 512 + d * 128 + pp;
      ap[0] = f2bf(Hr);
      ap[64] = f2bf(Hi);
      const float* hl = HLOC + ((size_t)g * 1024 + chunk) * 256 + d * 128 + pp;
      const float a = hl[0], b = hl[64];
      const float nHr = e.x * Hr - e.y * Hi + a;
      const float nHi = e.x * Hi + e.y * Hr + b;
      Hr = nHr; Hi = nHi;
    }
  }
}

DEVI void phase_s5_main(const Params& p, unsigned char* smem) {
  const u16* AP = (const u16*)(p.ws + OFF_AP);
  const u16* BT1 = (const u16*)(p.ws + OFF_BT1);
  u16* HB = (u16*)(p.ws + OFF_HB);
  const float* dsk = p.in[12];
  const int lane = threadIdx.x & 63, wave = threadIdx.x >> 6, wm = wave >> 1, wn = wave & 1;
  for (int tile = blockIdx.x; tile < 64 * 32; tile += gridDim.x) {
    const int g = tile >> 5, m0 = ((tile >> 2) & 7) * 128, n0 = (tile & 3) * 128;
    gemm_tile_dma(AP + ((size_t)g * 1024 + m0) * 768, 768, BT1 + ((size_t)g * 512 + n0) * 768, 768, 768, smem, [&](f32x4 (&acc)[4][4]) {
      const float dv = dsk[g * 16 + (lane & 15)];
#pragma unroll
      for (int i = 0; i < 4; ++i)
#pragma unroll
        for (int j = 0; j < 4; ++j)
#pragma unroll
          for (int r = 0; r < 4; ++r) {
            const int chunk = m0 + wm * 64 + i * 16 + (lane >> 4) * 4 + r;
            const int n = n0 + wn * 64 + j * 16 + (lane & 15);
            const float u = bf2f(AP[((size_t)g * 1024 + chunk) * 768 + n]);
            const float y = acc[i][j][r] + dv * u;
            HB[((size_t)chunk * 32 + (n >> 4)) * 1024 + g * 16 + (lane & 15)] = f2bf(gelu_(y));
          }
    });
  }
}

DEVI void phase_s5_glu(const Params& p, int s, unsigned char* smem) {
  const u16* HB = (const u16*)(p.ws + OFF_HB);
  const u16* Wt = (const u16*)(p.ws + OFF_WGLU);
  const float* Xin = p.in[s];
  float* Xo = p.out + (size_t)s * TS * 1024;
  const int lane = threadIdx.x & 63, wave = threadIdx.x >> 6, wm = wave >> 1, wn = wave & 1;
  for (int it = 0, mt, nt; tile_map(it, 256, 16, mt, nt); ++it) {
    const int m0 = mt * 128, n0 = nt * 128;
    gemm_tile_dma(HB + (size_t)m0 * 1024, 1024, Wt + (size_t)n0 * 1024, 1024, 1024, smem, [&](f32x4 (&acc)[4][4]) {
#pragma unroll
      for (int i = 0; i < 4; ++i)
#pragma unroll
        for (int jj = 0; jj < 4; jj += 2)
#pragma unroll
          for (int r = 0; r < 4; ++r) {
            const int row = m0 + wm * 64 + i * 16 + (lane >> 4) * 4 + r;
            const int nb = n0 + wn * 64 + jj * 16;
            const int o = (nb >> 5) * 16 + (lane & 15);
            const float mix = acc[i][jj][r] * sigmoid_(acc[i][jj + 1][r]);
            const size_t idx = (size_t)row * 1024 + o;
            Xo[idx] = ALPHA * Xin[idx] + mix;
          }
    });
  }
}

DEVI void phase_ln1_tables(const Params& p, int s, int layer) {
  float* X = p.out + (size_t)s * TS * 1024;
  u16* XB = (u16*)(p.ws + OFF_XB);
  const float* gam = p.in[23] + layer * 1024;
  const float* bet = p.in[24] + layer * 1024;
  const int lane = threadIdx.x & 63, wave = threadIdx.x >> 6;
  for (int t = blockIdx.x * 4 + wave; t < TS; t += gridDim.x * 4) {
    float4 v[4];
#pragma unroll
    for (int i = 0; i < 4; ++i) v[i] = *reinterpret_cast<const float4*>(X + (size_t)t * 1024 + i * 256 + lane * 4);
    float sm = 0.f;
#pragma unroll
    for (int i = 0; i < 4; ++i) sm += v[i].x + v[i].y + v[i].z + v[i].w;
#pragma unroll
    for (int m = 32; m >= 1; m >>= 1) sm += __shfl_xor(sm, m);
    const float mu = sm * (1.f / 1024.f);
    float sq = 0.f;
#pragma unroll
    for (int i = 0; i < 4; ++i) {
      const float a = v[i].x - mu, b = v[i].y - mu, c = v[i].z - mu, d = v[i].w - mu;
      sq += a * a + b * b + c * c + d * d;
    }
#pragma unroll
    for (int m = 32; m >= 1; m >>= 1) sq += __shfl_xor(sq, m);
    const float rs = rsqrtf(sq * (1.f / 1024.f) + LN_EPS);
#pragma unroll
    for (int i = 0; i < 4; ++i) {
      const int c0 = i * 256 + lane * 4;
      const float4 g4 = *reinterpret_cast<const float4*>(gam + c0);
      const float4 b4 = *reinterpret_cast<const float4*>(bet + c0);
      float4 o;
      o.x = (v[i].x - mu) * rs * g4.x + b4.x; o.y = (v[i].y - mu) * rs * g4.y + b4.y;
      o.z = (v[i].z - mu) * rs * g4.z + b4.z; o.w = (v[i].w - mu) * rs * g4.w + b4.w;
      *reinterpret_cast<float4*>(X + (size_t)t * 1024 + c0) = o;
      uint2 pk; pk.x = pack2(o.x, o.y); pk.y = pack2(o.z, o.w);
      *reinterpret_cast<uint2*>(XB + (size_t)t * 1024 + c0) = pk;
    }
  }
  float* SCL = (float*)(p.ws + OFF_SCL);
  for (int r = blockIdx.x * 4 + wave; r < 32768; r += gridDim.x * 4) {
    const int tab = r >> 14, row = r & 16383;
    const float4* sp = reinterpret_cast<const float4*>(p.in[29 + tab] + ((size_t)layer * 16384 + row) * 1024 + lane * 16);
    const float4 a = sp[0], b = sp[1], c = sp[2], d = sp[3];
    float am = fmaxf(fmaxf(fmaxf(fabsf(a.x), fabsf(a.y)), fmaxf(fabsf(a.z), fabsf(a.w))),
                     fmaxf(fmaxf(fabsf(b.x), fabsf(b.y)), fmaxf(fabsf(b.z), fabsf(b.w))));
    am = fmaxf(am, fmaxf(fmaxf(fmaxf(fabsf(c.x), fabsf(c.y)), fmaxf(fabsf(c.z), fabsf(c.w))),
                         fmaxf(fmaxf(fabsf(d.x), fabsf(d.y)), fmaxf(fabsf(d.z), fabsf(d.w)))));
#pragma unroll
    for (int m = 32; m >= 1; m >>= 1) am = fmaxf(am, __shfl_xor(am, m));
    const float sc = am > 0.f ? 224.f / am : 1.f;
    const float inv = am > 0.f ? am * (1.f / 224.f) : 1.f;
    uint4 o;
    int w = 0;
    w = __builtin_amdgcn_cvt_pk_fp8_f32(a.x * sc, a.y * sc, w, false); w = __builtin_amdgcn_cvt_pk_fp8_f32(a.z * sc, a.w * sc, w, true); o.x = (u32)w;
    w = __builtin_amdgcn_cvt_pk_fp8_f32(b.x * sc, b.y * sc, w, false); w = __builtin_amdgcn_cvt_pk_fp8_f32(b.z * sc, b.w * sc, w, true); o.y = (u32)w;
    w = __builtin_amdgcn_cvt_pk_fp8_f32(c.x * sc, c.y * sc, w, false); w = __builtin_amdgcn_cvt_pk_fp8_f32(c.z * sc, c.w * sc, w, true); o.z = (u32)w;
    w = __builtin_amdgcn_cvt_pk_fp8_f32(d.x * sc, d.y * sc, w, false); w = __builtin_amdgcn_cvt_pk_fp8_f32(d.z * sc, d.w * sc, w, true); o.w = (u32)w;
    *reinterpret_cast<uint4*>(p.ws + (tab ? OFF_VB8 : OFF_UB8) + (size_t)row * 1024 + lane * 16) = o;
    if (lane == 0) SCL[tab * 16384 + row] = inv;
  }
}

DEVI u32 enc_key(float s, int n) {
  u32 b = __float_as_uint(s);
  u32 srt = (b & 0x80000000u) ? ~b : (b | 0x80000000u);
  return (srt & ~127u) | (u32)(127 - n);
}
DEVI float dec_key(u32 key, int& n) {
  n = 127 - (int)(key & 127u);
  u32 srt = key & ~127u;
  u32 b = (srt & 0x80000000u) ? (srt & 0x7fffffffu) : ~srt;
  return __uint_as_float(b);
}

DEVI void phase_peer_q(const Params& p, int layer, unsigned char* smem) {
  const u16* XB = (const u16*)(p.ws + OFF_XB);
  const u16* Wt = (const u16*)(p.ws + OFF_WQ) + (size_t)layer * 2048 * 1024;
  const u16* SK = (const u16*)(p.ws + OFF_SK) + (size_t)layer * 2 * 128 * 128;
  u32* KEYS = (u32*)(p.ws + OFF_KEYS);
  const int tid = threadIdx.x, lane = tid & 63, wave = tid >> 6, wm = wave >> 1, wn = wave & 1;
  const int lr = lane & 15, lq = lane >> 4;
  u16* Qs = reinterpret_cast<u16*>(smem);
  u32* Sk = reinterpret_cast<u32*>(smem);
  for (int it = 0, mt, nt; tile_map(it, 256, 16, mt, nt); ++it) {
    const int m0 = mt * 128, hc = nt, n0 = hc * 128;
    const int c = hc & 1;
    gemm_tile_dma(XB + (size_t)m0 * 1024, 1024, Wt + (size_t)n0 * 1024, 1024, 1024, smem, [&](f32x4 (&acc)[4][4]) {
#pragma unroll
      for (int i = 0; i < 4; ++i)
#pragma unroll
        for (int j = 0; j < 4; ++j)
#pragma unroll
          for (int r = 0; r < 4; ++r)
            Qs[(wm * 64 + i * 16 + lq * 4 + r) * 136 + wn * 64 + j * 16 + lr] = f2bf(acc[i][j][r]);
      __syncthreads();
      f32x4 sc[4][4];
#pragma unroll
      for (int i = 0; i < 4; ++i)
#pragma unroll
        for (int j = 0; j < 4; ++j) sc[i][j] = f32x4{0.f, 0.f, 0.f, 0.f};
      const u16* skc = SK + (size_t)c * 128 * 128;
#pragma unroll
      for (int ks = 0; ks < 4; ++ks) {
        bf16x8 af[4], bfr[4];
#pragma unroll
        for (int i = 0; i < 4; ++i) af[i] = *reinterpret_cast<const bf16x8*>(Qs + (wm * 64 + i * 16 + lr) * 136 + ks * 32 + lq * 8);
#pragma unroll
        for (int j = 0; j < 4; ++j) bfr[j] = *reinterpret_cast<const bf16x8*>(skc + (size_t)(wn * 64 + j * 16 + lr) * 128 + ks * 32 + lq * 8);
#pragma unroll
        for (int i = 0; i < 4; ++i)
#pragma unroll
          for (int j = 0; j < 4; ++j) sc[i][j] = __builtin_amdgcn_mfma_f32_16x16x32_bf16(af[i], bfr[j], sc[i][j], 0, 0, 0);
      }
      __syncthreads();
#pragma unroll
      for (int i = 0; i < 4; ++i)
#pragma unroll
        for (int j = 0; j < 4; ++j)
#pragma unroll
          for (int r = 0; r < 4; ++r) {
            const int n = wn * 64 + j * 16 + lr;
            Sk[(wm * 64 + i * 16 + lq * 4 + r) * 129 + n] = enc_key(sc[i][j][r], n);
          }
      __syncthreads();
      if (tid < 128) {
        u32 top[16];
#pragma unroll
        for (int k = 0; k < 16; ++k) top[k] = 0u;
#pragma unroll 4
        for (int n = 0; n < 128; ++n) {
          u32 v = Sk[tid * 129 + n];
#pragma unroll
          for (int k = 0; k < 16; ++k) {
            const u32 hi = max(top[k], v);
            v = min(top[k], v);
            top[k] = hi;
          }
        }
        uint4* dst = reinterpret_cast<uint4*>(KEYS + ((size_t)(m0 + tid) * 16 + hc) * 16);
        dst[0] = uint4{top[0], top[1], top[2], top[3]};
        dst[1] = uint4{top[4], top[5], top[6], top[7]};
        dst[2] = uint4{top[8], top[9], top[10], top[11]};
        dst[3] = uint4{top[12], top[13], top[14], top[15]};
      }
    });
  }
}

DEVI void phase_peer_route(const Params& p) {
  const u32* KEYS = (const u32*)(p.ws + OFF_KEYS);
  int* IDX = (int*)(p.ws + OFF_IDX);
  float* GATE = (float*)(p.ws + OFF_GATE);
  float* SU = (float*)(p.ws + OFF_SU);
  const float* SCL = (const float*)(p.ws + OFF_SCL);
  const int gsz = gridDim.x * 256, gtid = blockIdx.x * 256 + threadIdx.x;
  for (int i = gtid; i < TS * 8; i += gsz) {
    const uint4* src = reinterpret_cast<const uint4*>(KEYS + (size_t)i * 32);
    u32 kk[32];
#pragma unroll
    for (int q = 0; q < 8; ++q) { const uint4 w = src[q]; kk[q * 4] = w.x; kk[q * 4 + 1] = w.y; kk[q * 4 + 2] = w.z; kk[q * 4 + 3] = w.w; }
    float s0[16], s1[16]; int i0[16], i1[16];
#pragma unroll
    for (int k = 0; k < 16; ++k) { s0[k] = dec_key(kk[k], i0[k]); s1[k] = dec_key(kk[16 + k], i1[k]); }
    float top[16];
#pragma unroll
    for (int k = 0; k < 16; ++k) top[k] = -3.0e38f;
#pragma unroll
    for (int k1 = 0; k1 < 16; ++k1)
#pragma unroll
      for (int k2 = 0; k2 < 16; ++k2)
        if ((k1 + 1) * (k2 + 1) <= 16) {
          float v = s0[k1] + s1[k2];
#pragma unroll
          for (int k = 0; k < 16; ++k) {
            const float hi = fmaxf(top[k], v);
            v = fminf(top[k], v);
            top[k] = hi;
          }
        }
    const float thr = top[15], mx = top[0];
    float den = 0.f;
#pragma unroll
    for (int k = 0; k < 16; ++k) den += __expf(top[k] - mx);
    const float inv = 1.f / den;
    int cnt = 0;
    int* idst = IDX + (size_t)i * 16;
    float* gdst = GATE + (size_t)i * 16;
    float* sdst = SU + (size_t)i * 16;
#pragma unroll
    for (int k1 = 0; k1 < 16; ++k1)
#pragma unroll
      for (int k2 = 0; k2 < 16; ++k2)
        if ((k1 + 1) * (k2 + 1) <= 16) {
          const float v = s0[k1] + s1[k2];
          if (v >= thr && cnt < 16) {
            const int e = i0[k1] * 128 + i1[k2];
            idst[cnt] = e;
            gdst[cnt] = __expf(v - mx) * inv * SCL[16384 + e];
            sdst[cnt] = SCL[e];
            ++cnt;
          }
        }
  }
}

DEVI f2 cvt8(u32 w, bool hi) { return hi ? __builtin_amdgcn_cvt_pk_f32_fp8((int)w, true) : __builtin_amdgcn_cvt_pk_f32_fp8((int)w, false); }

DEVI void phase_peer_gather(const Params& p, int s, int layer) {
  float* X = p.out + (size_t)s * TS * 1024;
  u16* XB = (u16*)(p.ws + OFF_XB);
  const unsigned char* Ub8 = p.ws + OFF_UB8;
  const unsigned char* Vb8 = p.ws + OFF_VB8;
  const int* IDX = (const int*)(p.ws + OFF_IDX);
  const float* GATE = (const float*)(p.ws + OFF_GATE);
  const float* SU = (const float*)(p.ws + OFF_SU);
  const float* gam = p.in[25] + layer * 1024;
  const float* bet = p.in[26] + layer * 1024;
  const int lane = threadIdx.x & 63, wave = threadIdx.x >> 6;
  const bool b5 = lane & 32, b4 = lane & 16, b3 = lane & 8;
  for (int t = blockIdx.x * 4 + wave; t < TS; t += gridDim.x * 4) {
    f2 x[8], o[8];
    {
      const float4* xp = reinterpret_cast<const float4*>(X + (size_t)t * 1024 + lane * 16);
      const float4 a = xp[0], b = xp[1], c = xp[2], d = xp[3];
      x[0] = f2{a.x, a.y}; x[1] = f2{a.z, a.w}; x[2] = f2{b.x, b.y}; x[3] = f2{b.z, b.w};
      x[4] = f2{c.x, c.y}; x[5] = f2{c.z, c.w}; x[6] = f2{d.x, d.y}; x[7] = f2{d.z, d.w};
    }
#pragma unroll
    for (int k = 0; k < 8; ++k) o[k] = f2{0.f, 0.f};
    const int iv0 = IDX[(size_t)t * 128 + lane], iv1 = IDX[(size_t)t * 128 + 64 + lane];
    const float gv0 = GATE[(size_t)t * 128 + lane], gv1 = GATE[(size_t)t * 128 + 64 + lane];
    const float su0 = SU[(size_t)t * 128 + lane], su1 = SU[(size_t)t * 128 + 64 + lane];
    for (int e0 = 0; e0 < 128; e0 += 8) {
      const bool lo = e0 < 64;
      const int ivs = lo ? iv0 : iv1;
      const float gvs = lo ? gv0 : gv1;
      const float sus = lo ? su0 : su1;
      uint4 uu[8], vv[8];
#pragma unroll
      for (int k = 0; k < 8; ++k) {
        const int ei = __builtin_amdgcn_readlane(ivs, (e0 & 63) + k);
        uu[k] = *reinterpret_cast<const uint4*>(Ub8 + (size_t)ei * 1024 + lane * 16);
        vv[k] = *reinterpret_cast<const uint4*>(Vb8 + (size_t)ei * 1024 + lane * 16);
      }
      float dk[8];
#pragma unroll
      for (int k = 0; k < 8; ++k) {
        f2 acc = cvt8(uu[k].x, false) * x[0];
        acc = cvt8(uu[k].x, true) * x[1] + acc;
        acc = cvt8(uu[k].y, false) * x[2] + acc;
        acc = cvt8(uu[k].y, true) * x[3] + acc;
        acc = cvt8(uu[k].z, false) * x[4] + acc;
        acc = cvt8(uu[k].z, true) * x[5] + acc;
        acc = cvt8(uu[k].w, false) * x[6] + acc;
        acc = cvt8(uu[k].w, true) * x[7] + acc;
        dk[k] = acc.x + acc.y;
      }
      float d4[4], d2[2], d1;
#pragma unroll
      for (int k = 0; k < 4; ++k) {
        const float keep = b5 ? dk[k + 4] : dk[k], send = b5 ? dk[k] : dk[k + 4];
        d4[k] = keep + __shfl_xor(send, 32);
      }
#pragma unroll
      for (int k = 0; k < 2; ++k) {
        const float keep = b4 ? d4[k + 2] : d4[k], send = b4 ? d4[k] : d4[k + 2];
        d2[k] = keep + __shfl_xor(send, 16);
      }
      {
        const float keep = b3 ? d2[1] : d2[0], send = b3 ? d2[0] : d2[1];
        d1 = keep + __shfl_xor(send, 8);
      }
      d1 += __shfl_xor(d1, 4);
      d1 += __shfl_xor(d1, 2);
      d1 += __shfl_xor(d1, 1);
      const int srcl = (e0 & 63) + (lane >> 3);
      const float suv = __shfl(sus, srcl), gvv = __shfl(gvs, srcl);
      const float w = gvv * gelu_(d1 * suv);
      const int wi = __float_as_int(w);
#pragma unroll
      for (int k = 0; k < 8; ++k) {
        const float wk = __int_as_float(__builtin_amdgcn_readlane(wi, k * 8));
        const f2 w2 = f2{wk, wk};
        o[0] = w2 * cvt8(vv[k].x, false) + o[0];
        o[1] = w2 * cvt8(vv[k].x, true) + o[1];
        o[2] = w2 * cvt8(vv[k].y, false) + o[2];
        o[3] = w2 * cvt8(vv[k].y, true) + o[3];
        o[4] = w2 * cvt8(vv[k].z, false) + o[4];
        o[5] = w2 * cvt8(vv[k].z, true) + o[5];
        o[6] = w2 * cvt8(vv[k].w, false) + o[6];
        o[7] = w2 * cvt8(vv[k].w, true) + o[7];
      }
    }
    float sm = 0.f;
#pragma unroll
    for (int k = 0; k < 8; ++k) { o[k] = ALPHA * x[k] + o[k]; sm += o[k].x + o[k].y; }
#pragma unroll
    for (int m = 32; m >= 1; m >>= 1) sm += __shfl_xor(sm, m);
    const float mu = sm * (1.f / 1024.f);
    float sq = 0.f;
#pragma unroll
    for (int k = 0; k < 8; ++k) { const float da = o[k].x - mu, db = o[k].y - mu; sq += da * da + db * db; }
#pragma unroll
    for (int m = 32; m >= 1; m >>= 1) sq += __shfl_xor(sq, m);
    const float rs = rsqrtf(sq * (1.f / 1024.f) + LN_EPS);
    const int c0 = lane * 16;
    float r[16];
#pragma unroll
    for (int k = 0; k < 8; ++k) {
      r[2 * k] = (o[k].x - mu) * rs * gam[c0 + 2 * k] + bet[c0 + 2 * k];
      r[2 * k + 1] = (o[k].y - mu) * rs * gam[c0 + 2 * k + 1] + bet[c0 + 2 * k + 1];
    }
    float4* dp = reinterpret_cast<float4*>(X + (size_t)t * 1024 + c0);
    dp[0] = float4{r[0], r[1], r[2], r[3]};
    dp[1] = float4{r[4], r[5], r[6], r[7]};
    dp[2] = float4{r[8], r[9], r[10], r[11]};
    dp[3] = float4{r[12], r[13], r[14], r[15]};
    uint4* bp = reinterpret_cast<uint4*>(XB + (size_t)t * 1024 + c0);
    bp[0] = pack8(r);
    bp[1] = pack8(r + 8);
  }
}

DEVI void phase_ple(const Params& p, int s, int layer, unsigned char* smem) {
  float* X = p.out + (size_t)s * TS * 1024;
  const u16* XB = (const u16*)(p.ws + OFF_XB);
  const float* P = p.in[2 + s] + (size_t)layer * TS * 256;
  const u16* Wp = (const u16*)(p.ws + OFF_WPROJ) + (size_t)layer * 1024 * 256;
  const u16* Wg = (const u16*)(p.ws + OFF_WPG) + (size_t)layer * 1024 * 1024;
  const int lane = threadIdx.x & 63, wave = threadIdx.x >> 6, wm = wave >> 1, wn = wave & 1;
  for (int it = 0, mt, nt; tile_map(it, 256, 8, mt, nt); ++it) {
    const int m0 = mt * 128, n0 = nt * 128;
    u32* pkl = reinterpret_cast<u32*>(smem + 36864) + threadIdx.x;
    gemm_tile_dma(XB + (size_t)m0 * 1024, 1024, Wg + (size_t)n0 * 1024, 1024, 1024, smem, [&](f32x4 (&acc)[4][4]) {
#pragma unroll
      for (int i = 0; i < 4; ++i)
#pragma unroll
        for (int j = 0; j < 4; ++j) {
          pkl[((i * 4 + j) * 2 + 0) * 256] = pack2(sigmoid_(acc[i][j][0]), sigmoid_(acc[i][j][1]));
          pkl[((i * 4 + j) * 2 + 1) * 256] = pack2(sigmoid_(acc[i][j][2]), sigmoid_(acc[i][j][3]));
        }
    });
    {
      LdF32 al{P + (size_t)m0 * 256, 256};
      LdBF bl{Wp + (size_t)n0 * 256, 256};
      gemm_tile(al, bl, 256, smem, [&](f32x4 (&acc)[4][4]) {
#pragma unroll
        for (int i = 0; i < 4; ++i)
#pragma unroll
          for (int j = 0; j < 4; ++j)
#pragma unroll
            for (int r = 0; r < 4; ++r) {
              const int row = m0 + wm * 64 + i * 16 + (lane >> 4) * 4 + r;
              const int col = n0 + wn * 64 + j * 16 + (lane & 15);
              const u32 w = pkl[((i * 4 + j) * 2 + (r >> 1)) * 256];
              const float sg = (r & 1) ? bfhi(w) : bflo(w);
              const size_t idx = (size_t)row * 1024 + col;
              X[idx] = X[idx] + acc[i][j][r] * sg;
            }
      });
    }
  }
}

DEVI void phase_rg_in(const Params& p, int s, unsigned char* smem) {
  const float* X = p.out + (size_t)s * TS * 1024;
  const u16* Wt = (const u16*)(p.ws + OFF_WRGIN);
  u16* GG = (u16*)(p.ws + OFF_GG);
  u16* R = (u16*)(p.ws + OFF_R);
  const int lane = threadIdx.x & 63, wave = threadIdx.x >> 6, wm = wave >> 1, wn = wave & 1;
  for (int it = 0, mt, nt; tile_map(it, 256, 16, mt, nt); ++it) {
    const int m0 = mt * 128, n0 = nt * 128;
    LdF32 al{X + (size_t)m0 * 1024, 1024};
    LdBF bl{Wt + (size_t)n0 * 1024, 1024};
    gemm_tile(al, bl, 1024, smem, [&](f32x4 (&acc)[4][4]) {
#pragma unroll
      for (int i = 0; i < 4; ++i)
#pragma unroll
        for (int j = 0; j < 4; ++j)
#pragma unroll
          for (int r = 0; r < 4; ++r) {
            const int row = m0 + wm * 64 + i * 16 + (lane >> 4) * 4 + r;
            const int col = n0 + wn * 64 + j * 16 + (lane & 15);
            if (n0 < 1024) GG[(size_t)row * 1024 + col] = f2bf(gelu_(acc[i][j][r]));
            else R[(size_t)row * 1024 + col - 1024] = f2bf(acc[i][j][r]);
          }
    });
  }
}

DEVI void phase_rg_conv(const Params& p, int s) {
  const int L = s ? 2048 : 4096;
  const u16* R = (const u16*)(p.ws + OFF_R);
  u16* C = (u16*)(p.ws + OFF_C);
  const float* cw = p.in[15];
  const float* cb = p.in[16];
  const int gsz = gridDim.x * 256, gtid = blockIdx.x * 256 + threadIdx.x;
  for (int i = gtid; i < TS * 128; i += gsz) {
    const int t = i >> 7, cv = (i & 127) * 8;
    const int pos = t & (L - 1);
    float acc[8];
#pragma unroll
    for (int j = 0; j < 8; ++j) acc[j] = cb[cv + j];
#pragma unroll
    for (int k = 0; k < 4; ++k) {
      const int pp = pos + k - 1;
      if (pp >= 0 && pp < L) {
        float rv[8];
        unpack8(*reinterpret_cast<const uint4*>(R + (size_t)(t + k - 1) * 1024 + cv), rv);
#pragma unroll
        for (int j = 0; j < 8; ++j) acc[j] = fmaf(rv[j], cw[k * 1024 + cv + j], acc[j]);
      }
    }
    *reinterpret_cast<uint4*>(C + (size_t)i * 8) = pack8(acc);
  }
}

DEVI void phase_rg_gates(const Params& p, unsigned char* smem) {
  const u16* C = (const u16*)(p.ws + OFF_C);
  const u16* Wt = (const u16*)(p.ws + OFF_WGATES);
  u32* AB = (u32*)(p.ws + OFF_AB);
  const float* ba = p.in[18];
  const float* bx = p.in[20];
  const float* lam = p.in[21];
  const int lane = threadIdx.x & 63, wave = threadIdx.x >> 6, wm = wave >> 1, wn = wave & 1;
  for (int it = 0, mt, nt32; tile_map(it, 256, 32, mt, nt32); ++it) {
    const int m0 = mt * 128, h = nt32 >> 3, nt = nt32 & 7, n0 = nt * 128;
    gemm_tile_dma(C + (size_t)m0 * 1024 + h * 256, 1024, Wt + ((size_t)h * 1024 + n0) * 256, 256, 256, smem, [&](f32x4 (&acc)[4][4]) {
#pragma unroll
      for (int jj = 0; jj < 4; jj += 2) {
        const int nb = n0 + wn * 64 + jj * 16;
        const int d = nb >> 9;
        const int ch = h * 256 + ((nb & 511) >> 5) * 16 + (lane & 15);
        const float bav = ba[d * 1024 + ch], bxv = bx[d * 1024 + ch];
        const float sp8 = -8.f * softplus_(-lam[d * 1024 + ch]);
#pragma unroll
        for (int i = 0; i < 4; ++i)
#pragma unroll
          for (int r = 0; r < 4; ++r) {
            const int row = m0 + wm * 64 + i * 16 + (lane >> 4) * 4 + r;
            const float rg = sigmoid_(acc[i][jj][r] + bav);
            const float ig = sigmoid_(acc[i][jj + 1][r] + bxv);
            const float la = sp8 * rg;
            const float cval = bf2f(C[(size_t)row * 1024 + ch]);
            const float b = __builtin_amdgcn_sqrtf(fmaxf(1.f - __expf(2.f * la), 0.f)) * ig * cval;
            AB[((size_t)row * 2 + d) * 1024 + ch] = pack2(la, b);
            if (r == 3) __builtin_amdgcn_sched_barrier(0);
          }
      }
    });
  }
}

DEVI void phase_rg_agg(const Params& p) {
  const u32* AB = (const u32*)(p.ws + OFF_AB);
  float2* AGG = (float2*)(p.ws + OFF_AGG);
  const int gsz = gridDim.x * 256, gtid = blockIdx.x * 256 + threadIdx.x;
  for (int i = gtid; i < 1024 * 2 * 1024; i += gsz) {
    const int ch = i & 1023, d = (i >> 10) & 1, chunk = i >> 11;
    const int c0 = chunk * 32;
    float h = 0.f, LA = 0.f;
#pragma unroll 8
    for (int k = 0; k < 32; ++k) {
      const int t = d ? (c0 + 31 - k) : (c0 + k);
      const u32 w = AB[((size_t)t * 2 + d) * 1024 + ch];
      const float la = bflo(w), b = bfhi(w);
      h = __expf(la) * h + b;
      LA += la;
    }
    AGG[((size_t)d * 1024 + chunk) * 1024 + ch] = float2{LA, h};
  }
}

DEVI void phase_rg_carry(const Params& p, int s) {
  const int L = s ? 2048 : 4096;
  const int nseq = TS / L, nch = L / 32;
  const float2* AGG = (const float2*)(p.ws + OFF_AGG);
  float* CAR = (float*)(p.ws + OFF_CAR);
  const int gsz = gridDim.x * 256, gtid = blockIdx.x * 256 + threadIdx.x;
  for (int i = gtid; i < nseq * 2 * 1024; i += gsz) {
    const int ch = i & 1023, d = (i >> 10) & 1, seq = i >> 11;
    float H = 0.f;
    for (int k = 0; k < nch; ++k) {
      const int chunk = seq * nch + (d ? (nch - 1 - k) : k);
      const size_t idx = ((size_t)d * 1024 + chunk) * 1024 + ch;
      CAR[idx] = H;
      const float2 ag = AGG[idx];
      H = __expf(ag.x) * H + ag.y;
    }
  }
}

DEVI void phase_rg_final(const Params& p) {
  const u32* AB = (const u32*)(p.ws + OFF_AB);
  const float* CAR = (const float*)(p.ws + OFF_CAR);
  const u16* GG = (const u16*)(p.ws + OFF_GG);
  u16* Y = (u16*)(p.ws + OFF_R);
  const int gsz = gridDim.x * 256, gtid = blockIdx.x * 256 + threadIdx.x;
  for (int i = gtid; i < 1024 * 1024; i += gsz) {
    const int ch = i & 1023, chunk = i >> 10;
    const int c0 = chunk * 32;
    float hf[32];
    float h = CAR[((size_t)chunk) * 1024 + ch];
#pragma unroll
    for (int k = 0; k < 32; ++k) {
      const u32 w = AB[((size_t)(c0 + k) * 2 + 0) * 1024 + ch];
      h = __expf(bflo(w)) * h + bfhi(w);
      hf[k] = h;
    }
    h = CAR[((size_t)1024 + chunk) * 1024 + ch];
#pragma unroll
    for (int k = 31; k >= 0; --k) {
      const u32 w = AB[((size_t)(c0 + k) * 2 + 1) * 1024 + ch];
      h = __expf(bflo(w)) * h + bfhi(w);
      const size_t idx = (size_t)(c0 + k) * 1024 + ch;
      Y[idx] = f2bf((hf[k] + h) * bf2f(GG[idx]));
    }
  }
}

DEVI void phase_rg_out(const Params& p, int s, unsigned char* smem) {
  float* X = p.out + (size_t)s * TS * 1024;
  const u16* Y = (const u16*)(p.ws + OFF_R);
  const u16* Wt = (const u16*)(p.ws + OFF_WRGOUT);
  const int lane = threadIdx.x & 63, wave = threadIdx.x >> 6, wm = wave >> 1, wn = wave & 1;
  for (int it = 0, mt, nt; tile_map(it, 256, 8, mt, nt); ++it) {
    const int m0 = mt * 128, n0 = nt * 128;
    gemm_tile_dma(Y + (size_t)m0 * 1024, 1024, Wt + (size_t)n0 * 1024, 1024, 1024, smem, [&](f32x4 (&acc)[4][4]) {
#pragma unroll
      for (int i = 0; i < 4; ++i)
#pragma unroll
        for (int j = 0; j < 4; ++j)
#pragma unroll
          for (int r = 0; r < 4; ++r) {
            const int row = m0 + wm * 64 + i * 16 + (lane >> 4) * 4 + r;
            const int col = n0 + wn * 64 + j * 16 + (lane & 15);
            const size_t idx = (size_t)row * 1024 + col;
            X[idx] = ALPHA * X[idx] + acc[i][j][r];
          }
    });
  }
}

constexpr int NPS = 22;
constexpr int NSETUP = 3;
constexpr int NPHASE = NSETUP + 2 * NPS;

template <int PH>
DEVI void run_phase(const Params& p, unsigned char* smem) {
  if constexpr (PH == 0) {
    phase_setup(p);
  } else if constexpr (PH == 1) {
    phase_setup2(p);
  } else if constexpr (PH == 2) {
    phase_setup3(p);
  } else {
    constexpr int s = (PH - NSETUP) / NPS, q = (PH - NSETUP) % NPS;
    if constexpr (q == 0) phase_s5_in(p, s, smem);
    else if constexpr (q == 1) phase_s5_state(p, smem);
    else if constexpr (q == 2) phase_s5_cscan(p, s);
    else if constexpr (q == 3) phase_s5_main(p, smem);
    else if constexpr (q == 4) phase_s5_glu(p, s, smem);
    else if constexpr (q == 5) phase_ln1_tables(p, s, 0);
    else if constexpr (q == 6) phase_peer_q(p, 0, smem);
    else if constexpr (q == 7) phase_peer_route(p);
    else if constexpr (q == 8) phase_peer_gather(p, s, 0);
    else if constexpr (q == 9) phase_ple(p, s, 0, smem);
    else if constexpr (q == 10) phase_rg_in(p, s, smem);
    else if constexpr (q == 11) phase_rg_conv(p, s);
    else if constexpr (q == 12) phase_rg_gates(p, smem);
    else if constexpr (q == 13) phase_rg_agg(p);
    else if constexpr (q == 14) phase_rg_carry(p, s);
    else if constexpr (q == 15) phase_rg_final(p);
    else if constexpr (q == 16) phase_rg_out(p, s, smem);
    else if constexpr (q == 17) phase_ln1_tables(p, s, 1);
    else if constexpr (q == 18) phase_peer_q(p, 1, smem);
    else if constexpr (q == 19) phase_peer_route(p);
    else if constexpr (q == 20) phase_peer_gather(p, s, 1);
    else if constexpr (q == 21) phase_ple(p, s, 1, smem);
  }
}

#define XB_TMO      128
#define XB_XCNT(j)  (256  + 64 * (j))
#define XB_XSUB(j)  (1280 + 64 * (j))
#define XB_XGEN(j)  (2304 + 64 * (j))
#define XB_TOP      3328
#define XB_TOPGEN   3392
#define XCD_BAR_WORDS 3456
#define XB_SPIN_CAP (1u << 18)
#define LAS __attribute__((address_space(3)))
DEVI unsigned xb_ld(unsigned* p) { return __hip_atomic_load(p, __ATOMIC_RELAXED, __HIP_MEMORY_SCOPE_AGENT); }
DEVI unsigned xb_add(unsigned* p, unsigned v) { return __hip_atomic_fetch_add(p, v, __ATOMIC_RELAXED, __HIP_MEMORY_SCOPE_AGENT); }
DEVI unsigned xb_xcc_id() { return (unsigned)__builtin_amdgcn_s_getreg((3 << 11) | 20) & 0xFu; }
#define XB_SPIN(cond, bar) do { unsigned _sp = 0; while (cond) { __builtin_amdgcn_s_sleep(1); \
    if ((++_sp & 255u) == 0u) { if (xb_ld(&(bar)[XB_TMO])) break; if (_sp > XB_SPIN_CAP) { atomicAdd(&(bar)[XB_TMO], 1u); break; } } } } while (0)
struct XcdBarrier { unsigned* bar; unsigned x; volatile LAS unsigned* st; };
DEVI XcdBarrier xcd_barrier_post(unsigned* bar, volatile LAS unsigned* st) {
  XcdBarrier b; b.bar = bar; b.x = xb_xcc_id(); b.st = st;
  if (threadIdx.x == 0) (void)xb_add(&bar[XB_XCNT(b.x)], 1u);
  return b;
}
DEVI void xcd_barrier_complete(unsigned* bar, unsigned x, unsigned& nloc, unsigned& nx) {
  const unsigned G = gridDim.x * gridDim.y * gridDim.z;
  unsigned sum, cnt, mine, sp = 0u;
  for (;;) {
    sum = 0u; cnt = 0u; mine = 0u;
#pragma unroll
    for (unsigned j = 0; j < 16; ++j) { const unsigned c = xb_ld(&bar[XB_XCNT(j)]); sum += c; cnt += (c > 0u) ? 1u : 0u; mine = (j == x) ? c : mine; }
    if (sum == G) break;
    __builtin_amdgcn_s_sleep(1);
    if ((++sp & 255u) == 0u) { if (xb_ld(&bar[XB_TMO])) break; if (sp > XB_SPIN_CAP) { atomicAdd(&bar[XB_TMO], 1u); break; } }
  }
  nloc = mine > 0u ? mine : 1u; nx = cnt > 0u ? cnt : 1u;
}
DEVI void xcd_barrier(const XcdBarrier& b) {
  asm volatile("s_waitcnt vmcnt(0)" ::: "memory");
  __syncthreads();
  if (threadIdx.x == 0) {
    unsigned* bar = b.bar;
    __builtin_amdgcn_s_waitcnt(0);
    unsigned nloc = b.st[0], nx = b.st[1];
    if (nloc == 0u) { xcd_barrier_complete(bar, b.x, nloc, nx); b.st[0] = nloc; b.st[1] = nx; }
    const unsigned old = xb_add(&bar[XB_XSUB(b.x)], 1u);
    const unsigned gen = old / nloc;
    if (old + 1u == (gen + 1u) * nloc) {
      __builtin_amdgcn_fence(__ATOMIC_RELEASE, "agent");
      asm volatile("s_waitcnt vmcnt(0)" ::: "memory");
      const unsigned og = xb_add(&bar[XB_TOP], 1u);
      const unsigned tg = og / nx;
      if (og + 1u == (tg + 1u) * nx) xb_add(&bar[XB_TOPGEN], 1u);
      else XB_SPIN(xb_ld(&bar[XB_TOPGEN]) == tg, bar);
      __builtin_amdgcn_fence(__ATOMIC_ACQUIRE, "agent");
      xb_add(&bar[XB_XGEN(b.x)], 1u);
      asm volatile("s_waitcnt vmcnt(0)" ::: "memory");
    } else {
      XB_SPIN(xb_ld(&bar[XB_XGEN(b.x)]) == gen, bar);
      __builtin_amdgcn_fence(__ATOMIC_ACQUIRE, "agent");
      asm volatile("s_waitcnt vmcnt(0)" ::: "memory");
    }
  }
  __syncthreads();
}

template <int PH>
DEVI void run_steps(const Params& p, int lo, int hi, unsigned char* smem, const XcdBarrier& xb) {
  if constexpr (PH < NPHASE) {
    if (PH >= lo && PH < hi) {
      run_phase<PH>(p, smem);
      if (PH + 1 < hi) {
        if (PH == 0) cg::this_grid().sync();
        else xcd_barrier(xb);
      }
    }
    run_steps<PH + 1>(p, lo, hi, smem, xb);
  }
}

__global__ void __launch_bounds__(256, 2) mega(Params p, int ph_lo, int ph_hi) {
  extern __shared__ __attribute__((aligned(16))) unsigned char smem[];
  volatile LAS unsigned* st = (volatile LAS unsigned*)(smem + LDS_BYTES);
  if (threadIdx.x == 0) { st[0] = 0u; st[1] = 0u; }
  __syncthreads();
  const XcdBarrier xb = xcd_barrier_post((unsigned*)(p.ws + OFF_BAR), st);
  run_steps<0>(p, ph_lo, ph_hi, smem, xb);
}

extern "C" void kernel_launch(void* const* d_in, const int* in_sizes, int n_in, void* d_out, int out_size, void* d_ws,
                              size_t ws_size, hipStream_t stream) {
  static int grid = 0;
  if (grid == 0) {
    if (n_in != 33 || ws_size < WS_END) {
      fprintf(stderr, "kernel_launch: need 33 inputs and %zu bytes ws; got %d, %zu\n", (size_t)WS_END, n_in, ws_size);
      grid = -1;
      return;
    }
    int dev = 0, cus = 0, per_cu = 0;
    hipGetDevice(&dev);
    hipDeviceGetAttribute(&cus, hipDeviceAttributeMultiprocessorCount, dev);
    if (hipFuncSetAttribute((const void*)mega, hipFuncAttributeMaxDynamicSharedMemorySize, LDS_BYTES + 16) != hipSuccess) {
      fprintf(stderr, "kernel_launch: hipFuncSetAttribute failed\n");
      grid = -1;
      return;
    }
    hipOccupancyMaxActiveBlocksPerMultiprocessor(&per_cu, (const void*)mega, 256, LDS_BYTES + 16);
    if (per_cu < 1) per_cu = 1;
    if (per_cu > 2) per_cu = 2;
    grid = cus * per_cu;
    fprintf(stderr, "kernel_launch: cus %d per_cu %d grid %d\n", cus, per_cu, grid);
  }
  if (grid < 0) return;
  (void)hipMemsetAsync((unsigned char*)d_ws + OFF_BAR, 0, XCD_BAR_WORDS * sizeof(unsigned), stream);
  Params p{};
  for (int i = 0; i < 33; ++i) p.in[i] = (const float*)d_in[i];
  p.out = (float*)d_out;
  p.ws = (unsigned char*)d_ws;
#if COOP
  int lo = 0, hi = NPHASE;
  void* args[] = {&p, &lo, &hi};
  hipError_t e = hipLaunchCooperativeKernel((const void*)mega, dim3(grid), dim3(256), args, LDS_BYTES + 16, stream);
  if (e != hipSuccess) fprintf(stderr, "cooperative launch failed: %s (grid %d)\n", hipGetErrorString(e), grid);
#else
  for (int ph = 0; ph < NPHASE; ++ph) {
    hipLaunchKernelGGL(mega, dim3(grid), dim3(256), LDS_BYTES + 16, stream, p, ph, ph + 1);
  }
#endif
}
```

```cpp
#include <hip/hip_runtime.h>
#include <hip/hip_cooperative_groups.h>
#include <cstdio>
namespace cg = cooperative_groups;

#ifndef COOP
#define COOP 1
#endif

typedef unsigned short u16;
typedef unsigned int u32;
using bf16x8 = __attribute__((ext_vector_type(8))) short;
using f32x4 = __attribute__((ext_vector_type(4))) float;
typedef float f2 __attribute__((ext_vector_type(2)));
typedef float v32f __attribute__((ext_vector_type(32)));
typedef float v16f __attribute__((ext_vector_type(16)));
typedef unsigned v6u __attribute__((ext_vector_type(6)));

#define DEVI __device__ __forceinline__

constexpr int TS = 32768;
constexpr float ALPHA = 1.41421356237309515f;
constexpr float LN_EPS = 1e-5f;
constexpr size_t MBy = 1ull << 20;

constexpr size_t OFF_WS5IN = 0;
constexpr size_t OFF_WGLU = 2 * MBy;
constexpr size_t OFF_WRGIN = 6 * MBy;
constexpr size_t OFF_WGATES = 10 * MBy;
constexpr size_t OFF_WRGOUT = 12 * MBy;
constexpr size_t OFF_WQ = 14 * MBy;
constexpr size_t OFF_SK = 22 * MBy;
constexpr size_t OFF_WPROJ = 23 * MBy;
constexpr size_t OFF_WPG = 24 * MBy;
constexpr size_t OFF_UB = 28 * MBy;
constexpr size_t OFF_VB = 60 * MBy;
constexpr size_t OFF_UB8 = OFF_UB;
constexpr size_t OFF_VB8 = OFF_UB + 16 * MBy;
constexpr size_t OFF_SCL = OFF_UB + 32 * MBy;
constexpr size_t OFF_ACT = 92 * MBy;
constexpr size_t OFF_XB = OFF_ACT;
constexpr size_t OFF_KEYS = OFF_ACT + 64 * MBy;
constexpr size_t OFF_IDX = OFF_ACT + 96 * MBy;
constexpr size_t OFF_GATE = OFF_ACT + 112 * MBy;
constexpr size_t OFF_SU = OFF_ACT + 128 * MBy;
constexpr size_t OFF_AP = OFF_ACT;
constexpr size_t OFF_HLOC = OFF_ACT + 104 * MBy;
constexpr size_t OFF_HB = OFF_ACT + 192 * MBy;
constexpr size_t OFF_GG = OFF_ACT;
constexpr size_t OFF_R = OFF_ACT + 64 * MBy;
constexpr size_t OFF_C = OFF_ACT + 128 * MBy;
constexpr size_t OFF_AB = OFF_ACT + 192 * MBy;
constexpr size_t OFF_AGG = OFF_ACT + 448 * MBy;
constexpr size_t OFF_CAR = OFF_ACT + 464 * MBy;
constexpr size_t OFF_BT1 = OFF_ACT + 472 * MBy;
constexpr size_t OFF_WST = OFF_BT1 + 48 * MBy;
constexpr size_t OFF_KTAB = OFF_WST + 16 * MBy;
constexpr size_t OFF_POW = OFF_KTAB + 4 * MBy;
constexpr size_t OFF_BBAR = OFF_POW + 3 * MBy;
constexpr size_t OFF_BAR = OFF_BBAR + 1 * MBy;
constexpr size_t WS_END = OFF_BAR + 1 * MBy;

constexpr int LDS_BYTES = 36864 + 32768;

struct Params {
  const float* in[33];
  float* out;
  unsigned char* ws;
};

DEVI u16 f2bf(float f) {
  u32 u = __float_as_uint(f);
  u += 0x7FFFu + ((u >> 16) & 1u);
  return (u16)(u >> 16);
}
DEVI float bf2f(u16 h) { return __uint_as_float(((u32)h) << 16); }
DEVI u32 pack2(float lo, float hi) { return (u32)f2bf(lo) | ((u32)f2bf(hi) << 16); }
DEVI float bflo(u32 w) { return __uint_as_float(w << 16); }
DEVI float bfhi(u32 w) { return __uint_as_float(w & 0xffff0000u); }
DEVI float sigmoid_(float x) { return __builtin_amdgcn_rcpf(1.f + __expf(-x)); }
DEVI float gelu_(float x) {
  float z = 0.7978845608028654f * (x + 0.044715f * x * x * x);
  return x * __builtin_amdgcn_rcpf(1.f + __expf(-2.f * z));
}
DEVI float softplus_(float x) { return fmaxf(x, 0.f) + log1pf(__expf(-fabsf(x))); }
DEVI void unpack8(const uint4& w, float* f) {
  f[0] = bflo(w.x); f[1] = bfhi(w.x); f[2] = bflo(w.y); f[3] = bfhi(w.y);
  f[4] = bflo(w.z); f[5] = bfhi(w.z); f[6] = bflo(w.w); f[7] = bfhi(w.w);
}
DEVI uint4 pack8(const float* f) {
  uint4 o; o.x = pack2(f[0], f[1]); o.y = pack2(f[2], f[3]); o.z = pack2(f[4], f[5]); o.w = pack2(f[6], f[7]);
  return o;
}

struct LdBF {
  const u16* base; int ld;
  typedef uint4 Raw;
  DEVI Raw load(int row, int k) const { return *reinterpret_cast<const uint4*>(base + (size_t)row * ld + k); }
  DEVI static uint4 cvt(const Raw& r) { return r; }
};
struct RawF { float4 a, b; };
struct LdF32 {
  const float* base; int ld;
  typedef RawF Raw;
  DEVI Raw load(int row, int k) const {
    const float4* q = reinterpret_cast<const float4*>(base + (size_t)row * ld + k);
    RawF r; r.a = q[0]; r.b = q[1]; return r;
  }
  DEVI static uint4 cvt(const Raw& r) {
    uint4 o; o.x = pack2(r.a.x, r.a.y); o.y = pack2(r.a.z, r.a.w); o.z = pack2(r.b.x, r.b.y); o.w = pack2(r.b.z, r.b.w);
    return o;
  }
};

template <class AL, class BL, class EP>
DEVI void gemm_tile(const AL al, const BL bl, const int K, unsigned char* smem, EP ep) {
  u16* As = reinterpret_cast<u16*>(smem);
  u16* Bs = As + 128 * 72;
  const int tid = threadIdx.x, lane = tid & 63, wave = tid >> 6, wm = wave >> 1, wn = wave & 1;
  const int lr = lane & 15, lq = lane >> 4;
  f32x4 acc[4][4];
#pragma unroll
  for (int i = 0; i < 4; ++i)
#pragma unroll
    for (int j = 0; j < 4; ++j) acc[i][j] = f32x4{0.f, 0.f, 0.f, 0.f};
  typename AL::Raw ra[4];
  typename BL::Raw rb[4];
  const int prow = tid >> 3, pk = (tid & 7) * 8;
#pragma unroll
  for (int i = 0; i < 4; ++i) { ra[i] = al.load(prow + i * 32, pk); rb[i] = bl.load(prow + i * 32, pk); }
  for (int kt = 0; kt < K; kt += 64) {
    __syncthreads();
#pragma unroll
    for (int i = 0; i < 4; ++i) {
      *reinterpret_cast<uint4*>(As + (prow + i * 32) * 72 + pk) = AL::cvt(ra[i]);
      *reinterpret_cast<uint4*>(Bs + (prow + i * 32) * 72 + pk) = BL::cvt(rb[i]);
    }
    __syncthreads();
    if (kt + 64 < K) {
#pragma unroll
      for (int i = 0; i < 4; ++i) { ra[i] = al.load(prow + i * 32, kt + 64 + pk); rb[i] = bl.load(prow + i * 32, kt + 64 + pk); }
    }
#pragma unroll
    for (int ks = 0; ks < 2; ++ks) {
      bf16x8 af[4], bfr[4];
#pragma unroll
      for (int i = 0; i < 4; ++i) af[i] = *reinterpret_cast<const bf16x8*>(As + (wm * 64 + i * 16 + lr) * 72 + ks * 32 + lq * 8);
#pragma unroll
      for (int j = 0; j < 4; ++j) bfr[j] = *reinterpret_cast<const bf16x8*>(Bs + (wn * 64 + j * 16 + lr) * 72 + ks * 32 + lq * 8);
#pragma unroll
      for (int i = 0; i < 4; ++i)
#pragma unroll
        for (int j = 0; j < 4; ++j) acc[i][j] = __builtin_amdgcn_mfma_f32_16x16x32_bf16(af[i], bfr[j], acc[i][j], 0, 0, 0);
    }
  }
  __syncthreads();
  ep(acc);
}

typedef __attribute__((address_space(3))) unsigned lds_u32;
template <class EP>
DEVI void gemm_tile_dma(const u16* A, const int lda, const u16* Bt, const int ldb, const int K, unsigned char* smem, EP ep) {
  const int tid = threadIdx.x, lane = tid & 63, wave = tid >> 6, wm = wave >> 1, wn = wave & 1;
  const int lr = lane & 15, lq = lane >> 4;
  f32x4 acc[4][4];
#pragma unroll
  for (int i = 0; i < 4; ++i)
#pragma unroll
    for (int j = 0; j < 4; ++j) acc[i][j] = f32x4{0.f, 0.f, 0.f, 0.f};
  const int rr = lane >> 3, qq = (lane & 7) ^ rr;
  const u16* ag = A + (size_t)(wave * 32 + rr) * lda + qq * 8;
  const u16* bg = Bt + (size_t)(wave * 32 + rr) * ldb + qq * 8;
  unsigned char* wbase = smem + wave * 4096;
#define GT_ISSUE(stage, kt)                                                                                              \
  do {                                                                                                                   \
    _Pragma("unroll") for (int j = 0; j < 4; ++j) {                                                                      \
      __builtin_amdgcn_global_load_lds((const unsigned*)(ag + (size_t)j * 8 * lda + (kt)),                               \
                                       (lds_u32*)(wbase + (stage) * 32768 + j * 1024), 16, 0, 0);                        \
      __builtin_amdgcn_global_load_lds((const unsigned*)(bg + (size_t)j * 8 * ldb + (kt)),                               \
                                       (lds_u32*)(wbase + (stage) * 32768 + 16384 + j * 1024), 16, 0, 0);                \
    }                                                                                                                    \
  } while (0)
  __syncthreads();
  GT_ISSUE(0, 0);
  const int sw = lr & 7;
  int it = 0;
  for (int kt = 0; kt < K; kt += 64, ++it) {
    asm volatile("s_waitcnt vmcnt(0)" ::: "memory");
    __syncthreads();
    if (kt + 64 < K) GT_ISSUE((it + 1) & 1, kt + 64);
    const unsigned char* As = smem + (it & 1) * 32768;
    const unsigned char* Bs = As + 16384;
#pragma unroll
    for (int ks = 0; ks < 2; ++ks) {
      bf16x8 af[4], bfr[4];
      const int ch = ((ks * 4 + lq) ^ sw) * 16;
#pragma unroll
      for (int i = 0; i < 4; ++i) af[i] = *reinterpret_cast<const bf16x8*>(As + (wm * 64 + i * 16 + lr) * 128 + ch);
#pragma unroll
      for (int j = 0; j < 4; ++j) bfr[j] = *reinterpret_cast<const bf16x8*>(Bs + (wn * 64 + j * 16 + lr) * 128 + ch);
#pragma unroll
      for (int i = 0; i < 4; ++i)
#pragma unroll
        for (int j = 0; j < 4; ++j) acc[i][j] = __builtin_amdgcn_mfma_f32_16x16x32_bf16(af[i], bfr[j], acc[i][j], 0, 0, 0);
    }
  }
#undef GT_ISSUE
  __syncthreads();
  ep(acc);
}

DEVI bool tile_map(int it, int nmt, int nnt, int& mt, int& nt) {
  const int xcd = blockIdx.x & 7, j = blockIdx.x >> 3;
  const int per = gridDim.x >> 3;
  const int slot = it * per + j;
  const int S = (slot >> 6) * 8 + xcd;
  const int nsn = nnt >> 3, nsm = nmt >> 3;
  if (S >= nsn * nsm) return false;
  const int sm = S / nsn, sn = S - sm * nsn;
  const int w = slot & 63;
  mt = sm * 8 + (w >> 3);
  nt = sn * 8 + (w & 7);
  return true;
}

template <int PERM>
DEVI void cvt_wt(const float* W, int K, int N, u16* out, int a0, int a1) {
  const int gsz = gridDim.x * 256, gtid = blockIdx.x * 256 + threadIdx.x;
  const int total = N * (K >> 3);
  for (int i = gtid; i < total; i += gsz) {
    const int n = i % N, kv = i / N;
    float v[8];
#pragma unroll
    for (int j = 0; j < 8; ++j) v[j] = W[(size_t)(kv * 8 + j) * N + n];
    int np = n;
    if (PERM == 1) { const int g = n >> 10, o = n & 1023; np = (o >> 4) * 32 + g * 16 + (o & 15); }
    if (PERM == 2) { np = a0 * 512 + (n >> 4) * 32 + a1 * 16 + (n & 15); }
    *reinterpret_cast<uint4*>(out + (size_t)np * K + kv * 8) = pack8(v);
  }
}

DEVI void cvt_plain(const float* src, u16* dst, size_t n8) {
  const size_t gsz = (size_t)gridDim.x * 256, gtid = (size_t)blockIdx.x * 256 + threadIdx.x;
  for (size_t i = gtid; i < n8; i += gsz) {
    const float4* q = reinterpret_cast<const float4*>(src + i * 8);
    float4 a = q[0], b = q[1];
    uint4 o; o.x = pack2(a.x, a.y); o.y = pack2(a.z, a.w); o.z = pack2(b.x, b.y); o.w = pack2(b.z, b.w);
    *reinterpret_cast<uint4*>(dst + i * 8) = o;
  }
}

DEVI void phase_setup(const Params& p) {
  unsigned char* ws = p.ws;
  cvt_wt<0>(p.in[4], 1024, 1024, (u16*)(ws + OFF_WS5IN), 0, 0);
  cvt_wt<1>(p.in[13], 1024, 2048, (u16*)(ws + OFF_WGLU), 0, 0);
  cvt_wt<0>(p.in[14], 1024, 2048, (u16*)(ws + OFF_WRGIN), 0, 0);
  for (int d = 0; d < 2; ++d)
    for (int gate = 0; gate < 2; ++gate)
      for (int h = 0; h < 4; ++h)
        cvt_wt<2>((gate ? p.in[19] : p.in[17]) + (size_t)(d * 4 + h) * 65536, 256, 256,
                  (u16*)(ws + OFF_WGATES) + (size_t)h * 1024 * 256, d, gate);
  cvt_wt<0>(p.in[22], 1024, 1024, (u16*)(ws + OFF_WRGOUT), 0, 0);
  for (int l = 0; l < 2; ++l) {
    cvt_wt<0>(p.in[27] + (size_t)l * 1024 * 2048, 1024, 2048, (u16*)(ws + OFF_WQ) + (size_t)l * 2048 * 1024, 0, 0);
    cvt_wt<0>(p.in[31] + (size_t)l * 256 * 1024, 256, 1024, (u16*)(ws + OFF_WPROJ) + (size_t)l * 1024 * 256, 0, 0);
    cvt_wt<0>(p.in[32] + (size_t)l * 1024 * 1024, 1024, 1024, (u16*)(ws + OFF_WPG) + (size_t)l * 1024 * 1024, 0, 0);
  }
  cvt_plain(p.in[28], (u16*)(ws + OFF_SK), 65536 / 8);
  const int gsz = gridDim.x * 256, gtid = blockIdx.x * 256 + threadIdx.x;
  float2* POW = (float2*)(ws + OFF_POW);
  float2* BBAR = (float2*)(ws + OFF_BBAR);
  for (int i = gtid; i < 2 * 64 * 33 * 64; i += gsz) {
    const int pp = i & 63, n = (i >> 6) % 33, dg = i / (64 * 33);
    const float step = expf(p.in[7][dg]);
    const float lr_ = p.in[5][dg * 64 + pp], li_ = p.in[6][dg * 64 + pp];
    const float mag = expf((float)n * (lr_ * step)), ang = (float)n * (li_ * step);
    POW[i] = float2{mag * cosf(ang), mag * sinf(ang)};
  }
  for (int i = gtid; i < 2 * 64 * 64; i += gsz) {
    const int dg = i >> 6;
    const float step = expf(p.in[7][dg]);
    const float lr_ = p.in[5][i], li_ = p.in[6][i];
    const float mag = expf(lr_ * step), ang = li_ * step;
    const float ar = mag * cosf(ang), ai = mag * sinf(ang);
    const float den = lr_ * lr_ + li_ * li_;
    const float zr = ar - 1.f;
    const float qr = (zr * lr_ + ai * li_) / den, qi = (ai * lr_ - zr * li_) / den;
#pragma unroll
    for (int c = 0; c < 16; ++c) {
      const float br = p.in[8][(size_t)i * 16 + c], bi = p.in[9][(size_t)i * 16 + c];
      BBAR[(size_t)i * 16 + c] = float2{qr * br - qi * bi, qr * bi + qi * br};
    }
  }
}

DEVI float s5_kterm(const Params& p, const float2* POW, const float2* BBAR, int d, int g, int n, int c, int cp) {
  const int dg = d * 64 + g;
  const float* cr = p.in[10] + ((size_t)dg * 16 + c) * 64;
  const float* ci = p.in[11] + ((size_t)dg * 16 + c) * 64;
  const float2* E = POW + ((size_t)dg * 33 + n) * 64;
  const float2* BB = BBAR + (size_t)dg * 64 * 16 + cp;
  float s = 0.f;
#pragma unroll 8
  for (int pp = 0; pp < 64; ++pp) {
    const float2 e = E[pp], bb = BB[pp * 16];
    const float Cr = cr[pp], Ci = ci[pp];
    const float cer = Cr * e.x - Ci * e.y, cei = Cr * e.y + Ci * e.x;
    s += cer * bb.x - cei * bb.y;
  }
  return s;
}

DEVI void phase_setup2(const Params& p) {
  unsigned char* ws = p.ws;
  const int gsz = gridDim.x * 256, gtid = blockIdx.x * 256 + threadIdx.x;
  const float2* POW = (const float2*)(ws + OFF_POW);
  const float2* BBAR = (const float2*)(ws + OFF_BBAR);
  float* KTAB = (float*)(ws + OFF_KTAB);
  u16* WST = (u16*)(ws + OFF_WST);
  u16* BT1 = (u16*)(ws + OFF_BT1);
  for (int i = gtid; i < 64 * 63 * 256; i += gsz) {
    const int cp = i & 15, c = (i >> 4) & 15, ti = (i >> 8) % 63, g = i / (63 * 256);
    const int tau = ti - 31;
    float s = 0.f;
    if (tau >= 0) s += s5_kterm(p, POW, BBAR, 0, g, tau, c, cp);
    if (tau <= 0) s += s5_kterm(p, POW, BBAR, 1, g, -tau, c, cp);
    KTAB[i] = s;
  }
  for (int i = gtid; i < 64 * 256 * 64; i += gsz) {
    const int kv = i & 63, np = (i >> 6) & 255, g = i >> 14;
    const int d = np >> 7, ri = (np >> 6) & 1, pp = np & 63, s = kv >> 1, c0 = (kv & 1) * 8;
    const int npow = d ? s : 31 - s;
    const float2 e = POW[((size_t)(d * 64 + g) * 33 + npow) * 64 + pp];
    float v[8];
#pragma unroll
    for (int j = 0; j < 8; ++j) {
      const float2 bb = BBAR[((size_t)(d * 64 + g) * 64 + pp) * 16 + c0 + j];
      v[j] = ri ? (e.x * bb.y + e.y * bb.x) : (e.x * bb.x - e.y * bb.y);
    }
    *reinterpret_cast<uint4*>(WST + ((size_t)g * 256 + np) * 512 + kv * 8) = pack8(v);
  }
  for (int i = gtid; i < 64 * 512 * 32; i += gsz) {
    const int kv = i & 31, n = (i >> 5) & 511, g = i >> 14;
    const int t = n >> 4, c = n & 15, kk0 = kv * 8;
    const int d = kk0 >> 7, ri = (kk0 >> 6) & 1, p0 = kk0 & 63;
    const int npow = d ? 32 - t : t + 1;
    const int dg = d * 64 + g;
    float v[8];
#pragma unroll
    for (int j = 0; j < 8; ++j) {
      const int pp = p0 + j;
      const float Cr = p.in[10][((size_t)dg * 16 + c) * 64 + pp], Ci = p.in[11][((size_t)dg * 16 + c) * 64 + pp];
      const float2 e = POW[((size_t)dg * 33 + npow) * 64 + pp];
      v[j] = ri ? -(Cr * e.y + Ci * e.x) : (Cr * e.x - Ci * e.y);
    }
    *reinterpret_cast<uint4*>(BT1 + ((size_t)g * 512 + n) * 768 + 512 + kv * 8) = pack8(v);
  }
}

DEVI void phase_setup3(const Params& p) {
  const int gsz = gridDim.x * 256, gtid = blockIdx.x * 256 + threadIdx.x;
  const float* KTAB = (const float*)(p.ws + OFF_KTAB);
  u16* BT1 = (u16*)(p.ws + OFF_BT1);
  for (int i = gtid; i < 64 * 512 * 64; i += gsz) {
    const int kv = i & 63, n = (i >> 6) & 511, g = i >> 15;
    const int t = n >> 4, c = n & 15, s = kv >> 1, c0 = (kv & 1) * 8;
    const float* src = KTAB + (((size_t)g * 63 + (t - s + 31)) * 16 + c) * 16 + c0;
    float v[8];
#pragma unroll
    for (int j = 0; j < 8; ++j) v[j] = src[j];
    *reinterpret_cast<uint4*>(BT1 + ((size_t)g * 512 + n) * 768 + kv * 8) = pack8(v);
  }
}

DEVI void phase_s5_in(const Params& p, int s, unsigned char* smem) {
  const float* X = p.in[s];
  const u16* Wt = (const u16*)(p.ws + OFF_WS5IN);
  u16* AP = (u16*)(p.ws + OFF_AP);
  const int lane = threadIdx.x & 63, wave = threadIdx.x >> 6, wm = wave >> 1, wn = wave & 1;
  for (int it = 0, mt, nt; tile_map(it, 256, 8, mt, nt); ++it) {
    const int m0 = mt * 128, n0 = nt * 128;
    LdF32 al{X + (size_t)m0 * 1024, 1024};
    LdBF bl{Wt + (size_t)n0 * 1024, 1024};
    gemm_tile(al, bl, 1024, smem, [&](f32x4 (&acc)[4][4]) {
#pragma unroll
      for (int i = 0; i < 4; ++i)
#pragma unroll
        for (int j = 0; j < 4; ++j)
#pragma unroll
          for (int r = 0; r < 4; ++r) {
            const int row = m0 + wm * 64 + i * 16 + (lane >> 4) * 4 + r;
            const int col = n0 + wn * 64 + j * 16 + (lane & 15);
            AP[((size_t)(col >> 4) * 1024 + (row >> 5)) * 768 + (row & 31) * 16 + (col & 15)] = f2bf(acc[i][j][r]);
          }
    });
  }
}

DEVI void phase_s5_state(const Params& p, unsigned char* smem) {
  const u16* AP = (const u16*)(p.ws + OFF_AP);
  const u16* WST = (const u16*)(p.ws + OFF_WST);
  float* HLOC = (float*)(p.ws + OFF_HLOC);
  const int lane = threadIdx.x & 63, wave = threadIdx.x >> 6, wm = wave >> 1, wn = wave & 1;
  for (int tile = blockIdx.x; tile < 64 * 16; tile += gridDim.x) {
    const int g = tile >> 4, m0 = ((tile >> 1) & 7) * 128, n0 = (tile & 1) * 128;
    gemm_tile_dma(AP + ((size_t)g * 1024 + m0) * 768, 768, WST + ((size_t)g * 256 + n0) * 512, 512, 512, smem, [&](f32x4 (&acc)[4][4]) {
#pragma unroll
      for (int i = 0; i < 4; ++i)
#pragma unroll
        for (int j = 0; j < 4; ++j)
#pragma unroll
          for (int r = 0; r < 4; ++r) {
            const int row = m0 + wm * 64 + i * 16 + (lane >> 4) * 4 + r;
            const int col = n0 + wn * 64 + j * 16 + (lane & 15);
            HLOC[((size_t)g * 1024 + row) * 256 + col] = acc[i][j][r];
          }
    });
  }
}

DEVI void phase_s5_cscan(const Params& p, int s) {
  const int L = s ? 2048 : 4096;
  const int nseq = TS / L, nch = L / 32;
  u16* AP = (u16*)(p.ws + OFF_AP);
  const float* HLOC = (const float*)(p.ws + OFF_HLOC);
  const float2* POW = (const float2*)(p.ws + OFF_POW);
  const int gsz = gridDim.x * 256, gtid = blockIdx.x * 256 + threadIdx.x;
  for (int i = gtid; i < 64 * nseq * 128; i += gsz) {
    const int pp = i & 63, d = (i >> 6) & 1, g = (i >> 7) & 63, seq = i >> 13;
    const float2 e = POW[((size_t)(d * 64 + g) * 33 + 32) * 64 + pp];
    float Hr = 0.f, Hi = 0.f;
#pragma unroll 4
    for (int j = 0; j < nch; ++j) {
      const int chunk = seq * nch + (d ? (nch - 1 - j) : j);
      u16* ap = AP + ((size_t)g * 1024 + chunk) * 768 + 512 + d * 128 + pp;
      ap[0] = f2bf(Hr);
      ap[64] = f2bf(Hi);
      const float* hl = HLOC + ((size_t)g * 1024 + chunk) * 256 + d * 128 + pp;
      const float a = hl[0], b = hl[64];
      const float nHr = e.x * Hr - e.y * Hi + a;
      const float nHi = e.x * Hi + e.y * Hr + b;
      Hr = nHr; Hi = nHi;
    }
  }
}

DEVI void phase_s5_main(const Params& p, unsigned char* smem) {
  const u16* AP = (const u16*)(p.ws + OFF_AP);
  const u16* BT1 = (const u16*)(p.ws + OFF_BT1);
  u16* HB = (u16*)(p.ws + OFF_HB);
  const float* dsk = p.in[12];
  const int lane = threadIdx.x & 63, wave = threadIdx.x >> 6, wm = wave >> 1, wn = wave & 1;
  for (int tile = blockIdx.x; tile < 64 * 32; tile += gridDim.x) {
    const int g = tile >> 5, m0 = ((tile >> 2) & 7) * 128, n0 = (tile & 3) * 128;
    gemm_tile_dma(AP + ((size_t)g * 1024 + m0) * 768, 768, BT1 + ((size_t)g * 512 + n0) * 768, 768, 768, smem, [&](f32x4 (&acc)[4][4]) {
      const float dv = dsk[g * 16 + (lane & 15)];
#pragma unroll
      for (int i = 0; i < 4; ++i)
#pragma unroll
        for (int j = 0; j < 4; ++j)
#pragma unroll
          for (int r = 0; r < 4; ++r) {
            const int chunk = m0 + wm * 64 + i * 16 + (lane >> 4) * 4 + r;
            const int n = n0 + wn * 64 + j * 16 + (lane & 15);
            const float u = bf2f(AP[((size_t)g * 1024 + chunk) * 768 + n]);
            const float y = acc[i][j][r] + dv * u;
            HB[((size_t)chunk * 32 + (n >> 4)) * 1024 + g * 16 + (lane & 15)] = f2bf(gelu_(y));
          }
    });
  }
}

DEVI void phase_s5_glu(const Params& p, int s, unsigned char* smem) {
  const u16* HB = (const u16*)(p.ws + OFF_HB);
  const u16* Wt = (const u16*)(p.ws + OFF_WGLU);
  const float* Xin = p.in[s];
  float* Xo = p.out + (size_t)s * TS * 1024;
  const int lane = threadIdx.x & 63, wave = threadIdx.x >> 6, wm = wave >> 1, wn = wave & 1;
  for (int it = 0, mt, nt; tile_map(it, 256, 16, mt, nt); ++it) {
    const int m0 = mt * 128, n0 = nt * 128;
    gemm_tile_dma(HB + (size_t)m0 * 1024, 1024, Wt + (size_t)n0 * 1024, 1024, 1024, smem, [&](f32x4 (&acc)[4][4]) {
#pragma unroll
      for (int i = 0; i < 4; ++i)
#pragma unroll
        for (int jj = 0; jj < 4; jj += 2)
#pragma unroll
          for (int r = 0; r < 4; ++r) {
            const int row = m0 + wm * 64 + i * 16 + (lane >> 4) * 4 + r;
            const int nb = n0 + wn * 64 + jj * 16;
            const int o = (nb >> 5) * 16 + (lane & 15);
            const float mix = acc[i][jj][r] * sigmoid_(acc[i][jj + 1][r]);
            const size_t idx = (size_t)row * 1024 + o;
            Xo[idx] = ALPHA * Xin[idx] + mix;
          }
    });
  }
}

DEVI void phase_ln1_tables(const Params& p, int s, int layer, unsigned char* smem) {
  float* X = p.out + (size_t)s * TS * 1024;
  u16* XB = (u16*)(p.ws + OFF_XB);
  const float* gam = p.in[23] + layer * 1024;
  const float* bet = p.in[24] + layer * 1024;
  const int lane = threadIdx.x & 63, wave = threadIdx.x >> 6;
  for (int t = blockIdx.x * 4 + wave; t < TS; t += gridDim.x * 4) {
    float4 v[4];
#pragma unroll
    for (int i = 0; i < 4; ++i) v[i] = *reinterpret_cast<const float4*>(X + (size_t)t * 1024 + i * 256 + lane * 4);
    float sm = 0.f;
#pragma unroll
    for (int i = 0; i < 4; ++i) sm += v[i].x + v[i].y + v[i].z + v[i].w;
#pragma unroll
    for (int m = 32; m >= 1; m >>= 1) sm += __shfl_xor(sm, m);
    const float mu = sm * (1.f / 1024.f);
    float sq = 0.f;
#pragma unroll
    for (int i = 0; i < 4; ++i) {
      const float a = v[i].x - mu, b = v[i].y - mu, c = v[i].z - mu, d = v[i].w - mu;
      sq += a * a + b * b + c * c + d * d;
    }
#pragma unroll
    for (int m = 32; m >= 1; m >>= 1) sq += __shfl_xor(sq, m);
    const float rs = rsqrtf(sq * (1.f / 1024.f) + LN_EPS);
#pragma unroll
    for (int i = 0; i < 4; ++i) {
      const int c0 = i * 256 + lane * 4;
      const float4 g4 = *reinterpret_cast<const float4*>(gam + c0);
      const float4 b4 = *reinterpret_cast<const float4*>(bet + c0);
      float4 o;
      o.x = (v[i].x - mu) * rs * g4.x + b4.x; o.y = (v[i].y - mu) * rs * g4.y + b4.y;
      o.z = (v[i].z - mu) * rs * g4.z + b4.z; o.w = (v[i].w - mu) * rs * g4.w + b4.w;
      *reinterpret_cast<float4*>(X + (size_t)t * 1024 + c0) = o;
      uint2 pk; pk.x = pack2(o.x, o.y); pk.y = pack2(o.z, o.w);
      *reinterpret_cast<uint2*>(XB + (size_t)t * 1024 + c0) = pk;
    }
  }
  float* SCL = (float*)(p.ws + OFF_SCL);
  float* lds = reinterpret_cast<float*>(smem) + (threadIdx.x & 63) + (threadIdx.x >> 6) * 2048;
  int srck[32];
  {
    v16f ra, rb;
#pragma unroll
    for (int j = 0; j < 16; ++j) { ra[j] = (j < 8) ? 0.125f * j : 1.f + 0.125f * (j - 8); rb[j] = (j < 8) ? 2.f + 0.25f * j : 4.f + 0.5f * (j - 8); }
    const v6u pk = __builtin_amdgcn_cvt_scalef32_2xpk16_fp6_f32(ra, rb, 1.0f);
    const v32f dd = __builtin_amdgcn_cvt_scalef32_pk32_f32_fp6(pk, 1.0f);
#pragma unroll
    for (int k = 0; k < 32; ++k) {
      const float v = dd[k];
      const float fi = v < 1.f ? v * 8.f : (v < 2.f ? 8.f + (v - 1.f) * 8.f : (v < 4.f ? 16.f + (v - 2.f) * 4.f : 24.f + (v - 4.f) * 2.f));
      srck[k] = ((int)(fi + 0.5f)) & 31;
    }
  }
  const int ll = lane & 31, hs = lane >> 5;
  for (int r2 = blockIdx.x * 4 + wave; r2 < 16384; r2 += gridDim.x * 4) {
    const int r = r2 * 2 + hs;
    const int tab = r >> 14, row = r & 16383;
    const float4* sp = reinterpret_cast<const float4*>(p.in[29 + tab] + ((size_t)layer * 16384 + row) * 1024 + ll * 32);
    float s[32];
#pragma unroll
    for (int j = 0; j < 8; ++j) { const float4 a = sp[j]; s[4 * j] = a.x; s[4 * j + 1] = a.y; s[4 * j + 2] = a.z; s[4 * j + 3] = a.w; }
    float am = 0.f;
#pragma unroll
    for (int k = 0; k < 32; ++k) am = fmaxf(am, fabsf(s[k]));
#pragma unroll
    for (int m = 16; m >= 1; m >>= 1) am = fmaxf(am, __shfl_xor(am, m));
    const float sc = am > 0.f ? 7.5f / am : 1.f;
    const float inv = am > 0.f ? am * (1.f / 7.5f) : 1.f;
#pragma unroll
    for (int k = 0; k < 32; ++k) lds[srck[k] * 64] = s[k] * sc;
    v16f ia, ib;
#pragma unroll
    for (int j = 0; j < 16; ++j) { ia[j] = lds[j * 64]; ib[j] = lds[(16 + j) * 64]; }
    const v6u pk = __builtin_amdgcn_cvt_scalef32_2xpk16_fp6_f32(ia, ib, 1.0f);
    unsigned char* dst = p.ws + (tab ? OFF_VB8 : OFF_UB8) + (size_t)row * 768;
    *reinterpret_cast<uint4*>(dst + ll * 16) = uint4{pk[0], pk[1], pk[2], pk[3]};
    *reinterpret_cast<uint2*>(dst + 512 + ll * 8) = uint2{pk[4], pk[5]};
    if (ll == 0) SCL[tab * 16384 + row] = inv;
  }
}

DEVI u32 enc_key(float s, int n) {
  u32 b = __float_as_uint(s);
  u32 srt = (b & 0x80000000u) ? ~b : (b | 0x80000000u);
  return (srt & ~127u) | (u32)(127 - n);
}
DEVI float dec_key(u32 key, int& n) {
  n = 127 - (int)(key & 127u);
  u32 srt = key & ~127u;
  u32 b = (srt & 0x80000000u) ? (srt & 0x7fffffffu) : ~srt;
  return __uint_as_float(b);
}

DEVI void phase_peer_q(const Params& p, int layer, unsigned char* smem) {
  const u16* XB = (const u16*)(p.ws + OFF_XB);
  const u16* Wt = (const u16*)(p.ws + OFF_WQ) + (size_t)layer * 2048 * 1024;
  const u16* SK = (const u16*)(p.ws + OFF_SK) + (size_t)layer * 2 * 128 * 128;
  u32* KEYS = (u32*)(p.ws + OFF_KEYS);
  const int tid = threadIdx.x, lane = tid & 63, wave = tid >> 6, wm = wave >> 1, wn = wave & 1;
  const int lr = lane & 15, lq = lane >> 4;
  u16* Qs = reinterpret_cast<u16*>(smem);
  u32* Sk = reinterpret_cast<u32*>(smem);
  for (int it = 0, mt, nt; tile_map(it, 256, 16, mt, nt); ++it) {
    const int m0 = mt * 128, hc = nt, n0 = hc * 128;
    const int c = hc & 1;
    gemm_tile_dma(XB + (size_t)m0 * 1024, 1024, Wt + (size_t)n0 * 1024, 1024, 1024, smem, [&](f32x4 (&acc)[4][4]) {
#pragma unroll
      for (int i = 0; i < 4; ++i)
#pragma unroll
        for (int j = 0; j < 4; ++j)
#pragma unroll
          for (int r = 0; r < 4; ++r)
            Qs[(wm * 64 + i * 16 + lq * 4 + r) * 136 + wn * 64 + j * 16 + lr] = f2bf(acc[i][j][r]);
      __syncthreads();
      f32x4 sc[4][4];
#pragma unroll
      for (int i = 0; i < 4; ++i)
#pragma unroll
        for (int j = 0; j < 4; ++j) sc[i][j] = f32x4{0.f, 0.f, 0.f, 0.f};
      const u16* skc = SK + (size_t)c * 128 * 128;
#pragma unroll
      for (int ks = 0; ks < 4; ++ks) {
        bf16x8 af[4], bfr[4];
#pragma unroll
        for (int i = 0; i < 4; ++i) af[i] = *reinterpret_cast<const bf16x8*>(Qs + (wm * 64 + i * 16 + lr) * 136 + ks * 32 + lq * 8);
#pragma unroll
        for (int j = 0; j < 4; ++j) bfr[j] = *reinterpret_cast<const bf16x8*>(skc + (size_t)(wn * 64 + j * 16 + lr) * 128 + ks * 32 + lq * 8);
#pragma unroll
        for (int i = 0; i < 4; ++i)
#pragma unroll
          for (int j = 0; j < 4; ++j) sc[i][j] = __builtin_amdgcn_mfma_f32_16x16x32_bf16(af[i], bfr[j], sc[i][j], 0, 0, 0);
      }
      __syncthreads();
#pragma unroll
      for (int i = 0; i < 4; ++i)
#pragma unroll
        for (int j = 0; j < 4; ++j)
#pragma unroll
          for (int r = 0; r < 4; ++r) {
            const int n = wn * 64 + j * 16 + lr;
            Sk[(wm * 64 + i * 16 + lq * 4 + r) * 129 + n] = enc_key(sc[i][j][r], n);
          }
      __syncthreads();
      if (tid < 128) {
        u32 top[16];
#pragma unroll
        for (int k = 0; k < 16; ++k) top[k] = 0u;
#pragma unroll 4
        for (int n = 0; n < 128; ++n) {
          u32 v = Sk[tid * 129 + n];
#pragma unroll
          for (int k = 0; k < 16; ++k) {
            const u32 hi = max(top[k], v);
            v = min(top[k], v);
            top[k] = hi;
          }
        }
        uint4* dst = reinterpret_cast<uint4*>(KEYS + ((size_t)(m0 + tid) * 16 + hc) * 16);
        dst[0] = uint4{top[0], top[1], top[2], top[3]};
        dst[1] = uint4{top[4], top[5], top[6], top[7]};
        dst[2] = uint4{top[8], top[9], top[10], top[11]};
        dst[3] = uint4{top[12], top[13], top[14], top[15]};
      }
    });
  }
}

DEVI void phase_peer_route(const Params& p) {
  const u32* KEYS = (const u32*)(p.ws + OFF_KEYS);
  int* IDX = (int*)(p.ws + OFF_IDX);
  float* GATE = (float*)(p.ws + OFF_GATE);
  float* SU = (float*)(p.ws + OFF_SU);
  const float* SCL = (const float*)(p.ws + OFF_SCL);
  const int gsz = gridDim.x * 256, gtid = blockIdx.x * 256 + threadIdx.x;
  for (int i = gtid; i < TS * 8; i += gsz) {
    const uint4* src = reinterpret_cast<const uint4*>(KEYS + (size_t)i * 32);
    u32 kk[32];
#pragma unroll
    for (int q = 0; q < 8; ++q) { const uint4 w = src[q]; kk[q * 4] = w.x; kk[q * 4 + 1] = w.y; kk[q * 4 + 2] = w.z; kk[q * 4 + 3] = w.w; }
    float s0[16], s1[16]; int i0[16], i1[16];
#pragma unroll
    for (int k = 0; k < 16; ++k) { s0[k] = dec_key(kk[k], i0[k]); s1[k] = dec_key(kk[16 + k], i1[k]); }
    float top[16];
#pragma unroll
    for (int k = 0; k < 16; ++k) top[k] = -3.0e38f;
#pragma unroll
    for (int k1 = 0; k1 < 16; ++k1)
#pragma unroll
      for (int k2 = 0; k2 < 16; ++k2)
        if ((k1 + 1) * (k2 + 1) <= 16) {
          float v = s0[k1] + s1[k2];
#pragma unroll
          for (int k = 0; k < 16; ++k) {
            const float hi = fmaxf(top[k], v);
            v = fminf(top[k], v);
            top[k] = hi;
          }
        }
    const float thr = top[15], mx = top[0];
    float den = 0.f;
#pragma unroll
    for (int k = 0; k < 16; ++k) den += __expf(top[k] - mx);
    const float inv = 1.f / den;
    int cnt = 0;
    int* idst = IDX + (size_t)i * 16;
    float* gdst = GATE + (size_t)i * 16;
    float* sdst = SU + (size_t)i * 16;
#pragma unroll
    for (int k1 = 0; k1 < 16; ++k1)
#pragma unroll
      for (int k2 = 0; k2 < 16; ++k2)
        if ((k1 + 1) * (k2 + 1) <= 16) {
          const float v = s0[k1] + s1[k2];
          if (v >= thr && cnt < 16) {
            const int e = i0[k1] * 128 + i1[k2];
            idst[cnt] = e;
            gdst[cnt] = __expf(v - mx) * inv * SCL[16384 + e];
            sdst[cnt] = SCL[e];
            ++cnt;
          }
        }
  }
}

DEVI f2 cvt8(u32 w, bool hi) { return hi ? __builtin_amdgcn_cvt_pk_f32_fp8((int)w, true) : __builtin_amdgcn_cvt_pk_f32_fp8((int)w, false); }

DEVI v32f ld_fp6_row(const unsigned char* base, int ei, int ll) {
  const unsigned char* r = base + (size_t)ei * 768;
  const uint4 a = *reinterpret_cast<const uint4*>(r + ll * 16);
  const uint2 b = *reinterpret_cast<const uint2*>(r + 512 + ll * 8);
  v6u pk; pk[0] = a.x; pk[1] = a.y; pk[2] = a.z; pk[3] = a.w; pk[4] = b.x; pk[5] = b.y;
  return __builtin_amdgcn_cvt_scalef32_pk32_f32_fp6(pk, 1.0f);
}

struct Raw6 { uint4 a; uint2 b; };
DEVI Raw6 ld_raw6(const unsigned char* base, int ei, int ll) {
  const unsigned char* r = base + (size_t)ei * 768;
  Raw6 o;
  o.a = *reinterpret_cast<const uint4*>(r + ll * 16);
  o.b = *reinterpret_cast<const uint2*>(r + 512 + ll * 8);
  return o;
}
DEVI v32f dec6(const Raw6& r) {
  v6u pk; pk[0] = r.a.x; pk[1] = r.a.y; pk[2] = r.a.z; pk[3] = r.a.w; pk[4] = r.b.x; pk[5] = r.b.y;
  return __builtin_amdgcn_cvt_scalef32_pk32_f32_fp6(pk, 1.0f);
}

DEVI void phase_peer_gather(const Params& p, int s, int layer) {
  float* X = p.out + (size_t)s * TS * 1024;
  u16* XB = (u16*)(p.ws + OFF_XB);
  const unsigned char* Ub = p.ws + OFF_UB8;
  const unsigned char* Vb = p.ws + OFF_VB8;
  const int* IDX = (const int*)(p.ws + OFF_IDX);
  const float* GATE = (const float*)(p.ws + OFF_GATE);
  const float* SU = (const float*)(p.ws + OFF_SU);
  const float* gam = p.in[25] + layer * 1024;
  const float* bet = p.in[26] + layer * 1024;
  const int lane = threadIdx.x & 63, wave = threadIdx.x >> 6;
  const int ll = lane & 31, hs = lane >> 5;
  const bool b4 = lane & 16, b3 = lane & 8;
  for (int t = blockIdx.x * 4 + wave; t < TS; t += gridDim.x * 4) {
    float x[32], o[32];
    {
      const float4* xp = reinterpret_cast<const float4*>(X + (size_t)t * 1024 + ll * 32);
#pragma unroll
      for (int j = 0; j < 8; ++j) { const float4 a = xp[j]; x[4 * j] = a.x; x[4 * j + 1] = a.y; x[4 * j + 2] = a.z; x[4 * j + 3] = a.w; }
    }
#pragma unroll
    for (int k = 0; k < 32; ++k) o[k] = 0.f;
    const int iv0 = IDX[(size_t)t * 128 + lane], iv1 = IDX[(size_t)t * 128 + 64 + lane];
    const float gv0 = GATE[(size_t)t * 128 + lane], gv1 = GATE[(size_t)t * 128 + 64 + lane];
    const float su0 = SU[(size_t)t * 128 + lane], su1 = SU[(size_t)t * 128 + 64 + lane];
    for (int e0 = 0; e0 < 128; e0 += 8) {
      const bool lo = e0 < 64;
      const int ivs = lo ? iv0 : iv1;
      const float gvs = lo ? gv0 : gv1;
      const float sus = lo ? su0 : su1;
      int ei[4];
#pragma unroll
      for (int q = 0; q < 4; ++q) {
        const int ea = __builtin_amdgcn_readlane(ivs, (e0 & 63) + 2 * q);
        const int eb = __builtin_amdgcn_readlane(ivs, (e0 & 63) + 2 * q + 1);
        ei[q] = hs ? eb : ea;
      }
      Raw6 cu[4], cv[4];
#pragma unroll
      for (int q = 0; q < 4; ++q) { cu[q] = ld_raw6(Ub, ei[q], ll); cv[q] = ld_raw6(Vb, ei[q], ll); }
      float dq[4];
#pragma unroll
      for (int q = 0; q < 4; ++q) {
        const v32f u = dec6(cu[q]);
        float d0 = 0.f, d1 = 0.f;
#pragma unroll
        for (int k = 0; k < 32; k += 2) { d0 = fmaf(u[k], x[k], d0); d1 = fmaf(u[k + 1], x[k + 1], d1); }
        dq[q] = d0 + d1;
      }
      float d2[2], d1;
#pragma unroll
      for (int k = 0; k < 2; ++k) {
        const float keep = b4 ? dq[k + 2] : dq[k], send = b4 ? dq[k] : dq[k + 2];
        d2[k] = keep + __shfl_xor(send, 16);
      }
      {
        const float keep = b3 ? d2[1] : d2[0], send = b3 ? d2[0] : d2[1];
        d1 = keep + __shfl_xor(send, 8);
      }
      d1 += __shfl_xor(d1, 4);
      d1 += __shfl_xor(d1, 2);
      d1 += __shfl_xor(d1, 1);
      const int qmine = (b4 ? 2 : 0) + (b3 ? 1 : 0);
      const int srcl = (e0 & 63) + 2 * qmine + hs;
      const float suv = __shfl(sus, srcl), gvv = __shfl(gvs, srcl);
      const float w = gvv * gelu_(d1 * suv);
#pragma unroll
      for (int q = 0; q < 4; ++q) {
        const float wq = __shfl(w, (lane & 32) | ((q >> 1) << 4) | ((q & 1) << 3));
        const v32f v = dec6(cv[q]);
#pragma unroll
        for (int k = 0; k < 32; ++k) o[k] = fmaf(wq, v[k], o[k]);
      }
    }
    float sm = 0.f;
#pragma unroll
    for (int k = 0; k < 32; ++k) { o[k] += __shfl_xor(o[k], 32); o[k] = ALPHA * x[k] + o[k]; sm += o[k]; }
#pragma unroll
    for (int m = 16; m >= 1; m >>= 1) sm += __shfl_xor(sm, m);
    const float mu = sm * (1.f / 1024.f);
    float sq = 0.f;
#pragma unroll
    for (int k = 0; k < 32; ++k) { const float dd = o[k] - mu; sq += dd * dd; }
#pragma unroll
    for (int m = 16; m >= 1; m >>= 1) sq += __shfl_xor(sq, m);
    const float rs = rsqrtf(sq * (1.f / 1024.f) + LN_EPS);
    if (hs == 0) {
      const int c0 = ll * 32;
#pragma unroll
      for (int j = 0; j < 4; ++j) {
        float r[8];
#pragma unroll
        for (int k = 0; k < 8; ++k) r[k] = (o[j * 8 + k] - mu) * rs * gam[c0 + j * 8 + k] + bet[c0 + j * 8 + k];
        float4* dp = reinterpret_cast<float4*>(X + (size_t)t * 1024 + c0 + j * 8);
        dp[0] = float4{r[0], r[1], r[2], r[3]};
        dp[1] = float4{r[4], r[5], r[6], r[7]};
        *reinterpret_cast<uint4*>(XB + (size_t)t * 1024 + c0 + j * 8) = pack8(r);
      }
    }
  }
}

DEVI void phase_ple(const Params& p, int s, int layer, unsigned char* smem) {
  float* X = p.out + (size_t)s * TS * 1024;
  const u16* XB = (const u16*)(p.ws + OFF_XB);
  const float* P = p.in[2 + s] + (size_t)layer * TS * 256;
  const u16* Wp = (const u16*)(p.ws + OFF_WPROJ) + (size_t)layer * 1024 * 256;
  const u16* Wg = (const u16*)(p.ws + OFF_WPG) + (size_t)layer * 1024 * 1024;
  const int lane = threadIdx.x & 63, wave = threadIdx.x >> 6, wm = wave >> 1, wn = wave & 1;
  for (int it = 0, mt, nt; tile_map(it, 256, 8, mt, nt); ++it) {
    const int m0 = mt * 128, n0 = nt * 128;
    u32* pkl = reinterpret_cast<u32*>(smem + 36864) + threadIdx.x;
    gemm_tile_dma(XB + (size_t)m0 * 1024, 1024, Wg + (size_t)n0 * 1024, 1024, 1024, smem, [&](f32x4 (&acc)[4][4]) {
#pragma unroll
      for (int i = 0; i < 4; ++i)
#pragma unroll
        for (int j = 0; j < 4; ++j) {
          pkl[((i * 4 + j) * 2 + 0) * 256] = pack2(sigmoid_(acc[i][j][0]), sigmoid_(acc[i][j][1]));
          pkl[((i * 4 + j) * 2 + 1) * 256] = pack2(sigmoid_(acc[i][j][2]), sigmoid_(acc[i][j][3]));
        }
    });
    {
      LdF32 al{P + (size_t)m0 * 256, 256};
      LdBF bl{Wp + (size_t)n0 * 256, 256};
      gemm_tile(al, bl, 256, smem, [&](f32x4 (&acc)[4][4]) {
#pragma unroll
        for (int i = 0; i < 4; ++i)
#pragma unroll
          for (int j = 0; j < 4; ++j)
#pragma unroll
            for (int r = 0; r < 4; ++r) {
              const int row = m0 + wm * 64 + i * 16 + (lane >> 4) * 4 + r;
              const int col = n0 + wn * 64 + j * 16 + (lane & 15);
              const u32 w = pkl[((i * 4 + j) * 2 + (r >> 1)) * 256];
              const float sg = (r & 1) ? bfhi(w) : bflo(w);
              const size_t idx = (size_t)row * 1024 + col;
              X[idx] = X[idx] + acc[i][j][r] * sg;
            }
      });
    }
  }
}

DEVI void phase_rg_in(const Params& p, int s, unsigned char* smem) {
  const float* X = p.out + (size_t)s * TS * 1024;
  const u16* Wt = (const u16*)(p.ws + OFF_WRGIN);
  u16* GG = (u16*)(p.ws + OFF_GG);
  u16* R = (u16*)(p.ws + OFF_R);
  const int lane = threadIdx.x & 63, wave = threadIdx.x >> 6, wm = wave >> 1, wn = wave & 1;
  for (int it = 0, mt, nt; tile_map(it, 256, 16, mt, nt); ++it) {
    const int m0 = mt * 128, n0 = nt * 128;
    LdF32 al{X + (size_t)m0 * 1024, 1024};
    LdBF bl{Wt + (size_t)n0 * 1024, 1024};
    gemm_tile(al, bl, 1024, smem, [&](f32x4 (&acc)[4][4]) {
#pragma unroll
      for (int i = 0; i < 4; ++i)
#pragma unroll
        for (int j = 0; j < 4; ++j)
#pragma unroll
          for (int r = 0; r < 4; ++r) {
            const int row = m0 + wm * 64 + i * 16 + (lane >> 4) * 4 + r;
            const int col = n0 + wn * 64 + j * 16 + (lane & 15);
            if (n0 < 1024) GG[(size_t)row * 1024 + col] = f2bf(gelu_(acc[i][j][r]));
            else R[(size_t)row * 1024 + col - 1024] = f2bf(acc[i][j][r]);
          }
    });
  }
}

DEVI void phase_rg_conv(const Params& p, int s) {
  const int L = s ? 2048 : 4096;
  const u16* R = (const u16*)(p.ws + OFF_R);
  u16* C = (u16*)(p.ws + OFF_C);
  const float* cw = p.in[15];
  const float* cb = p.in[16];
  const int gsz = gridDim.x * 256, gtid = blockIdx.x * 256 + threadIdx.x;
  for (int i = gtid; i < TS * 128; i += gsz) {
    const int t = i >> 7, cv = (i & 127) * 8;
    const int pos = t & (L - 1);
    float acc[8];
#pragma unroll
    for (int j = 0; j < 8; ++j) acc[j] = cb[cv + j];
#pragma unroll
    for (int k = 0; k < 4; ++k) {
      const int pp = pos + k - 1;
      if (pp >= 0 && pp < L) {
        float rv[8];
        unpack8(*reinterpret_cast<const uint4*>(R + (size_t)(t + k - 1) * 1024 + cv), rv);
#pragma unroll
        for (int j = 0; j < 8; ++j) acc[j] = fmaf(rv[j], cw[k * 1024 + cv + j], acc[j]);
      }
    }
    *reinterpret_cast<uint4*>(C + (size_t)i * 8) = pack8(acc);
  }
}

DEVI void phase_rg_gates(const Params& p, unsigned char* smem) {
  const u16* C = (const u16*)(p.ws + OFF_C);
  const u16* Wt = (const u16*)(p.ws + OFF_WGATES);
  u32* AB = (u32*)(p.ws + OFF_AB);
  const float* ba = p.in[18];
  const float* bx = p.in[20];
  const float* lam = p.in[21];
  const int lane = threadIdx.x & 63, wave = threadIdx.x >> 6, wm = wave >> 1, wn = wave & 1;
  for (int it = 0, mt, nt32; tile_map(it, 256, 32, mt, nt32); ++it) {
    const int m0 = mt * 128, h = nt32 >> 3, nt = nt32 & 7, n0 = nt * 128;
    gemm_tile_dma(C + (size_t)m0 * 1024 + h * 256, 1024, Wt + ((size_t)h * 1024 + n0) * 256, 256, 256, smem, [&](f32x4 (&acc)[4][4]) {
#pragma unroll
      for (int jj = 0; jj < 4; jj += 2) {
        const int nb = n0 + wn * 64 + jj * 16;
        const int d = nb >> 9;
        const int ch = h * 256 + ((nb & 511) >> 5) * 16 + (lane & 15);
        const float bav = ba[d * 1024 + ch], bxv = bx[d * 1024 + ch];
        const float sp8 = -8.f * softplus_(-lam[d * 1024 + ch]);
#pragma unroll
        for (int i = 0; i < 4; ++i)
#pragma unroll
          for (int r = 0; r < 4; ++r) {
            const int row = m0 + wm * 64 + i * 16 + (lane >> 4) * 4 + r;
            const float rg = sigmoid_(acc[i][jj][r] + bav);
            const float ig = sigmoid_(acc[i][jj + 1][r] + bxv);
            const float la = sp8 * rg;
            const float cval = bf2f(C[(size_t)row * 1024 + ch]);
            const float b = __builtin_amdgcn_sqrtf(fmaxf(1.f - __expf(2.f * la), 0.f)) * ig * cval;
            AB[((size_t)row * 2 + d) * 1024 + ch] = pack2(la, b);
            if (r == 3) __builtin_amdgcn_sched_barrier(0);
          }
      }
    });
  }
}

DEVI void phase_rg_agg(const Params& p) {
  const u32* AB = (const u32*)(p.ws + OFF_AB);
  float2* AGG = (float2*)(p.ws + OFF_AGG);
  const int gsz = gridDim.x * 256, gtid = blockIdx.x * 256 + threadIdx.x;
  for (int i = gtid; i < 1024 * 2 * 1024; i += gsz) {
    const int ch = i & 1023, d = (i >> 10) & 1, chunk = i >> 11;
    const int c0 = chunk * 32;
    float h = 0.f, LA = 0.f;
#pragma unroll 8
    for (int k = 0; k < 32; ++k) {
      const int t = d ? (c0 + 31 - k) : (c0 + k);
      const u32 w = AB[((size_t)t * 2 + d) * 1024 + ch];
      const float la = bflo(w), b = bfhi(w);
      h = __expf(la) * h + b;
      LA += la;
    }
    AGG[((size_t)d * 1024 + chunk) * 1024 + ch] = float2{LA, h};
  }
}

DEVI void phase_rg_carry(const Params& p, int s) {
  const int L = s ? 2048 : 4096;
  const int nseq = TS / L, nch = L / 32;
  const float2* AGG = (const float2*)(p.ws + OFF_AGG);
  float* CAR = (float*)(p.ws + OFF_CAR);
  const int gsz = gridDim.x * 256, gtid = blockIdx.x * 256 + threadIdx.x;
  for (int i = gtid; i < nseq * 2 * 1024; i += gsz) {
    const int ch = i & 1023, d = (i >> 10) & 1, seq = i >> 11;
    float H = 0.f;
    for (int k = 0; k < nch; ++k) {
      const int chunk = seq * nch + (d ? (nch - 1 - k) : k);
      const size_t idx = ((size_t)d * 1024 + chunk) * 1024 + ch;
      CAR[idx] = H;
      const float2 ag = AGG[idx];
      H = __expf(ag.x) * H + ag.y;
    }
  }
}

DEVI void phase_rg_final(const Params& p) {
  const u32* AB = (const u32*)(p.ws + OFF_AB);
  const float* CAR = (const float*)(p.ws + OFF_CAR);
  const u16* GG = (const u16*)(p.ws + OFF_GG);
  u16* Y = (u16*)(p.ws + OFF_R);
  const int gsz = gridDim.x * 256, gtid = blockIdx.x * 256 + threadIdx.x;
  for (int i = gtid; i < 1024 * 1024; i += gsz) {
    const int ch = i & 1023, chunk = i >> 10;
    const int c0 = chunk * 32;
    float hf[32];
    float h = CAR[((size_t)chunk) * 1024 + ch];
#pragma unroll
    for (int k = 0; k < 32; ++k) {
      const u32 w = AB[((size_t)(c0 + k) * 2 + 0) * 1024 + ch];
      h = __expf(bflo(w)) * h + bfhi(w);
      hf[k] = h;
    }
    h = CAR[((size_t)1024 + chunk) * 1024 + ch];
#pragma unroll
    for (int k = 31; k >= 0; --k) {
      const u32 w = AB[((size_t)(c0 + k) * 2 + 1) * 1024 + ch];
      h = __expf(bflo(w)) * h + bfhi(w);
      const size_t idx = (size_t)(c0 + k) * 1024 + ch;
      Y[idx] = f2bf((hf[k] + h) * bf2f(GG[idx]));
    }
  }
}

DEVI void phase_rg_out(const Params& p, int s, unsigned char* smem) {
  float* X = p.out + (size_t)s * TS * 1024;
  const u16* Y = (const u16*)(p.ws + OFF_R);
  const u16* Wt = (const u16*)(p.ws + OFF_WRGOUT);
  const int lane = threadIdx.x & 63, wave = threadIdx.x >> 6, wm = wave >> 1, wn = wave & 1;
  for (int it = 0, mt, nt; tile_map(it, 256, 8, mt, nt); ++it) {
    const int m0 = mt * 128, n0 = nt * 128;
    gemm_tile_dma(Y + (size_t)m0 * 1024, 1024, Wt + (size_t)n0 * 1024, 1024, 1024, smem, [&](f32x4 (&acc)[4][4]) {
#pragma unroll
      for (int i = 0; i < 4; ++i)
#pragma unroll
        for (int j = 0; j < 4; ++j)
#pragma unroll
          for (int r = 0; r < 4; ++r) {
            const int row = m0 + wm * 64 + i * 16 + (lane >> 4) * 4 + r;
            const int col = n0 + wn * 64 + j * 16 + (lane & 15);
            const size_t idx = (size_t)row * 1024 + col;
            X[idx] = ALPHA * X[idx] + acc[i][j][r];
          }
    });
  }
}

constexpr int NPS = 22;
constexpr int NSETUP = 3;
constexpr int NPHASE = NSETUP + 2 * NPS;

template <int PH>
DEVI void run_phase(const Params& p, unsigned char* smem) {
  if constexpr (PH == 0) {
    phase_setup(p);
  } else if constexpr (PH == 1) {
    phase_setup2(p);
  } else if constexpr (PH == 2) {
    phase_setup3(p);
  } else {
    constexpr int s = (PH - NSETUP) / NPS, q = (PH - NSETUP) % NPS;
    if constexpr (q == 0) phase_s5_in(p, s, smem);
    else if constexpr (q == 1) phase_s5_state(p, smem);
    else if constexpr (q == 2) phase_s5_cscan(p, s);
    else if constexpr (q == 3) phase_s5_main(p, smem);
    else if constexpr (q == 4) phase_s5_glu(p, s, smem);
    else if constexpr (q == 5) phase_ln1_tables(p, s, 0, smem);
    else if constexpr (q == 6) phase_peer_q(p, 0, smem);
    else if constexpr (q == 7) phase_peer_route(p);
    else if constexpr (q == 8) phase_peer_gather(p, s, 0);
    else if constexpr (q == 9) phase_ple(p, s, 0, smem);
    else if constexpr (q == 10) phase_rg_in(p, s, smem);
    else if constexpr (q == 11) phase_rg_conv(p, s);
    else if constexpr (q == 12) phase_rg_gates(p, smem);
    else if constexpr (q == 13) phase_rg_agg(p);
    else if constexpr (q == 14) phase_rg_carry(p, s);
    else if constexpr (q == 15) phase_rg_final(p);
    else if constexpr (q == 16) phase_rg_out(p, s, smem);
    else if constexpr (q == 17) phase_ln1_tables(p, s, 1, smem);
    else if constexpr (q == 18) phase_peer_q(p, 1, smem);
    else if constexpr (q == 19) phase_peer_route(p);
    else if constexpr (q == 20) phase_peer_gather(p, s, 1);
    else if constexpr (q == 21) phase_ple(p, s, 1, smem);
  }
}

#define XB_TMO      128
#define XB_XCNT(j)  (256  + 64 * (j))
#define XB_XSUB(j)  (1280 + 64 * (j))
#define XB_XGEN(j)  (2304 + 64 * (j))
#define XB_TOP      3328
#define XB_TOPGEN   3392
#define XCD_BAR_WORDS 3456
#define XB_SPIN_CAP (1u << 18)
#define LAS __attribute__((address_space(3)))
DEVI unsigned xb_ld(unsigned* p) { return __hip_atomic_load(p, __ATOMIC_RELAXED, __HIP_MEMORY_SCOPE_AGENT); }
DEVI unsigned xb_add(unsigned* p, unsigned v) { return __hip_atomic_fetch_add(p, v, __ATOMIC_RELAXED, __HIP_MEMORY_SCOPE_AGENT); }
DEVI unsigned xb_xcc_id() { return (unsigned)__builtin_amdgcn_s_getreg((3 << 11) | 20) & 0xFu; }
#define XB_SPIN(cond, bar) do { unsigned _sp = 0; while (cond) { __builtin_amdgcn_s_sleep(1); \
    if ((++_sp & 255u) == 0u) { if (xb_ld(&(bar)[XB_TMO])) break; if (_sp > XB_SPIN_CAP) { atomicAdd(&(bar)[XB_TMO], 1u); break; } } } } while (0)
struct XcdBarrier { unsigned* bar; unsigned x; volatile LAS unsigned* st; };
DEVI XcdBarrier xcd_barrier_post(unsigned* bar, volatile LAS unsigned* st) {
  XcdBarrier b; b.bar = bar; b.x = xb_xcc_id(); b.st = st;
  if (threadIdx.x == 0) (void)xb_add(&bar[XB_XCNT(b.x)], 1u);
  return b;
}
DEVI void xcd_barrier_complete(unsigned* bar, unsigned x, unsigned& nloc, unsigned& nx) {
  const unsigned G = gridDim.x * gridDim.y * gridDim.z;
  unsigned sum, cnt, mine, sp = 0u;
  for (;;) {
    sum = 0u; cnt = 0u; mine = 0u;
#pragma unroll
    for (unsigned j = 0; j < 16; ++j) { const unsigned c = xb_ld(&bar[XB_XCNT(j)]); sum += c; cnt += (c > 0u) ? 1u : 0u; mine = (j == x) ? c : mine; }
    if (sum == G) break;
    __builtin_amdgcn_s_sleep(1);
    if ((++sp & 255u) == 0u) { if (xb_ld(&bar[XB_TMO])) break; if (sp > XB_SPIN_CAP) { atomicAdd(&bar[XB_TMO], 1u); break; } }
  }
  nloc = mine > 0u ? mine : 1u; nx = cnt > 0u ? cnt : 1u;
}
DEVI void xcd_barrier(const XcdBarrier& b) {
  asm volatile("s_waitcnt vmcnt(0)" ::: "memory");
  __syncthreads();
  if (threadIdx.x == 0) {
    unsigned* bar = b.bar;
    __builtin_amdgcn_s_waitcnt(0);
    unsigned nloc = b.st[0], nx = b.st[1];
    if (nloc == 0u) { xcd_barrier_complete(bar, b.x, nloc, nx); b.st[0] = nloc; b.st[1] = nx; }
    const unsigned old = xb_add(&bar[XB_XSUB(b.x)], 1u);
    const unsigned gen = old / nloc;
    if (old + 1u == (gen + 1u) * nloc) {
      __builtin_amdgcn_fence(__ATOMIC_RELEASE, "agent");
      asm volatile("s_waitcnt vmcnt(0)" ::: "memory");
      const unsigned og = xb_add(&bar[XB_TOP], 1u);
      const unsigned tg = og / nx;
      if (og + 1u == (tg + 1u) * nx) xb_add(&bar[XB_TOPGEN], 1u);
      else XB_SPIN(xb_ld(&bar[XB_TOPGEN]) == tg, bar);
      __builtin_amdgcn_fence(__ATOMIC_ACQUIRE, "agent");
      xb_add(&bar[XB_XGEN(b.x)], 1u);
      asm volatile("s_waitcnt vmcnt(0)" ::: "memory");
    } else {
      XB_SPIN(xb_ld(&bar[XB_XGEN(b.x)]) == gen, bar);
      __builtin_amdgcn_fence(__ATOMIC_ACQUIRE, "agent");
      asm volatile("s_waitcnt vmcnt(0)" ::: "memory");
    }
  }
  __syncthreads();
}

template <int PH>
DEVI void run_steps(const Params& p, int lo, int hi, unsigned char* smem, const XcdBarrier& xb) {
  if constexpr (PH < NPHASE) {
    if (PH >= lo && PH < hi) {
      run_phase<PH>(p, smem);
      if (PH + 1 < hi) {
        if (PH == 0) cg::this_grid().sync();
        else xcd_barrier(xb);
      }
    }
    run_steps<PH + 1>(p, lo, hi, smem, xb);
  }
}

__global__ void __launch_bounds__(256, 2) mega(Params p, int ph_lo, int ph_hi) {
  extern __shared__ __attribute__((aligned(16))) unsigned char smem[];
  volatile LAS unsigned* st = (volatile LAS unsigned*)(smem + LDS_BYTES);
  if (threadIdx.x == 0) { st[0] = 0u; st[1] = 0u; }
  __syncthreads();
  const XcdBarrier xb = xcd_barrier_post((unsigned*)(p.ws + OFF_BAR), st);
  run_steps<0>(p, ph_lo, ph_hi, smem, xb);
}

extern "C" void kernel_launch(void* const* d_in, const int* in_sizes, int n_in, void* d_out, int out_size, void* d_ws,
                              size_t ws_size, hipStream_t stream) {
  static int grid = 0;
  if (grid == 0) {
    if (n_in != 33 || ws_size < WS_END) {
      fprintf(stderr, "kernel_launch: need 33 inputs and %zu bytes ws; got %d, %zu\n", (size_t)WS_END, n_in, ws_size);
      grid = -1;
      return;
    }
    int dev = 0, cus = 0, per_cu = 0;
    hipGetDevice(&dev);
    hipDeviceGetAttribute(&cus, hipDeviceAttributeMultiprocessorCount, dev);
    if (hipFuncSetAttribute((const void*)mega, hipFuncAttributeMaxDynamicSharedMemorySize, LDS_BYTES + 16) != hipSuccess) {
      fprintf(stderr, "kernel_launch: hipFuncSetAttribute failed\n");
      grid = -1;
      return;
    }
    hipOccupancyMaxActiveBlocksPerMultiprocessor(&per_cu, (const void*)mega, 256, LDS_BYTES + 16);
    if (per_cu < 1) per_cu = 1;
    if (per_cu > 2) per_cu = 2;
    grid = cus * per_cu;
    fprintf(stderr, "kernel_launch: cus %d per_cu %d grid %d\n", cus, per_cu, grid);
  }
  if (grid < 0) return;
  (void)hipMemsetAsync((unsigned char*)d_ws + OFF_BAR, 0, XCD_BAR_WORDS * sizeof(unsigned), stream);
  Params p{};
  for (int i = 0; i < 33; ++i) p.in[i] = (const float*)d_in[i];
  p.out = (float*)d_out;
  p.ws = (unsigned char*)d_ws;
#if COOP
  int lo = 0, hi = NPHASE;
  void* args[] = {&p, &lo, &hi};
  hipError_t e = hipLaunchCooperativeKernel((const void*)mega, dim3(grid), dim3(256), args, LDS_BYTES + 16, stream);
  if (e != hipSuccess) fprintf(stderr, "cooperative launch failed: %s (grid %d)\n", hipGetErrorString(e), grid);
#else
  for (int ph = 0; ph < NPHASE; ++ph) {
    hipLaunchKernelGGL(mega, dim3(grid), dim3(256), LDS_BYTES + 16, stream, p, ph, ph + 1);
  }
#endif
}
```

```cpp
#include <hip/hip_runtime.h>
#include <hip/hip_cooperative_groups.h>
#include <cstdio>
namespace cg = cooperative_groups;

#ifndef COOP
#define COOP 1
#endif

typedef unsigned short u16;
typedef unsigned int u32;
using bf16x8 = __attribute__((ext_vector_type(8))) short;
using f32x4 = __attribute__((ext_vector_type(4))) float;
typedef float f2 __attribute__((ext_vector_type(2)));
typedef float v32f __attribute__((ext_vector_type(32)));
typedef float v16f __attribute__((ext_vector_type(16)));
typedef unsigned v6u __attribute__((ext_vector_type(6)));

#define DEVI __device__ __forceinline__

constexpr int TS = 32768;
constexpr float ALPHA = 1.41421356237309515f;
constexpr float LN_EPS = 1e-5f;
constexpr size_t MBy = 1ull << 20;

constexpr size_t OFF_WS5IN = 0;
constexpr size_t OFF_WGLU = 2 * MBy;
constexpr size_t OFF_WRGIN = 6 * MBy;
constexpr size_t OFF_WGATES = 10 * MBy;
constexpr size_t OFF_WRGOUT = 12 * MBy;
constexpr size_t OFF_WQ = 14 * MBy;
constexpr size_t OFF_SK = 22 * MBy;
constexpr size_t OFF_WPROJ = 23 * MBy;
constexpr size_t OFF_WPG = 24 * MBy;
constexpr size_t OFF_UB = 28 * MBy;
constexpr size_t OFF_VB = 60 * MBy;
constexpr size_t OFF_UB8 = OFF_UB;
constexpr size_t OFF_VB8 = OFF_UB + 16 * MBy;
constexpr size_t OFF_SCL = OFF_UB + 32 * MBy;
constexpr size_t OFF_ACT = 92 * MBy;
constexpr size_t OFF_XB = OFF_ACT;
constexpr size_t OFF_KEYS = OFF_ACT + 64 * MBy;
constexpr size_t OFF_IDX = OFF_ACT + 96 * MBy;
constexpr size_t OFF_GATE = OFF_ACT + 112 * MBy;
constexpr size_t OFF_SU = OFF_ACT + 128 * MBy;
constexpr size_t OFF_PB = OFF_ACT + 144 * MBy;
constexpr size_t OFF_XB2 = OFF_ACT + 192 * MBy;
constexpr size_t OFF_XIN = OFF_ACT + 256 * MBy;
constexpr size_t OFF_AP = OFF_ACT;
constexpr size_t OFF_HLOC = OFF_ACT + 104 * MBy;
constexpr size_t OFF_HB = OFF_ACT + 192 * MBy;
constexpr size_t OFF_GG = OFF_ACT;
constexpr size_t OFF_R = OFF_ACT + 64 * MBy;
constexpr size_t OFF_C = OFF_ACT + 128 * MBy;
constexpr size_t OFF_AB = OFF_ACT + 192 * MBy;
constexpr size_t OFF_AGG = OFF_ACT + 448 * MBy;
constexpr size_t OFF_CAR = OFF_ACT + 464 * MBy;
constexpr size_t OFF_BT1 = OFF_ACT + 472 * MBy;
constexpr size_t OFF_WST = OFF_BT1 + 48 * MBy;
constexpr size_t OFF_KTAB = OFF_WST + 16 * MBy;
constexpr size_t OFF_POW = OFF_KTAB + 4 * MBy;
constexpr size_t OFF_BBAR = OFF_POW + 3 * MBy;
constexpr size_t OFF_BAR = OFF_BBAR + 1 * MBy;
constexpr size_t WS_END = OFF_BAR + 1 * MBy;

constexpr int LDS_BYTES = 36864 + 32768;

struct Params {
  const float* in[33];
  float* out;
  unsigned char* ws;
};

DEVI u16 f2bf(float f) {
  u32 u = __float_as_uint(f);
  u += 0x7FFFu + ((u >> 16) & 1u);
  return (u16)(u >> 16);
}
DEVI float bf2f(u16 h) { return __uint_as_float(((u32)h) << 16); }
DEVI u32 pack2(float lo, float hi) { return (u32)f2bf(lo) | ((u32)f2bf(hi) << 16); }
DEVI float bflo(u32 w) { return __uint_as_float(w << 16); }
DEVI float bfhi(u32 w) { return __uint_as_float(w & 0xffff0000u); }
DEVI float sigmoid_(float x) { return __builtin_amdgcn_rcpf(1.f + __expf(-x)); }
DEVI float gelu_(float x) {
  float z = 0.7978845608028654f * (x + 0.044715f * x * x * x);
  return x * __builtin_amdgcn_rcpf(1.f + __expf(-2.f * z));
}
DEVI float softplus_(float x) { return fmaxf(x, 0.f) + log1pf(__expf(-fabsf(x))); }
DEVI void unpack8(const uint4& w, float* f) {
  f[0] = bflo(w.x); f[1] = bfhi(w.x); f[2] = bflo(w.y); f[3] = bfhi(w.y);
  f[4] = bflo(w.z); f[5] = bfhi(w.z); f[6] = bflo(w.w); f[7] = bfhi(w.w);
}
DEVI uint4 pack8(const float* f) {
  uint4 o; o.x = pack2(f[0], f[1]); o.y = pack2(f[2], f[3]); o.z = pack2(f[4], f[5]); o.w = pack2(f[6], f[7]);
  return o;
}

struct LdBF {
  const u16* base; int ld;
  typedef uint4 Raw;
  DEVI Raw load(int row, int k) const { return *reinterpret_cast<const uint4*>(base + (size_t)row * ld + k); }
  DEVI static uint4 cvt(const Raw& r) { return r; }
};
struct RawF { float4 a, b; };
struct LdF32 {
  const float* base; int ld;
  typedef RawF Raw;
  DEVI Raw load(int row, int k) const {
    const float4* q = reinterpret_cast<const float4*>(base + (size_t)row * ld + k);
    RawF r; r.a = q[0]; r.b = q[1]; return r;
  }
  DEVI static uint4 cvt(const Raw& r) {
    uint4 o; o.x = pack2(r.a.x, r.a.y); o.y = pack2(r.a.z, r.a.w); o.z = pack2(r.b.x, r.b.y); o.w = pack2(r.b.z, r.b.w);
    return o;
  }
};

template <class AL, class BL, class EP>
DEVI void gemm_tile(const AL al, const BL bl, const int K, unsigned char* smem, EP ep) {
  u16* As = reinterpret_cast<u16*>(smem);
  u16* Bs = As + 128 * 72;
  const int tid = threadIdx.x, lane = tid & 63, wave = tid >> 6, wm = wave >> 1, wn = wave & 1;
  const int lr = lane & 15, lq = lane >> 4;
  f32x4 acc[4][4];
#pragma unroll
  for (int i = 0; i < 4; ++i)
#pragma unroll
    for (int j = 0; j < 4; ++j) acc[i][j] = f32x4{0.f, 0.f, 0.f, 0.f};
  typename AL::Raw ra[4];
  typename BL::Raw rb[4];
  const int prow = tid >> 3, pk = (tid & 7) * 8;
#pragma unroll
  for (int i = 0; i < 4; ++i) { ra[i] = al.load(prow + i * 32, pk); rb[i] = bl.load(prow + i * 32, pk); }
  for (int kt = 0; kt < K; kt += 64) {
    __syncthreads();
#pragma unroll
    for (int i = 0; i < 4; ++i) {
      *reinterpret_cast<uint4*>(As + (prow + i * 32) * 72 + pk) = AL::cvt(ra[i]);
      *reinterpret_cast<uint4*>(Bs + (prow + i * 32) * 72 + pk) = BL::cvt(rb[i]);
    }
    __syncthreads();
    if (kt + 64 < K) {
#pragma unroll
      for (int i = 0; i < 4; ++i) { ra[i] = al.load(prow + i * 32, kt + 64 + pk); rb[i] = bl.load(prow + i * 32, kt + 64 + pk); }
    }
#pragma unroll
    for (int ks = 0; ks < 2; ++ks) {
      bf16x8 af[4], bfr[4];
#pragma unroll
      for (int i = 0; i < 4; ++i) af[i] = *reinterpret_cast<const bf16x8*>(As + (wm * 64 + i * 16 + lr) * 72 + ks * 32 + lq * 8);
#pragma unroll
      for (int j = 0; j < 4; ++j) bfr[j] = *reinterpret_cast<const bf16x8*>(Bs + (wn * 64 + j * 16 + lr) * 72 + ks * 32 + lq * 8);
#pragma unroll
      for (int i = 0; i < 4; ++i)
#pragma unroll
        for (int j = 0; j < 4; ++j) acc[i][j] = __builtin_amdgcn_mfma_f32_16x16x32_bf16(af[i], bfr[j], acc[i][j], 0, 0, 0);
    }
  }
  __syncthreads();
  ep(acc);
}

typedef __attribute__((address_space(3))) unsigned lds_u32;
template <class EP>
DEVI void gemm_tile_dma(const u16* A, const int lda, const u16* Bt, const int ldb, const int K, unsigned char* smem, EP ep) {
  const int tid = threadIdx.x, lane = tid & 63, wave = tid >> 6, wm = wave >> 1, wn = wave & 1;
  const int lr = lane & 15, lq = lane >> 4;
  f32x4 acc[4][4];
#pragma unroll
  for (int i = 0; i < 4; ++i)
#pragma unroll
    for (int j = 0; j < 4; ++j) acc[i][j] = f32x4{0.f, 0.f, 0.f, 0.f};
  const int rr = lane >> 3, qq = (lane & 7) ^ rr;
  const u16* ag = A + (size_t)(wave * 32 + rr) * lda + qq * 8;
  const u16* bg = Bt + (size_t)(wave * 32 + rr) * ldb + qq * 8;
  unsigned char* wbase = smem + wave * 4096;
#define GT_ISSUE(stage, kt)                                                                                              \
  do {                                                                                                                   \
    _Pragma("unroll") for (int j = 0; j < 4; ++j) {                                                                      \
      __builtin_amdgcn_global_load_lds((const unsigned*)(ag + (size_t)j * 8 * lda + (kt)),                               \
                                       (lds_u32*)(wbase + (stage) * 32768 + j * 1024), 16, 0, 0);                        \
      __builtin_amdgcn_global_load_lds((const unsigned*)(bg + (size_t)j * 8 * ldb + (kt)),                               \
                                       (lds_u32*)(wbase + (stage) * 32768 + 16384 + j * 1024), 16, 0, 0);                \
    }                                                                                                                    \
  } while (0)
  __syncthreads();
  GT_ISSUE(0, 0);
  const int sw = lr & 7;
  int it = 0;
  for (int kt = 0; kt < K; kt += 64, ++it) {
    asm volatile("s_waitcnt vmcnt(0)" ::: "memory");
    __syncthreads();
    if (kt + 64 < K) GT_ISSUE((it + 1) & 1, kt + 64);
    const unsigned char* As = smem + (it & 1) * 32768;
    const unsigned char* Bs = As + 16384;
#pragma unroll
    for (int ks = 0; ks < 2; ++ks) {
      bf16x8 af[4], bfr[4];
      const int ch = ((ks * 4 + lq) ^ sw) * 16;
#pragma unroll
      for (int i = 0; i < 4; ++i) af[i] = *reinterpret_cast<const bf16x8*>(As + (wm * 64 + i * 16 + lr) * 128 + ch);
#pragma unroll
      for (int j = 0; j < 4; ++j) bfr[j] = *reinterpret_cast<const bf16x8*>(Bs + (wn * 64 + j * 16 + lr) * 128 + ch);
      __builtin_amdgcn_s_setprio(1);
#pragma unroll
      for (int i = 0; i < 4; ++i)
#pragma unroll
        for (int j = 0; j < 4; ++j) acc[i][j] = __builtin_amdgcn_mfma_f32_16x16x32_bf16(af[i], bfr[j], acc[i][j], 0, 0, 0);
      __builtin_amdgcn_s_setprio(0);
    }
  }
#undef GT_ISSUE
  __syncthreads();
  ep(acc);
}

DEVI bool tile_map(int it, int nmt, int nnt, int& mt, int& nt) {
  const int xcd = blockIdx.x & 7, j = blockIdx.x >> 3;
  const int per = gridDim.x >> 3;
  const int slot = it * per + j;
  const int S = (slot >> 6) * 8 + xcd;
  const int nsn = nnt >> 3, nsm = nmt >> 3;
  if (S >= nsn * nsm) return false;
  const int sm = S / nsn, sn = S - sm * nsn;
  const int w = slot & 63;
  mt = sm * 8 + (w >> 3);
  nt = sn * 8 + (w & 7);
  return true;
}

template <int PERM>
DEVI void cvt_wt(const float* W, int K, int N, u16* out, int a0, int a1) {
  const int gsz = gridDim.x * 256, gtid = blockIdx.x * 256 + threadIdx.x;
  const int total = N * (K >> 3);
  for (int i = gtid; i < total; i += gsz) {
    const int n = i % N, kv = i / N;
    float v[8];
#pragma unroll
    for (int j = 0; j < 8; ++j) v[j] = W[(size_t)(kv * 8 + j) * N + n];
    int np = n;
    if (PERM == 1) { const int g = n >> 10, o = n & 1023; np = (o >> 4) * 32 + g * 16 + (o & 15); }
    if (PERM == 2) { np = a0 * 512 + (n >> 4) * 32 + a1 * 16 + (n & 15); }
    *reinterpret_cast<uint4*>(out + (size_t)np * K + kv * 8) = pack8(v);
  }
}

DEVI void cvt_plain(const float* src, u16* dst, size_t n8) {
  const size_t gsz = (size_t)gridDim.x * 256, gtid = (size_t)blockIdx.x * 256 + threadIdx.x;
  for (size_t i = gtid; i < n8; i += gsz) {
    const float4* q = reinterpret_cast<const float4*>(src + i * 8);
    float4 a = q[0], b = q[1];
    uint4 o; o.x = pack2(a.x, a.y); o.y = pack2(a.z, a.w); o.z = pack2(b.x, b.y); o.w = pack2(b.z, b.w);
    *reinterpret_cast<uint4*>(dst + i * 8) = o;
  }
}

DEVI void phase_setup(const Params& p) {
  unsigned char* ws = p.ws;
  cvt_wt<0>(p.in[4], 1024, 1024, (u16*)(ws + OFF_WS5IN), 0, 0);
  cvt_wt<1>(p.in[13], 1024, 2048, (u16*)(ws + OFF_WGLU), 0, 0);
  cvt_wt<0>(p.in[14], 1024, 2048, (u16*)(ws + OFF_WRGIN), 0, 0);
  for (int d = 0; d < 2; ++d)
    for (int gate = 0; gate < 2; ++gate)
      for (int h = 0; h < 4; ++h)
        cvt_wt<2>((gate ? p.in[19] : p.in[17]) + (size_t)(d * 4 + h) * 65536, 256, 256,
                  (u16*)(ws + OFF_WGATES) + (size_t)h * 1024 * 256, d, gate);
  cvt_wt<0>(p.in[22], 1024, 1024, (u16*)(ws + OFF_WRGOUT), 0, 0);
  for (int l = 0; l < 2; ++l) {
    cvt_wt<0>(p.in[27] + (size_t)l * 1024 * 2048, 1024, 2048, (u16*)(ws + OFF_WQ) + (size_t)l * 2048 * 1024, 0, 0);
    cvt_wt<0>(p.in[31] + (size_t)l * 256 * 1024, 256, 1024, (u16*)(ws + OFF_WPROJ) + (size_t)l * 1024 * 256, 0, 0);
    cvt_wt<0>(p.in[32] + (size_t)l * 1024 * 1024, 1024, 1024, (u16*)(ws + OFF_WPG) + (size_t)l * 1024 * 1024, 0, 0);
  }
  cvt_plain(p.in[28], (u16*)(ws + OFF_SK), 65536 / 8);
  const int gsz = gridDim.x * 256, gtid = blockIdx.x * 256 + threadIdx.x;
  float2* POW = (float2*)(ws + OFF_POW);
  float2* BBAR = (float2*)(ws + OFF_BBAR);
  for (int i = gtid; i < 2 * 64 * 33 * 64; i += gsz) {
    const int pp = i & 63, n = (i >> 6) % 33, dg = i / (64 * 33);
    const float step = expf(p.in[7][dg]);
    const float lr_ = p.in[5][dg * 64 + pp], li_ = p.in[6][dg * 64 + pp];
    const float mag = expf((float)n * (lr_ * step)), ang = (float)n * (li_ * step);
    POW[i] = float2{mag * cosf(ang), mag * sinf(ang)};
  }
  for (int i = gtid; i < 2 * 64 * 64; i += gsz) {
    const int dg = i >> 6;
    const float step = expf(p.in[7][dg]);
    const float lr_ = p.in[5][i], li_ = p.in[6][i];
    const float mag = expf(lr_ * step), ang = li_ * step;
    const float ar = mag * cosf(ang), ai = mag * sinf(ang);
    const float den = lr_ * lr_ + li_ * li_;
    const float zr = ar - 1.f;
    const float qr = (zr * lr_ + ai * li_) / den, qi = (ai * lr_ - zr * li_) / den;
#pragma unroll
    for (int c = 0; c < 16; ++c) {
      const float br = p.in[8][(size_t)i * 16 + c], bi = p.in[9][(size_t)i * 16 + c];
      BBAR[(size_t)i * 16 + c] = float2{qr * br - qi * bi, qr * bi + qi * br};
    }
  }
}

DEVI float s5_kterm(const Params& p, const float2* POW, const float2* BBAR, int d, int g, int n, int c, int cp) {
  const int dg = d * 64 + g;
  const float* cr = p.in[10] + ((size_t)dg * 16 + c) * 64;
  const float* ci = p.in[11] + ((size_t)dg * 16 + c) * 64;
  const float2* E = POW + ((size_t)dg * 33 + n) * 64;
  const float2* BB = BBAR + (size_t)dg * 64 * 16 + cp;
  float s = 0.f;
#pragma unroll 8
  for (int pp = 0; pp < 64; ++pp) {
    const float2 e = E[pp], bb = BB[pp * 16];
    const float Cr = cr[pp], Ci = ci[pp];
    const float cer = Cr * e.x - Ci * e.y, cei = Cr * e.y + Ci * e.x;
    s += cer * bb.x - cei * bb.y;
  }
  return s;
}

DEVI void phase_setup2(const Params& p) {
  unsigned char* ws = p.ws;
  const int gsz = gridDim.x * 256, gtid = blockIdx.x * 256 + threadIdx.x;
  const float2* POW = (const float2*)(ws + OFF_POW);
  const float2* BBAR = (const float2*)(ws + OFF_BBAR);
  float* KTAB = (float*)(ws + OFF_KTAB);
  u16* WST = (u16*)(ws + OFF_WST);
  u16* BT1 = (u16*)(ws + OFF_BT1);
  for (int i = gtid; i < 64 * 63 * 256; i += gsz) {
    const int cp = i & 15, c = (i >> 4) & 15, ti = (i >> 8) % 63, g = i / (63 * 256);
    const int tau = ti - 31;
    float s = 0.f;
    if (tau >= 0) s += s5_kterm(p, POW, BBAR, 0, g, tau, c, cp);
    if (tau <= 0) s += s5_kterm(p, POW, BBAR, 1, g, -tau, c, cp);
    KTAB[i] = s;
  }
  for (int i = gtid; i < 64 * 256 * 64; i += gsz) {
    const int kv = i & 63, np = (i >> 6) & 255, g = i >> 14;
    const int d = np >> 7, ri = (np >> 6) & 1, pp = np & 63, s = kv >> 1, c0 = (kv & 1) * 8;
    const int npow = d ? s : 31 - s;
    const float2 e = POW[((size_t)(d * 64 + g) * 33 + npow) * 64 + pp];
    float v[8];
#pragma unroll
    for (int j = 0; j < 8; ++j) {
      const float2 bb = BBAR[((size_t)(d * 64 + g) * 64 + pp) * 16 + c0 + j];
      v[j] = ri ? (e.x * bb.y + e.y * bb.x) : (e.x * bb.x - e.y * bb.y);
    }
    *reinterpret_cast<uint4*>(WST + ((size_t)g * 256 + np) * 512 + kv * 8) = pack8(v);
  }
  for (int i = gtid; i < 64 * 512 * 32; i += gsz) {
    const int kv = i & 31, n = (i >> 5) & 511, g = i >> 14;
    const int t = n >> 4, c = n & 15, kk0 = kv * 8;
    const int d = kk0 >> 7, ri = (kk0 >> 6) & 1, p0 = kk0 & 63;
    const int npow = d ? 32 - t : t + 1;
    const int dg = d * 64 + g;
    float v[8];
#pragma unroll
    for (int j = 0; j < 8; ++j) {
      const int pp = p0 + j;
      const float Cr = p.in[10][((size_t)dg * 16 + c) * 64 + pp], Ci = p.in[11][((size_t)dg * 16 + c) * 64 + pp];
      const float2 e = POW[((size_t)dg * 33 + npow) * 64 + pp];
      v[j] = ri ? -(Cr * e.y + Ci * e.x) : (Cr * e.x - Ci * e.y);
    }
    *reinterpret_cast<uint4*>(BT1 + ((size_t)g * 512 + n) * 768 + 512 + kv * 8) = pack8(v);
  }
}

DEVI void phase_setup3(const Params& p) {
  cvt_plain(p.in[0], (u16*)(p.ws + OFF_XIN), (size_t)TS * 1024 / 8);
  const int gsz = gridDim.x * 256, gtid = blockIdx.x * 256 + threadIdx.x;
  const float* KTAB = (const float*)(p.ws + OFF_KTAB);
  u16* BT1 = (u16*)(p.ws + OFF_BT1);
  for (int i = gtid; i < 64 * 512 * 64; i += gsz) {
    const int kv = i & 63, n = (i >> 6) & 511, g = i >> 15;
    const int t = n >> 4, c = n & 15, s = kv >> 1, c0 = (kv & 1) * 8;
    const float* src = KTAB + (((size_t)g * 63 + (t - s + 31)) * 16 + c) * 16 + c0;
    float v[8];
#pragma unroll
    for (int j = 0; j < 8; ++j) v[j] = src[j];
    *reinterpret_cast<uint4*>(BT1 + ((size_t)g * 512 + n) * 768 + kv * 8) = pack8(v);
  }
}

DEVI void phase_s5_in(const Params& p, int s, unsigned char* smem) {
  const u16* XIN = (const u16*)(p.ws + OFF_XIN);
  const u16* Wt = (const u16*)(p.ws + OFF_WS5IN);
  u16* AP = (u16*)(p.ws + OFF_AP);
  const int lane = threadIdx.x & 63, wave = threadIdx.x >> 6, wm = wave >> 1, wn = wave & 1;
  for (int it = 0, mt, nt; tile_map(it, 256, 8, mt, nt); ++it) {
    const int m0 = mt * 128, n0 = nt * 128;
    gemm_tile_dma(XIN + (size_t)m0 * 1024, 1024, Wt + (size_t)n0 * 1024, 1024, 1024, smem, [&](f32x4 (&acc)[4][4]) {
#pragma unroll
      for (int i = 0; i < 4; ++i)
#pragma unroll
        for (int j = 0; j < 4; ++j)
#pragma unroll
          for (int r = 0; r < 4; ++r) {
            const int row = m0 + wm * 64 + i * 16 + (lane >> 4) * 4 + r;
            const int col = n0 + wn * 64 + j * 16 + (lane & 15);
            AP[((size_t)(col >> 4) * 1024 + (row >> 5)) * 768 + (row & 31) * 16 + (col & 15)] = f2bf(acc[i][j][r]);
          }
    });
  }
}

DEVI void phase_s5_state(const Params& p, unsigned char* smem) {
  const u16* AP = (const u16*)(p.ws + OFF_AP);
  const u16* WST = (const u16*)(p.ws + OFF_WST);
  float* HLOC = (float*)(p.ws + OFF_HLOC);
  const int lane = threadIdx.x & 63, wave = threadIdx.x >> 6, wm = wave >> 1, wn = wave & 1;
  for (int tile = blockIdx.x; tile < 64 * 16; tile += gridDim.x) {
    const int g = tile >> 4, m0 = ((tile >> 1) & 7) * 128, n0 = (tile & 1) * 128;
    gemm_tile_dma(AP + ((size_t)g * 1024 + m0) * 768, 768, WST + ((size_t)g * 256 + n0) * 512, 512, 512, smem, [&](f32x4 (&acc)[4][4]) {
#pragma unroll
      for (int i = 0; i < 4; ++i)
#pragma unroll
        for (int j = 0; j < 4; ++j)
#pragma unroll
          for (int r = 0; r < 4; ++r) {
            const int row = m0 + wm * 64 + i * 16 + (lane >> 4) * 4 + r;
            const int col = n0 + wn * 64 + j * 16 + (lane & 15);
            HLOC[((size_t)g * 1024 + row) * 256 + col] = acc[i][j][r];
          }
    });
  }
}

DEVI void phase_s5_cscan(const Params& p, int s) {
  const int L = s ? 2048 : 4096;
  const int nseq = TS / L, nch = L / 32;
  u16* AP = (u16*)(p.ws + OFF_AP);
  const float* HLOC = (const float*)(p.ws + OFF_HLOC);
  const float2* POW = (const float2*)(p.ws + OFF_POW);
  const int gsz = gridDim.x * 256, gtid = blockIdx.x * 256 + threadIdx.x;
  for (int i = gtid; i < 64 * nseq * 128; i += gsz) {
    const int pp = i & 63, d = (i >> 6) & 1, g = (i >> 7) & 63, seq = i >> 13;
    const float2 e = POW[((size_t)(d * 64 + g) * 33 + 32) * 64 + pp];
    float Hr = 0.f, Hi = 0.f;
#pragma unroll 8
    for (int j = 0; j < nch; ++j) {
      const int chunk = seq * nch + (d ? (nch - 1 - j) : j);
      u16* ap = AP + ((size_t)g * 1024 + chunk) * 768 + 512 + d * 128 + pp;
      ap[0] = f2bf(Hr);
      ap[64] = f2bf(Hi);
      const float* hl = HLOC + ((size_t)g * 1024 + chunk) * 256 + d * 128 + pp;
      const float a = hl[0], b = hl[64];
      const float nHr = e.x * Hr - e.y * Hi + a;
      const float nHi = e.x * Hi + e.y * Hr + b;
      Hr = nHr; Hi = nHi;
    }
  }
}

DEVI void phase_s5_main(const Params& p, unsigned char* smem) {
  const u16* AP = (const u16*)(p.ws + OFF_AP);
  const u16* BT1 = (const u16*)(p.ws + OFF_BT1);
  u16* HB = (u16*)(p.ws + OFF_HB);
  const float* dsk = p.in[12];
  const int lane = threadIdx.x & 63, wave = threadIdx.x >> 6, wm = wave >> 1, wn = wave & 1;
  for (int tile = blockIdx.x; tile < 64 * 32; tile += gridDim.x) {
    const int g = tile >> 5, m0 = ((tile >> 2) & 7) * 128, n0 = (tile & 3) * 128;
    gemm_tile_dma(AP + ((size_t)g * 1024 + m0) * 768, 768, BT1 + ((size_t)g * 512 + n0) * 768, 768, 768, smem, [&](f32x4 (&acc)[4][4]) {
      const float dv = dsk[g * 16 + (lane & 15)];
#pragma unroll
      for (int i = 0; i < 4; ++i)
#pragma unroll
        for (int j = 0; j < 4; ++j)
#pragma unroll
          for (int r = 0; r < 4; ++r) {
            const int chunk = m0 + wm * 64 + i * 16 + (lane >> 4) * 4 + r;
            const int n = n0 + wn * 64 + j * 16 + (lane & 15);
            const float u = bf2f(AP[((size_t)g * 1024 + chunk) * 768 + n]);
            const float y = acc[i][j][r] + dv * u;
            HB[((size_t)chunk * 32 + (n >> 4)) * 1024 + g * 16 + (lane & 15)] = f2bf(gelu_(y));
          }
    });
  }
}

DEVI void phase_s5_glu(const Params& p, int s, unsigned char* smem) {
  const u16* HB = (const u16*)(p.ws + OFF_HB);
  const u16* Wt = (const u16*)(p.ws + OFF_WGLU);
  const float* Xin = p.in[s];
  float* Xo = p.out + (size_t)s * TS * 1024;
  const int lane = threadIdx.x & 63, wave = threadIdx.x >> 6, wm = wave >> 1, wn = wave & 1;
  for (int it = 0, mt, nt; tile_map(it, 256, 16, mt, nt); ++it) {
    const int m0 = mt * 128, n0 = nt * 128;
    gemm_tile_dma(HB + (size_t)m0 * 1024, 1024, Wt + (size_t)n0 * 1024, 1024, 1024, smem, [&](f32x4 (&acc)[4][4]) {
#pragma unroll
      for (int i = 0; i < 4; ++i)
#pragma unroll
        for (int jj = 0; jj < 4; jj += 2)
#pragma unroll
          for (int r = 0; r < 4; ++r) {
            const int row = m0 + wm * 64 + i * 16 + (lane >> 4) * 4 + r;
            const int nb = n0 + wn * 64 + jj * 16;
            const int o = (nb >> 5) * 16 + (lane & 15);
            const float mix = acc[i][jj][r] * sigmoid_(acc[i][jj + 1][r]);
            const size_t idx = (size_t)row * 1024 + o;
            Xo[idx] = ALPHA * Xin[idx] + mix;
          }
    });
  }
}

DEVI void phase_ln1_tables(const Params& p, int s, int layer, unsigned char* smem) {
  float* X = p.out + (size_t)s * TS * 1024;
  u16* XB = (u16*)(p.ws + OFF_XB);
  const float* gam = p.in[23] + layer * 1024;
  const float* bet = p.in[24] + layer * 1024;
  const int lane = threadIdx.x & 63, wave = threadIdx.x >> 6;
  for (int t = blockIdx.x * 4 + wave; t < TS; t += gridDim.x * 4) {
    float4 v[4];
#pragma unroll
    for (int i = 0; i < 4; ++i) v[i] = *reinterpret_cast<const float4*>(X + (size_t)t * 1024 + i * 256 + lane * 4);
    float sm = 0.f;
#pragma unroll
    for (int i = 0; i < 4; ++i) sm += v[i].x + v[i].y + v[i].z + v[i].w;
#pragma unroll
    for (int m = 32; m >= 1; m >>= 1) sm += __shfl_xor(sm, m);
    const float mu = sm * (1.f / 1024.f);
    float sq = 0.f;
#pragma unroll
    for (int i = 0; i < 4; ++i) {
      const float a = v[i].x - mu, b = v[i].y - mu, c = v[i].z - mu, d = v[i].w - mu;
      sq += a * a + b * b + c * c + d * d;
    }
#pragma unroll
    for (int m = 32; m >= 1; m >>= 1) sq += __shfl_xor(sq, m);
    const float rs = rsqrtf(sq * (1.f / 1024.f) + LN_EPS);
#pragma unroll
    for (int i = 0; i < 4; ++i) {
      const int c0 = i * 256 + lane * 4;
      const float4 g4 = *reinterpret_cast<const float4*>(gam + c0);
      const float4 b4 = *reinterpret_cast<const float4*>(bet + c0);
      float4 o;
      o.x = (v[i].x - mu) * rs * g4.x + b4.x; o.y = (v[i].y - mu) * rs * g4.y + b4.y;
      o.z = (v[i].z - mu) * rs * g4.z + b4.z; o.w = (v[i].w - mu) * rs * g4.w + b4.w;
      *reinterpret_cast<float4*>(X + (size_t)t * 1024 + c0) = o;
      uint2 pk; pk.x = pack2(o.x, o.y); pk.y = pack2(o.z, o.w);
      *reinterpret_cast<uint2*>(XB + (size_t)t * 1024 + c0) = pk;
    }
  }
  float* SCL = (float*)(p.ws + OFF_SCL);
  float* lds = reinterpret_cast<float*>(smem) + (threadIdx.x & 63) + (threadIdx.x >> 6) * 2048;
  int srck[32];
  {
    v16f ra, rb;
#pragma unroll
    for (int j = 0; j < 16; ++j) { ra[j] = (j < 8) ? 0.125f * j : 1.f + 0.125f * (j - 8); rb[j] = (j < 8) ? 2.f + 0.25f * j : 4.f + 0.5f * (j - 8); }
    const v6u pk = __builtin_amdgcn_cvt_scalef32_2xpk16_fp6_f32(ra, rb, 1.0f);
    const v32f dd = __builtin_amdgcn_cvt_scalef32_pk32_f32_fp6(pk, 1.0f);
#pragma unroll
    for (int k = 0; k < 32; ++k) {
      const float v = dd[k];
      const float fi = v < 1.f ? v * 8.f : (v < 2.f ? 8.f + (v - 1.f) * 8.f : (v < 4.f ? 16.f + (v - 2.f) * 4.f : 24.f + (v - 4.f) * 2.f));
      srck[k] = ((int)(fi + 0.5f)) & 31;
    }
  }
  const int ll = lane & 31, hs = lane >> 5;
  for (int r2 = blockIdx.x * 4 + wave; r2 < 16384; r2 += gridDim.x * 4) {
    const int r = r2 * 2 + hs;
    const int tab = r >> 14, row = r & 16383;
    const float4* sp = reinterpret_cast<const float4*>(p.in[29 + tab] + ((size_t)layer * 16384 + row) * 1024 + ll * 32);
    float s[32];
#pragma unroll
    for (int j = 0; j < 8; ++j) { const float4 a = sp[j]; s[4 * j] = a.x; s[4 * j + 1] = a.y; s[4 * j + 2] = a.z; s[4 * j + 3] = a.w; }
    float am = 0.f;
#pragma unroll
    for (int k = 0; k < 32; ++k) am = fmaxf(am, fabsf(s[k]));
#pragma unroll
    for (int m = 16; m >= 1; m >>= 1) am = fmaxf(am, __shfl_xor(am, m));
    const float sc = am > 0.f ? 7.5f / am : 1.f;
    const float inv = am > 0.f ? am * (1.f / 7.5f) : 1.f;
#pragma unroll
    for (int k = 0; k < 32; ++k) lds[srck[k] * 64] = s[k] * sc;
    v16f ia, ib;
#pragma unroll
    for (int j = 0; j < 16; ++j) { ia[j] = lds[j * 64]; ib[j] = lds[(16 + j) * 64]; }
    const v6u pk = __builtin_amdgcn_cvt_scalef32_2xpk16_fp6_f32(ia, ib, 1.0f);
    unsigned char* dst = p.ws + (tab ? OFF_VB8 : OFF_UB8) + (size_t)row * 768;
    *reinterpret_cast<uint4*>(dst + ll * 16) = uint4{pk[0], pk[1], pk[2], pk[3]};
    *reinterpret_cast<uint2*>(dst + 512 + ll * 8) = uint2{pk[4], pk[5]};
    if (ll == 0) SCL[tab * 16384 + row] = inv;
  }
}

DEVI u32 enc_key(float s, int n) {
  u32 b = __float_as_uint(s);
  u32 srt = (b & 0x80000000u) ? ~b : (b | 0x80000000u);
  return (srt & ~127u) | (u32)(127 - n);
}
DEVI float dec_key(u32 key, int& n) {
  n = 127 - (int)(key & 127u);
  u32 srt = key & ~127u;
  u32 b = (srt & 0x80000000u) ? (srt & 0x7fffffffu) : ~srt;
  return __uint_as_float(b);
}

DEVI void phase_peer_q(const Params& p, int layer, unsigned char* smem) {
  const u16* XB = (const u16*)(p.ws + OFF_XB);
  const u16* Wt = (const u16*)(p.ws + OFF_WQ) + (size_t)layer * 2048 * 1024;
  const u16* SK = (const u16*)(p.ws + OFF_SK) + (size_t)layer * 2 * 128 * 128;
  u32* KEYS = (u32*)(p.ws + OFF_KEYS);
  const int tid = threadIdx.x, lane = tid & 63, wave = tid >> 6, wm = wave >> 1, wn = wave & 1;
  const int lr = lane & 15, lq = lane >> 4;
  u16* Qs = reinterpret_cast<u16*>(smem);
  u32* Sk = reinterpret_cast<u32*>(smem);
  for (int it = 0, mt, nt; tile_map(it, 256, 16, mt, nt); ++it) {
    const int m0 = mt * 128, hc = nt, n0 = hc * 128;
    const int c = hc & 1;
    gemm_tile_dma(XB + (size_t)m0 * 1024, 1024, Wt + (size_t)n0 * 1024, 1024, 1024, smem, [&](f32x4 (&acc)[4][4]) {
#pragma unroll
      for (int i = 0; i < 4; ++i)
#pragma unroll
        for (int j = 0; j < 4; ++j)
#pragma unroll
          for (int r = 0; r < 4; ++r)
            Qs[(wm * 64 + i * 16 + lq * 4 + r) * 136 + wn * 64 + j * 16 + lr] = f2bf(acc[i][j][r]);
      __syncthreads();
      f32x4 sc[4][4];
#pragma unroll
      for (int i = 0; i < 4; ++i)
#pragma unroll
        for (int j = 0; j < 4; ++j) sc[i][j] = f32x4{0.f, 0.f, 0.f, 0.f};
      const u16* skc = SK + (size_t)c * 128 * 128;
#pragma unroll
      for (int ks = 0; ks < 4; ++ks) {
        bf16x8 af[4], bfr[4];
#pragma unroll
        for (int i = 0; i < 4; ++i) af[i] = *reinterpret_cast<const bf16x8*>(Qs + (wm * 64 + i * 16 + lr) * 136 + ks * 32 + lq * 8);
#pragma unroll
        for (int j = 0; j < 4; ++j) bfr[j] = *reinterpret_cast<const bf16x8*>(skc + (size_t)(wn * 64 + j * 16 + lr) * 128 + ks * 32 + lq * 8);
#pragma unroll
        for (int i = 0; i < 4; ++i)
#pragma unroll
          for (int j = 0; j < 4; ++j) sc[i][j] = __builtin_amdgcn_mfma_f32_16x16x32_bf16(af[i], bfr[j], sc[i][j], 0, 0, 0);
      }
      __syncthreads();
#pragma unroll
      for (int i = 0; i < 4; ++i)
#pragma unroll
        for (int j = 0; j < 4; ++j)
#pragma unroll
          for (int r = 0; r < 4; ++r) {
            const int n = wn * 64 + j * 16 + lr;
            Sk[(wm * 64 + i * 16 + lq * 4 + r) * 129 + n] = enc_key(sc[i][j][r], n);
          }
      __syncthreads();
      if (tid < 128) {
        u32 top[16];
#pragma unroll
        for (int k = 0; k < 16; ++k) top[k] = 0u;
#pragma unroll 4
        for (int n = 0; n < 128; ++n) {
          u32 v = Sk[tid * 129 + n];
#pragma unroll
          for (int k = 0; k < 16; ++k) {
            const u32 hi = max(top[k], v);
            v = min(top[k], v);
            top[k] = hi;
          }
        }
        uint4* dst = reinterpret_cast<uint4*>(KEYS + ((size_t)(m0 + tid) * 16 + hc) * 16);
        dst[0] = uint4{top[0], top[1], top[2], top[3]};
        dst[1] = uint4{top[4], top[5], top[6], top[7]};
        dst[2] = uint4{top[8], top[9], top[10], top[11]};
        dst[3] = uint4{top[12], top[13], top[14], top[15]};
      }
    });
  }
}

DEVI void phase_peer_route(const Params& p, int s, int layer) {
  cvt_plain(p.in[2 + s] + (size_t)layer * TS * 256, (u16*)(p.ws + OFF_PB), (size_t)TS * 256 / 8);
  const u32* KEYS = (const u32*)(p.ws + OFF_KEYS);
  int* IDX = (int*)(p.ws + OFF_IDX);
  float* GATE = (float*)(p.ws + OFF_GATE);
  float* SU = (float*)(p.ws + OFF_SU);
  const float* SCL = (const float*)(p.ws + OFF_SCL);
  const int gsz = gridDim.x * 256, gtid = blockIdx.x * 256 + threadIdx.x;
  for (int i = gtid; i < TS * 8; i += gsz) {
    const uint4* src = reinterpret_cast<const uint4*>(KEYS + (size_t)i * 32);
    u32 kk[32];
#pragma unroll
    for (int q = 0; q < 8; ++q) { const uint4 w = src[q]; kk[q * 4] = w.x; kk[q * 4 + 1] = w.y; kk[q * 4 + 2] = w.z; kk[q * 4 + 3] = w.w; }
    float s0[16], s1[16]; int i0[16], i1[16];
#pragma unroll
    for (int k = 0; k < 16; ++k) { s0[k] = dec_key(kk[k], i0[k]); s1[k] = dec_key(kk[16 + k], i1[k]); }
    float top[16];
#pragma unroll
    for (int k = 0; k < 16; ++k) top[k] = -3.0e38f;
#pragma unroll
    for (int k1 = 0; k1 < 16; ++k1)
#pragma unroll
      for (int k2 = 0; k2 < 16; ++k2)
        if ((k1 + 1) * (k2 + 1) <= 16) {
          float v = s0[k1] + s1[k2];
#pragma unroll
          for (int k = 0; k < 16; ++k) {
            const float hi = fmaxf(top[k], v);
            v = fminf(top[k], v);
            top[k] = hi;
          }
        }
    const float thr = top[15], mx = top[0];
    float den = 0.f;
#pragma unroll
    for (int k = 0; k < 16; ++k) den += __expf(top[k] - mx);
    const float inv = 1.f / den;
    int cnt = 0;
    int* idst = IDX + (size_t)i * 16;
    float* gdst = GATE + (size_t)i * 16;
    float* sdst = SU + (size_t)i * 16;
#pragma unroll
    for (int k1 = 0; k1 < 16; ++k1)
#pragma unroll
      for (int k2 = 0; k2 < 16; ++k2)
        if ((k1 + 1) * (k2 + 1) <= 16) {
          const float v = s0[k1] + s1[k2];
          if (v >= thr && cnt < 16) {
            const int e = i0[k1] * 128 + i1[k2];
            idst[cnt] = e;
            gdst[cnt] = __expf(v - mx) * inv * SCL[16384 + e];
            sdst[cnt] = SCL[e];
            ++cnt;
          }
        }
  }
}

DEVI f2 cvt8(u32 w, bool hi) { return hi ? __builtin_amdgcn_cvt_pk_f32_fp8((int)w, true) : __builtin_amdgcn_cvt_pk_f32_fp8((int)w, false); }

DEVI v32f ld_fp6_row(const unsigned char* base, int ei, int ll) {
  const unsigned char* r = base + (size_t)ei * 768;
  const uint4 a = *reinterpret_cast<const uint4*>(r + ll * 16);
  const uint2 b = *reinterpret_cast<const uint2*>(r + 512 + ll * 8);
  v6u pk; pk[0] = a.x; pk[1] = a.y; pk[2] = a.z; pk[3] = a.w; pk[4] = b.x; pk[5] = b.y;
  return __builtin_amdgcn_cvt_scalef32_pk32_f32_fp6(pk, 1.0f);
}

struct Raw6 { uint4 a; uint2 b; };
DEVI Raw6 ld_raw6(const unsigned char* base, int ei, int ll) {
  const unsigned char* r = base + (size_t)ei * 768;
  Raw6 o;
  o.a = *reinterpret_cast<const uint4*>(r + ll * 16);
  o.b = *reinterpret_cast<const uint2*>(r + 512 + ll * 8);
  return o;
}
DEVI v32f dec6(const Raw6& r) {
  v6u pk; pk[0] = r.a.x; pk[1] = r.a.y; pk[2] = r.a.z; pk[3] = r.a.w; pk[4] = r.b.x; pk[5] = r.b.y;
  return __builtin_amdgcn_cvt_scalef32_pk32_f32_fp6(pk, 1.0f);
}

DEVI void phase_peer_gather(const Params& p, int s, int layer) {
  float* X = p.out + (size_t)s * TS * 1024;
  u16* XB = (u16*)(p.ws + OFF_XB);
  const unsigned char* Ub = p.ws + OFF_UB8;
  const unsigned char* Vb = p.ws + OFF_VB8;
  const int* IDX = (const int*)(p.ws + OFF_IDX);
  const float* GATE = (const float*)(p.ws + OFF_GATE);
  const float* SU = (const float*)(p.ws + OFF_SU);
  const float* gam = p.in[25] + layer * 1024;
  const float* bet = p.in[26] + layer * 1024;
  const int lane = threadIdx.x & 63, wave = threadIdx.x >> 6;
  const int ll = lane & 31, hs = lane >> 5;
  const bool b4 = lane & 16, b3 = lane & 8;
  for (int t = blockIdx.x * 4 + wave; t < TS; t += gridDim.x * 4) {
    float x[32], o[32];
    {
      const float4* xp = reinterpret_cast<const float4*>(X + (size_t)t * 1024 + ll * 32);
#pragma unroll
      for (int j = 0; j < 8; ++j) { const float4 a = xp[j]; x[4 * j] = a.x; x[4 * j + 1] = a.y; x[4 * j + 2] = a.z; x[4 * j + 3] = a.w; }
    }
#pragma unroll
    for (int k = 0; k < 32; ++k) o[k] = 0.f;
    const int iv0 = IDX[(size_t)t * 128 + lane], iv1 = IDX[(size_t)t * 128 + 64 + lane];
    const float gv0 = GATE[(size_t)t * 128 + lane], gv1 = GATE[(size_t)t * 128 + 64 + lane];
    const float su0 = SU[(size_t)t * 128 + lane], su1 = SU[(size_t)t * 128 + 64 + lane];
    for (int e0 = 0; e0 < 128; e0 += 8) {
      const bool lo = e0 < 64;
      const int ivs = lo ? iv0 : iv1;
      const float gvs = lo ? gv0 : gv1;
      const float sus = lo ? su0 : su1;
      int ei[4];
#pragma unroll
      for (int q = 0; q < 4; ++q) {
        const int ea = __builtin_amdgcn_readlane(ivs, (e0 & 63) + 2 * q);
        const int eb = __builtin_amdgcn_readlane(ivs, (e0 & 63) + 2 * q + 1);
        ei[q] = hs ? eb : ea;
      }
      Raw6 cu[4], cv[4];
#pragma unroll
      for (int q = 0; q < 4; ++q) { cu[q] = ld_raw6(Ub, ei[q], ll); cv[q] = ld_raw6(Vb, ei[q], ll); }
      float dq[4];
#pragma unroll
      for (int q = 0; q < 4; ++q) {
        const v32f u = dec6(cu[q]);
        float d0 = 0.f, d1 = 0.f;
#pragma unroll
        for (int k = 0; k < 32; k += 2) { d0 = fmaf(u[k], x[k], d0); d1 = fmaf(u[k + 1], x[k + 1], d1); }
        dq[q] = d0 + d1;
      }
      float d2[2], d1;
#pragma unroll
      for (int k = 0; k < 2; ++k) {
        const float keep = b4 ? dq[k + 2] : dq[k], send = b4 ? dq[k] : dq[k + 2];
        d2[k] = keep + __shfl_xor(send, 16);
      }
      {
        const float keep = b3 ? d2[1] : d2[0], send = b3 ? d2[0] : d2[1];
        d1 = keep + __shfl_xor(send, 8);
      }
      d1 += __shfl_xor(d1, 4);
      d1 += __shfl_xor(d1, 2);
      d1 += __shfl_xor(d1, 1);
      const int qmine = (b4 ? 2 : 0) + (b3 ? 1 : 0);
      const int srcl = (e0 & 63) + 2 * qmine + hs;
      const float suv = __shfl(sus, srcl), gvv = __shfl(gvs, srcl);
      const float w = gvv * gelu_(d1 * suv);
#pragma unroll
      for (int q = 0; q < 4; ++q) {
        const float wq = __shfl(w, (lane & 32) | ((q >> 1) << 4) | ((q & 1) << 3));
        const v32f v = dec6(cv[q]);
#pragma unroll
        for (int k = 0; k < 32; ++k) o[k] = fmaf(wq, v[k], o[k]);
      }
    }
    float sm = 0.f;
#pragma unroll
    for (int k = 0; k < 32; ++k) { o[k] += __shfl_xor(o[k], 32); o[k] = ALPHA * x[k] + o[k]; sm += o[k]; }
#pragma unroll
    for (int m = 16; m >= 1; m >>= 1) sm += __shfl_xor(sm, m);
    const float mu = sm * (1.f / 1024.f);
    float sq = 0.f;
#pragma unroll
    for (int k = 0; k < 32; ++k) { const float dd = o[k] - mu; sq += dd * dd; }
#pragma unroll
    for (int m = 16; m >= 1; m >>= 1) sq += __shfl_xor(sq, m);
    const float rs = rsqrtf(sq * (1.f / 1024.f) + LN_EPS);
    if (hs == 0) {
      const int c0 = ll * 32;
#pragma unroll
      for (int j = 0; j < 4; ++j) {
        float r[8];
#pragma unroll
        for (int k = 0; k < 8; ++k) r[k] = (o[j * 8 + k] - mu) * rs * gam[c0 + j * 8 + k] + bet[c0 + j * 8 + k];
        float4* dp = reinterpret_cast<float4*>(X + (size_t)t * 1024 + c0 + j * 8);
        dp[0] = float4{r[0], r[1], r[2], r[3]};
        dp[1] = float4{r[4], r[5], r[6], r[7]};
        *reinterpret_cast<uint4*>(XB + (size_t)t * 1024 + c0 + j * 8) = pack8(r);
      }
    }
  }
}

DEVI void phase_ple(const Params& p, int s, int layer, unsigned char* smem) {
  float* X = p.out + (size_t)s * TS * 1024;
  const u16* XB = (const u16*)(p.ws + OFF_XB);
  const u16* PB = (const u16*)(p.ws + OFF_PB);
  u16* XB2 = (u16*)(p.ws + OFF_XB2);
  const u16* Wp = (const u16*)(p.ws + OFF_WPROJ) + (size_t)layer * 1024 * 256;
  const u16* Wg = (const u16*)(p.ws + OFF_WPG) + (size_t)layer * 1024 * 1024;
  const int lane = threadIdx.x & 63, wave = threadIdx.x >> 6, wm = wave >> 1, wn = wave & 1;
  for (int it = 0, mt, nt; tile_map(it, 256, 8, mt, nt); ++it) {
    const int m0 = mt * 128, n0 = nt * 128;
    u32 pk[4][4][2];
    gemm_tile_dma(XB + (size_t)m0 * 1024, 1024, Wg + (size_t)n0 * 1024, 1024, 1024, smem, [&](f32x4 (&acc)[4][4]) {
#pragma unroll
      for (int i = 0; i < 4; ++i)
#pragma unroll
        for (int j = 0; j < 4; ++j) {
          pk[i][j][0] = pack2(sigmoid_(acc[i][j][0]), sigmoid_(acc[i][j][1]));
          pk[i][j][1] = pack2(sigmoid_(acc[i][j][2]), sigmoid_(acc[i][j][3]));
        }
    });
    gemm_tile_dma(PB + (size_t)m0 * 256, 256, Wp + (size_t)n0 * 256, 256, 256, smem, [&](f32x4 (&acc)[4][4]) {
#pragma unroll
      for (int i = 0; i < 4; ++i)
#pragma unroll
        for (int j = 0; j < 4; ++j)
#pragma unroll
          for (int r = 0; r < 4; ++r) {
            const int row = m0 + wm * 64 + i * 16 + (lane >> 4) * 4 + r;
            const int col = n0 + wn * 64 + j * 16 + (lane & 15);
            const u32 w = pk[i][j][r >> 1];
            const float sg = (r & 1) ? bfhi(w) : bflo(w);
            const size_t idx = (size_t)row * 1024 + col;
            const float v = X[idx] + acc[i][j][r] * sg;
            X[idx] = v;
            if (layer == 0) XB2[idx] = f2bf(v);
          }
    });
  }
  if (layer == 1 && s == 0) cvt_plain(p.in[1], (u16*)(p.ws + OFF_XIN), (size_t)TS * 1024 / 8);
}

DEVI void phase_rg_in(const Params& p, int s, unsigned char* smem) {
  const u16* XB2 = (const u16*)(p.ws + OFF_XB2);
  const u16* Wt = (const u16*)(p.ws + OFF_WRGIN);
  u16* GG = (u16*)(p.ws + OFF_GG);
  u16* R = (u16*)(p.ws + OFF_R);
  const int lane = threadIdx.x & 63, wave = threadIdx.x >> 6, wm = wave >> 1, wn = wave & 1;
  for (int it = 0, mt, nt; tile_map(it, 256, 16, mt, nt); ++it) {
    const int m0 = mt * 128, n0 = nt * 128;
    gemm_tile_dma(XB2 + (size_t)m0 * 1024, 1024, Wt + (size_t)n0 * 1024, 1024, 1024, smem, [&](f32x4 (&acc)[4][4]) {
#pragma unroll
      for (int i = 0; i < 4; ++i)
#pragma unroll
        for (int j = 0; j < 4; ++j)
#pragma unroll
          for (int r = 0; r < 4; ++r) {
            const int row = m0 + wm * 64 + i * 16 + (lane >> 4) * 4 + r;
            const int col = n0 + wn * 64 + j * 16 + (lane & 15);
            if (n0 < 1024) GG[(size_t)row * 1024 + col] = f2bf(gelu_(acc[i][j][r]));
            else R[(size_t)row * 1024 + col - 1024] = f2bf(acc[i][j][r]);
          }
    });
  }
}

DEVI void phase_rg_conv(const Params& p, int s) {
  const int L = s ? 2048 : 4096;
  const u16* R = (const u16*)(p.ws + OFF_R);
  u16* C = (u16*)(p.ws + OFF_C);
  const float* cw = p.in[15];
  const float* cb = p.in[16];
  const int gsz = gridDim.x * 256, gtid = blockIdx.x * 256 + threadIdx.x;
  for (int i = gtid; i < TS * 128; i += gsz) {
    const int t = i >> 7, cv = (i & 127) * 8;
    const int pos = t & (L - 1);
    float acc[8];
#pragma unroll
    for (int j = 0; j < 8; ++j) acc[j] = cb[cv + j];
#pragma unroll
    for (int k = 0; k < 4; ++k) {
      const int pp = pos + k - 1;
      if (pp >= 0 && pp < L) {
        float rv[8];
        unpack8(*reinterpret_cast<const uint4*>(R + (size_t)(t + k - 1) * 1024 + cv), rv);
#pragma unroll
        for (int j = 0; j < 8; ++j) acc[j] = fmaf(rv[j], cw[k * 1024 + cv + j], acc[j]);
      }
    }
    *reinterpret_cast<uint4*>(C + (size_t)i * 8) = pack8(acc);
  }
}

DEVI void phase_rg_gates(const Params& p, unsigned char* smem) {
  const u16* C = (const u16*)(p.ws + OFF_C);
  const u16* Wt = (const u16*)(p.ws + OFF_WGATES);
  u32* AB = (u32*)(p.ws + OFF_AB);
  const float* ba = p.in[18];
  const float* bx = p.in[20];
  const float* lam = p.in[21];
  const int lane = threadIdx.x & 63, wave = threadIdx.x >> 6, wm = wave >> 1, wn = wave & 1;
  for (int it = 0, mt, nt32; tile_map(it, 256, 32, mt, nt32); ++it) {
    const int m0 = mt * 128, h = nt32 >> 3, nt = nt32 & 7, n0 = nt * 128;
    gemm_tile_dma(C + (size_t)m0 * 1024 + h * 256, 1024, Wt + ((size_t)h * 1024 + n0) * 256, 256, 256, smem, [&](f32x4 (&acc)[4][4]) {
#pragma unroll
      for (int jj = 0; jj < 4; jj += 2) {
        const int nb = n0 + wn * 64 + jj * 16;
        const int d = nb >> 9;
        const int ch = h * 256 + ((nb & 511) >> 5) * 16 + (lane & 15);
        const float bav = ba[d * 1024 + ch], bxv = bx[d * 1024 + ch];
        const float sp8 = -8.f * softplus_(-lam[d * 1024 + ch]);
#pragma unroll
        for (int i = 0; i < 4; ++i)
#pragma unroll
          for (int r = 0; r < 4; ++r) {
            const int row = m0 + wm * 64 + i * 16 + (lane >> 4) * 4 + r;
            const float rg = sigmoid_(acc[i][jj][r] + bav);
            const float ig = sigmoid_(acc[i][jj + 1][r] + bxv);
            const float la = sp8 * rg;
            const float cval = bf2f(C[(size_t)row * 1024 + ch]);
            const float b = __builtin_amdgcn_sqrtf(fmaxf(1.f - __expf(2.f * la), 0.f)) * ig * cval;
            AB[((size_t)row * 2 + d) * 1024 + ch] = pack2(la, b);
            if (r == 3) __builtin_amdgcn_sched_barrier(0);
          }
      }
    });
  }
}

DEVI void phase_rg_agg(const Params& p) {
  const u32* AB = (const u32*)(p.ws + OFF_AB);
  float2* AGG = (float2*)(p.ws + OFF_AGG);
  const int gsz = gridDim.x * 256, gtid = blockIdx.x * 256 + threadIdx.x;
  for (int i = gtid; i < 1024 * 2 * 1024; i += gsz) {
    const int ch = i & 1023, d = (i >> 10) & 1, chunk = i >> 11;
    const int c0 = chunk * 32;
    float h = 0.f, LA = 0.f;
#pragma unroll 8
    for (int k = 0; k < 32; ++k) {
      const int t = d ? (c0 + 31 - k) : (c0 + k);
      const u32 w = AB[((size_t)t * 2 + d) * 1024 + ch];
      const float la = bflo(w), b = bfhi(w);
      h = __expf(la) * h + b;
      LA += la;
    }
    AGG[((size_t)d * 1024 + chunk) * 1024 + ch] = float2{LA, h};
  }
}

DEVI void phase_rg_carry(const Params& p, int s) {
  const int L = s ? 2048 : 4096;
  const int nseq = TS / L, nch = L / 32;
  const float2* AGG = (const float2*)(p.ws + OFF_AGG);
  float* CAR = (float*)(p.ws + OFF_CAR);
  const int gsz = gridDim.x * 256, gtid = blockIdx.x * 256 + threadIdx.x;
  for (int i = gtid; i < nseq * 2 * 1024; i += gsz) {
    const int ch = i & 1023, d = (i >> 10) & 1, seq = i >> 11;
    float H = 0.f;
#pragma unroll 8
    for (int k = 0; k < nch; ++k) {
      const int chunk = seq * nch + (d ? (nch - 1 - k) : k);
      const size_t idx = ((size_t)d * 1024 + chunk) * 1024 + ch;
      CAR[idx] = H;
      const float2 ag = AGG[idx];
      H = __expf(ag.x) * H + ag.y;
    }
  }
}

DEVI void phase_rg_final(const Params& p) {
  const u32* AB = (const u32*)(p.ws + OFF_AB);
  const float* CAR = (const float*)(p.ws + OFF_CAR);
  const u16* GG = (const u16*)(p.ws + OFF_GG);
  u16* Y = (u16*)(p.ws + OFF_R);
  const int gsz = gridDim.x * 256, gtid = blockIdx.x * 256 + threadIdx.x;
  for (int i = gtid; i < 1024 * 1024; i += gsz) {
    const int ch = i & 1023, chunk = i >> 10;
    const int c0 = chunk * 32;
    float hf[32];
    float h = CAR[((size_t)chunk) * 1024 + ch];
#pragma unroll
    for (int k = 0; k < 32; ++k) {
      const u32 w = AB[((size_t)(c0 + k) * 2 + 0) * 1024 + ch];
      h = __expf(bflo(w)) * h + bfhi(w);
      hf[k] = h;
    }
    h = CAR[((size_t)1024 + chunk) * 1024 + ch];
#pragma unroll
    for (int k = 31; k >= 0; --k) {
      const u32 w = AB[((size_t)(c0 + k) * 2 + 1) * 1024 + ch];
      h = __expf(bflo(w)) * h + bfhi(w);
      const size_t idx = (size_t)(c0 + k) * 1024 + ch;
      Y[idx] = f2bf((hf[k] + h) * bf2f(GG[idx]));
    }
  }
}

DEVI void phase_rg_out(const Params& p, int s, unsigned char* smem) {
  float* X = p.out + (size_t)s * TS * 1024;
  const u16* Y = (const u16*)(p.ws + OFF_R);
  const u16* Wt = (const u16*)(p.ws + OFF_WRGOUT);
  const int lane = threadIdx.x & 63, wave = threadIdx.x >> 6, wm = wave >> 1, wn = wave & 1;
  for (int it = 0, mt, nt; tile_map(it, 256, 8, mt, nt); ++it) {
    const int m0 = mt * 128, n0 = nt * 128;
    gemm_tile_dma(Y + (size_t)m0 * 1024, 1024, Wt + (size_t)n0 * 1024, 1024, 1024, smem, [&](f32x4 (&acc)[4][4]) {
#pragma unroll
      for (int i = 0; i < 4; ++i)
#pragma unroll
        for (int j = 0; j < 4; ++j)
#pragma unroll
          for (int r = 0; r < 4; ++r) {
            const int row = m0 + wm * 64 + i * 16 + (lane >> 4) * 4 + r;
            const int col = n0 + wn * 64 + j * 16 + (lane & 15);
            const size_t idx = (size_t)row * 1024 + col;
            X[idx] = ALPHA * X[idx] + acc[i][j][r];
          }
    });
  }
}

constexpr int NPS = 22;
constexpr int NSETUP = 3;
constexpr int NPHASE = NSETUP + 2 * NPS;

template <int PH>
DEVI void run_phase(const Params& p, unsigned char* smem) {
  if constexpr (PH == 0) {
    phase_setup(p);
  } else if constexpr (PH == 1) {
    phase_setup2(p);
  } else if constexpr (PH == 2) {
    phase_setup3(p);
  } else {
    constexpr int s = (PH - NSETUP) / NPS, q = (PH - NSETUP) % NPS;
    if constexpr (q == 0) phase_s5_in(p, s, smem);
    else if constexpr (q == 1) phase_s5_state(p, smem);
    else if constexpr (q == 2) phase_s5_cscan(p, s);
    else if constexpr (q == 3) phase_s5_main(p, smem);
    else if constexpr (q == 4) phase_s5_glu(p, s, smem);
    else if constexpr (q == 5) phase_ln1_tables(p, s, 0, smem);
    else if constexpr (q == 6) phase_peer_q(p, 0, smem);
    else if constexpr (q == 7) phase_peer_route(p, s, 0);
    else if constexpr (q == 8) phase_peer_gather(p, s, 0);
    else if constexpr (q == 9) phase_ple(p, s, 0, smem);
    else if constexpr (q == 10) phase_rg_in(p, s, smem);
    else if constexpr (q == 11) phase_rg_conv(p, s);
    else if constexpr (q == 12) phase_rg_gates(p, smem);
    else if constexpr (q == 13) phase_rg_agg(p);
    else if constexpr (q == 14) phase_rg_carry(p, s);
    else if constexpr (q == 15) phase_rg_final(p);
    else if constexpr (q == 16) phase_rg_out(p, s, smem);
    else if constexpr (q == 17) phase_ln1_tables(p, s, 1, smem);
    else if constexpr (q == 18) phase_peer_q(p, 1, smem);
    else if constexpr (q == 19) phase_peer_route(p, s, 1);
    else if constexpr (q == 20) phase_peer_gather(p, s, 1);
    else if constexpr (q == 21) phase_ple(p, s, 1, smem);
  }
}

#define XB_TMO      128
#define XB_XCNT(j)  (256  + 64 * (j))
#define XB_XSUB(j)  (1280 + 64 * (j))
#define XB_XGEN(j)  (2304 + 64 * (j))
#define XB_TOP      3328
#define XB_TOPGEN   3392
#define XCD_BAR_WORDS 3456
#define XB_SPIN_CAP (1u << 18)
#define LAS __attribute__((address_space(3)))
DEVI unsigned xb_ld(unsigned* p) { return __hip_atomic_load(p, __ATOMIC_RELAXED, __HIP_MEMORY_SCOPE_AGENT); }
DEVI unsigned xb_add(unsigned* p, unsigned v) { return __hip_atomic_fetch_add(p, v, __ATOMIC_RELAXED, __HIP_MEMORY_SCOPE_AGENT); }
DEVI unsigned xb_xcc_id() { return (unsigned)__builtin_amdgcn_s_getreg((3 << 11) | 20) & 0xFu; }
#define XB_SPIN(cond, bar) do { unsigned _sp = 0; while (cond) { __builtin_amdgcn_s_sleep(1); \
    if ((++_sp & 255u) == 0u) { if (xb_ld(&(bar)[XB_TMO])) break; if (_sp > XB_SPIN_CAP) { atomicAdd(&(bar)[XB_TMO], 1u); break; } } } } while (0)
struct XcdBarrier { unsigned* bar; unsigned x; volatile LAS unsigned* st; };
DEVI XcdBarrier xcd_barrier_post(unsigned* bar, volatile LAS unsigned* st) {
  XcdBarrier b; b.bar = bar; b.x = xb_xcc_id(); b.st = st;
  if (threadIdx.x == 0) (void)xb_add(&bar[XB_XCNT(b.x)], 1u);
  return b;
}
DEVI void xcd_barrier_complete(unsigned* bar, unsigned x, unsigned& nloc, unsigned& nx) {
  const unsigned G = gridDim.x * gridDim.y * gridDim.z;
  unsigned sum, cnt, mine, sp = 0u;
  for (;;) {
    sum = 0u; cnt = 0u; mine = 0u;
#pragma unroll
    for (unsigned j = 0; j < 16; ++j) { const unsigned c = xb_ld(&bar[XB_XCNT(j)]); sum += c; cnt += (c > 0u) ? 1u : 0u; mine = (j == x) ? c : mine; }
    if (sum == G) break;
    __builtin_amdgcn_s_sleep(1);
    if ((++sp & 255u) == 0u) { if (xb_ld(&bar[XB_TMO])) break; if (sp > XB_SPIN_CAP) { atomicAdd(&bar[XB_TMO], 1u); break; } }
  }
  nloc = mine > 0u ? mine : 1u; nx = cnt > 0u ? cnt : 1u;
}
DEVI void xcd_barrier(const XcdBarrier& b) {
  asm volatile("s_waitcnt vmcnt(0)" ::: "memory");
  __syncthreads();
  if (threadIdx.x == 0) {
    unsigned* bar = b.bar;
    __builtin_amdgcn_s_waitcnt(0);
    unsigned nloc = b.st[0], nx = b.st[1];
    if (nloc == 0u) { xcd_barrier_complete(bar, b.x, nloc, nx); b.st[0] = nloc; b.st[1] = nx; }
    const unsigned old = xb_add(&bar[XB_XSUB(b.x)], 1u);
    const unsigned gen = old / nloc;
    if (old + 1u == (gen + 1u) * nloc) {
      __builtin_amdgcn_fence(__ATOMIC_RELEASE, "agent");
      asm volatile("s_waitcnt vmcnt(0)" ::: "memory");
      const unsigned og = xb_add(&bar[XB_TOP], 1u);
      const unsigned tg = og / nx;
      if (og + 1u == (tg + 1u) * nx) xb_add(&bar[XB_TOPGEN], 1u);
      else XB_SPIN(xb_ld(&bar[XB_TOPGEN]) == tg, bar);
      __builtin_amdgcn_fence(__ATOMIC_ACQUIRE, "agent");
      xb_add(&bar[XB_XGEN(b.x)], 1u);
      asm volatile("s_waitcnt vmcnt(0)" ::: "memory");
    } else {
      XB_SPIN(xb_ld(&bar[XB_XGEN(b.x)]) == gen, bar);
      __builtin_amdgcn_fence(__ATOMIC_ACQUIRE, "agent");
      asm volatile("s_waitcnt vmcnt(0)" ::: "memory");
    }
  }
  __syncthreads();
}

template <int PH>
DEVI void run_steps(const Params& p, int lo, int hi, unsigned char* smem, const XcdBarrier& xb) {
  if constexpr (PH < NPHASE) {
    if (PH >= lo && PH < hi) {
      run_phase<PH>(p, smem);
      if (PH + 1 < hi) {
        if (PH == 0) cg::this_grid().sync();
        else xcd_barrier(xb);
      }
    }
    run_steps<PH + 1>(p, lo, hi, smem, xb);
  }
}

__global__ void __launch_bounds__(256, 2) mega(Params p, int ph_lo, int ph_hi) {
  extern __shared__ __attribute__((aligned(16))) unsigned char smem[];
  volatile LAS unsigned* st = (volatile LAS unsigned*)(smem + LDS_BYTES);
  if (threadIdx.x == 0) { st[0] = 0u; st[1] = 0u; }
  __syncthreads();
  const XcdBarrier xb = xcd_barrier_post((unsigned*)(p.ws + OFF_BAR), st);
  run_steps<0>(p, ph_lo, ph_hi, smem, xb);
}

extern "C" void kernel_launch(void* const* d_in, const int* in_sizes, int n_in, void* d_out, int out_size, void* d_ws,
                              size_t ws_size, hipStream_t stream) {
  static int grid = 0;
  if (grid == 0) {
    if (n_in != 33 || ws_size < WS_END) {
      fprintf(stderr, "kernel_launch: need 33 inputs and %zu bytes ws; got %d, %zu\n", (size_t)WS_END, n_in, ws_size);
      grid = -1;
      return;
    }
    int dev = 0, cus = 0, per_cu = 0;
    hipGetDevice(&dev);
    hipDeviceGetAttribute(&cus, hipDeviceAttributeMultiprocessorCount, dev);
    if (hipFuncSetAttribute((const void*)mega, hipFuncAttributeMaxDynamicSharedMemorySize, LDS_BYTES + 16) != hipSuccess) {
      fprintf(stderr, "kernel_launch: hipFuncSetAttribute failed\n");
      grid = -1;
      return;
    }
    hipOccupancyMaxActiveBlocksPerMultiprocessor(&per_cu, (const void*)mega, 256, LDS_BYTES + 16);
    if (per_cu < 1) per_cu = 1;
    if (per_cu > 2) per_cu = 2;
    grid = cus * per_cu;
    fprintf(stderr, "kernel_launch: cus %d per_cu %d grid %d\n", cus, per_cu, grid);
  }
  if (grid < 0) return;
  (void)hipMemsetAsync((unsigned char*)d_ws + OFF_BAR, 0, XCD_BAR_WORDS * sizeof(unsigned), stream);
  Params p{};
  for (int i = 0; i < 33; ++i) p.in[i] = (const float*)d_in[i];
  p.out = (float*)d_out;
  p.ws = (unsigned char*)d_ws;
#if COOP
  int lo = 0, hi = NPHASE;
  void* args[] = {&p, &lo, &hi};
  hipError_t e = hipLaunchCooperativeKernel((const void*)mega, dim3(grid), dim3(256), args, LDS_BYTES + 16, stream);
  if (e != hipSuccess) fprintf(stderr, "cooperative launch failed: %s (grid %d)\n", hipGetErrorString(e), grid);
#else
  for (int ph = 0; ph < NPHASE; ++ph) {
    hipLaunchKernelGGL(mega, dim3(grid), dim3(256), LDS_BYTES + 16, stream, p, ph, ph + 1);
  }
#endif
}
```

```cpp
#include <hip/hip_runtime.h>
#include <hip/hip_cooperative_groups.h>
#include <cstdio>
namespace cg = cooperative_groups;

#ifndef COOP
#define COOP 1
#endif

typedef unsigned short u16;
typedef unsigned int u32;
using bf16x8 = __attribute__((ext_vector_type(8))) short;
using f32x4 = __attribute__((ext_vector_type(4))) float;
typedef float f2 __attribute__((ext_vector_type(2)));
typedef float v32f __attribute__((ext_vector_type(32)));
typedef float v16f __attribute__((ext_vector_type(16)));
typedef unsigned v6u __attribute__((ext_vector_type(6)));

#define DEVI __device__ __forceinline__

constexpr int TS = 32768;
constexpr float ALPHA = 1.41421356237309515f;
constexpr float LN_EPS = 1e-5f;
constexpr size_t MBy = 1ull << 20;

constexpr size_t OFF_WS5IN = 0;
constexpr size_t OFF_WGLU = 2 * MBy;
constexpr size_t OFF_WRGIN = 6 * MBy;
constexpr size_t OFF_WGATES = 10 * MBy;
constexpr size_t OFF_WRGOUT = 12 * MBy;
constexpr size_t OFF_WQ = 14 * MBy;
constexpr size_t OFF_SK = 22 * MBy;
constexpr size_t OFF_WPROJ = 23 * MBy;
constexpr size_t OFF_WPG = 24 * MBy;
constexpr size_t OFF_UB = 28 * MBy;
constexpr size_t OFF_VB = 60 * MBy;
constexpr size_t TB_STRIDE = 26 * MBy;
constexpr size_t OFF_UB8 = OFF_UB;
constexpr size_t OFF_VB8 = OFF_UB + 12 * MBy;
constexpr size_t OFF_SCL = OFF_UB + 24 * MBy;
constexpr size_t OFF_ACT = 92 * MBy;
constexpr size_t OFF_XB = OFF_ACT;
constexpr size_t OFF_KEYS = OFF_ACT + 64 * MBy;
constexpr size_t OFF_IDX = OFF_ACT + 96 * MBy;
constexpr size_t OFF_GATE = OFF_ACT + 112 * MBy;
constexpr size_t OFF_SU = OFF_ACT + 128 * MBy;
constexpr size_t OFF_PB = OFF_ACT + 144 * MBy;
constexpr size_t OFF_XB2 = OFF_ACT + 192 * MBy;
constexpr size_t OFF_XIN = OFF_ACT + 256 * MBy;
constexpr size_t OFF_AP = OFF_ACT;
constexpr size_t OFF_HLOC = OFF_ACT + 104 * MBy;
constexpr size_t OFF_HB = OFF_ACT + 192 * MBy;
constexpr size_t OFF_GG = OFF_ACT;
constexpr size_t OFF_R = OFF_ACT + 64 * MBy;
constexpr size_t OFF_C = OFF_ACT + 128 * MBy;
constexpr size_t OFF_AB = OFF_ACT + 192 * MBy;
constexpr size_t OFF_AGG = OFF_ACT + 448 * MBy;
constexpr size_t OFF_CAR = OFF_ACT + 464 * MBy;
constexpr size_t OFF_BT1 = OFF_ACT + 472 * MBy;
constexpr size_t OFF_WST = OFF_BT1 + 48 * MBy;
constexpr size_t OFF_KTAB = OFF_WST + 16 * MBy;
constexpr size_t OFF_POW = OFF_KTAB + 4 * MBy;
constexpr size_t OFF_BBAR = OFF_POW + 3 * MBy;
constexpr size_t OFF_BAR = OFF_BBAR + 1 * MBy;
constexpr size_t WS_END = OFF_BAR + 1 * MBy;

constexpr int LDS_BYTES = 36864 + 32768;

struct Params {
  const float* in[33];
  float* out;
  unsigned char* ws;
};

DEVI u16 f2bf(float f) {
  u32 u = __float_as_uint(f);
  u += 0x7FFFu + ((u >> 16) & 1u);
  return (u16)(u >> 16);
}
DEVI float bf2f(u16 h) { return __uint_as_float(((u32)h) << 16); }
DEVI u32 pack2(float lo, float hi) { return (u32)f2bf(lo) | ((u32)f2bf(hi) << 16); }
DEVI float bflo(u32 w) { return __uint_as_float(w << 16); }
DEVI float bfhi(u32 w) { return __uint_as_float(w & 0xffff0000u); }
DEVI float sigmoid_(float x) { return __builtin_amdgcn_rcpf(1.f + __expf(-x)); }
DEVI float gelu_(float x) {
  float z = 0.7978845608028654f * (x + 0.044715f * x * x * x);
  return x * __builtin_amdgcn_rcpf(1.f + __expf(-2.f * z));
}
DEVI float softplus_(float x) { return fmaxf(x, 0.f) + log1pf(__expf(-fabsf(x))); }
DEVI void unpack8(const uint4& w, float* f) {
  f[0] = bflo(w.x); f[1] = bfhi(w.x); f[2] = bflo(w.y); f[3] = bfhi(w.y);
  f[4] = bflo(w.z); f[5] = bfhi(w.z); f[6] = bflo(w.w); f[7] = bfhi(w.w);
}
DEVI uint4 pack8(const float* f) {
  uint4 o; o.x = pack2(f[0], f[1]); o.y = pack2(f[2], f[3]); o.z = pack2(f[4], f[5]); o.w = pack2(f[6], f[7]);
  return o;
}

struct LdBF {
  const u16* base; int ld;
  typedef uint4 Raw;
  DEVI Raw load(int row, int k) const { return *reinterpret_cast<const uint4*>(base + (size_t)row * ld + k); }
  DEVI static uint4 cvt(const Raw& r) { return r; }
};
struct RawF { float4 a, b; };
struct LdF32 {
  const float* base; int ld;
  typedef RawF Raw;
  DEVI Raw load(int row, int k) const {
    const float4* q = reinterpret_cast<const float4*>(base + (size_t)row * ld + k);
    RawF r; r.a = q[0]; r.b = q[1]; return r;
  }
  DEVI static uint4 cvt(const Raw& r) {
    uint4 o; o.x = pack2(r.a.x, r.a.y); o.y = pack2(r.a.z, r.a.w); o.z = pack2(r.b.x, r.b.y); o.w = pack2(r.b.z, r.b.w);
    return o;
  }
};

template <class AL, class BL, class EP>
DEVI void gemm_tile(const AL al, const BL bl, const int K, unsigned char* smem, EP ep) {
  u16* As = reinterpret_cast<u16*>(smem);
  u16* Bs = As + 128 * 72;
  const int tid = threadIdx.x, lane = tid & 63, wave = tid >> 6, wm = wave >> 1, wn = wave & 1;
  const int lr = lane & 15, lq = lane >> 4;
  f32x4 acc[4][4];
#pragma unroll
  for (int i = 0; i < 4; ++i)
#pragma unroll
    for (int j = 0; j < 4; ++j) acc[i][j] = f32x4{0.f, 0.f, 0.f, 0.f};
  typename AL::Raw ra[4];
  typename BL::Raw rb[4];
  const int prow = tid >> 3, pk = (tid & 7) * 8;
#pragma unroll
  for (int i = 0; i < 4; ++i) { ra[i] = al.load(prow + i * 32, pk); rb[i] = bl.load(prow + i * 32, pk); }
  for (int kt = 0; kt < K; kt += 64) {
    __syncthreads();
#pragma unroll
    for (int i = 0; i < 4; ++i) {
      *reinterpret_cast<uint4*>(As + (prow + i * 32) * 72 + pk) = AL::cvt(ra[i]);
      *reinterpret_cast<uint4*>(Bs + (prow + i * 32) * 72 + pk) = BL::cvt(rb[i]);
    }
    __syncthreads();
    if (kt + 64 < K) {
#pragma unroll
      for (int i = 0; i < 4; ++i) { ra[i] = al.load(prow + i * 32, kt + 64 + pk); rb[i] = bl.load(prow + i * 32, kt + 64 + pk); }
    }
#pragma unroll
    for (int ks = 0; ks < 2; ++ks) {
      bf16x8 af[4], bfr[4];
#pragma unroll
      for (int i = 0; i < 4; ++i) af[i] = *reinterpret_cast<const bf16x8*>(As + (wm * 64 + i * 16 + lr) * 72 + ks * 32 + lq * 8);
#pragma unroll
      for (int j = 0; j < 4; ++j) bfr[j] = *reinterpret_cast<const bf16x8*>(Bs + (wn * 64 + j * 16 + lr) * 72 + ks * 32 + lq * 8);
#pragma unroll
      for (int i = 0; i < 4; ++i)
#pragma unroll
        for (int j = 0; j < 4; ++j) acc[i][j] = __builtin_amdgcn_mfma_f32_16x16x32_bf16(af[i], bfr[j], acc[i][j], 0, 0, 0);
    }
  }
  __syncthreads();
  ep(acc);
}

typedef __attribute__((address_space(3))) unsigned lds_u32;
template <bool TR = false, class EP>
DEVI void gemm_tile_dma(const u16* A, const int lda, const u16* Bt, const int ldb, const int K, unsigned char* smem, EP ep,
                        const u16* An = nullptr, const u16* Bn = nullptr, const bool pre = false) {
  const int tid = threadIdx.x, lane = tid & 63, wave = tid >> 6, wm = wave >> 1, wn = wave & 1;
  const int lr = lane & 15, lq = lane >> 4;
  f32x4 acc[4][4];
#pragma unroll
  for (int i = 0; i < 4; ++i)
#pragma unroll
    for (int j = 0; j < 4; ++j) acc[i][j] = f32x4{0.f, 0.f, 0.f, 0.f};
  const int rr = lane >> 3, qq = (lane & 7) ^ rr;
  const size_t aoff = (size_t)(wave * 32 + rr) * lda + qq * 8, boff = (size_t)(wave * 32 + rr) * ldb + qq * 8;
  const u16* ag = A + aoff;
  const u16* bg = Bt + boff;
  unsigned char* wbase = smem + wave * 4096;
#define GT_ISSUE(AP_, BP_, stage, kt)                                                                                    \
  do {                                                                                                                   \
    _Pragma("unroll") for (int j = 0; j < 4; ++j) {                                                                      \
      __builtin_amdgcn_global_load_lds((const unsigned*)((AP_) + (size_t)j * 8 * lda + (kt)),                            \
                                       (lds_u32*)(wbase + (stage) * 32768 + j * 1024), 16, 0, 0);                        \
      __builtin_amdgcn_global_load_lds((const unsigned*)((BP_) + (size_t)j * 8 * ldb + (kt)),                            \
                                       (lds_u32*)(wbase + (stage) * 32768 + 16384 + j * 1024), 16, 0, 0);                \
    }                                                                                                                    \
  } while (0)
  if (!pre) {
    __syncthreads();
    GT_ISSUE(ag, bg, 0, 0);
  }
  const int sw = lr & 7;
  int it = 0;
  for (int kt = 0; kt < K; kt += 64, ++it) {
    asm volatile("s_waitcnt vmcnt(0)" ::: "memory");
    __syncthreads();
    if (kt + 64 < K) GT_ISSUE(ag, bg, (it + 1) & 1, kt + 64);
    else if (An != nullptr) GT_ISSUE(An + aoff, Bn + boff, 0, 0);
    const unsigned char* As = smem + (it & 1) * 32768;
    const unsigned char* Bs = As + 16384;
#pragma unroll
    for (int ks = 0; ks < 2; ++ks) {
      bf16x8 af[4], bfr[4];
      const int ch = ((ks * 4 + lq) ^ sw) * 16;
#pragma unroll
      for (int i = 0; i < 4; ++i) af[i] = *reinterpret_cast<const bf16x8*>(As + (wm * 64 + i * 16 + lr) * 128 + ch);
#pragma unroll
      for (int j = 0; j < 4; ++j) bfr[j] = *reinterpret_cast<const bf16x8*>(Bs + (wn * 64 + j * 16 + lr) * 128 + ch);
      __builtin_amdgcn_s_setprio(1);
#pragma unroll
      for (int i = 0; i < 4; ++i)
#pragma unroll
        for (int j = 0; j < 4; ++j)
          acc[i][j] = TR ? __builtin_amdgcn_mfma_f32_16x16x32_bf16(bfr[j], af[i], acc[i][j], 0, 0, 0)
                         : __builtin_amdgcn_mfma_f32_16x16x32_bf16(af[i], bfr[j], acc[i][j], 0, 0, 0);
      __builtin_amdgcn_s_setprio(0);
    }
  }
#undef GT_ISSUE
  if (An == nullptr) __syncthreads();
  ep(acc);
}

DEVI bool tile_map(int it, int nmt, int nnt, int& mt, int& nt) {
  const int xcd = blockIdx.x & 7, j = blockIdx.x >> 3;
  const int per = gridDim.x >> 3;
  const int slot = it * per + j;
  const int S = (slot >> 6) * 8 + xcd;
  const int nsn = nnt >> 3, nsm = nmt >> 3;
  if (S >= nsn * nsm) return false;
  const int sm = S / nsn, sn = S - sm * nsn;
  const int w = slot & 63;
  mt = sm * 8 + (w >> 3);
  nt = sn * 8 + (w & 7);
  return true;
}

template <int PERM>
DEVI void cvt_wt(const float* W, int K, int N, u16* out, int a0, int a1) {
  const int gsz = gridDim.x * 256, gtid = blockIdx.x * 256 + threadIdx.x;
  const int total = N * (K >> 3);
  for (int i = gtid; i < total; i += gsz) {
    const int n = i % N, kv = i / N;
    float v[8];
#pragma unroll
    for (int j = 0; j < 8; ++j) v[j] = W[(size_t)(kv * 8 + j) * N + n];
    int np = n;
    if (PERM == 1) { const int g = n >> 10, o = n & 1023; np = (o >> 4) * 32 + g * 16 + (o & 15); }
    if (PERM == 2) { np = a0 * 512 + (n >> 4) * 32 + a1 * 16 + (n & 15); }
    *reinterpret_cast<uint4*>(out + (size_t)np * K + kv * 8) = pack8(v);
  }
}

DEVI void cvt_plain(const float* src, u16* dst, size_t n8) {
  const size_t gsz = (size_t)gridDim.x * 256, gtid = (size_t)blockIdx.x * 256 + threadIdx.x;
  for (size_t i = gtid; i < n8; i += gsz) {
    const float4* q = reinterpret_cast<const float4*>(src + i * 8);
    float4 a = q[0], b = q[1];
    uint4 o; o.x = pack2(a.x, a.y); o.y = pack2(a.z, a.w); o.z = pack2(b.x, b.y); o.w = pack2(b.z, b.w);
    *reinterpret_cast<uint4*>(dst + i * 8) = o;
  }
}

DEVI void phase_setup(const Params& p) {
  unsigned char* ws = p.ws;
  cvt_wt<0>(p.in[4], 1024, 1024, (u16*)(ws + OFF_WS5IN), 0, 0);
  cvt_wt<1>(p.in[13], 1024, 2048, (u16*)(ws + OFF_WGLU), 0, 0);
  cvt_wt<0>(p.in[14], 1024, 2048, (u16*)(ws + OFF_WRGIN), 0, 0);
  for (int d = 0; d < 2; ++d)
    for (int gate = 0; gate < 2; ++gate)
      for (int h = 0; h < 4; ++h)
        cvt_wt<2>((gate ? p.in[19] : p.in[17]) + (size_t)(d * 4 + h) * 65536, 256, 256,
                  (u16*)(ws + OFF_WGATES) + (size_t)h * 1024 * 256, d, gate);
  cvt_wt<0>(p.in[22], 1024, 1024, (u16*)(ws + OFF_WRGOUT), 0, 0);
  for (int l = 0; l < 2; ++l) {
    cvt_wt<0>(p.in[27] + (size_t)l * 1024 * 2048, 1024, 2048, (u16*)(ws + OFF_WQ) + (size_t)l * 2048 * 1024, 0, 0);
    cvt_wt<0>(p.in[31] + (size_t)l * 256 * 1024, 256, 1024, (u16*)(ws + OFF_WPROJ) + (size_t)l * 1024 * 256, 0, 0);
    cvt_wt<0>(p.in[32] + (size_t)l * 1024 * 1024, 1024, 1024, (u16*)(ws + OFF_WPG) + (size_t)l * 1024 * 1024, 0, 0);
  }
  cvt_plain(p.in[28], (u16*)(ws + OFF_SK), 65536 / 8);
  const int gsz = gridDim.x * 256, gtid = blockIdx.x * 256 + threadIdx.x;
  float2* POW = (float2*)(ws + OFF_POW);
  float2* BBAR = (float2*)(ws + OFF_BBAR);
  for (int i = gtid; i < 2 * 64 * 33 * 64; i += gsz) {
    const int pp = i & 63, n = (i >> 6) % 33, dg = i / (64 * 33);
    const float step = expf(p.in[7][dg]);
    const float lr_ = p.in[5][dg * 64 + pp], li_ = p.in[6][dg * 64 + pp];
    const float mag = expf((float)n * (lr_ * step)), ang = (float)n * (li_ * step);
    POW[i] = float2{mag * cosf(ang), mag * sinf(ang)};
  }
  for (int i = gtid; i < 2 * 64 * 64; i += gsz) {
    const int dg = i >> 6;
    const float step = expf(p.in[7][dg]);
    const float lr_ = p.in[5][i], li_ = p.in[6][i];
    const float mag = expf(lr_ * step), ang = li_ * step;
    const float ar = mag * cosf(ang), ai = mag * sinf(ang);
    const float den = lr_ * lr_ + li_ * li_;
    const float zr = ar - 1.f;
    const float qr = (zr * lr_ + ai * li_) / den, qi = (ai * lr_ - zr * li_) / den;
#pragma unroll
    for (int c = 0; c < 16; ++c) {
      const float br = p.in[8][(size_t)i * 16 + c], bi = p.in[9][(size_t)i * 16 + c];
      BBAR[(size_t)i * 16 + c] = float2{qr * br - qi * bi, qr * bi + qi * br};
    }
  }
}

DEVI float s5_kterm(const Params& p, const float2* POW, const float2* BBAR, int d, int g, int n, int c, int cp) {
  const int dg = d * 64 + g;
  const float* cr = p.in[10] + ((size_t)dg * 16 + c) * 64;
  const float* ci = p.in[11] + ((size_t)dg * 16 + c) * 64;
  const float2* E = POW + ((size_t)dg * 33 + n) * 64;
  const float2* BB = BBAR + (size_t)dg * 64 * 16 + cp;
  float s = 0.f;
#pragma unroll 8
  for (int pp = 0; pp < 64; ++pp) {
    const float2 e = E[pp], bb = BB[pp * 16];
    const float Cr = cr[pp], Ci = ci[pp];
    const float cer = Cr * e.x - Ci * e.y, cei = Cr * e.y + Ci * e.x;
    s += cer * bb.x - cei * bb.y;
  }
  return s;
}

DEVI void phase_tables(const Params& p, int layer, unsigned char* smem);

DEVI void phase_setup2(const Params& p, unsigned char* smem) {
  phase_tables(p, 0, smem);
  phase_tables(p, 1, smem);
  unsigned char* ws = p.ws;
  const int gsz = gridDim.x * 256, gtid = blockIdx.x * 256 + threadIdx.x;
  const float2* POW = (const float2*)(ws + OFF_POW);
  const float2* BBAR = (const float2*)(ws + OFF_BBAR);
  float* KTAB = (float*)(ws + OFF_KTAB);
  u16* WST = (u16*)(ws + OFF_WST);
  u16* BT1 = (u16*)(ws + OFF_BT1);
  for (int i = gtid; i < 64 * 63 * 256; i += gsz) {
    const int cp = i & 15, c = (i >> 4) & 15, ti = (i >> 8) % 63, g = i / (63 * 256);
    const int tau = ti - 31;
    float s = 0.f;
    if (tau >= 0) s += s5_kterm(p, POW, BBAR, 0, g, tau, c, cp);
    if (tau <= 0) s += s5_kterm(p, POW, BBAR, 1, g, -tau, c, cp);
    KTAB[i] = s;
  }
  for (int i = gtid; i < 64 * 256 * 64; i += gsz) {
    const int kv = i & 63, np = (i >> 6) & 255, g = i >> 14;
    const int d = np >> 7, ri = (np >> 6) & 1, pp = np & 63, s = kv >> 1, c0 = (kv & 1) * 8;
    const int npow = d ? s : 31 - s;
    const float2 e = POW[((size_t)(d * 64 + g) * 33 + npow) * 64 + pp];
    float v[8];
#pragma unroll
    for (int j = 0; j < 8; ++j) {
      const float2 bb = BBAR[((size_t)(d * 64 + g) * 64 + pp) * 16 + c0 + j];
      v[j] = ri ? (e.x * bb.y + e.y * bb.x) : (e.x * bb.x - e.y * bb.y);
    }
    *reinterpret_cast<uint4*>(WST + ((size_t)g * 256 + np) * 512 + kv * 8) = pack8(v);
  }
  for (int i = gtid; i < 64 * 512 * 32; i += gsz) {
    const int kv = i & 31, n = (i >> 5) & 511, g = i >> 14;
    const int t = n >> 4, c = n & 15, kk0 = kv * 8;
    const int d = kk0 >> 7, ri = (kk0 >> 6) & 1, p0 = kk0 & 63;
    const int npow = d ? 32 - t : t + 1;
    const int dg = d * 64 + g;
    float v[8];
#pragma unroll
    for (int j = 0; j < 8; ++j) {
      const int pp = p0 + j;
      const float Cr = p.in[10][((size_t)dg * 16 + c) * 64 + pp], Ci = p.in[11][((size_t)dg * 16 + c) * 64 + pp];
      const float2 e = POW[((size_t)dg * 33 + npow) * 64 + pp];
      v[j] = ri ? -(Cr * e.y + Ci * e.x) : (Cr * e.x - Ci * e.y);
    }
    *reinterpret_cast<uint4*>(BT1 + ((size_t)g * 512 + n) * 768 + 512 + kv * 8) = pack8(v);
  }
}

DEVI void phase_setup3(const Params& p) {
  cvt_plain(p.in[0], (u16*)(p.ws + OFF_XIN), (size_t)TS * 1024 / 8);
  const int gsz = gridDim.x * 256, gtid = blockIdx.x * 256 + threadIdx.x;
  const float* KTAB = (const float*)(p.ws + OFF_KTAB);
  u16* BT1 = (u16*)(p.ws + OFF_BT1);
  for (int i = gtid; i < 64 * 512 * 64; i += gsz) {
    const int kv = i & 63, n = (i >> 6) & 511, g = i >> 15;
    const int t = n >> 4, c = n & 15, s = kv >> 1, c0 = (kv & 1) * 8;
    const float* src = KTAB + (((size_t)g * 63 + (t - s + 31)) * 16 + c) * 16 + c0;
    float v[8];
#pragma unroll
    for (int j = 0; j < 8; ++j) v[j] = src[j];
    *reinterpret_cast<uint4*>(BT1 + ((size_t)g * 512 + n) * 768 + kv * 8) = pack8(v);
  }
}

DEVI void phase_s5_in(const Params& p, int s, unsigned char* smem) {
  const u16* XIN = (const u16*)(p.ws + OFF_XIN);
  const u16* Wt = (const u16*)(p.ws + OFF_WS5IN);
  u16* AP = (u16*)(p.ws + OFF_AP);
  const int lane = threadIdx.x & 63, wave = threadIdx.x >> 6, wm = wave >> 1, wn = wave & 1;
  bool pre_ = false;
  for (int it = 0, mt, nt; tile_map(it, 256, 8, mt, nt); ++it) {
    int mtn, ntn;
    const bool nxt_ = tile_map(it + 1, 256, 8, mtn, ntn);
    const int m0 = mt * 128, n0 = nt * 128;
    gemm_tile_dma<true>(XIN + (size_t)m0 * 1024, 1024, Wt + (size_t)n0 * 1024, 1024, 1024, smem, [&](f32x4 (&acc)[4][4]) {
#pragma unroll
      for (int i = 0; i < 4; ++i)
#pragma unroll
        for (int j = 0; j < 4; ++j) {
          const int row = m0 + wm * 64 + i * 16 + (lane & 15);
          const int col = n0 + wn * 64 + j * 16 + (lane >> 4) * 4;
          uint2 w; w.x = pack2(acc[i][j][0], acc[i][j][1]); w.y = pack2(acc[i][j][2], acc[i][j][3]);
          *reinterpret_cast<uint2*>(AP + ((size_t)(col >> 4) * 1024 + (row >> 5)) * 768 + (row & 31) * 16 + (col & 15)) = w;
        }
    }, nxt_ ? (XIN + (size_t)(mtn * 128) * 1024) : nullptr, nxt_ ? (Wt + (size_t)(ntn * 128) * 1024) : nullptr, pre_);
    pre_ = nxt_;
  }
}

DEVI void phase_s5_state(const Params& p, unsigned char* smem) {
  const u16* AP = (const u16*)(p.ws + OFF_AP);
  const u16* WST = (const u16*)(p.ws + OFF_WST);
  float* HLOC = (float*)(p.ws + OFF_HLOC);
  const int lane = threadIdx.x & 63, wave = threadIdx.x >> 6, wm = wave >> 1, wn = wave & 1;
  for (int tile = blockIdx.x; tile < 64 * 16; tile += gridDim.x) {
    const int g = tile >> 4, m0 = ((tile >> 1) & 7) * 128, n0 = (tile & 1) * 128;
    gemm_tile_dma(AP + ((size_t)g * 1024 + m0) * 768, 768, WST + ((size_t)g * 256 + n0) * 512, 512, 512, smem, [&](f32x4 (&acc)[4][4]) {
#pragma unroll
      for (int i = 0; i < 4; ++i)
#pragma unroll
        for (int j = 0; j < 4; ++j)
#pragma unroll
          for (int r = 0; r < 4; ++r) {
            const int row = m0 + wm * 64 + i * 16 + (lane >> 4) * 4 + r;
            const int col = n0 + wn * 64 + j * 16 + (lane & 15);
            HLOC[((size_t)g * 1024 + row) * 256 + col] = acc[i][j][r];
          }
    });
  }
}

DEVI void phase_s5_cscan(const Params& p, int s) {
  const int L = s ? 2048 : 4096;
  const int nseq = TS / L, nch = L / 32;
  u16* AP = (u16*)(p.ws + OFF_AP);
  const float* HLOC = (const float*)(p.ws + OFF_HLOC);
  const float2* POW = (const float2*)(p.ws + OFF_POW);
  const int gsz = gridDim.x * 256, gtid = blockIdx.x * 256 + threadIdx.x;
  for (int i = gtid; i < 64 * nseq * 128; i += gsz) {
    const int pp = i & 63, d = (i >> 6) & 1, g = (i >> 7) & 63, seq = i >> 13;
    const float2 e = POW[((size_t)(d * 64 + g) * 33 + 32) * 64 + pp];
    float Hr = 0.f, Hi = 0.f;
#pragma unroll 8
    for (int j = 0; j < nch; ++j) {
      const int chunk = seq * nch + (d ? (nch - 1 - j) : j);
      u16* ap = AP + ((size_t)g * 1024 + chunk) * 768 + 512 + d * 128 + pp;
      ap[0] = f2bf(Hr);
      ap[64] = f2bf(Hi);
      const float* hl = HLOC + ((size_t)g * 1024 + chunk) * 256 + d * 128 + pp;
      const float a = hl[0], b = hl[64];
      const float nHr = e.x * Hr - e.y * Hi + a;
      const float nHi = e.x * Hi + e.y * Hr + b;
      Hr = nHr; Hi = nHi;
    }
  }
}

DEVI void phase_s5_main(const Params& p, unsigned char* smem) {
  const u16* AP = (const u16*)(p.ws + OFF_AP);
  const u16* BT1 = (const u16*)(p.ws + OFF_BT1);
  u16* HB = (u16*)(p.ws + OFF_HB);
  const float* dsk = p.in[12];
  const int lane = threadIdx.x & 63, wave = threadIdx.x >> 6, wm = wave >> 1, wn = wave & 1;
  for (int tile = blockIdx.x; tile < 64 * 32; tile += gridDim.x) {
    const int g = tile >> 5, m0 = ((tile >> 2) & 7) * 128, n0 = (tile & 3) * 128;
    gemm_tile_dma(AP + ((size_t)g * 1024 + m0) * 768, 768, BT1 + ((size_t)g * 512 + n0) * 768, 768, 768, smem, [&](f32x4 (&acc)[4][4]) {
      const float dv = dsk[g * 16 + (lane & 15)];
#pragma unroll
      for (int i = 0; i < 4; ++i)
#pragma unroll
        for (int j = 0; j < 4; ++j)
#pragma unroll
          for (int r = 0; r < 4; ++r) {
            const int chunk = m0 + wm * 64 + i * 16 + (lane >> 4) * 4 + r;
            const int n = n0 + wn * 64 + j * 16 + (lane & 15);
            const float u = bf2f(AP[((size_t)g * 1024 + chunk) * 768 + n]);
            const float y = acc[i][j][r] + dv * u;
            HB[((size_t)chunk * 32 + (n >> 4)) * 1024 + g * 16 + (lane & 15)] = f2bf(gelu_(y));
          }
    });
  }
}

DEVI void phase_s5_glu(const Params& p, int s, unsigned char* smem) {
  const u16* HB = (const u16*)(p.ws + OFF_HB);
  const u16* Wt = (const u16*)(p.ws + OFF_WGLU);
  const float* Xin = p.in[s];
  float* Xo = p.out + (size_t)s * TS * 1024;
  const int lane = threadIdx.x & 63, wave = threadIdx.x >> 6, wm = wave >> 1, wn = wave & 1;
  bool pre_ = false;
  for (int it = 0, mt, nt; tile_map(it, 256, 16, mt, nt); ++it) {
    int mtn, ntn;
    const bool nxt_ = tile_map(it + 1, 256, 16, mtn, ntn);
    const int m0 = mt * 128, n0 = nt * 128;
    gemm_tile_dma<true>(HB + (size_t)m0 * 1024, 1024, Wt + (size_t)n0 * 1024, 1024, 1024, smem, [&](f32x4 (&acc)[4][4]) {
#pragma unroll
      for (int i = 0; i < 4; ++i)
#pragma unroll
        for (int jj = 0; jj < 4; jj += 2) {
          const int row = m0 + wm * 64 + i * 16 + (lane & 15);
          const int nb = n0 + wn * 64 + jj * 16;
          const int o = (nb >> 5) * 16 + (lane >> 4) * 4;
          const size_t idx = (size_t)row * 1024 + o;
          const float4 xi = *reinterpret_cast<const float4*>(Xin + idx);
          float4 v;
          v.x = ALPHA * xi.x + acc[i][jj][0] * sigmoid_(acc[i][jj + 1][0]);
          v.y = ALPHA * xi.y + acc[i][jj][1] * sigmoid_(acc[i][jj + 1][1]);
          v.z = ALPHA * xi.z + acc[i][jj][2] * sigmoid_(acc[i][jj + 1][2]);
          v.w = ALPHA * xi.w + acc[i][jj][3] * sigmoid_(acc[i][jj + 1][3]);
          *reinterpret_cast<float4*>(Xo + idx) = v;
        }
    }, nxt_ ? (HB + (size_t)(mtn * 128) * 1024) : nullptr, nxt_ ? (Wt + (size_t)(ntn * 128) * 1024) : nullptr, pre_);
    pre_ = nxt_;
  }
}

DEVI void phase_ln1_tables(const Params& p, int s, int layer, unsigned char* smem) {
  float* X = p.out + (size_t)s * TS * 1024;
  u16* XB = (u16*)(p.ws + OFF_XB);
  const float* gam = p.in[23] + layer * 1024;
  const float* bet = p.in[24] + layer * 1024;
  const int lane = threadIdx.x & 63, wave = threadIdx.x >> 6;
  for (int t = blockIdx.x * 4 + wave; t < TS; t += gridDim.x * 4) {
    float4 v[4];
#pragma unroll
    for (int i = 0; i < 4; ++i) v[i] = *reinterpret_cast<const float4*>(X + (size_t)t * 1024 + i * 256 + lane * 4);
    float sm = 0.f;
#pragma unroll
    for (int i = 0; i < 4; ++i) sm += v[i].x + v[i].y + v[i].z + v[i].w;
#pragma unroll
    for (int m = 32; m >= 1; m >>= 1) sm += __shfl_xor(sm, m);
    const float mu = sm * (1.f / 1024.f);
    float sq = 0.f;
#pragma unroll
    for (int i = 0; i < 4; ++i) {
      const float a = v[i].x - mu, b = v[i].y - mu, c = v[i].z - mu, d = v[i].w - mu;
      sq += a * a + b * b + c * c + d * d;
    }
#pragma unroll
    for (int m = 32; m >= 1; m >>= 1) sq += __shfl_xor(sq, m);
    const float rs = rsqrtf(sq * (1.f / 1024.f) + LN_EPS);
#pragma unroll
    for (int i = 0; i < 4; ++i) {
      const int c0 = i * 256 + lane * 4;
      const float4 g4 = *reinterpret_cast<const float4*>(gam + c0);
      const float4 b4 = *reinterpret_cast<const float4*>(bet + c0);
      float4 o;
      o.x = (v[i].x - mu) * rs * g4.x + b4.x; o.y = (v[i].y - mu) * rs * g4.y + b4.y;
      o.z = (v[i].z - mu) * rs * g4.z + b4.z; o.w = (v[i].w - mu) * rs * g4.w + b4.w;
      *reinterpret_cast<float4*>(X + (size_t)t * 1024 + c0) = o;
      uint2 pk; pk.x = pack2(o.x, o.y); pk.y = pack2(o.z, o.w);
      *reinterpret_cast<uint2*>(XB + (size_t)t * 1024 + c0) = pk;
    }
  }
}

DEVI void phase_tables(const Params& p, int layer, unsigned char* smem) {
  const int lane = threadIdx.x & 63, wave = threadIdx.x >> 6;
  float* SCL = (float*)(p.ws + OFF_SCL + (size_t)layer * TB_STRIDE);
  float* lds = reinterpret_cast<float*>(smem) + (threadIdx.x & 63) + (threadIdx.x >> 6) * 2048;
  int srck[32];
  {
    v16f ra, rb;
#pragma unroll
    for (int j = 0; j < 16; ++j) { ra[j] = (j < 8) ? 0.125f * j : 1.f + 0.125f * (j - 8); rb[j] = (j < 8) ? 2.f + 0.25f * j : 4.f + 0.5f * (j - 8); }
    const v6u pk = __builtin_amdgcn_cvt_scalef32_2xpk16_fp6_f32(ra, rb, 1.0f);
    const v32f dd = __builtin_amdgcn_cvt_scalef32_pk32_f32_fp6(pk, 1.0f);
#pragma unroll
    for (int k = 0; k < 32; ++k) {
      const float v = dd[k];
      const float fi = v < 1.f ? v * 8.f : (v < 2.f ? 8.f + (v - 1.f) * 8.f : (v < 4.f ? 16.f + (v - 2.f) * 4.f : 24.f + (v - 4.f) * 2.f));
      srck[k] = ((int)(fi + 0.5f)) & 31;
    }
  }
  const int ll = lane & 31, hs = lane >> 5;
  for (int r2 = blockIdx.x * 4 + wave; r2 < 16384; r2 += gridDim.x * 4) {
    const int r = r2 * 2 + hs;
    const int tab = r >> 14, row = r & 16383;
    const float4* sp = reinterpret_cast<const float4*>(p.in[29 + tab] + ((size_t)layer * 16384 + row) * 1024 + ll * 32);
    float s[32];
#pragma unroll
    for (int j = 0; j < 8; ++j) { const float4 a = sp[j]; s[4 * j] = a.x; s[4 * j + 1] = a.y; s[4 * j + 2] = a.z; s[4 * j + 3] = a.w; }
    float am = 0.f;
#pragma unroll
    for (int k = 0; k < 32; ++k) am = fmaxf(am, fabsf(s[k]));
#pragma unroll
    for (int m = 16; m >= 1; m >>= 1) am = fmaxf(am, __shfl_xor(am, m));
    const float sc = am > 0.f ? 7.5f / am : 1.f;
    const float inv = am > 0.f ? am * (1.f / 7.5f) : 1.f;
#pragma unroll
    for (int k = 0; k < 32; ++k) lds[srck[k] * 64] = s[k] * sc;
    v16f ia, ib;
#pragma unroll
    for (int j = 0; j < 16; ++j) { ia[j] = lds[j * 64]; ib[j] = lds[(16 + j) * 64]; }
    const v6u pk = __builtin_amdgcn_cvt_scalef32_2xpk16_fp6_f32(ia, ib, 1.0f);
    unsigned char* dst = p.ws + (size_t)layer * TB_STRIDE + (tab ? OFF_VB8 : OFF_UB8) + (size_t)row * 768;
    *reinterpret_cast<uint4*>(dst + ll * 16) = uint4{pk[0], pk[1], pk[2], pk[3]};
    *reinterpret_cast<uint2*>(dst + 512 + ll * 8) = uint2{pk[4], pk[5]};
    if (ll == 0) SCL[tab * 16384 + row] = inv;
  }
}

DEVI u32 enc_key(float s, int n) {
  u32 b = __float_as_uint(s);
  u32 srt = (b & 0x80000000u) ? ~b : (b | 0x80000000u);
  return (srt & ~127u) | (u32)(127 - n);
}
DEVI float dec_key(u32 key, int& n) {
  n = 127 - (int)(key & 127u);
  u32 srt = key & ~127u;
  u32 b = (srt & 0x80000000u) ? (srt & 0x7fffffffu) : ~srt;
  return __uint_as_float(b);
}

DEVI void phase_peer_q(const Params& p, int layer, unsigned char* smem) {
  const u16* XB = (const u16*)(p.ws + OFF_XB);
  const u16* Wt = (const u16*)(p.ws + OFF_WQ) + (size_t)layer * 2048 * 1024;
  const u16* SK = (const u16*)(p.ws + OFF_SK) + (size_t)layer * 2 * 128 * 128;
  u32* KEYS = (u32*)(p.ws + OFF_KEYS);
  const int tid = threadIdx.x, lane = tid & 63, wave = tid >> 6, wm = wave >> 1, wn = wave & 1;
  const int lr = lane & 15, lq = lane >> 4;
  u16* Qs = reinterpret_cast<u16*>(smem);
  u32* Sk = reinterpret_cast<u32*>(smem);
  for (int it = 0, mt, nt; tile_map(it, 256, 16, mt, nt); ++it) {
    const int m0 = mt * 128, hc = nt, n0 = hc * 128;
    const int c = hc & 1;
    gemm_tile_dma(XB + (size_t)m0 * 1024, 1024, Wt + (size_t)n0 * 1024, 1024, 1024, smem, [&](f32x4 (&acc)[4][4]) {
#pragma unroll
      for (int i = 0; i < 4; ++i)
#pragma unroll
        for (int j = 0; j < 4; ++j)
#pragma unroll
          for (int r = 0; r < 4; ++r)
            Qs[(wm * 64 + i * 16 + lq * 4 + r) * 136 + wn * 64 + j * 16 + lr] = f2bf(acc[i][j][r]);
      __syncthreads();
      f32x4 sc[4][4];
#pragma unroll
      for (int i = 0; i < 4; ++i)
#pragma unroll
        for (int j = 0; j < 4; ++j) sc[i][j] = f32x4{0.f, 0.f, 0.f, 0.f};
      const u16* skc = SK + (size_t)c * 128 * 128;
#pragma unroll
      for (int ks = 0; ks < 4; ++ks) {
        bf16x8 af[4], bfr[4];
#pragma unroll
        for (int i = 0; i < 4; ++i) af[i] = *reinterpret_cast<const bf16x8*>(Qs + (wm * 64 + i * 16 + lr) * 136 + ks * 32 + lq * 8);
#pragma unroll
        for (int j = 0; j < 4; ++j) bfr[j] = *reinterpret_cast<const bf16x8*>(skc + (size_t)(wn * 64 + j * 16 + lr) * 128 + ks * 32 + lq * 8);
#pragma unroll
        for (int i = 0; i < 4; ++i)
#pragma unroll
          for (int j = 0; j < 4; ++j) sc[i][j] = __builtin_amdgcn_mfma_f32_16x16x32_bf16(af[i], bfr[j], sc[i][j], 0, 0, 0);
      }
      __syncthreads();
#pragma unroll
      for (int i = 0; i < 4; ++i)
#pragma unroll
        for (int j = 0; j < 4; ++j)
#pragma unroll
          for (int r = 0; r < 4; ++r) {
            const int n = wn * 64 + j * 16 + lr;
            Sk[(wm * 64 + i * 16 + lq * 4 + r) * 129 + n] = enc_key(sc[i][j][r], n);
          }
      __syncthreads();
      if (tid < 128) {
        u32 top[16];
#pragma unroll
        for (int k = 0; k < 16; ++k) top[k] = 0u;
#pragma unroll 4
        for (int n = 0; n < 128; ++n) {
          u32 v = Sk[tid * 129 + n];
#pragma unroll
          for (int k = 0; k < 16; ++k) {
            const u32 hi = max(top[k], v);
            v = min(top[k], v);
            top[k] = hi;
          }
        }
        uint4* dst = reinterpret_cast<uint4*>(KEYS + ((size_t)(m0 + tid) * 16 + hc) * 16);
        dst[0] = uint4{top[0], top[1], top[2], top[3]};
        dst[1] = uint4{top[4], top[5], top[6], top[7]};
        dst[2] = uint4{top[8], top[9], top[10], top[11]};
        dst[3] = uint4{top[12], top[13], top[14], top[15]};
      }
    });
  }
}

DEVI void phase_peer_route(const Params& p, int s, int layer) {
  cvt_plain(p.in[2 + s] + (size_t)layer * TS * 256, (u16*)(p.ws + OFF_PB), (size_t)TS * 256 / 8);
  const u32* KEYS = (const u32*)(p.ws + OFF_KEYS);
  int* IDX = (int*)(p.ws + OFF_IDX);
  float* GATE = (float*)(p.ws + OFF_GATE);
  float* SU = (float*)(p.ws + OFF_SU);
  const float* SCL = (const float*)(p.ws + OFF_SCL + (size_t)layer * TB_STRIDE);
  const int gsz = gridDim.x * 256, gtid = blockIdx.x * 256 + threadIdx.x;
  for (int i = gtid; i < TS * 8; i += gsz) {
    const uint4* src = reinterpret_cast<const uint4*>(KEYS + (size_t)i * 32);
    u32 kk[32];
#pragma unroll
    for (int q = 0; q < 8; ++q) { const uint4 w = src[q]; kk[q * 4] = w.x; kk[q * 4 + 1] = w.y; kk[q * 4 + 2] = w.z; kk[q * 4 + 3] = w.w; }
    float s0[16], s1[16]; int i0[16], i1[16];
#pragma unroll
    for (int k = 0; k < 16; ++k) { s0[k] = dec_key(kk[k], i0[k]); s1[k] = dec_key(kk[16 + k], i1[k]); }
    float top[16];
#pragma unroll
    for (int k = 0; k < 16; ++k) top[k] = -3.0e38f;
#pragma unroll
    for (int k1 = 0; k1 < 16; ++k1)
#pragma unroll
      for (int k2 = 0; k2 < 16; ++k2)
        if ((k1 + 1) * (k2 + 1) <= 16) {
          float v = s0[k1] + s1[k2];
#pragma unroll
          for (int k = 0; k < 16; ++k) {
            const float hi = fmaxf(top[k], v);
            v = fminf(top[k], v);
            top[k] = hi;
          }
        }
    const float thr = top[15], mx = top[0];
    float den = 0.f;
#pragma unroll
    for (int k = 0; k < 16; ++k) den += __expf(top[k] - mx);
    const float inv = 1.f / den;
    int cnt = 0;
    int* idst = IDX + (size_t)i * 16;
    float* gdst = GATE + (size_t)i * 16;
    float* sdst = SU + (size_t)i * 16;
#pragma unroll
    for (int k1 = 0; k1 < 16; ++k1)
#pragma unroll
      for (int k2 = 0; k2 < 16; ++k2)
        if ((k1 + 1) * (k2 + 1) <= 16) {
          const float v = s0[k1] + s1[k2];
          if (v >= thr && cnt < 16) {
            const int e = i0[k1] * 128 + i1[k2];
            idst[cnt] = e;
            gdst[cnt] = __expf(v - mx) * inv * SCL[16384 + e];
            sdst[cnt] = SCL[e];
            ++cnt;
          }
        }
  }
}

DEVI f2 cvt8(u32 w, bool hi) { return hi ? __builtin_amdgcn_cvt_pk_f32_fp8((int)w, true) : __builtin_amdgcn_cvt_pk_f32_fp8((int)w, false); }

DEVI v32f ld_fp6_row(const unsigned char* base, int ei, int ll) {
  const unsigned char* r = base + (size_t)ei * 768;
  const uint4 a = *reinterpret_cast<const uint4*>(r + ll * 16);
  const uint2 b = *reinterpret_cast<const uint2*>(r + 512 + ll * 8);
  v6u pk; pk[0] = a.x; pk[1] = a.y; pk[2] = a.z; pk[3] = a.w; pk[4] = b.x; pk[5] = b.y;
  return __builtin_amdgcn_cvt_scalef32_pk32_f32_fp6(pk, 1.0f);
}

struct Raw6 { uint4 a; uint2 b; };
DEVI Raw6 ld_raw6(const unsigned char* base, int ei, int ll) {
  const unsigned char* r = base + (size_t)ei * 768;
  Raw6 o;
  o.a = *reinterpret_cast<const uint4*>(r + ll * 16);
  o.b = *reinterpret_cast<const uint2*>(r + 512 + ll * 8);
  return o;
}
DEVI v32f dec6(const Raw6& r) {
  v6u pk; pk[0] = r.a.x; pk[1] = r.a.y; pk[2] = r.a.z; pk[3] = r.a.w; pk[4] = r.b.x; pk[5] = r.b.y;
  return __builtin_amdgcn_cvt_scalef32_pk32_f32_fp6(pk, 1.0f);
}

DEVI void phase_peer_gather(const Params& p, int s, int layer) {
  float* X = p.out + (size_t)s * TS * 1024;
  u16* XB = (u16*)(p.ws + OFF_XB);
  const unsigned char* Ub = p.ws + OFF_UB8 + (size_t)layer * TB_STRIDE;
  const unsigned char* Vb = p.ws + OFF_VB8 + (size_t)layer * TB_STRIDE;
  const int* IDX = (const int*)(p.ws + OFF_IDX);
  const float* GATE = (const float*)(p.ws + OFF_GATE);
  const float* SU = (const float*)(p.ws + OFF_SU);
  const float* gam = p.in[25] + layer * 1024;
  const float* bet = p.in[26] + layer * 1024;
  const int lane = threadIdx.x & 63, wave = threadIdx.x >> 6;
  const int ll = lane & 31, hs = lane >> 5;
  const bool b4 = lane & 16, b3 = lane & 8;
  for (int t = blockIdx.x * 4 + wave; t < TS; t += gridDim.x * 4) {
    float x[32], o[32];
    {
      const float4* xp = reinterpret_cast<const float4*>(X + (size_t)t * 1024 + ll * 32);
#pragma unroll
      for (int j = 0; j < 8; ++j) { const float4 a = xp[j]; x[4 * j] = a.x; x[4 * j + 1] = a.y; x[4 * j + 2] = a.z; x[4 * j + 3] = a.w; }
    }
#pragma unroll
    for (int k = 0; k < 32; ++k) o[k] = 0.f;
    const int iv0 = IDX[(size_t)t * 128 + lane], iv1 = IDX[(size_t)t * 128 + 64 + lane];
    const float gv0 = GATE[(size_t)t * 128 + lane], gv1 = GATE[(size_t)t * 128 + 64 + lane];
    const float su0 = SU[(size_t)t * 128 + lane], su1 = SU[(size_t)t * 128 + 64 + lane];
    for (int e0 = 0; e0 < 128; e0 += 8) {
      const bool lo = e0 < 64;
      const int ivs = lo ? iv0 : iv1;
      const float gvs = lo ? gv0 : gv1;
      const float sus = lo ? su0 : su1;
      int ei[4];
#pragma unroll
      for (int q = 0; q < 4; ++q) {
        const int ea = __builtin_amdgcn_readlane(ivs, (e0 & 63) + 2 * q);
        const int eb = __builtin_amdgcn_readlane(ivs, (e0 & 63) + 2 * q + 1);
        ei[q] = hs ? eb : ea;
      }
      Raw6 cu[4], cv[4];
#pragma unroll
      for (int q = 0; q < 4; ++q) { cu[q] = ld_raw6(Ub, ei[q], ll); cv[q] = ld_raw6(Vb, ei[q], ll); }
      float dq[4];
#pragma unroll
      for (int q = 0; q < 4; ++q) {
        const v32f u = dec6(cu[q]);
        float d0 = 0.f, d1 = 0.f;
#pragma unroll
        for (int k = 0; k < 32; k += 2) { d0 = fmaf(u[k], x[k], d0); d1 = fmaf(u[k + 1], x[k + 1], d1); }
        dq[q] = d0 + d1;
      }
      float d2[2], d1;
#pragma unroll
      for (int k = 0; k < 2; ++k) {
        const float keep = b4 ? dq[k + 2] : dq[k], send = b4 ? dq[k] : dq[k + 2];
        d2[k] = keep + __shfl_xor(send, 16);
      }
      {
        const float keep = b3 ? d2[1] : d2[0], send = b3 ? d2[0] : d2[1];
        d1 = keep + __shfl_xor(send, 8);
      }
      d1 += __shfl_xor(d1, 4);
      d1 += __shfl_xor(d1, 2);
      d1 += __shfl_xor(d1, 1);
      const int qmine = (b4 ? 2 : 0) + (b3 ? 1 : 0);
      const int srcl = (e0 & 63) + 2 * qmine + hs;
      const float suv = __shfl(sus, srcl), gvv = __shfl(gvs, srcl);
      const float w = gvv * gelu_(d1 * suv);
#pragma unroll
      for (int q = 0; q < 4; ++q) {
        const float wq = __shfl(w, (lane & 32) | ((q >> 1) << 4) | ((q & 1) << 3));
        const v32f v = dec6(cv[q]);
#pragma unroll
        for (int k = 0; k < 32; ++k) o[k] = fmaf(wq, v[k], o[k]);
      }
    }
    float sm = 0.f;
#pragma unroll
    for (int k = 0; k < 32; ++k) { o[k] += __shfl_xor(o[k], 32); o[k] = ALPHA * x[k] + o[k]; sm += o[k]; }
#pragma unroll
    for (int m = 16; m >= 1; m >>= 1) sm += __shfl_xor(sm, m);
    const float mu = sm * (1.f / 1024.f);
    float sq = 0.f;
#pragma unroll
    for (int k = 0; k < 32; ++k) { const float dd = o[k] - mu; sq += dd * dd; }
#pragma unroll
    for (int m = 16; m >= 1; m >>= 1) sq += __shfl_xor(sq, m);
    const float rs = rsqrtf(sq * (1.f / 1024.f) + LN_EPS);
    if (hs == 0) {
      const int c0 = ll * 32;
#pragma unroll
      for (int j = 0; j < 4; ++j) {
        float r[8];
#pragma unroll
        for (int k = 0; k < 8; ++k) r[k] = (o[j * 8 + k] - mu) * rs * gam[c0 + j * 8 + k] + bet[c0 + j * 8 + k];
        float4* dp = reinterpret_cast<float4*>(X + (size_t)t * 1024 + c0 + j * 8);
        dp[0] = float4{r[0], r[1], r[2], r[3]};
        dp[1] = float4{r[4], r[5], r[6], r[7]};
        *reinterpret_cast<uint4*>(XB + (size_t)t * 1024 + c0 + j * 8) = pack8(r);
      }
    }
  }
}

DEVI void phase_ple(const Params& p, int s, int layer, unsigned char* smem) {
  float* X = p.out + (size_t)s * TS * 1024;
  const u16* XB = (const u16*)(p.ws + OFF_XB);
  const u16* PB = (const u16*)(p.ws + OFF_PB);
  u16* XB2 = (u16*)(p.ws + OFF_XB2);
  const u16* Wp = (const u16*)(p.ws + OFF_WPROJ) + (size_t)layer * 1024 * 256;
  const u16* Wg = (const u16*)(p.ws + OFF_WPG) + (size_t)layer * 1024 * 1024;
  const int lane = threadIdx.x & 63, wave = threadIdx.x >> 6, wm = wave >> 1, wn = wave & 1;
  for (int it = 0, mt, nt; tile_map(it, 256, 8, mt, nt); ++it) {
    const int m0 = mt * 128, n0 = nt * 128;
    u32 pk[4][4][2];
    gemm_tile_dma(XB + (size_t)m0 * 1024, 1024, Wg + (size_t)n0 * 1024, 1024, 1024, smem, [&](f32x4 (&acc)[4][4]) {
#pragma unroll
      for (int i = 0; i < 4; ++i)
#pragma unroll
        for (int j = 0; j < 4; ++j) {
          pk[i][j][0] = pack2(sigmoid_(acc[i][j][0]), sigmoid_(acc[i][j][1]));
          pk[i][j][1] = pack2(sigmoid_(acc[i][j][2]), sigmoid_(acc[i][j][3]));
        }
    });
    gemm_tile_dma(PB + (size_t)m0 * 256, 256, Wp + (size_t)n0 * 256, 256, 256, smem, [&](f32x4 (&acc)[4][4]) {
#pragma unroll
      for (int i = 0; i < 4; ++i)
#pragma unroll
        for (int j = 0; j < 4; ++j)
#pragma unroll
          for (int r = 0; r < 4; ++r) {
            const int row = m0 + wm * 64 + i * 16 + (lane >> 4) * 4 + r;
            const int col = n0 + wn * 64 + j * 16 + (lane & 15);
            const u32 w = pk[i][j][r >> 1];
            const float sg = (r & 1) ? bfhi(w) : bflo(w);
            const size_t idx = (size_t)row * 1024 + col;
            const float v = X[idx] + acc[i][j][r] * sg;
            X[idx] = v;
            if (layer == 0) XB2[idx] = f2bf(v);
          }
    });
  }
  if (layer == 1 && s == 0) cvt_plain(p.in[1], (u16*)(p.ws + OFF_XIN), (size_t)TS * 1024 / 8);
}

DEVI void phase_rg_in(const Params& p, int s, unsigned char* smem) {
  const u16* XB2 = (const u16*)(p.ws + OFF_XB2);
  const u16* Wt = (const u16*)(p.ws + OFF_WRGIN);
  u16* GG = (u16*)(p.ws + OFF_GG);
  u16* R = (u16*)(p.ws + OFF_R);
  const int lane = threadIdx.x & 63, wave = threadIdx.x >> 6, wm = wave >> 1, wn = wave & 1;
  bool pre_ = false;
  for (int it = 0, mt, nt; tile_map(it, 256, 16, mt, nt); ++it) {
    int mtn, ntn;
    const bool nxt_ = tile_map(it + 1, 256, 16, mtn, ntn);
    const int m0 = mt * 128, n0 = nt * 128;
    gemm_tile_dma<true>(XB2 + (size_t)m0 * 1024, 1024, Wt + (size_t)n0 * 1024, 1024, 1024, smem, [&](f32x4 (&acc)[4][4]) {
#pragma unroll
      for (int i = 0; i < 4; ++i)
#pragma unroll
        for (int j = 0; j < 4; ++j) {
          const int row = m0 + wm * 64 + i * 16 + (lane & 15);
          const int col = n0 + wn * 64 + j * 16 + (lane >> 4) * 4;
          uint2 w;
          if (n0 < 1024) {
            w.x = pack2(gelu_(acc[i][j][0]), gelu_(acc[i][j][1])); w.y = pack2(gelu_(acc[i][j][2]), gelu_(acc[i][j][3]));
            *reinterpret_cast<uint2*>(GG + (size_t)row * 1024 + col) = w;
          } else {
            w.x = pack2(acc[i][j][0], acc[i][j][1]); w.y = pack2(acc[i][j][2], acc[i][j][3]);
            *reinterpret_cast<uint2*>(R + (size_t)row * 1024 + col - 1024) = w;
          }
        }
    }, nxt_ ? (XB2 + (size_t)(mtn * 128) * 1024) : nullptr, nxt_ ? (Wt + (size_t)(ntn * 128) * 1024) : nullptr, pre_);
    pre_ = nxt_;
  }
}

DEVI void phase_rg_conv(const Params& p, int s) {
  const int L = s ? 2048 : 4096;
  const u16* R = (const u16*)(p.ws + OFF_R);
  u16* C = (u16*)(p.ws + OFF_C);
  const float* cw = p.in[15];
  const float* cb = p.in[16];
  const int gsz = gridDim.x * 256, gtid = blockIdx.x * 256 + threadIdx.x;
  for (int i = gtid; i < TS * 128; i += gsz) {
    const int t = i >> 7, cv = (i & 127) * 8;
    const int pos = t & (L - 1);
    float acc[8];
#pragma unroll
    for (int j = 0; j < 8; ++j) acc[j] = cb[cv + j];
#pragma unroll
    for (int k = 0; k < 4; ++k) {
      const int pp = pos + k - 1;
      if (pp >= 0 && pp < L) {
        float rv[8];
        unpack8(*reinterpret_cast<const uint4*>(R + (size_t)(t + k - 1) * 1024 + cv), rv);
#pragma unroll
        for (int j = 0; j < 8; ++j) acc[j] = fmaf(rv[j], cw[k * 1024 + cv + j], acc[j]);
      }
    }
    *reinterpret_cast<uint4*>(C + (size_t)i * 8) = pack8(acc);
  }
}

DEVI void phase_rg_gates(const Params& p, unsigned char* smem) {
  const u16* C = (const u16*)(p.ws + OFF_C);
  const u16* Wt = (const u16*)(p.ws + OFF_WGATES);
  u32* AB = (u32*)(p.ws + OFF_AB);
  const float* ba = p.in[18];
  const float* bx = p.in[20];
  const float* lam = p.in[21];
  const int lane = threadIdx.x & 63, wave = threadIdx.x >> 6, wm = wave >> 1, wn = wave & 1;
  for (int it = 0, mt, nt32; tile_map(it, 256, 32, mt, nt32); ++it) {
    const int m0 = mt * 128, h = nt32 >> 3, nt = nt32 & 7, n0 = nt * 128;
    gemm_tile_dma(C + (size_t)m0 * 1024 + h * 256, 1024, Wt + ((size_t)h * 1024 + n0) * 256, 256, 256, smem, [&](f32x4 (&acc)[4][4]) {
#pragma unroll
      for (int jj = 0; jj < 4; jj += 2) {
        const int nb = n0 + wn * 64 + jj * 16;
        const int d = nb >> 9;
        const int ch = h * 256 + ((nb & 511) >> 5) * 16 + (lane & 15);
        const float bav = ba[d * 1024 + ch], bxv = bx[d * 1024 + ch];
        const float sp8 = -8.f * softplus_(-lam[d * 1024 + ch]);
#pragma unroll
        for (int i = 0; i < 4; ++i)
#pragma unroll
          for (int r = 0; r < 4; ++r) {
            const int row = m0 + wm * 64 + i * 16 + (lane >> 4) * 4 + r;
            const float rg = sigmoid_(acc[i][jj][r] + bav);
            const float ig = sigmoid_(acc[i][jj + 1][r] + bxv);
            const float la = sp8 * rg;
            const float cval = bf2f(C[(size_t)row * 1024 + ch]);
            const float b = __builtin_amdgcn_sqrtf(fmaxf(1.f - __expf(2.f * la), 0.f)) * ig * cval;
            AB[((size_t)row * 2 + d) * 1024 + ch] = pack2(la, b);
            if (r == 3) __builtin_amdgcn_sched_barrier(0);
          }
      }
    });
  }
}

DEVI void phase_rg_agg(const Params& p) {
  const u32* AB = (const u32*)(p.ws + OFF_AB);
  float2* AGG = (float2*)(p.ws + OFF_AGG);
  const int gsz = gridDim.x * 256, gtid = blockIdx.x * 256 + threadIdx.x;
  for (int i = gtid; i < 1024 * 2 * 1024; i += gsz) {
    const int ch = i & 1023, d = (i >> 10) & 1, chunk = i >> 11;
    const int c0 = chunk * 32;
    float h = 0.f, LA = 0.f;
#pragma unroll 8
    for (int k = 0; k < 32; ++k) {
      const int t = d ? (c0 + 31 - k) : (c0 + k);
      const u32 w = AB[((size_t)t * 2 + d) * 1024 + ch];
      const float la = bflo(w), b = bfhi(w);
      h = __expf(la) * h + b;
      LA += la;
    }
    AGG[((size_t)d * 1024 + chunk) * 1024 + ch] = float2{LA, h};
  }
}

DEVI void phase_rg_carry(const Params& p, int s) {
  const int L = s ? 2048 : 4096;
  const int nseq = TS / L, nch = L / 32;
  const float2* AGG = (const float2*)(p.ws + OFF_AGG);
  float* CAR = (float*)(p.ws + OFF_CAR);
  const int gsz = gridDim.x * 256, gtid = blockIdx.x * 256 + threadIdx.x;
  for (int i = gtid; i < nseq * 2 * 1024; i += gsz) {
    const int ch = i & 1023, d = (i >> 10) & 1, seq = i >> 11;
    float H = 0.f;
#pragma unroll 8
    for (int k = 0; k < nch; ++k) {
      const int chunk = seq * nch + (d ? (nch - 1 - k) : k);
      const size_t idx = ((size_t)d * 1024 + chunk) * 1024 + ch;
      CAR[idx] = H;
      const float2 ag = AGG[idx];
      H = __expf(ag.x) * H + ag.y;
    }
  }
}

DEVI void phase_rg_final(const Params& p) {
  const u32* AB = (const u32*)(p.ws + OFF_AB);
  const float* CAR = (const float*)(p.ws + OFF_CAR);
  const u16* GG = (const u16*)(p.ws + OFF_GG);
  u16* Y = (u16*)(p.ws + OFF_R);
  const int gsz = gridDim.x * 256, gtid = blockIdx.x * 256 + threadIdx.x;
  for (int i = gtid; i < 1024 * 1024; i += gsz) {
    const int ch = i & 1023, chunk = i >> 10;
    const int c0 = chunk * 32;
    float hf[32];
    float h = CAR[((size_t)chunk) * 1024 + ch];
#pragma unroll
    for (int k = 0; k < 32; ++k) {
      const u32 w = AB[((size_t)(c0 + k) * 2 + 0) * 1024 + ch];
      h = __expf(bflo(w)) * h + bfhi(w);
      hf[k] = h;
    }
    h = CAR[((size_t)1024 + chunk) * 1024 + ch];
#pragma unroll
    for (int k = 31; k >= 0; --k) {
      const u32 w = AB[((size_t)(c0 + k) * 2 + 1) * 1024 + ch];
      h = __expf(bflo(w)) * h + bfhi(w);
      const size_t idx = (size_t)(c0 + k) * 1024 + ch;
      Y[idx] = f2bf((hf[k] + h) * bf2f(GG[idx]));
    }
  }
}

DEVI void phase_rg_out(const Params& p, int s, unsigned char* smem) {
  float* X = p.out + (size_t)s * TS * 1024;
  const u16* Y = (const u16*)(p.ws + OFF_R);
  const u16* Wt = (const u16*)(p.ws + OFF_WRGOUT);
  const int lane = threadIdx.x & 63, wave = threadIdx.x >> 6, wm = wave >> 1, wn = wave & 1;
  bool pre_ = false;
  for (int it = 0, mt, nt; tile_map(it, 256, 8, mt, nt); ++it) {
    int mtn, ntn;
    const bool nxt_ = tile_map(it + 1, 256, 8, mtn, ntn);
    const int m0 = mt * 128, n0 = nt * 128;
    gemm_tile_dma<true>(Y + (size_t)m0 * 1024, 1024, Wt + (size_t)n0 * 1024, 1024, 1024, smem, [&](f32x4 (&acc)[4][4]) {
#pragma unroll
      for (int i = 0; i < 4; ++i)
#pragma unroll
        for (int j = 0; j < 4; ++j) {
          const int row = m0 + wm * 64 + i * 16 + (lane & 15);
          const int col = n0 + wn * 64 + j * 16 + (lane >> 4) * 4;
          float4* xp = reinterpret_cast<float4*>(X + (size_t)row * 1024 + col);
          float4 v = *xp;
          v.x = ALPHA * v.x + acc[i][j][0]; v.y = ALPHA * v.y + acc[i][j][1]; v.z = ALPHA * v.z + acc[i][j][2]; v.w = ALPHA * v.w + acc[i][j][3];
          *xp = v;
        }
    }, nxt_ ? (Y + (size_t)(mtn * 128) * 1024) : nullptr, nxt_ ? (Wt + (size_t)(ntn * 128) * 1024) : nullptr, pre_);
    pre_ = nxt_;
  }
}

constexpr int NPS = 22;
constexpr int NSETUP = 3;
constexpr int NPHASE = NSETUP + 2 * NPS;

template <int PH>
DEVI void run_phase(const Params& p, unsigned char* smem) {
  if constexpr (PH == 0) {
    phase_setup(p);
  } else if constexpr (PH == 1) {
    phase_setup2(p, smem);
  } else if constexpr (PH == 2) {
    phase_setup3(p);
  } else {
    constexpr int s = (PH - NSETUP) / NPS, q = (PH - NSETUP) % NPS;
    if constexpr (q == 0) phase_s5_in(p, s, smem);
    else if constexpr (q == 1) phase_s5_state(p, smem);
    else if constexpr (q == 2) phase_s5_cscan(p, s);
    else if constexpr (q == 3) phase_s5_main(p, smem);
    else if constexpr (q == 4) phase_s5_glu(p, s, smem);
    else if constexpr (q == 5) phase_ln1_tables(p, s, 0, smem);
    else if constexpr (q == 6) phase_peer_q(p, 0, smem);
    else if constexpr (q == 7) phase_peer_route(p, s, 0);
    else if constexpr (q == 8) phase_peer_gather(p, s, 0);
    else if constexpr (q == 9) phase_ple(p, s, 0, smem);
    else if constexpr (q == 10) phase_rg_in(p, s, smem);
    else if constexpr (q == 11) phase_rg_conv(p, s);
    else if constexpr (q == 12) phase_rg_gates(p, smem);
    else if constexpr (q == 13) phase_rg_agg(p);
    else if constexpr (q == 14) phase_rg_carry(p, s);
    else if constexpr (q == 15) phase_rg_final(p);
    else if constexpr (q == 16) phase_rg_out(p, s, smem);
    else if constexpr (q == 17) phase_ln1_tables(p, s, 1, smem);
    else if constexpr (q == 18) phase_peer_q(p, 1, smem);
    else if constexpr (q == 19) phase_peer_route(p, s, 1);
    else if constexpr (q == 20) phase_peer_gather(p, s, 1);
    else if constexpr (q == 21) phase_ple(p, s, 1, smem);
  }
}

#define XB_TMO      128
#define XB_XCNT(j)  (256  + 64 * (j))
#define XB_XSUB(j)  (1280 + 64 * (j))
#define XB_XGEN(j)  (2304 + 64 * (j))
#define XB_TOP      3328
#define XB_TOPGEN   3392
#define XCD_BAR_WORDS 3456
#define XB_SPIN_CAP (1u << 18)
#define LAS __attribute__((address_space(3)))
DEVI unsigned xb_ld(unsigned* p) { return __hip_atomic_load(p, __ATOMIC_RELAXED, __HIP_MEMORY_SCOPE_AGENT); }
DEVI unsigned xb_add(unsigned* p, unsigned v) { return __hip_atomic_fetch_add(p, v, __ATOMIC_RELAXED, __HIP_MEMORY_SCOPE_AGENT); }
DEVI unsigned xb_xcc_id() { return (unsigned)__builtin_amdgcn_s_getreg((3 << 11) | 20) & 0xFu; }
#define XB_SPIN(cond, bar) do { unsigned _sp = 0; while (cond) { __builtin_amdgcn_s_sleep(1); \
    if ((++_sp & 255u) == 0u) { if (xb_ld(&(bar)[XB_TMO])) break; if (_sp > XB_SPIN_CAP) { atomicAdd(&(bar)[XB_TMO], 1u); break; } } } } while (0)
struct XcdBarrier { unsigned* bar; unsigned x; volatile LAS unsigned* st; };
DEVI XcdBarrier xcd_barrier_post(unsigned* bar, volatile LAS unsigned* st) {
  XcdBarrier b; b.bar = bar; b.x = xb_xcc_id(); b.st = st;
  if (threadIdx.x == 0) (void)xb_add(&bar[XB_XCNT(b.x)], 1u);
  return b;
}
DEVI void xcd_barrier_complete(unsigned* bar, unsigned x, unsigned& nloc, unsigned& nx) {
  const unsigned G = gridDim.x * gridDim.y * gridDim.z;
  unsigned sum, cnt, mine, sp = 0u;
  for (;;) {
    sum = 0u; cnt = 0u; mine = 0u;
#pragma unroll
    for (unsigned j = 0; j < 16; ++j) { const unsigned c = xb_ld(&bar[XB_XCNT(j)]); sum += c; cnt += (c > 0u) ? 1u : 0u; mine = (j == x) ? c : mine; }
    if (sum == G) break;
    __builtin_amdgcn_s_sleep(1);
    if ((++sp & 255u) == 0u) { if (xb_ld(&bar[XB_TMO])) break; if (sp > XB_SPIN_CAP) { atomicAdd(&bar[XB_TMO], 1u); break; } }
  }
  nloc = mine > 0u ? mine : 1u; nx = cnt > 0u ? cnt : 1u;
}
DEVI void xcd_barrier(const XcdBarrier& b) {
  asm volatile("s_waitcnt vmcnt(0)" ::: "memory");
  __syncthreads();
  if (threadIdx.x == 0) {
    unsigned* bar = b.bar;
    __builtin_amdgcn_s_waitcnt(0);
    unsigned nloc = b.st[0], nx = b.st[1];
    if (nloc == 0u) { xcd_barrier_complete(bar, b.x, nloc, nx); b.st[0] = nloc; b.st[1] = nx; }
    const unsigned old = xb_add(&bar[XB_XSUB(b.x)], 1u);
    const unsigned gen = old / nloc;
    if (old + 1u == (gen + 1u) * nloc) {
      __builtin_amdgcn_fence(__ATOMIC_RELEASE, "agent");
      asm volatile("s_waitcnt vmcnt(0)" ::: "memory");
      const unsigned og = xb_add(&bar[XB_TOP], 1u);
      const unsigned tg = og / nx;
      if (og + 1u == (tg + 1u) * nx) xb_add(&bar[XB_TOPGEN], 1u);
      else XB_SPIN(xb_ld(&bar[XB_TOPGEN]) == tg, bar);
      __builtin_amdgcn_fence(__ATOMIC_ACQUIRE, "agent");
      xb_add(&bar[XB_XGEN(b.x)], 1u);
      asm volatile("s_waitcnt vmcnt(0)" ::: "memory");
    } else {
      XB_SPIN(xb_ld(&bar[XB_XGEN(b.x)]) == gen, bar);
      __builtin_amdgcn_fence(__ATOMIC_ACQUIRE, "agent");
      asm volatile("s_waitcnt vmcnt(0)" ::: "memory");
    }
  }
  __syncthreads();
}

template <int PH>
DEVI void run_steps(const Params& p, int lo, int hi, unsigned char* smem, const XcdBarrier& xb) {
  if constexpr (PH < NPHASE) {
    if (PH >= lo && PH < hi) {
      run_phase<PH>(p, smem);
      if (PH + 1 < hi) {
        if (PH == 0) cg::this_grid().sync();
        else xcd_barrier(xb);
      }
    }
    run_steps<PH + 1>(p, lo, hi, smem, xb);
  }
}

__global__ void __launch_bounds__(256, 2) mega(Params p, int ph_lo, int ph_hi) {
  extern __shared__ __attribute__((aligned(16))) unsigned char smem[];
  volatile LAS unsigned* st = (volatile LAS unsigned*)(smem + LDS_BYTES);
  if (threadIdx.x == 0) { st[0] = 0u; st[1] = 0u; }
  __syncthreads();
  const XcdBarrier xb = xcd_barrier_post((unsigned*)(p.ws + OFF_BAR), st);
  run_steps<0>(p, ph_lo, ph_hi, smem, xb);
}

extern "C" void kernel_launch(void* const* d_in, const int* in_sizes, int n_in, void* d_out, int out_size, void* d_ws,
                              size_t ws_size, hipStream_t stream) {
  static int grid = 0;
  if (grid == 0) {
    if (n_in != 33 || ws_size < WS_END) {
      fprintf(stderr, "kernel_launch: need 33 inputs and %zu bytes ws; got %d, %zu\n", (size_t)WS_END, n_in, ws_size);
      grid = -1;
      return;
    }
    int dev = 0, cus = 0, per_cu = 0;
    hipGetDevice(&dev);
    hipDeviceGetAttribute(&cus, hipDeviceAttributeMultiprocessorCount, dev);
    if (hipFuncSetAttribute((const void*)mega, hipFuncAttributeMaxDynamicSharedMemorySize, LDS_BYTES + 16) != hipSuccess) {
      fprintf(stderr, "kernel_launch: hipFuncSetAttribute failed\n");
      grid = -1;
      return;
    }
    hipOccupancyMaxActiveBlocksPerMultiprocessor(&per_cu, (const void*)mega, 256, LDS_BYTES + 16);
    if (per_cu < 1) per_cu = 1;
    if (per_cu > 2) per_cu = 2;
    grid = cus * per_cu;
    fprintf(stderr, "kernel_launch: cus %d per_cu %d grid %d\n", cus, per_cu, grid);
  }
  if (grid < 0) return;
  (void)hipMemsetAsync((unsigned char*)d_ws + OFF_BAR, 0, XCD_BAR_WORDS * sizeof(unsigned), stream);
  Params p{};
  for (int i = 0; i < 33; ++i) p.in[i] = (const float*)d_in[i];
  p.out = (float*)d_out;
  p.ws = (unsigned char*)d_ws;
#if COOP
  int lo = 0, hi = NPHASE;
  void* args[] = {&p, &lo, &hi};
  hipError_t e = hipLaunchCooperativeKernel((const void*)mega, dim3(grid), dim3(256), args, LDS_BYTES + 16, stream);
  if (e != hipSuccess) fprintf(stderr, "cooperative launch failed: %s (grid %d)\n", hipGetErrorString(e), grid);
#else
  for (int ph = 0; ph < NPHASE; ++ph) {
    hipLaunchKernelGGL(mega, dim3(grid), dim3(256), LDS_BYTES + 16, stream, p, ph, ph + 1);
  }
#endif
}
```

```cpp
#include <hip/hip_runtime.h>
#include <hip/hip_cooperative_groups.h>
#include <cstdio>
namespace cg = cooperative_groups;

#ifndef COOP
#define COOP 1
#endif

typedef unsigned short u16;
typedef unsigned int u32;
using bf16x8 = __attribute__((ext_vector_type(8))) short;
using f32x4 = __attribute__((ext_vector_type(4))) float;
typedef float f2 __attribute__((ext_vector_type(2)));
typedef float v32f __attribute__((ext_vector_type(32)));
typedef float v16f __attribute__((ext_vector_type(16)));
typedef unsigned v6u __attribute__((ext_vector_type(6)));

#define DEVI __device__ __forceinline__

constexpr int TS = 32768;
constexpr float ALPHA = 1.41421356237309515f;
constexpr float LN_EPS = 1e-5f;
constexpr size_t MBy = 1ull << 20;

constexpr size_t OFF_WS5IN = 0;
constexpr size_t OFF_WGLU = 2 * MBy;
constexpr size_t OFF_WRGIN = 6 * MBy;
constexpr size_t OFF_WGATES = 10 * MBy;
constexpr size_t OFF_WRGOUT = 12 * MBy;
constexpr size_t OFF_WQ = 14 * MBy;
constexpr size_t OFF_SK = 22 * MBy;
constexpr size_t OFF_WPROJ = 23 * MBy;
constexpr size_t OFF_WPG = 24 * MBy;
constexpr size_t OFF_UB = 28 * MBy;
constexpr size_t OFF_VB = 60 * MBy;
constexpr size_t TB_STRIDE = 26 * MBy;
constexpr size_t OFF_UB8 = OFF_UB;
constexpr size_t OFF_VB8 = OFF_UB + 12 * MBy;
constexpr size_t OFF_SCL = OFF_UB + 24 * MBy;
constexpr size_t OFF_ACT = 92 * MBy;
constexpr size_t OFF_XB = OFF_ACT;
constexpr size_t OFF_KEYS = OFF_ACT + 64 * MBy;
constexpr size_t OFF_IDX = OFF_ACT + 96 * MBy;
constexpr size_t OFF_GATE = OFF_ACT + 112 * MBy;
constexpr size_t OFF_SU = OFF_ACT + 128 * MBy;
constexpr size_t OFF_PB = OFF_ACT + 144 * MBy;
constexpr size_t OFF_XB2 = OFF_ACT + 192 * MBy;
constexpr size_t OFF_XIN = OFF_ACT + 256 * MBy;
constexpr size_t OFF_AP = OFF_ACT;
constexpr size_t OFF_HLOC = OFF_ACT + 104 * MBy;
constexpr size_t OFF_HB = OFF_ACT + 192 * MBy;
constexpr size_t OFF_GG = OFF_ACT;
constexpr size_t OFF_R = OFF_ACT + 64 * MBy;
constexpr size_t OFF_C = OFF_ACT + 128 * MBy;
constexpr size_t OFF_AB = OFF_ACT + 192 * MBy;
constexpr size_t OFF_AGG = OFF_ACT + 448 * MBy;
constexpr size_t OFF_CAR = OFF_ACT + 464 * MBy;
constexpr size_t OFF_BT1 = OFF_ACT + 472 * MBy;
constexpr size_t OFF_WST = OFF_BT1 + 48 * MBy;
constexpr size_t OFF_KTAB = OFF_WST + 16 * MBy;
constexpr size_t OFF_POW = OFF_KTAB + 4 * MBy;
constexpr size_t OFF_BBAR = OFF_POW + 3 * MBy;
constexpr size_t OFF_BAR = OFF_BBAR + 1 * MBy;
constexpr size_t WS_END = OFF_BAR + 1 * MBy;

constexpr int LDS_BYTES = 36864 + 32768;

struct Params {
  const float* in[33];
  float* out;
  unsigned char* ws;
};

DEVI u16 f2bf(float f) {
  u32 u = __float_as_uint(f);
  u += 0x7FFFu + ((u >> 16) & 1u);
  return (u16)(u >> 16);
}
DEVI float bf2f(u16 h) { return __uint_as_float(((u32)h) << 16); }
DEVI u32 pack2(float lo, float hi) { return (u32)f2bf(lo) | ((u32)f2bf(hi) << 16); }
DEVI float bflo(u32 w) { return __uint_as_float(w << 16); }
DEVI float bfhi(u32 w) { return __uint_as_float(w & 0xffff0000u); }
DEVI float sigmoid_(float x) { return __builtin_amdgcn_rcpf(1.f + __expf(-x)); }
DEVI float gelu_(float x) {
  float z = 0.7978845608028654f * (x + 0.044715f * x * x * x);
  return x * __builtin_amdgcn_rcpf(1.f + __expf(-2.f * z));
}
DEVI float softplus_(float x) { return fmaxf(x, 0.f) + log1pf(__expf(-fabsf(x))); }
DEVI void unpack8(const uint4& w, float* f) {
  f[0] = bflo(w.x); f[1] = bfhi(w.x); f[2] = bflo(w.y); f[3] = bfhi(w.y);
  f[4] = bflo(w.z); f[5] = bfhi(w.z); f[6] = bflo(w.w); f[7] = bfhi(w.w);
}
DEVI uint4 pack8(const float* f) {
  uint4 o; o.x = pack2(f[0], f[1]); o.y = pack2(f[2], f[3]); o.z = pack2(f[4], f[5]); o.w = pack2(f[6], f[7]);
  return o;
}

struct LdBF {
  const u16* base; int ld;
  typedef uint4 Raw;
  DEVI Raw load(int row, int k) const { return *reinterpret_cast<const uint4*>(base + (size_t)row * ld + k); }
  DEVI static uint4 cvt(const Raw& r) { return r; }
};
struct RawF { float4 a, b; };
struct LdF32 {
  const float* base; int ld;
  typedef RawF Raw;
  DEVI Raw load(int row, int k) const {
    const float4* q = reinterpret_cast<const float4*>(base + (size_t)row * ld + k);
    RawF r; r.a = q[0]; r.b = q[1]; return r;
  }
  DEVI static uint4 cvt(const Raw& r) {
    uint4 o; o.x = pack2(r.a.x, r.a.y); o.y = pack2(r.a.z, r.a.w); o.z = pack2(r.b.x, r.b.y); o.w = pack2(r.b.z, r.b.w);
    return o;
  }
};

template <class AL, class BL, class EP>
DEVI void gemm_tile(const AL al, const BL bl, const int K, unsigned char* smem, EP ep) {
  u16* As = reinterpret_cast<u16*>(smem);
  u16* Bs = As + 128 * 72;
  const int tid = threadIdx.x, lane = tid & 63, wave = tid >> 6, wm = wave >> 1, wn = wave & 1;
  const int lr = lane & 15, lq = lane >> 4;
  f32x4 acc[4][4];
#pragma unroll
  for (int i = 0; i < 4; ++i)
#pragma unroll
    for (int j = 0; j < 4; ++j) acc[i][j] = f32x4{0.f, 0.f, 0.f, 0.f};
  typename AL::Raw ra[4];
  typename BL::Raw rb[4];
  const int prow = tid >> 3, pk = (tid & 7) * 8;
#pragma unroll
  for (int i = 0; i < 4; ++i) { ra[i] = al.load(prow + i * 32, pk); rb[i] = bl.load(prow + i * 32, pk); }
  for (int kt = 0; kt < K; kt += 64) {
    __syncthreads();
#pragma unroll
    for (int i = 0; i < 4; ++i) {
      *reinterpret_cast<uint4*>(As + (prow + i * 32) * 72 + pk) = AL::cvt(ra[i]);
      *reinterpret_cast<uint4*>(Bs + (prow + i * 32) * 72 + pk) = BL::cvt(rb[i]);
    }
    __syncthreads();
    if (kt + 64 < K) {
#pragma unroll
      for (int i = 0; i < 4; ++i) { ra[i] = al.load(prow + i * 32, kt + 64 + pk); rb[i] = bl.load(prow + i * 32, kt + 64 + pk); }
    }
#pragma unroll
    for (int ks = 0; ks < 2; ++ks) {
      bf16x8 af[4], bfr[4];
#pragma unroll
      for (int i = 0; i < 4; ++i) af[i] = *reinterpret_cast<const bf16x8*>(As + (wm * 64 + i * 16 + lr) * 72 + ks * 32 + lq * 8);
#pragma unroll
      for (int j = 0; j < 4; ++j) bfr[j] = *reinterpret_cast<const bf16x8*>(Bs + (wn * 64 + j * 16 + lr) * 72 + ks * 32 + lq * 8);
#pragma unroll
      for (int i = 0; i < 4; ++i)
#pragma unroll
        for (int j = 0; j < 4; ++j) acc[i][j] = __builtin_amdgcn_mfma_f32_16x16x32_bf16(af[i], bfr[j], acc[i][j], 0, 0, 0);
    }
  }
  __syncthreads();
  ep(acc);
}

typedef __attribute__((address_space(3))) unsigned lds_u32;
template <bool TR = false, class EP>
DEVI void gemm_tile_dma(const u16* A, const int lda, const u16* Bt, const int ldb, const int K, unsigned char* smem, EP ep,
                        const u16* An = nullptr, const u16* Bn = nullptr, const bool pre = false) {
  const int tid = threadIdx.x, lane = tid & 63, wave = tid >> 6, wm = wave >> 1, wn = wave & 1;
  const int lr = lane & 15, lq = lane >> 4;
  f32x4 acc[4][4];
#pragma unroll
  for (int i = 0; i < 4; ++i)
#pragma unroll
    for (int j = 0; j < 4; ++j) acc[i][j] = f32x4{0.f, 0.f, 0.f, 0.f};
  const int rr = lane >> 3, qq = (lane & 7) ^ rr;
  const size_t aoff = (size_t)(wave * 32 + rr) * lda + qq * 8, boff = (size_t)(wave * 32 + rr) * ldb + qq * 8;
  const u16* ag = A + aoff;
  const u16* bg = Bt + boff;
  unsigned char* wbase = smem + wave * 4096;
#define GT_ISSUE(AP_, BP_, stage, kt)                                                                                    \
  do {                                                                                                                   \
    _Pragma("unroll") for (int j = 0; j < 4; ++j) {                                                                      \
      __builtin_amdgcn_global_load_lds((const unsigned*)((AP_) + (size_t)j * 8 * lda + (kt)),                            \
                                       (lds_u32*)(wbase + (stage) * 32768 + j * 1024), 16, 0, 0);                        \
      __builtin_amdgcn_global_load_lds((const unsigned*)((BP_) + (size_t)j * 8 * ldb + (kt)),                            \
                                       (lds_u32*)(wbase + (stage) * 32768 + 16384 + j * 1024), 16, 0, 0);                \
    }                                                                                                                    \
  } while (0)
  if (!pre) {
    __syncthreads();
    GT_ISSUE(ag, bg, 0, 0);
  }
  const int sw = lr & 7;
  int it = 0;
  for (int kt = 0; kt < K; kt += 64, ++it) {
    asm volatile("s_waitcnt vmcnt(0)" ::: "memory");
    __syncthreads();
    if (kt + 64 < K) GT_ISSUE(ag, bg, (it + 1) & 1, kt + 64);
    else if (An != nullptr) GT_ISSUE(An + aoff, Bn + boff, 0, 0);
    const unsigned char* As = smem + (it & 1) * 32768;
    const unsigned char* Bs = As + 16384;
#pragma unroll
    for (int ks = 0; ks < 2; ++ks) {
      bf16x8 af[4], bfr[4];
      const int ch = ((ks * 4 + lq) ^ sw) * 16;
#pragma unroll
      for (int i = 0; i < 4; ++i) af[i] = *reinterpret_cast<const bf16x8*>(As + (wm * 64 + i * 16 + lr) * 128 + ch);
#pragma unroll
      for (int j = 0; j < 4; ++j) bfr[j] = *reinterpret_cast<const bf16x8*>(Bs + (wn * 64 + j * 16 + lr) * 128 + ch);
      __builtin_amdgcn_s_setprio(1);
#pragma unroll
      for (int i = 0; i < 4; ++i)
#pragma unroll
        for (int j = 0; j < 4; ++j)
          acc[i][j] = TR ? __builtin_amdgcn_mfma_f32_16x16x32_bf16(bfr[j], af[i], acc[i][j], 0, 0, 0)
                         : __builtin_amdgcn_mfma_f32_16x16x32_bf16(af[i], bfr[j], acc[i][j], 0, 0, 0);
      __builtin_amdgcn_s_setprio(0);
    }
  }
#undef GT_ISSUE
  if (An == nullptr) __syncthreads();
  ep(acc);
}

DEVI bool tile_map(int it, int nmt, int nnt, int& mt, int& nt) {
  const int xcd = blockIdx.x & 7, j = blockIdx.x >> 3;
  const int per = gridDim.x >> 3;
  const int slot = it * per + j;
  const int S = (slot >> 6) * 8 + xcd;
  const int nsn = nnt >> 3, nsm = nmt >> 3;
  if (S >= nsn * nsm) return false;
  const int sm = S / nsn, sn = S - sm * nsn;
  const int w = slot & 63;
  mt = sm * 8 + (w >> 3);
  nt = sn * 8 + (w & 7);
  return true;
}

template <int PERM>
DEVI void cvt_wt(const float* W, int K, int N, u16* out, int a0, int a1) {
  const int gsz = gridDim.x * 256, gtid = blockIdx.x * 256 + threadIdx.x;
  const int total = N * (K >> 3);
  for (int i = gtid; i < total; i += gsz) {
    const int n = i % N, kv = i / N;
    float v[8];
#pragma unroll
    for (int j = 0; j < 8; ++j) v[j] = W[(size_t)(kv * 8 + j) * N + n];
    int np = n;
    if (PERM == 1) { const int g = n >> 10, o = n & 1023; np = (o >> 4) * 32 + g * 16 + (o & 15); }
    if (PERM == 2) { np = a0 * 512 + (n >> 4) * 32 + a1 * 16 + (n & 15); }
    *reinterpret_cast<uint4*>(out + (size_t)np * K + kv * 8) = pack8(v);
  }
}

DEVI void cvt_plain(const float* src, u16* dst, size_t n8) {
  const size_t gsz = (size_t)gridDim.x * 256, gtid = (size_t)blockIdx.x * 256 + threadIdx.x;
  for (size_t i = gtid; i < n8; i += gsz) {
    const float4* q = reinterpret_cast<const float4*>(src + i * 8);
    float4 a = q[0], b = q[1];
    uint4 o; o.x = pack2(a.x, a.y); o.y = pack2(a.z, a.w); o.z = pack2(b.x, b.y); o.w = pack2(b.z, b.w);
    *reinterpret_cast<uint4*>(dst + i * 8) = o;
  }
}

DEVI void phase_setup(const Params& p) {
  unsigned char* ws = p.ws;
  cvt_wt<0>(p.in[4], 1024, 1024, (u16*)(ws + OFF_WS5IN), 0, 0);
  cvt_wt<1>(p.in[13], 1024, 2048, (u16*)(ws + OFF_WGLU), 0, 0);
  cvt_wt<0>(p.in[14], 1024, 2048, (u16*)(ws + OFF_WRGIN), 0, 0);
  for (int d = 0; d < 2; ++d)
    for (int gate = 0; gate < 2; ++gate)
      for (int h = 0; h < 4; ++h)
        cvt_wt<2>((gate ? p.in[19] : p.in[17]) + (size_t)(d * 4 + h) * 65536, 256, 256,
                  (u16*)(ws + OFF_WGATES) + (size_t)h * 1024 * 256, d, gate);
  cvt_wt<0>(p.in[22], 1024, 1024, (u16*)(ws + OFF_WRGOUT), 0, 0);
  for (int l = 0; l < 2; ++l) {
    cvt_wt<0>(p.in[27] + (size_t)l * 1024 * 2048, 1024, 2048, (u16*)(ws + OFF_WQ) + (size_t)l * 2048 * 1024, 0, 0);
    cvt_wt<0>(p.in[31] + (size_t)l * 256 * 1024, 256, 1024, (u16*)(ws + OFF_WPROJ) + (size_t)l * 1024 * 256, 0, 0);
    cvt_wt<0>(p.in[32] + (size_t)l * 1024 * 1024, 1024, 1024, (u16*)(ws + OFF_WPG) + (size_t)l * 1024 * 1024, 0, 0);
  }
  cvt_plain(p.in[28], (u16*)(ws + OFF_SK), 65536 / 8);
  const int gsz = gridDim.x * 256, gtid = blockIdx.x * 256 + threadIdx.x;
  float2* POW = (float2*)(ws + OFF_POW);
  float2* BBAR = (float2*)(ws + OFF_BBAR);
  for (int i = gtid; i < 2 * 64 * 33 * 64; i += gsz) {
    const int pp = i & 63, n = (i >> 6) % 33, dg = i / (64 * 33);
    const float step = expf(p.in[7][dg]);
    const float lr_ = p.in[5][dg * 64 + pp], li_ = p.in[6][dg * 64 + pp];
    const float mag = expf((float)n * (lr_ * step)), ang = (float)n * (li_ * step);
    POW[i] = float2{mag * cosf(ang), mag * sinf(ang)};
  }
  for (int i = gtid; i < 2 * 64 * 64; i += gsz) {
    const int dg = i >> 6;
    const float step = expf(p.in[7][dg]);
    const float lr_ = p.in[5][i], li_ = p.in[6][i];
    const float mag = expf(lr_ * step), ang = li_ * step;
    const float ar = mag * cosf(ang), ai = mag * sinf(ang);
    const float den = lr_ * lr_ + li_ * li_;
    const float zr = ar - 1.f;
    const float qr = (zr * lr_ + ai * li_) / den, qi = (ai * lr_ - zr * li_) / den;
#pragma unroll
    for (int c = 0; c < 16; ++c) {
      const float br = p.in[8][(size_t)i * 16 + c], bi = p.in[9][(size_t)i * 16 + c];
      BBAR[(size_t)i * 16 + c] = float2{qr * br - qi * bi, qr * bi + qi * br};
    }
  }
}

DEVI float s5_kterm(const Params& p, const float2* POW, const float2* BBAR, int d, int g, int n, int c, int cp) {
  const int dg = d * 64 + g;
  const float* cr = p.in[10] + ((size_t)dg * 16 + c) * 64;
  const float* ci = p.in[11] + ((size_t)dg * 16 + c) * 64;
  const float2* E = POW + ((size_t)dg * 33 + n) * 64;
  const float2* BB = BBAR + (size_t)dg * 64 * 16 + cp;
  float s = 0.f;
#pragma unroll 8
  for (int pp = 0; pp < 64; ++pp) {
    const float2 e = E[pp], bb = BB[pp * 16];
    const float Cr = cr[pp], Ci = ci[pp];
    const float cer = Cr * e.x - Ci * e.y, cei = Cr * e.y + Ci * e.x;
    s += cer * bb.x - cei * bb.y;
  }
  return s;
}

DEVI void phase_tables(const Params& p, int layer, unsigned char* smem);

DEVI void phase_setup2(const Params& p, unsigned char* smem) {
  phase_tables(p, 0, smem);
  phase_tables(p, 1, smem);
  unsigned char* ws = p.ws;
  const int gsz = gridDim.x * 256, gtid = blockIdx.x * 256 + threadIdx.x;
  const float2* POW = (const float2*)(ws + OFF_POW);
  const float2* BBAR = (const float2*)(ws + OFF_BBAR);
  float* KTAB = (float*)(ws + OFF_KTAB);
  u16* WST = (u16*)(ws + OFF_WST);
  u16* BT1 = (u16*)(ws + OFF_BT1);
  for (int i = gtid; i < 64 * 63 * 256; i += gsz) {
    const int cp = i & 15, c = (i >> 4) & 15, ti = (i >> 8) % 63, g = i / (63 * 256);
    const int tau = ti - 31;
    float s = 0.f;
    if (tau >= 0) s += s5_kterm(p, POW, BBAR, 0, g, tau, c, cp);
    if (tau <= 0) s += s5_kterm(p, POW, BBAR, 1, g, -tau, c, cp);
    KTAB[i] = s;
  }
  for (int i = gtid; i < 64 * 256 * 64; i += gsz) {
    const int kv = i & 63, np = (i >> 6) & 255, g = i >> 14;
    const int d = np >> 7, ri = (np >> 6) & 1, pp = np & 63, s = kv >> 1, c0 = (kv & 1) * 8;
    const int npow = d ? s : 31 - s;
    const float2 e = POW[((size_t)(d * 64 + g) * 33 + npow) * 64 + pp];
    float v[8];
#pragma unroll
    for (int j = 0; j < 8; ++j) {
      const float2 bb = BBAR[((size_t)(d * 64 + g) * 64 + pp) * 16 + c0 + j];
      v[j] = ri ? (e.x * bb.y + e.y * bb.x) : (e.x * bb.x - e.y * bb.y);
    }
    *reinterpret_cast<uint4*>(WST + ((size_t)g * 256 + np) * 512 + kv * 8) = pack8(v);
  }
  for (int i = gtid; i < 64 * 512 * 32; i += gsz) {
    const int kv = i & 31, n = (i >> 5) & 511, g = i >> 14;
    const int t = n >> 4, c = n & 15, kk0 = kv * 8;
    const int d = kk0 >> 7, ri = (kk0 >> 6) & 1, p0 = kk0 & 63;
    const int npow = d ? 32 - t : t + 1;
    const int dg = d * 64 + g;
    float v[8];
#pragma unroll
    for (int j = 0; j < 8; ++j) {
      const int pp = p0 + j;
      const float Cr = p.in[10][((size_t)dg * 16 + c) * 64 + pp], Ci = p.in[11][((size_t)dg * 16 + c) * 64 + pp];
      const float2 e = POW[((size_t)dg * 33 + npow) * 64 + pp];
      v[j] = ri ? -(Cr * e.y + Ci * e.x) : (Cr * e.x - Ci * e.y);
    }
    *reinterpret_cast<uint4*>(BT1 + ((size_t)g * 512 + n) * 768 + 512 + kv * 8) = pack8(v);
  }
}

DEVI void phase_setup3(const Params& p) {
  cvt_plain(p.in[0], (u16*)(p.ws + OFF_XIN), (size_t)TS * 1024 / 8);
  const int gsz = gridDim.x * 256, gtid = blockIdx.x * 256 + threadIdx.x;
  const float* KTAB = (const float*)(p.ws + OFF_KTAB);
  u16* BT1 = (u16*)(p.ws + OFF_BT1);
  for (int i = gtid; i < 64 * 512 * 64; i += gsz) {
    const int kv = i & 63, n = (i >> 6) & 511, g = i >> 15;
    const int t = n >> 4, c = n & 15, s = kv >> 1, c0 = (kv & 1) * 8;
    const float* src = KTAB + (((size_t)g * 63 + (t - s + 31)) * 16 + c) * 16 + c0;
    float v[8];
#pragma unroll
    for (int j = 0; j < 8; ++j) v[j] = src[j];
    *reinterpret_cast<uint4*>(BT1 + ((size_t)g * 512 + n) * 768 + kv * 8) = pack8(v);
  }
}

DEVI void phase_s5_in(const Params& p, int s, unsigned char* smem) {
  const u16* XIN = (const u16*)(p.ws + OFF_XIN);
  const u16* Wt = (const u16*)(p.ws + OFF_WS5IN);
  u16* AP = (u16*)(p.ws + OFF_AP);
  const int lane = threadIdx.x & 63, wave = threadIdx.x >> 6, wm = wave >> 1, wn = wave & 1;
  bool pre_ = false;
  for (int it = 0, mt, nt; tile_map(it, 256, 8, mt, nt); ++it) {
    int mtn, ntn;
    const bool nxt_ = tile_map(it + 1, 256, 8, mtn, ntn);
    const int m0 = mt * 128, n0 = nt * 128;
    gemm_tile_dma<true>(XIN + (size_t)m0 * 1024, 1024, Wt + (size_t)n0 * 1024, 1024, 1024, smem, [&](f32x4 (&acc)[4][4]) {
#pragma unroll
      for (int i = 0; i < 4; ++i)
#pragma unroll
        for (int j = 0; j < 4; ++j) {
          const int row = m0 + wm * 64 + i * 16 + (lane & 15);
          const int col = n0 + wn * 64 + j * 16 + (lane >> 4) * 4;
          uint2 w; w.x = pack2(acc[i][j][0], acc[i][j][1]); w.y = pack2(acc[i][j][2], acc[i][j][3]);
          *reinterpret_cast<uint2*>(AP + ((size_t)(col >> 4) * 1024 + (row >> 5)) * 768 + (row & 31) * 16 + (col & 15)) = w;
        }
    }, nxt_ ? (XIN + (size_t)(mtn * 128) * 1024) : nullptr, nxt_ ? (Wt + (size_t)(ntn * 128) * 1024) : nullptr, pre_);
    pre_ = nxt_;
  }
}

DEVI void phase_s5_state(const Params& p, unsigned char* smem) {
  const u16* AP = (const u16*)(p.ws + OFF_AP);
  const u16* WST = (const u16*)(p.ws + OFF_WST);
  float* HLOC = (float*)(p.ws + OFF_HLOC);
  const int lane = threadIdx.x & 63, wave = threadIdx.x >> 6, wm = wave >> 1, wn = wave & 1;
  for (int tile = blockIdx.x; tile < 64 * 16; tile += gridDim.x) {
    const int g = tile >> 4, m0 = ((tile >> 1) & 7) * 128, n0 = (tile & 1) * 128;
    gemm_tile_dma(AP + ((size_t)g * 1024 + m0) * 768, 768, WST + ((size_t)g * 256 + n0) * 512, 512, 512, smem, [&](f32x4 (&acc)[4][4]) {
#pragma unroll
      for (int i = 0; i < 4; ++i)
#pragma unroll
        for (int j = 0; j < 4; ++j)
#pragma unroll
          for (int r = 0; r < 4; ++r) {
            const int row = m0 + wm * 64 + i * 16 + (lane >> 4) * 4 + r;
            const int col = n0 + wn * 64 + j * 16 + (lane & 15);
            HLOC[((size_t)g * 1024 + row) * 256 + col] = acc[i][j][r];
          }
    });
  }
}

DEVI void phase_s5_cscan(const Params& p, int s) {
  const int L = s ? 2048 : 4096;
  const int nseq = TS / L, nch = L / 32;
  u16* AP = (u16*)(p.ws + OFF_AP);
  const float* HLOC = (const float*)(p.ws + OFF_HLOC);
  const float2* POW = (const float2*)(p.ws + OFF_POW);
  const int gsz = gridDim.x * 256, gtid = blockIdx.x * 256 + threadIdx.x;
  for (int i = gtid; i < 64 * nseq * 128; i += gsz) {
    const int pp = i & 63, d = (i >> 6) & 1, g = (i >> 7) & 63, seq = i >> 13;
    const float2 e = POW[((size_t)(d * 64 + g) * 33 + 32) * 64 + pp];
    float Hr = 0.f, Hi = 0.f;
#pragma unroll 8
    for (int j = 0; j < nch; ++j) {
      const int chunk = seq * nch + (d ? (nch - 1 - j) : j);
      u16* ap = AP + ((size_t)g * 1024 + chunk) * 768 + 512 + d * 128 + pp;
      ap[0] = f2bf(Hr);
      ap[64] = f2bf(Hi);
      const float* hl = HLOC + ((size_t)g * 1024 + chunk) * 256 + d * 128 + pp;
      const float a = hl[0], b = hl[64];
      const float nHr = e.x * Hr - e.y * Hi + a;
      const float nHi = e.x * Hi + e.y * Hr + b;
      Hr = nHr; Hi = nHi;
    }
  }
}

DEVI void phase_s5_main(const Params& p, unsigned char* smem) {
  const u16* AP = (const u16*)(p.ws + OFF_AP);
  const u16* BT1 = (const u16*)(p.ws + OFF_BT1);
  u16* HB = (u16*)(p.ws + OFF_HB);
  const float* dsk = p.in[12];
  const int lane = threadIdx.x & 63, wave = threadIdx.x >> 6, wm = wave >> 1, wn = wave & 1;
  for (int tile = blockIdx.x; tile < 64 * 32; tile += gridDim.x) {
    const int g = tile >> 5, m0 = ((tile >> 2) & 7) * 128, n0 = (tile & 3) * 128;
    gemm_tile_dma(AP + ((size_t)g * 1024 + m0) * 768, 768, BT1 + ((size_t)g * 512 + n0) * 768, 768, 768, smem, [&](f32x4 (&acc)[4][4]) {
      const float dv = dsk[g * 16 + (lane & 15)];
#pragma unroll
      for (int i = 0; i < 4; ++i)
#pragma unroll
        for (int j = 0; j < 4; ++j)
#pragma unroll
          for (int r = 0; r < 4; ++r) {
            const int chunk = m0 + wm * 64 + i * 16 + (lane >> 4) * 4 + r;
            const int n = n0 + wn * 64 + j * 16 + (lane & 15);
            const float u = bf2f(AP[((size_t)g * 1024 + chunk) * 768 + n]);
            const float y = acc[i][j][r] + dv * u;
            HB[((size_t)chunk * 32 + (n >> 4)) * 1024 + g * 16 + (lane & 15)] = f2bf(gelu_(y));
          }
    });
  }
}

DEVI void phase_s5_glu(const Params& p, int s, unsigned char* smem) {
  const u16* HB = (const u16*)(p.ws + OFF_HB);
  const u16* Wt = (const u16*)(p.ws + OFF_WGLU);
  const float* Xin = p.in[s];
  float* Xo = p.out + (size_t)s * TS * 1024;
  const int lane = threadIdx.x & 63, wave = threadIdx.x >> 6, wm = wave >> 1, wn = wave & 1;
  bool pre_ = false;
  for (int it = 0, mt, nt; tile_map(it, 256, 16, mt, nt); ++it) {
    int mtn, ntn;
    const bool nxt_ = tile_map(it + 1, 256, 16, mtn, ntn);
    const int m0 = mt * 128, n0 = nt * 128;
    gemm_tile_dma<true>(HB + (size_t)m0 * 1024, 1024, Wt + (size_t)n0 * 1024, 1024, 1024, smem, [&](f32x4 (&acc)[4][4]) {
#pragma unroll
      for (int i = 0; i < 4; ++i)
#pragma unroll
        for (int jj = 0; jj < 4; jj += 2) {
          const int row = m0 + wm * 64 + i * 16 + (lane & 15);
          const int nb = n0 + wn * 64 + jj * 16;
          const int o = (nb >> 5) * 16 + (lane >> 4) * 4;
          const size_t idx = (size_t)row * 1024 + o;
          const float4 xi = *reinterpret_cast<const float4*>(Xin + idx);
          float4 v;
          v.x = ALPHA * xi.x + acc[i][jj][0] * sigmoid_(acc[i][jj + 1][0]);
          v.y = ALPHA * xi.y + acc[i][jj][1] * sigmoid_(acc[i][jj + 1][1]);
          v.z = ALPHA * xi.z + acc[i][jj][2] * sigmoid_(acc[i][jj + 1][2]);
          v.w = ALPHA * xi.w + acc[i][jj][3] * sigmoid_(acc[i][jj + 1][3]);
          *reinterpret_cast<float4*>(Xo + idx) = v;
        }
    }, nxt_ ? (HB + (size_t)(mtn * 128) * 1024) : nullptr, nxt_ ? (Wt + (size_t)(ntn * 128) * 1024) : nullptr, pre_);
    pre_ = nxt_;
  }
}

DEVI void phase_ln1_tables(const Params& p, int s, int layer, unsigned char* smem) {
  float* X = p.out + (size_t)s * TS * 1024;
  u16* XB = (u16*)(p.ws + OFF_XB);
  const float* gam = p.in[23] + layer * 1024;
  const float* bet = p.in[24] + layer * 1024;
  const int lane = threadIdx.x & 63, wave = threadIdx.x >> 6;
  for (int t = blockIdx.x * 4 + wave; t < TS; t += gridDim.x * 4) {
    float4 v[4];
#pragma unroll
    for (int i = 0; i < 4; ++i) v[i] = *reinterpret_cast<const float4*>(X + (size_t)t * 1024 + i * 256 + lane * 4);
    float sm = 0.f;
#pragma unroll
    for (int i = 0; i < 4; ++i) sm += v[i].x + v[i].y + v[i].z + v[i].w;
#pragma unroll
    for (int m = 32; m >= 1; m >>= 1) sm += __shfl_xor(sm, m);
    const float mu = sm * (1.f / 1024.f);
    float sq = 0.f;
#pragma unroll
    for (int i = 0; i < 4; ++i) {
      const float a = v[i].x - mu, b = v[i].y - mu, c = v[i].z - mu, d = v[i].w - mu;
      sq += a * a + b * b + c * c + d * d;
    }
#pragma unroll
    for (int m = 32; m >= 1; m >>= 1) sq += __shfl_xor(sq, m);
    const float rs = rsqrtf(sq * (1.f / 1024.f) + LN_EPS);
#pragma unroll
    for (int i = 0; i < 4; ++i) {
      const int c0 = i * 256 + lane * 4;
      const float4 g4 = *reinterpret_cast<const float4*>(gam + c0);
      const float4 b4 = *reinterpret_cast<const float4*>(bet + c0);
      float4 o;
      o.x = (v[i].x - mu) * rs * g4.x + b4.x; o.y = (v[i].y - mu) * rs * g4.y + b4.y;
      o.z = (v[i].z - mu) * rs * g4.z + b4.z; o.w = (v[i].w - mu) * rs * g4.w + b4.w;
      uint2 pk; pk.x = pack2(o.x, o.y); pk.y = pack2(o.z, o.w);
      *reinterpret_cast<uint2*>(XB + (size_t)t * 1024 + c0) = pk;
    }
  }
}

DEVI void phase_tables(const Params& p, int layer, unsigned char* smem) {
  const int lane = threadIdx.x & 63, wave = threadIdx.x >> 6;
  float* SCL = (float*)(p.ws + OFF_SCL + (size_t)layer * TB_STRIDE);
  float* lds = reinterpret_cast<float*>(smem) + (threadIdx.x & 63) + (threadIdx.x >> 6) * 2048;
  int srck[32];
  {
    v16f ra, rb;
#pragma unroll
    for (int j = 0; j < 16; ++j) { ra[j] = (j < 8) ? 0.125f * j : 1.f + 0.125f * (j - 8); rb[j] = (j < 8) ? 2.f + 0.25f * j : 4.f + 0.5f * (j - 8); }
    const v6u pk = __builtin_amdgcn_cvt_scalef32_2xpk16_fp6_f32(ra, rb, 1.0f);
    const v32f dd = __builtin_amdgcn_cvt_scalef32_pk32_f32_fp6(pk, 1.0f);
#pragma unroll
    for (int k = 0; k < 32; ++k) {
      const float v = dd[k];
      const float fi = v < 1.f ? v * 8.f : (v < 2.f ? 8.f + (v - 1.f) * 8.f : (v < 4.f ? 16.f + (v - 2.f) * 4.f : 24.f + (v - 4.f) * 2.f));
      srck[k] = ((int)(fi + 0.5f)) & 31;
    }
  }
  const int ll = lane & 31, hs = lane >> 5;
  for (int r2 = blockIdx.x * 4 + wave; r2 < 16384; r2 += gridDim.x * 4) {
    const int r = r2 * 2 + hs;
    const int tab = r >> 14, row = r & 16383;
    const float4* sp = reinterpret_cast<const float4*>(p.in[29 + tab] + ((size_t)layer * 16384 + row) * 1024 + ll * 32);
    float s[32];
#pragma unroll
    for (int j = 0; j < 8; ++j) { const float4 a = sp[j]; s[4 * j] = a.x; s[4 * j + 1] = a.y; s[4 * j + 2] = a.z; s[4 * j + 3] = a.w; }
    float am = 0.f;
#pragma unroll
    for (int k = 0; k < 32; ++k) am = fmaxf(am, fabsf(s[k]));
#pragma unroll
    for (int m = 16; m >= 1; m >>= 1) am = fmaxf(am, __shfl_xor(am, m));
    const float sc = am > 0.f ? 7.5f / am : 1.f;
    const float inv = am > 0.f ? am * (1.f / 7.5f) : 1.f;
#pragma unroll
    for (int k = 0; k < 32; ++k) lds[srck[k] * 64] = s[k] * sc;
    v16f ia, ib;
#pragma unroll
    for (int j = 0; j < 16; ++j) { ia[j] = lds[j * 64]; ib[j] = lds[(16 + j) * 64]; }
    const v6u pk = __builtin_amdgcn_cvt_scalef32_2xpk16_fp6_f32(ia, ib, 1.0f);
    unsigned char* dst = p.ws + (size_t)layer * TB_STRIDE + (tab ? OFF_VB8 : OFF_UB8) + (size_t)row * 768;
    *reinterpret_cast<uint4*>(dst + ll * 16) = uint4{pk[0], pk[1], pk[2], pk[3]};
    *reinterpret_cast<uint2*>(dst + 512 + ll * 8) = uint2{pk[4], pk[5]};
    if (ll == 0) SCL[tab * 16384 + row] = inv;
  }
}

DEVI u32 enc_key(float s, int n) {
  u32 b = __float_as_uint(s);
  u32 srt = (b & 0x80000000u) ? ~b : (b | 0x80000000u);
  return (srt & ~127u) | (u32)(127 - n);
}
DEVI float dec_key(u32 key, int& n) {
  n = 127 - (int)(key & 127u);
  u32 srt = key & ~127u;
  u32 b = (srt & 0x80000000u) ? (srt & 0x7fffffffu) : ~srt;
  return __uint_as_float(b);
}

DEVI void phase_peer_q(const Params& p, int layer, unsigned char* smem) {
  const u16* XB = (const u16*)(p.ws + OFF_XB);
  const u16* Wt = (const u16*)(p.ws + OFF_WQ) + (size_t)layer * 2048 * 1024;
  const u16* SK = (const u16*)(p.ws + OFF_SK) + (size_t)layer * 2 * 128 * 128;
  u32* KEYS = (u32*)(p.ws + OFF_KEYS);
  const int tid = threadIdx.x, lane = tid & 63, wave = tid >> 6, wm = wave >> 1, wn = wave & 1;
  const int lr = lane & 15, lq = lane >> 4;
  u16* Qs = reinterpret_cast<u16*>(smem);
  u32* Sk = reinterpret_cast<u32*>(smem);
  for (int it = 0, mt, nt; tile_map(it, 256, 16, mt, nt); ++it) {
    const int m0 = mt * 128, hc = nt, n0 = hc * 128;
    const int c = hc & 1;
    gemm_tile_dma(XB + (size_t)m0 * 1024, 1024, Wt + (size_t)n0 * 1024, 1024, 1024, smem, [&](f32x4 (&acc)[4][4]) {
#pragma unroll
      for (int i = 0; i < 4; ++i)
#pragma unroll
        for (int j = 0; j < 4; ++j)
#pragma unroll
          for (int r = 0; r < 4; ++r)
            Qs[(wm * 64 + i * 16 + lq * 4 + r) * 136 + wn * 64 + j * 16 + lr] = f2bf(acc[i][j][r]);
      __syncthreads();
      f32x4 sc[4][4];
#pragma unroll
      for (int i = 0; i < 4; ++i)
#pragma unroll
        for (int j = 0; j < 4; ++j) sc[i][j] = f32x4{0.f, 0.f, 0.f, 0.f};
      const u16* skc = SK + (size_t)c * 128 * 128;
#pragma unroll
      for (int ks = 0; ks < 4; ++ks) {
        bf16x8 af[4], bfr[4];
#pragma unroll
        for (int i = 0; i < 4; ++i) af[i] = *reinterpret_cast<const bf16x8*>(Qs + (wm * 64 + i * 16 + lr) * 136 + ks * 32 + lq * 8);
#pragma unroll
        for (int j = 0; j < 4; ++j) bfr[j] = *reinterpret_cast<const bf16x8*>(skc + (size_t)(wn * 64 + j * 16 + lr) * 128 + ks * 32 + lq * 8);
#pragma unroll
        for (int i = 0; i < 4; ++i)
#pragma unroll
          for (int j = 0; j < 4; ++j) sc[i][j] = __builtin_amdgcn_mfma_f32_16x16x32_bf16(af[i], bfr[j], sc[i][j], 0, 0, 0);
      }
      __syncthreads();
#pragma unroll
      for (int i = 0; i < 4; ++i)
#pragma unroll
        for (int j = 0; j < 4; ++j)
#pragma unroll
          for (int r = 0; r < 4; ++r) {
            const int n = wn * 64 + j * 16 + lr;
            Sk[(wm * 64 + i * 16 + lq * 4 + r) * 129 + n] = enc_key(sc[i][j][r], n);
          }
      __syncthreads();
      if (tid < 128) {
        u32 top[16];
#pragma unroll
        for (int k = 0; k < 16; ++k) top[k] = 0u;
#pragma unroll 4
        for (int n = 0; n < 128; ++n) {
          u32 v = Sk[tid * 129 + n];
#pragma unroll
          for (int k = 0; k < 16; ++k) {
            const u32 hi = max(top[k], v);
            v = min(top[k], v);
            top[k] = hi;
          }
        }
        uint4* dst = reinterpret_cast<uint4*>(KEYS + ((size_t)(m0 + tid) * 16 + hc) * 16);
        dst[0] = uint4{top[0], top[1], top[2], top[3]};
        dst[1] = uint4{top[4], top[5], top[6], top[7]};
        dst[2] = uint4{top[8], top[9], top[10], top[11]};
        dst[3] = uint4{top[12], top[13], top[14], top[15]};
      }
    });
  }
}

DEVI void phase_peer_route(const Params& p, int s, int layer) {
  cvt_plain(p.in[2 + s] + (size_t)layer * TS * 256, (u16*)(p.ws + OFF_PB), (size_t)TS * 256 / 8);
  const u32* KEYS = (const u32*)(p.ws + OFF_KEYS);
  int* IDX = (int*)(p.ws + OFF_IDX);
  float* GATE = (float*)(p.ws + OFF_GATE);
  float* SU = (float*)(p.ws + OFF_SU);
  const float* SCL = (const float*)(p.ws + OFF_SCL + (size_t)layer * TB_STRIDE);
  const int gsz = gridDim.x * 256, gtid = blockIdx.x * 256 + threadIdx.x;
  for (int i = gtid; i < TS * 8; i += gsz) {
    const uint4* src = reinterpret_cast<const uint4*>(KEYS + (size_t)i * 32);
    u32 kk[32];
#pragma unroll
    for (int q = 0; q < 8; ++q) { const uint4 w = src[q]; kk[q * 4] = w.x; kk[q * 4 + 1] = w.y; kk[q * 4 + 2] = w.z; kk[q * 4 + 3] = w.w; }
    float s0[16], s1[16]; int i0[16], i1[16];
#pragma unroll
    for (int k = 0; k < 16; ++k) { s0[k] = dec_key(kk[k], i0[k]); s1[k] = dec_key(kk[16 + k], i1[k]); }
    float top[16];
#pragma unroll
    for (int k = 0; k < 16; ++k) top[k] = -3.0e38f;
#pragma unroll
    for (int k1 = 0; k1 < 16; ++k1)
#pragma unroll
      for (int k2 = 0; k2 < 16; ++k2)
        if ((k1 + 1) * (k2 + 1) <= 16) {
          float v = s0[k1] + s1[k2];
#pragma unroll
          for (int k = 0; k < 16; ++k) {
            const float hi = fmaxf(top[k], v);
            v = fminf(top[k], v);
            top[k] = hi;
          }
        }
    const float thr = top[15], mx = top[0];
    float den = 0.f;
#pragma unroll
    for (int k = 0; k < 16; ++k) den += __expf(top[k] - mx);
    const float inv = 1.f / den;
    int cnt = 0;
    int* idst = IDX + (size_t)i * 16;
    float* gdst = GATE + (size_t)i * 16;
    float* sdst = SU + (size_t)i * 16;
#pragma unroll
    for (int k1 = 0; k1 < 16; ++k1)
#pragma unroll
      for (int k2 = 0; k2 < 16; ++k2)
        if ((k1 + 1) * (k2 + 1) <= 16) {
          const float v = s0[k1] + s1[k2];
          if (v >= thr && cnt < 16) {
            const int e = i0[k1] * 128 + i1[k2];
            idst[cnt] = e;
            gdst[cnt] = __expf(v - mx) * inv * SCL[16384 + e];
            sdst[cnt] = SCL[e];
            ++cnt;
          }
        }
  }
}

DEVI f2 cvt8(u32 w, bool hi) { return hi ? __builtin_amdgcn_cvt_pk_f32_fp8((int)w, true) : __builtin_amdgcn_cvt_pk_f32_fp8((int)w, false); }

DEVI v32f ld_fp6_row(const unsigned char* base, int ei, int ll) {
  const unsigned char* r = base + (size_t)ei * 768;
  const uint4 a = *reinterpret_cast<const uint4*>(r + ll * 16);
  const uint2 b = *reinterpret_cast<const uint2*>(r + 512 + ll * 8);
  v6u pk; pk[0] = a.x; pk[1] = a.y; pk[2] = a.z; pk[3] = a.w; pk[4] = b.x; pk[5] = b.y;
  return __builtin_amdgcn_cvt_scalef32_pk32_f32_fp6(pk, 1.0f);
}

struct Raw6 { uint4 a; uint2 b; };
DEVI Raw6 ld_raw6(const unsigned char* base, int ei, int ll) {
  const unsigned char* r = base + (size_t)ei * 768;
  Raw6 o;
  o.a = *reinterpret_cast<const uint4*>(r + ll * 16);
  o.b = *reinterpret_cast<const uint2*>(r + 512 + ll * 8);
  return o;
}
DEVI v32f dec6(const Raw6& r) {
  v6u pk; pk[0] = r.a.x; pk[1] = r.a.y; pk[2] = r.a.z; pk[3] = r.a.w; pk[4] = r.b.x; pk[5] = r.b.y;
  return __builtin_amdgcn_cvt_scalef32_pk32_f32_fp6(pk, 1.0f);
}

DEVI void phase_peer_gather(const Params& p, int s, int layer) {
  float* X = p.out + (size_t)s * TS * 1024;
  u16* XB = (u16*)(p.ws + OFF_XB);
  const unsigned char* Ub = p.ws + OFF_UB8 + (size_t)layer * TB_STRIDE;
  const unsigned char* Vb = p.ws + OFF_VB8 + (size_t)layer * TB_STRIDE;
  const int* IDX = (const int*)(p.ws + OFF_IDX);
  const float* GATE = (const float*)(p.ws + OFF_GATE);
  const float* SU = (const float*)(p.ws + OFF_SU);
  const float* gam = p.in[25] + layer * 1024;
  const float* bet = p.in[26] + layer * 1024;
  const int lane = threadIdx.x & 63, wave = threadIdx.x >> 6;
  const int ll = lane & 31, hs = lane >> 5;
  const bool b4 = lane & 16, b3 = lane & 8;
  for (int t = blockIdx.x * 4 + wave; t < TS; t += gridDim.x * 4) {
    float x[32], o[32];
    {
      const uint4* xp = reinterpret_cast<const uint4*>(XB + (size_t)t * 1024 + ll * 32);
#pragma unroll
      for (int j = 0; j < 4; ++j) { const uint4 a = xp[j]; unpack8(a, x + 8 * j); }
    }
#pragma unroll
    for (int k = 0; k < 32; ++k) o[k] = 0.f;
    const int iv0 = IDX[(size_t)t * 128 + lane], iv1 = IDX[(size_t)t * 128 + 64 + lane];
    const float gv0 = GATE[(size_t)t * 128 + lane], gv1 = GATE[(size_t)t * 128 + 64 + lane];
    const float su0 = SU[(size_t)t * 128 + lane], su1 = SU[(size_t)t * 128 + 64 + lane];
    for (int e0 = 0; e0 < 128; e0 += 8) {
      const bool lo = e0 < 64;
      const int ivs = lo ? iv0 : iv1;
      const float gvs = lo ? gv0 : gv1;
      const float sus = lo ? su0 : su1;
      int ei[4];
#pragma unroll
      for (int q = 0; q < 4; ++q) {
        const int ea = __builtin_amdgcn_readlane(ivs, (e0 & 63) + 2 * q);
        const int eb = __builtin_amdgcn_readlane(ivs, (e0 & 63) + 2 * q + 1);
        ei[q] = hs ? eb : ea;
      }
      Raw6 cu[4], cv[4];
#pragma unroll
      for (int q = 0; q < 4; ++q) { cu[q] = ld_raw6(Ub, ei[q], ll); cv[q] = ld_raw6(Vb, ei[q], ll); }
      float dq[4];
#pragma unroll
      for (int q = 0; q < 4; ++q) {
        const v32f u = dec6(cu[q]);
        float d0 = 0.f, d1 = 0.f;
#pragma unroll
        for (int k = 0; k < 32; k += 2) { d0 = fmaf(u[k], x[k], d0); d1 = fmaf(u[k + 1], x[k + 1], d1); }
        dq[q] = d0 + d1;
      }
      float d2[2], d1;
#pragma unroll
      for (int k = 0; k < 2; ++k) {
        const float keep = b4 ? dq[k + 2] : dq[k], send = b4 ? dq[k] : dq[k + 2];
        d2[k] = keep + __shfl_xor(send, 16);
      }
      {
        const float keep = b3 ? d2[1] : d2[0], send = b3 ? d2[0] : d2[1];
        d1 = keep + __shfl_xor(send, 8);
      }
      d1 += __shfl_xor(d1, 4);
      d1 += __shfl_xor(d1, 2);
      d1 += __shfl_xor(d1, 1);
      const int qmine = (b4 ? 2 : 0) + (b3 ? 1 : 0);
      const int srcl = (e0 & 63) + 2 * qmine + hs;
      const float suv = __shfl(sus, srcl), gvv = __shfl(gvs, srcl);
      const float w = gvv * gelu_(d1 * suv);
#pragma unroll
      for (int q = 0; q < 4; ++q) {
        const float wq = __shfl(w, (lane & 32) | ((q >> 1) << 4) | ((q & 1) << 3));
        const v32f v = dec6(cv[q]);
#pragma unroll
        for (int k = 0; k < 32; ++k) o[k] = fmaf(wq, v[k], o[k]);
      }
    }
    float sm = 0.f;
#pragma unroll
    for (int k = 0; k < 32; ++k) { o[k] += __shfl_xor(o[k], 32); o[k] = ALPHA * x[k] + o[k]; sm += o[k]; }
#pragma unroll
    for (int m = 16; m >= 1; m >>= 1) sm += __shfl_xor(sm, m);
    const float mu = sm * (1.f / 1024.f);
    float sq = 0.f;
#pragma unroll
    for (int k = 0; k < 32; ++k) { const float dd = o[k] - mu; sq += dd * dd; }
#pragma unroll
    for (int m = 16; m >= 1; m >>= 1) sq += __shfl_xor(sq, m);
    const float rs = rsqrtf(sq * (1.f / 1024.f) + LN_EPS);
    if (hs == 0) {
      const int c0 = ll * 32;
#pragma unroll
      for (int j = 0; j < 4; ++j) {
        float r[8];
#pragma unroll
        for (int k = 0; k < 8; ++k) r[k] = (o[j * 8 + k] - mu) * rs * gam[c0 + j * 8 + k] + bet[c0 + j * 8 + k];
        float4* dp = reinterpret_cast<float4*>(X + (size_t)t * 1024 + c0 + j * 8);
        dp[0] = float4{r[0], r[1], r[2], r[3]};
        dp[1] = float4{r[4], r[5], r[6], r[7]};
        *reinterpret_cast<uint4*>(XB + (size_t)t * 1024 + c0 + j * 8) = pack8(r);
      }
    }
  }
}

DEVI void phase_ple(const Params& p, int s, int layer, unsigned char* smem) {
  float* X = p.out + (size_t)s * TS * 1024;
  const u16* XB = (const u16*)(p.ws + OFF_XB);
  const u16* PB = (const u16*)(p.ws + OFF_PB);
  u16* XB2 = (u16*)(p.ws + OFF_XB2);
  const u16* Wp = (const u16*)(p.ws + OFF_WPROJ) + (size_t)layer * 1024 * 256;
  const u16* Wg = (const u16*)(p.ws + OFF_WPG) + (size_t)layer * 1024 * 1024;
  const int lane = threadIdx.x & 63, wave = threadIdx.x >> 6, wm = wave >> 1, wn = wave & 1;
  for (int it = 0, mt, nt; tile_map(it, 256, 8, mt, nt); ++it) {
    const int m0 = mt * 128, n0 = nt * 128;
    u32 pk[4][4][2];
    gemm_tile_dma(XB + (size_t)m0 * 1024, 1024, Wg + (size_t)n0 * 1024, 1024, 1024, smem, [&](f32x4 (&acc)[4][4]) {
#pragma unroll
      for (int i = 0; i < 4; ++i)
#pragma unroll
        for (int j = 0; j < 4; ++j) {
          pk[i][j][0] = pack2(sigmoid_(acc[i][j][0]), sigmoid_(acc[i][j][1]));
          pk[i][j][1] = pack2(sigmoid_(acc[i][j][2]), sigmoid_(acc[i][j][3]));
        }
    });
    gemm_tile_dma(PB + (size_t)m0 * 256, 256, Wp + (size_t)n0 * 256, 256, 256, smem, [&](f32x4 (&acc)[4][4]) {
#pragma unroll
      for (int i = 0; i < 4; ++i)
#pragma unroll
        for (int j = 0; j < 4; ++j)
#pragma unroll
          for (int r = 0; r < 4; ++r) {
            const int row = m0 + wm * 64 + i * 16 + (lane >> 4) * 4 + r;
            const int col = n0 + wn * 64 + j * 16 + (lane & 15);
            const u32 w = pk[i][j][r >> 1];
            const float sg = (r & 1) ? bfhi(w) : bflo(w);
            const size_t idx = (size_t)row * 1024 + col;
            const float v = X[idx] + acc[i][j][r] * sg;
            X[idx] = v;
            if (layer == 0) XB2[idx] = f2bf(v);
          }
    });
  }
  if (layer == 1 && s == 0) cvt_plain(p.in[1], (u16*)(p.ws + OFF_XIN), (size_t)TS * 1024 / 8);
}

DEVI void phase_rg_in(const Params& p, int s, unsigned char* smem) {
  const u16* XB2 = (const u16*)(p.ws + OFF_XB2);
  const u16* Wt = (const u16*)(p.ws + OFF_WRGIN);
  u16* GG = (u16*)(p.ws + OFF_GG);
  u16* R = (u16*)(p.ws + OFF_R);
  const int lane = threadIdx.x & 63, wave = threadIdx.x >> 6, wm = wave >> 1, wn = wave & 1;
  bool pre_ = false;
  for (int it = 0, mt, nt; tile_map(it, 256, 16, mt, nt); ++it) {
    int mtn, ntn;
    const bool nxt_ = tile_map(it + 1, 256, 16, mtn, ntn);
    const int m0 = mt * 128, n0 = nt * 128;
    gemm_tile_dma<true>(XB2 + (size_t)m0 * 1024, 1024, Wt + (size_t)n0 * 1024, 1024, 1024, smem, [&](f32x4 (&acc)[4][4]) {
#pragma unroll
      for (int i = 0; i < 4; ++i)
#pragma unroll
        for (int j = 0; j < 4; ++j) {
          const int row = m0 + wm * 64 + i * 16 + (lane & 15);
          const int col = n0 + wn * 64 + j * 16 + (lane >> 4) * 4;
          uint2 w;
          if (n0 < 1024) {
            w.x = pack2(gelu_(acc[i][j][0]), gelu_(acc[i][j][1])); w.y = pack2(gelu_(acc[i][j][2]), gelu_(acc[i][j][3]));
            *reinterpret_cast<uint2*>(GG + (size_t)row * 1024 + col) = w;
          } else {
            w.x = pack2(acc[i][j][0], acc[i][j][1]); w.y = pack2(acc[i][j][2], acc[i][j][3]);
            *reinterpret_cast<uint2*>(R + (size_t)row * 1024 + col - 1024) = w;
          }
        }
    }, nxt_ ? (XB2 + (size_t)(mtn * 128) * 1024) : nullptr, nxt_ ? (Wt + (size_t)(ntn * 128) * 1024) : nullptr, pre_);
    pre_ = nxt_;
  }
}

DEVI void phase_rg_conv(const Params& p, int s) {
  const int L = s ? 2048 : 4096;
  const u16* R = (const u16*)(p.ws + OFF_R);
  u16* C = (u16*)(p.ws + OFF_C);
  const float* cw = p.in[15];
  const float* cb = p.in[16];
  const int gsz = gridDim.x * 256, gtid = blockIdx.x * 256 + threadIdx.x;
  for (int i = gtid; i < TS * 128; i += gsz) {
    const int t = i >> 7, cv = (i & 127) * 8;
    const int pos = t & (L - 1);
    float acc[8];
#pragma unroll
    for (int j = 0; j < 8; ++j) acc[j] = cb[cv + j];
#pragma unroll
    for (int k = 0; k < 4; ++k) {
      const int pp = pos + k - 1;
      if (pp >= 0 && pp < L) {
        float rv[8];
        unpack8(*reinterpret_cast<const uint4*>(R + (size_t)(t + k - 1) * 1024 + cv), rv);
#pragma unroll
        for (int j = 0; j < 8; ++j) acc[j] = fmaf(rv[j], cw[k * 1024 + cv + j], acc[j]);
      }
    }
    *reinterpret_cast<uint4*>(C + (size_t)i * 8) = pack8(acc);
  }
}

DEVI void phase_rg_gates(const Params& p, unsigned char* smem) {
  const u16* C = (const u16*)(p.ws + OFF_C);
  const u16* Wt = (const u16*)(p.ws + OFF_WGATES);
  u32* AB = (u32*)(p.ws + OFF_AB);
  const float* ba = p.in[18];
  const float* bx = p.in[20];
  const float* lam = p.in[21];
  const int lane = threadIdx.x & 63, wave = threadIdx.x >> 6, wm = wave >> 1, wn = wave & 1;
  for (int it = 0, mt, nt32; tile_map(it, 256, 32, mt, nt32); ++it) {
    const int m0 = mt * 128, h = nt32 >> 3, nt = nt32 & 7, n0 = nt * 128;
    gemm_tile_dma(C + (size_t)m0 * 1024 + h * 256, 1024, Wt + ((size_t)h * 1024 + n0) * 256, 256, 256, smem, [&](f32x4 (&acc)[4][4]) {
#pragma unroll
      for (int jj = 0; jj < 4; jj += 2) {
        const int nb = n0 + wn * 64 + jj * 16;
        const int d = nb >> 9;
        const int ch = h * 256 + ((nb & 511) >> 5) * 16 + (lane & 15);
        const float bav = ba[d * 1024 + ch], bxv = bx[d * 1024 + ch];
        const float sp8 = -8.f * softplus_(-lam[d * 1024 + ch]);
#pragma unroll
        for (int i = 0; i < 4; ++i)
#pragma unroll
          for (int r = 0; r < 4; ++r) {
            const int row = m0 + wm * 64 + i * 16 + (lane >> 4) * 4 + r;
            const float rg = sigmoid_(acc[i][jj][r] + bav);
            const float ig = sigmoid_(acc[i][jj + 1][r] + bxv);
            const float la = sp8 * rg;
            const float cval = bf2f(C[(size_t)row * 1024 + ch]);
            const float b = __builtin_amdgcn_sqrtf(fmaxf(1.f - __expf(2.f * la), 0.f)) * ig * cval;
            AB[((size_t)row * 2 + d) * 1024 + ch] = pack2(la, b);
            if (r == 3) __builtin_amdgcn_sched_barrier(0);
          }
      }
    });
  }
}

DEVI void phase_rg_agg(const Params& p) {
  const u32* AB = (const u32*)(p.ws + OFF_AB);
  float2* AGG = (float2*)(p.ws + OFF_AGG);
  const int gsz = gridDim.x * 256, gtid = blockIdx.x * 256 + threadIdx.x;
  for (int i = gtid; i < 1024 * 2 * 1024; i += gsz) {
    const int ch = i & 1023, d = (i >> 10) & 1, chunk = i >> 11;
    const int c0 = chunk * 32;
    float h = 0.f, LA = 0.f;
#pragma unroll 8
    for (int k = 0; k < 32; ++k) {
      const int t = d ? (c0 + 31 - k) : (c0 + k);
      const u32 w = AB[((size_t)t * 2 + d) * 1024 + ch];
      const float la = bflo(w), b = bfhi(w);
      h = __expf(la) * h + b;
      LA += la;
    }
    AGG[((size_t)d * 1024 + chunk) * 1024 + ch] = float2{LA, h};
  }
}

DEVI void phase_rg_carry(const Params& p, int s) {
  const int L = s ? 2048 : 4096;
  const int nseq = TS / L, nch = L / 32;
  const float2* AGG = (const float2*)(p.ws + OFF_AGG);
  float* CAR = (float*)(p.ws + OFF_CAR);
  const int gsz = gridDim.x * 256, gtid = blockIdx.x * 256 + threadIdx.x;
  for (int i = gtid; i < nseq * 2 * 1024; i += gsz) {
    const int ch = i & 1023, d = (i >> 10) & 1, seq = i >> 11;
    float H = 0.f;
#pragma unroll 8
    for (int k = 0; k < nch; ++k) {
      const int chunk = seq * nch + (d ? (nch - 1 - k) : k);
      const size_t idx = ((size_t)d * 1024 + chunk) * 1024 + ch;
      CAR[idx] = H;
      const float2 ag = AGG[idx];
      H = __expf(ag.x) * H + ag.y;
    }
  }
}

DEVI void phase_rg_final(const Params& p) {
  const u32* AB = (const u32*)(p.ws + OFF_AB);
  const float* CAR = (const float*)(p.ws + OFF_CAR);
  const u16* GG = (const u16*)(p.ws + OFF_GG);
  u16* Y = (u16*)(p.ws + OFF_R);
  const int gsz = gridDim.x * 256, gtid = blockIdx.x * 256 + threadIdx.x;
  for (int i = gtid; i < 1024 * 1024; i += gsz) {
    const int ch = i & 1023, chunk = i >> 10;
    const int c0 = chunk * 32;
    float hf[32];
    float h = CAR[((size_t)chunk) * 1024 + ch];
#pragma unroll
    for (int k = 0; k < 32; ++k) {
      const u32 w = AB[((size_t)(c0 + k) * 2 + 0) * 1024 + ch];
      h = __expf(bflo(w)) * h + bfhi(w);
      hf[k] = h;
    }
    h = CAR[((size_t)1024 + chunk) * 1024 + ch];
#pragma unroll
    for (int k = 31; k >= 0; --k) {
      const u32 w = AB[((size_t)(c0 + k) * 2 + 1) * 1024 + ch];
      h = __expf(bflo(w)) * h + bfhi(w);
      const size_t idx = (size_t)(c0 + k) * 1024 + ch;
      Y[idx] = f2bf((hf[k] + h) * bf2f(GG[idx]));
    }
  }
}

DEVI void phase_rg_out(const Params& p, int s, unsigned char* smem) {
  float* X = p.out + (size_t)s * TS * 1024;
  const u16* Y = (const u16*)(p.ws + OFF_R);
  const u16* Wt = (const u16*)(p.ws + OFF_WRGOUT);
  const int lane = threadIdx.x & 63, wave = threadIdx.x >> 6, wm = wave >> 1, wn = wave & 1;
  bool pre_ = false;
  for (int it = 0, mt, nt; tile_map(it, 256, 8, mt, nt); ++it) {
    int mtn, ntn;
    const bool nxt_ = tile_map(it + 1, 256, 8, mtn, ntn);
    const int m0 = mt * 128, n0 = nt * 128;
    gemm_tile_dma<true>(Y + (size_t)m0 * 1024, 1024, Wt + (size_t)n0 * 1024, 1024, 1024, smem, [&](f32x4 (&acc)[4][4]) {
#pragma unroll
      for (int i = 0; i < 4; ++i)
#pragma unroll
        for (int j = 0; j < 4; ++j) {
          const int row = m0 + wm * 64 + i * 16 + (lane & 15);
          const int col = n0 + wn * 64 + j * 16 + (lane >> 4) * 4;
          float4* xp = reinterpret_cast<float4*>(X + (size_t)row * 1024 + col);
          float4 v = *xp;
          v.x = ALPHA * v.x + acc[i][j][0]; v.y = ALPHA * v.y + acc[i][j][1]; v.z = ALPHA * v.z + acc[i][j][2]; v.w = ALPHA * v.w + acc[i][j][3];
          *xp = v;
        }
    }, nxt_ ? (Y + (size_t)(mtn * 128) * 1024) : nullptr, nxt_ ? (Wt + (size_t)(ntn * 128) * 1024) : nullptr, pre_);
    pre_ = nxt_;
  }
}

constexpr int NPS = 22;
constexpr int NSETUP = 3;
constexpr int NPHASE = NSETUP + 2 * NPS;

template <int PH>
DEVI void run_phase(const Params& p, unsigned char* smem) {
  if constexpr (PH == 0) {
    phase_setup(p);
  } else if constexpr (PH == 1) {
    phase_setup2(p, smem);
  } else if constexpr (PH == 2) {
    phase_setup3(p);
  } else {
    constexpr int s = (PH - NSETUP) / NPS, q = (PH - NSETUP) % NPS;
    if constexpr (q == 0) phase_s5_in(p, s, smem);
    else if constexpr (q == 1) phase_s5_state(p, smem);
    else if constexpr (q == 2) phase_s5_cscan(p, s);
    else if constexpr (q == 3) phase_s5_main(p, smem);
    else if constexpr (q == 4) phase_s5_glu(p, s, smem);
    else if constexpr (q == 5) phase_ln1_tables(p, s, 0, smem);
    else if constexpr (q == 6) phase_peer_q(p, 0, smem);
    else if constexpr (q == 7) phase_peer_route(p, s, 0);
    else if constexpr (q == 8) phase_peer_gather(p, s, 0);
    else if constexpr (q == 9) phase_ple(p, s, 0, smem);
    else if constexpr (q == 10) phase_rg_in(p, s, smem);
    else if constexpr (q == 11) phase_rg_conv(p, s);
    else if constexpr (q == 12) phase_rg_gates(p, smem);
    else if constexpr (q == 13) phase_rg_agg(p);
    else if constexpr (q == 14) phase_rg_carry(p, s);
    else if constexpr (q == 15) phase_rg_final(p);
    else if constexpr (q == 16) phase_rg_out(p, s, smem);
    else if constexpr (q == 17) phase_ln1_tables(p, s, 1, smem);
    else if constexpr (q == 18) phase_peer_q(p, 1, smem);
    else if constexpr (q == 19) phase_peer_route(p, s, 1);
    else if constexpr (q == 20) phase_peer_gather(p, s, 1);
    else if constexpr (q == 21) phase_ple(p, s, 1, smem);
  }
}

#define XB_TMO      128
#define XB_XCNT(j)  (256  + 64 * (j))
#define XB_XSUB(j)  (1280 + 64 * (j))
#define XB_XGEN(j)  (2304 + 64 * (j))
#define XB_TOP      3328
#define XB_TOPGEN   3392
#define XCD_BAR_WORDS 3456
#define XB_SPIN_CAP (1u << 18)
#define LAS __attribute__((address_space(3)))
DEVI unsigned xb_ld(unsigned* p) { return __hip_atomic_load(p, __ATOMIC_RELAXED, __HIP_MEMORY_SCOPE_AGENT); }
DEVI unsigned xb_add(unsigned* p, unsigned v) { return __hip_atomic_fetch_add(p, v, __ATOMIC_RELAXED, __HIP_MEMORY_SCOPE_AGENT); }
DEVI unsigned xb_xcc_id() { return (unsigned)__builtin_amdgcn_s_getreg((3 << 11) | 20) & 0xFu; }
#define XB_SPIN(cond, bar) do { unsigned _sp = 0; while (cond) { __builtin_amdgcn_s_sleep(1); \
    if ((++_sp & 255u) == 0u) { if (xb_ld(&(bar)[XB_TMO])) break; if (_sp > XB_SPIN_CAP) { atomicAdd(&(bar)[XB_TMO], 1u); break; } } } } while (0)
struct XcdBarrier { unsigned* bar; unsigned x; volatile LAS unsigned* st; };
DEVI XcdBarrier xcd_barrier_post(unsigned* bar, volatile LAS unsigned* st) {
  XcdBarrier b; b.bar = bar; b.x = xb_xcc_id(); b.st = st;
  if (threadIdx.x == 0) (void)xb_add(&bar[XB_XCNT(b.x)], 1u);
  return b;
}
DEVI void xcd_barrier_complete(unsigned* bar, unsigned x, unsigned& nloc, unsigned& nx) {
  const unsigned G = gridDim.x * gridDim.y * gridDim.z;
  unsigned sum, cnt, mine, sp = 0u;
  for (;;) {
    sum = 0u; cnt = 0u; mine = 0u;
#pragma unroll
    for (unsigned j = 0; j < 16; ++j) { const unsigned c = xb_ld(&bar[XB_XCNT(j)]); sum += c; cnt += (c > 0u) ? 1u : 0u; mine = (j == x) ? c : mine; }
    if (sum == G) break;
    __builtin_amdgcn_s_sleep(1);
    if ((++sp & 255u) == 0u) { if (xb_ld(&bar[XB_TMO])) break; if (sp > XB_SPIN_CAP) { atomicAdd(&bar[XB_TMO], 1u); break; } }
  }
  nloc = mine > 0u ? mine : 1u; nx = cnt > 0u ? cnt : 1u;
}
DEVI void xcd_barrier(const XcdBarrier& b) {
  asm volatile("s_waitcnt vmcnt(0)" ::: "memory");
  __syncthreads();
  if (threadIdx.x == 0) {
    unsigned* bar = b.bar;
    __builtin_amdgcn_s_waitcnt(0);
    unsigned nloc = b.st[0], nx = b.st[1];
    if (nloc == 0u) { xcd_barrier_complete(bar, b.x, nloc, nx); b.st[0] = nloc; b.st[1] = nx; }
    const unsigned old = xb_add(&bar[XB_XSUB(b.x)], 1u);
    const unsigned gen = old / nloc;
    if (old + 1u == (gen + 1u) * nloc) {
      __builtin_amdgcn_fence(__ATOMIC_RELEASE, "agent");
      asm volatile("s_waitcnt vmcnt(0)" ::: "memory");
      const unsigned og = xb_add(&bar[XB_TOP], 1u);
      const unsigned tg = og / nx;
      if (og + 1u == (tg + 1u) * nx) xb_add(&bar[XB_TOPGEN], 1u);
      else XB_SPIN(xb_ld(&bar[XB_TOPGEN]) == tg, bar);
      __builtin_amdgcn_fence(__ATOMIC_ACQUIRE, "agent");
      xb_add(&bar[XB_XGEN(b.x)], 1u);
      asm volatile("s_waitcnt vmcnt(0)" ::: "memory");
    } else {
      XB_SPIN(xb_ld(&bar[XB_XGEN(b.x)]) == gen, bar);
      __builtin_amdgcn_fence(__ATOMIC_ACQUIRE, "agent");
      asm volatile("s_waitcnt vmcnt(0)" ::: "memory");
    }
  }
  __syncthreads();
}

template <int PH>
DEVI void run_steps(const Params& p, int lo, int hi, unsigned char* smem, const XcdBarrier& xb) {
  if constexpr (PH < NPHASE) {
    if (PH >= lo && PH < hi) {
      run_phase<PH>(p, smem);
      if (PH + 1 < hi) {
        if (lo < 0) cg::this_grid().sync();
        xcd_barrier(xb);
      }
    }
    run_steps<PH + 1>(p, lo, hi, smem, xb);
  }
}

__global__ void __launch_bounds__(256, 2) mega(Params p, int ph_lo, int ph_hi) {
  extern __shared__ __attribute__((aligned(16))) unsigned char smem[];
  volatile LAS unsigned* st = (volatile LAS unsigned*)(smem + LDS_BYTES);
  if (threadIdx.x == 0) { st[0] = 0u; st[1] = 0u; }
  __syncthreads();
  const XcdBarrier xb = xcd_barrier_post((unsigned*)(p.ws + OFF_BAR), st);
  run_steps<0>(p, ph_lo, ph_hi, smem, xb);
}

extern "C" void kernel_launch(void* const* d_in, const int* in_sizes, int n_in, void* d_out, int out_size, void* d_ws,
                              size_t ws_size, hipStream_t stream) {
  static int grid = 0;
  if (grid == 0) {
    if (n_in != 33 || ws_size < WS_END) {
      fprintf(stderr, "kernel_launch: need 33 inputs and %zu bytes ws; got %d, %zu\n", (size_t)WS_END, n_in, ws_size);
      grid = -1;
      return;
    }
    int dev = 0, cus = 0, per_cu = 0;
    hipGetDevice(&dev);
    hipDeviceGetAttribute(&cus, hipDeviceAttributeMultiprocessorCount, dev);
    if (hipFuncSetAttribute((const void*)mega, hipFuncAttributeMaxDynamicSharedMemorySize, LDS_BYTES + 16) != hipSuccess) {
      fprintf(stderr, "kernel_launch: hipFuncSetAttribute failed\n");
      grid = -1;
      return;
    }
    hipOccupancyMaxActiveBlocksPerMultiprocessor(&per_cu, (const void*)mega, 256, LDS_BYTES + 16);
    if (per_cu < 1) per_cu = 1;
    if (per_cu > 2) per_cu = 2;
    grid = cus * per_cu;
    fprintf(stderr, "kernel_launch: cus %d per_cu %d grid %d\n", cus, per_cu, grid);
  }
  if (grid < 0) return;
  (void)hipMemsetAsync((unsigned char*)d_ws + OFF_BAR, 0, XCD_BAR_WORDS * sizeof(unsigned), stream);
  Params p{};
  for (int i = 0; i < 33; ++i) p.in[i] = (const float*)d_in[i];
  p.out = (float*)d_out;
  p.ws = (unsigned char*)d_ws;
#if COOP
  int lo = 0, hi = NPHASE;
  void* args[] = {&p, &lo, &hi};
  hipError_t e = hipLaunchCooperativeKernel((const void*)mega, dim3(grid), dim3(256), args, LDS_BYTES + 16, stream);
  if (e != hipSuccess) fprintf(stderr, "cooperative launch failed: %s (grid %d)\n", hipGetErrorString(e), grid);
#else
  for (int ph = 0; ph < NPHASE; ++ph) {
    hipLaunchKernelGGL(mega, dim3(grid), dim3(256), LDS_BYTES + 16, stream, p, ph, ph + 1);
  }
#endif
}
```

```cpp
#include <hip/hip_runtime.h>
#include <hip/hip_cooperative_groups.h>
#include <cstdio>
namespace cg = cooperative_groups;

#ifndef COOP
#define COOP 1
#endif

typedef unsigned short u16;
typedef unsigned int u32;
using bf16x8 = __attribute__((ext_vector_type(8))) short;
using f32x4 = __attribute__((ext_vector_type(4))) float;
typedef float f2 __attribute__((ext_vector_type(2)));
typedef float v32f __attribute__((ext_vector_type(32)));
typedef float v16f __attribute__((ext_vector_type(16)));
typedef unsigned v6u __attribute__((ext_vector_type(6)));

#define DEVI __device__ __forceinline__

constexpr int TS = 32768;
constexpr float ALPHA = 1.41421356237309515f;
constexpr float LN_EPS = 1e-5f;
constexpr size_t MBy = 1ull << 20;

constexpr size_t OFF_WS5IN = 0;
constexpr size_t OFF_WGLU = 2 * MBy;
constexpr size_t OFF_WRGIN = 6 * MBy;
constexpr size_t OFF_WGATES = 10 * MBy;
constexpr size_t OFF_WRGOUT = 12 * MBy;
constexpr size_t OFF_WQ = 14 * MBy;
constexpr size_t OFF_SK = 22 * MBy;
constexpr size_t OFF_WPROJ = 23 * MBy;
constexpr size_t OFF_WPG = 24 * MBy;
constexpr size_t OFF_UB = 28 * MBy;
constexpr size_t OFF_VB = 60 * MBy;
constexpr size_t TB_STRIDE = 26 * MBy;
constexpr size_t OFF_UB8 = OFF_UB;
constexpr size_t OFF_VB8 = OFF_UB + 12 * MBy;
constexpr size_t OFF_SCL = OFF_UB + 24 * MBy;
constexpr size_t OFF_ACT = 92 * MBy;
constexpr size_t OFF_XB = OFF_ACT;
constexpr size_t OFF_KEYS = OFF_ACT + 64 * MBy;
constexpr size_t OFF_IDX = OFF_ACT + 96 * MBy;
constexpr size_t OFF_GATE = OFF_ACT + 112 * MBy;
constexpr size_t OFF_SU = OFF_ACT + 128 * MBy;
constexpr size_t OFF_PB = OFF_ACT + 144 * MBy;
constexpr size_t OFF_XB2 = OFF_ACT + 192 * MBy;
constexpr size_t OFF_XIN = OFF_ACT + 256 * MBy;
constexpr size_t OFF_AP = OFF_ACT;
constexpr size_t OFF_HLOC = OFF_ACT + 104 * MBy;
constexpr size_t OFF_HB = OFF_ACT + 192 * MBy;
constexpr size_t OFF_GG = OFF_ACT;
constexpr size_t OFF_R = OFF_ACT + 64 * MBy;
constexpr size_t OFF_C = OFF_ACT + 128 * MBy;
constexpr size_t OFF_AB = OFF_ACT + 192 * MBy;
constexpr size_t OFF_AGG = OFF_ACT + 448 * MBy;
constexpr size_t OFF_CAR = OFF_ACT + 464 * MBy;
constexpr size_t OFF_BT1 = OFF_ACT + 472 * MBy;
constexpr size_t OFF_WST = OFF_BT1 + 48 * MBy;
constexpr size_t OFF_KTAB = OFF_WST + 16 * MBy;
constexpr size_t OFF_POW = OFF_KTAB + 4 * MBy;
constexpr size_t OFF_BBAR = OFF_POW + 3 * MBy;
constexpr size_t OFF_BAR = OFF_BBAR + 1 * MBy;
constexpr size_t WS_END = OFF_BAR + 1 * MBy;

constexpr int LDS_BYTES = 36864 + 32768;

struct Params {
  const float* in[33];
  float* out;
  unsigned char* ws;
};

DEVI u16 f2bf(float f) {
  u32 u = __float_as_uint(f);
  u += 0x7FFFu + ((u >> 16) & 1u);
  return (u16)(u >> 16);
}
DEVI float bf2f(u16 h) { return __uint_as_float(((u32)h) << 16); }
DEVI u32 pack2(float lo, float hi) { return (u32)f2bf(lo) | ((u32)f2bf(hi) << 16); }
DEVI float bflo(u32 w) { return __uint_as_float(w << 16); }
DEVI float bfhi(u32 w) { return __uint_as_float(w & 0xffff0000u); }
DEVI float sigmoid_(float x) { return __builtin_amdgcn_rcpf(1.f + __expf(-x)); }
DEVI float gelu_(float x) {
  float z = 0.7978845608028654f * (x + 0.044715f * x * x * x);
  return x * __builtin_amdgcn_rcpf(1.f + __expf(-2.f * z));
}
DEVI float softplus_(float x) { return fmaxf(x, 0.f) + log1pf(__expf(-fabsf(x))); }
DEVI void unpack8(const uint4& w, float* f) {
  f[0] = bflo(w.x); f[1] = bfhi(w.x); f[2] = bflo(w.y); f[3] = bfhi(w.y);
  f[4] = bflo(w.z); f[5] = bfhi(w.z); f[6] = bflo(w.w); f[7] = bfhi(w.w);
}
DEVI uint4 pack8(const float* f) {
  uint4 o; o.x = pack2(f[0], f[1]); o.y = pack2(f[2], f[3]); o.z = pack2(f[4], f[5]); o.w = pack2(f[6], f[7]);
  return o;
}

struct LdBF {
  const u16* base; int ld;
  typedef uint4 Raw;
  DEVI Raw load(int row, int k) const { return *reinterpret_cast<const uint4*>(base + (size_t)row * ld + k); }
  DEVI static uint4 cvt(const Raw& r) { return r; }
};
struct RawF { float4 a, b; };
struct LdF32 {
  const float* base; int ld;
  typedef RawF Raw;
  DEVI Raw load(int row, int k) const {
    const float4* q = reinterpret_cast<const float4*>(base + (size_t)row * ld + k);
    RawF r; r.a = q[0]; r.b = q[1]; return r;
  }
  DEVI static uint4 cvt(const Raw& r) {
    uint4 o; o.x = pack2(r.a.x, r.a.y); o.y = pack2(r.a.z, r.a.w); o.z = pack2(r.b.x, r.b.y); o.w = pack2(r.b.z, r.b.w);
    return o;
  }
};

template <class AL, class BL, class EP>
DEVI void gemm_tile(const AL al, const BL bl, const int K, unsigned char* smem, EP ep) {
  u16* As = reinterpret_cast<u16*>(smem);
  u16* Bs = As + 128 * 72;
  const int tid = threadIdx.x, lane = tid & 63, wave = tid >> 6, wm = wave >> 1, wn = wave & 1;
  const int lr = lane & 15, lq = lane >> 4;
  f32x4 acc[4][4];
#pragma unroll
  for (int i = 0; i < 4; ++i)
#pragma unroll
    for (int j = 0; j < 4; ++j) acc[i][j] = f32x4{0.f, 0.f, 0.f, 0.f};
  typename AL::Raw ra[4];
  typename BL::Raw rb[4];
  const int prow = tid >> 3, pk = (tid & 7) * 8;
#pragma unroll
  for (int i = 0; i < 4; ++i) { ra[i] = al.load(prow + i * 32, pk); rb[i] = bl.load(prow + i * 32, pk); }
  for (int kt = 0; kt < K; kt += 64) {
    __syncthreads();
#pragma unroll
    for (int i = 0; i < 4; ++i) {
      *reinterpret_cast<uint4*>(As + (prow + i * 32) * 72 + pk) = AL::cvt(ra[i]);
      *reinterpret_cast<uint4*>(Bs + (prow + i * 32) * 72 + pk) = BL::cvt(rb[i]);
    }
    __syncthreads();
    if (kt + 64 < K) {
#pragma unroll
      for (int i = 0; i < 4; ++i) { ra[i] = al.load(prow + i * 32, kt + 64 + pk); rb[i] = bl.load(prow + i * 32, kt + 64 + pk); }
    }
#pragma unroll
    for (int ks = 0; ks < 2; ++ks) {
      bf16x8 af[4], bfr[4];
#pragma unroll
      for (int i = 0; i < 4; ++i) af[i] = *reinterpret_cast<const bf16x8*>(As + (wm * 64 + i * 16 + lr) * 72 + ks * 32 + lq * 8);
#pragma unroll
      for (int j = 0; j < 4; ++j) bfr[j] = *reinterpret_cast<const bf16x8*>(Bs + (wn * 64 + j * 16 + lr) * 72 + ks * 32 + lq * 8);
#pragma unroll
      for (int i = 0; i < 4; ++i)
#pragma unroll
        for (int j = 0; j < 4; ++j) acc[i][j] = __builtin_amdgcn_mfma_f32_16x16x32_bf16(af[i], bfr[j], acc[i][j], 0, 0, 0);
    }
  }
  __syncthreads();
  ep(acc);
}

typedef __attribute__((address_space(3))) unsigned lds_u32;
template <bool TR = false, class EP>
DEVI void gemm_tile_dma(const u16* A, const int lda, const u16* Bt, const int ldb, const int K, unsigned char* smem, EP ep,
                        const u16* An = nullptr, const u16* Bn = nullptr, const bool pre = false) {
  const int tid = threadIdx.x, lane = tid & 63, wave = tid >> 6, wm = wave >> 1, wn = wave & 1;
  const int lr = lane & 15, lq = lane >> 4;
  f32x4 acc[4][4];
#pragma unroll
  for (int i = 0; i < 4; ++i)
#pragma unroll
    for (int j = 0; j < 4; ++j) acc[i][j] = f32x4{0.f, 0.f, 0.f, 0.f};
  const int rr = lane >> 3, qq = (lane & 7) ^ rr;
  const size_t aoff = (size_t)(wave * 32 + rr) * lda + qq * 8, boff = (size_t)(wave * 32 + rr) * ldb + qq * 8;
  const u16* ag = A + aoff;
  const u16* bg = Bt + boff;
  unsigned char* wbase = smem + wave * 4096;
#define GT_ISSUE(AP_, BP_, stage, kt)                                                                                    \
  do {                                                                                                                   \
    _Pragma("unroll") for (int j = 0; j < 4; ++j) {                                                                      \
      __builtin_amdgcn_global_load_lds((const unsigned*)((AP_) + (size_t)j * 8 * lda + (kt)),                            \
                                       (lds_u32*)(wbase + (stage) * 32768 + j * 1024), 16, 0, 0);                        \
      __builtin_amdgcn_global_load_lds((const unsigned*)((BP_) + (size_t)j * 8 * ldb + (kt)),                            \
                                       (lds_u32*)(wbase + (stage) * 32768 + 16384 + j * 1024), 16, 0, 0);                \
    }                                                                                                                    \
  } while (0)
  if (!pre) {
    __syncthreads();
    GT_ISSUE(ag, bg, 0, 0);
  }
  const int sw = lr & 7;
  int it = 0;
  for (int kt = 0; kt < K; kt += 64, ++it) {
    asm volatile("s_waitcnt vmcnt(0)" ::: "memory");
    __syncthreads();
    if (kt + 64 < K) GT_ISSUE(ag, bg, (it + 1) & 1, kt + 64);
    else if (An != nullptr) GT_ISSUE(An + aoff, Bn + boff, 0, 0);
    const unsigned char* As = smem + (it & 1) * 32768;
    const unsigned char* Bs = As + 16384;
#pragma unroll
    for (int ks = 0; ks < 2; ++ks) {
      bf16x8 af[4], bfr[4];
      const int ch = ((ks * 4 + lq) ^ sw) * 16;
#pragma unroll
      for (int i = 0; i < 4; ++i) af[i] = *reinterpret_cast<const bf16x8*>(As + (wm * 64 + i * 16 + lr) * 128 + ch);
#pragma unroll
      for (int j = 0; j < 4; ++j) bfr[j] = *reinterpret_cast<const bf16x8*>(Bs + (wn * 64 + j * 16 + lr) * 128 + ch);
      __builtin_amdgcn_s_setprio(1);
#pragma unroll
      for (int i = 0; i < 4; ++i)
#pragma unroll
        for (int j = 0; j < 4; ++j)
          acc[i][j] = TR ? __builtin_amdgcn_mfma_f32_16x16x32_bf16(bfr[j], af[i], acc[i][j], 0, 0, 0)
                         : __builtin_amdgcn_mfma_f32_16x16x32_bf16(af[i], bfr[j], acc[i][j], 0, 0, 0);
      __builtin_amdgcn_s_setprio(0);
    }
  }
#undef GT_ISSUE
  if (An == nullptr) __syncthreads();
  ep(acc);
}

DEVI bool tile_map(int it, int nmt, int nnt, int& mt, int& nt) {
  const int xcd = blockIdx.x & 7, j = blockIdx.x >> 3;
  const int per = gridDim.x >> 3;
  const int slot = it * per + j;
  const int S = (slot >> 6) * 8 + xcd;
  const int nsn = nnt >> 3, nsm = nmt >> 3;
  if (S >= nsn * nsm) return false;
  const int sm = S / nsn, sn = S - sm * nsn;
  const int w = slot & 63;
  mt = sm * 8 + (w >> 3);
  nt = sn * 8 + (w & 7);
  return true;
}

template <int PERM>
DEVI void cvt_wt(const float* W, int K, int N, u16* out, int a0, int a1) {
  const int gsz = gridDim.x * 256, gtid = blockIdx.x * 256 + threadIdx.x;
  const int total = N * (K >> 3);
  for (int i = gtid; i < total; i += gsz) {
    const int n = i % N, kv = i / N;
    float v[8];
#pragma unroll
    for (int j = 0; j < 8; ++j) v[j] = W[(size_t)(kv * 8 + j) * N + n];
    int np = n;
    if (PERM == 1) { const int g = n >> 10, o = n & 1023; np = (o >> 4) * 32 + g * 16 + (o & 15); }
    if (PERM == 2) { np = a0 * 512 + (n >> 4) * 32 + a1 * 16 + (n & 15); }
    *reinterpret_cast<uint4*>(out + (size_t)np * K + kv * 8) = pack8(v);
  }
}

DEVI void cvt_plain(const float* src, u16* dst, size_t n8) {
  const size_t gsz = (size_t)gridDim.x * 256, gtid = (size_t)blockIdx.x * 256 + threadIdx.x;
  for (size_t i = gtid; i < n8; i += gsz) {
    const float4* q = reinterpret_cast<const float4*>(src + i * 8);
    float4 a = q[0], b = q[1];
    uint4 o; o.x = pack2(a.x, a.y); o.y = pack2(a.z, a.w); o.z = pack2(b.x, b.y); o.w = pack2(b.z, b.w);
    *reinterpret_cast<uint4*>(dst + i * 8) = o;
  }
}

DEVI void phase_setup(const Params& p) {
  unsigned char* ws = p.ws;
  cvt_wt<0>(p.in[4], 1024, 1024, (u16*)(ws + OFF_WS5IN), 0, 0);
  cvt_wt<1>(p.in[13], 1024, 2048, (u16*)(ws + OFF_WGLU), 0, 0);
  cvt_wt<0>(p.in[14], 1024, 2048, (u16*)(ws + OFF_WRGIN), 0, 0);
  for (int d = 0; d < 2; ++d)
    for (int gate = 0; gate < 2; ++gate)
      for (int h = 0; h < 4; ++h)
        cvt_wt<2>((gate ? p.in[19] : p.in[17]) + (size_t)(d * 4 + h) * 65536, 256, 256,
                  (u16*)(ws + OFF_WGATES) + (size_t)h * 1024 * 256, d, gate);
  cvt_wt<0>(p.in[22], 1024, 1024, (u16*)(ws + OFF_WRGOUT), 0, 0);
  for (int l = 0; l < 2; ++l) {
    cvt_wt<0>(p.in[27] + (size_t)l * 1024 * 2048, 1024, 2048, (u16*)(ws + OFF_WQ) + (size_t)l * 2048 * 1024, 0, 0);
    cvt_wt<0>(p.in[31] + (size_t)l * 256 * 1024, 256, 1024, (u16*)(ws + OFF_WPROJ) + (size_t)l * 1024 * 256, 0, 0);
    cvt_wt<0>(p.in[32] + (size_t)l * 1024 * 1024, 1024, 1024, (u16*)(ws + OFF_WPG) + (size_t)l * 1024 * 1024, 0, 0);
  }
  cvt_plain(p.in[28], (u16*)(ws + OFF_SK), 65536 / 8);
  const int gsz = gridDim.x * 256, gtid = blockIdx.x * 256 + threadIdx.x;
  float2* POW = (float2*)(ws + OFF_POW);
  float2* BBAR = (float2*)(ws + OFF_BBAR);
  for (int i = gtid; i < 2 * 64 * 33 * 64; i += gsz) {
    const int pp = i & 63, n = (i >> 6) % 33, dg = i / (64 * 33);
    const float step = expf(p.in[7][dg]);
    const float lr_ = p.in[5][dg * 64 + pp], li_ = p.in[6][dg * 64 + pp];
    const float mag = expf((float)n * (lr_ * step)), ang = (float)n * (li_ * step);
    POW[i] = float2{mag * cosf(ang), mag * sinf(ang)};
  }
  for (int i = gtid; i < 2 * 64 * 64; i += gsz) {
    const int dg = i >> 6;
    const float step = expf(p.in[7][dg]);
    const float lr_ = p.in[5][i], li_ = p.in[6][i];
    const float mag = expf(lr_ * step), ang = li_ * step;
    const float ar = mag * cosf(ang), ai = mag * sinf(ang);
    const float den = lr_ * lr_ + li_ * li_;
    const float zr = ar - 1.f;
    const float qr = (zr * lr_ + ai * li_) / den, qi = (ai * lr_ - zr * li_) / den;
#pragma unroll
    for (int c = 0; c < 16; ++c) {
      const float br = p.in[8][(size_t)i * 16 + c], bi = p.in[9][(size_t)i * 16 + c];
      BBAR[(size_t)i * 16 + c] = float2{qr * br - qi * bi, qr * bi + qi * br};
    }
  }
}

DEVI float s5_kterm(const Params& p, const float2* POW, const float2* BBAR, int d, int g, int n, int c, int cp) {
  const int dg = d * 64 + g;
  const float* cr = p.in[10] + ((size_t)dg * 16 + c) * 64;
  const float* ci = p.in[11] + ((size_t)dg * 16 + c) * 64;
  const float2* E = POW + ((size_t)dg * 33 + n) * 64;
  const float2* BB = BBAR + (size_t)dg * 64 * 16 + cp;
  float s = 0.f;
#pragma unroll 8
  for (int pp = 0; pp < 64; ++pp) {
    const float2 e = E[pp], bb = BB[pp * 16];
    const float Cr = cr[pp], Ci = ci[pp];
    const float cer = Cr * e.x - Ci * e.y, cei = Cr * e.y + Ci * e.x;
    s += cer * bb.x - cei * bb.y;
  }
  return s;
}

DEVI void phase_tables(const Params& p, int layer, unsigned char* smem);

DEVI void phase_setup2(const Params& p, unsigned char* smem) {
  phase_tables(p, 0, smem);
  phase_tables(p, 1, smem);
  unsigned char* ws = p.ws;
  const int gsz = gridDim.x * 256, gtid = blockIdx.x * 256 + threadIdx.x;
  const float2* POW = (const float2*)(ws + OFF_POW);
  const float2* BBAR = (const float2*)(ws + OFF_BBAR);
  float* KTAB = (float*)(ws + OFF_KTAB);
  u16* WST = (u16*)(ws + OFF_WST);
  u16* BT1 = (u16*)(ws + OFF_BT1);
  for (int i = gtid; i < 64 * 63 * 256; i += gsz) {
    const int cp = i & 15, c = (i >> 4) & 15, ti = (i >> 8) % 63, g = i / (63 * 256);
    const int tau = ti - 31;
    float s = 0.f;
    if (tau >= 0) s += s5_kterm(p, POW, BBAR, 0, g, tau, c, cp);
    if (tau <= 0) s += s5_kterm(p, POW, BBAR, 1, g, -tau, c, cp);
    KTAB[i] = s;
  }
  for (int i = gtid; i < 64 * 256 * 64; i += gsz) {
    const int kv = i & 63, np = (i >> 6) & 255, g = i >> 14;
    const int d = np >> 7, ri = (np >> 6) & 1, pp = np & 63, s = kv >> 1, c0 = (kv & 1) * 8;
    const int npow = d ? s : 31 - s;
    const float2 e = POW[((size_t)(d * 64 + g) * 33 + npow) * 64 + pp];
    float v[8];
#pragma unroll
    for (int j = 0; j < 8; ++j) {
      const float2 bb = BBAR[((size_t)(d * 64 + g) * 64 + pp) * 16 + c0 + j];
      v[j] = ri ? (e.x * bb.y + e.y * bb.x) : (e.x * bb.x - e.y * bb.y);
    }
    *reinterpret_cast<uint4*>(WST + ((size_t)g * 256 + np) * 512 + kv * 8) = pack8(v);
  }
  for (int i = gtid; i < 64 * 512 * 32; i += gsz) {
    const int kv = i & 31, n = (i >> 5) & 511, g = i >> 14;
    const int t = n >> 4, c = n & 15, kk0 = kv * 8;
    const int d = kk0 >> 7, ri = (kk0 >> 6) & 1, p0 = kk0 & 63;
    const int npow = d ? 32 - t : t + 1;
    const int dg = d * 64 + g;
    float v[8];
#pragma unroll
    for (int j = 0; j < 8; ++j) {
      const int pp = p0 + j;
      const float Cr = p.in[10][((size_t)dg * 16 + c) * 64 + pp], Ci = p.in[11][((size_t)dg * 16 + c) * 64 + pp];
      const float2 e = POW[((size_t)dg * 33 + npow) * 64 + pp];
      v[j] = ri ? -(Cr * e.y + Ci * e.x) : (Cr * e.x - Ci * e.y);
    }
    *reinterpret_cast<uint4*>(BT1 + ((size_t)g * 512 + n) * 768 + 512 + kv * 8) = pack8(v);
  }
}

DEVI void phase_setup3(const Params& p) {
  cvt_plain(p.in[0], (u16*)(p.ws + OFF_XIN), (size_t)TS * 1024 / 8);
  const int gsz = gridDim.x * 256, gtid = blockIdx.x * 256 + threadIdx.x;
  const float* KTAB = (const float*)(p.ws + OFF_KTAB);
  u16* BT1 = (u16*)(p.ws + OFF_BT1);
  for (int i = gtid; i < 64 * 512 * 64; i += gsz) {
    const int kv = i & 63, n = (i >> 6) & 511, g = i >> 15;
    const int t = n >> 4, c = n & 15, s = kv >> 1, c0 = (kv & 1) * 8;
    const float* src = KTAB + (((size_t)g * 63 + (t - s + 31)) * 16 + c) * 16 + c0;
    float v[8];
#pragma unroll
    for (int j = 0; j < 8; ++j) v[j] = src[j];
    *reinterpret_cast<uint4*>(BT1 + ((size_t)g * 512 + n) * 768 + kv * 8) = pack8(v);
  }
}

DEVI void phase_s5_in(const Params& p, int s, unsigned char* smem) {
  const u16* XIN = (const u16*)(p.ws + OFF_XIN);
  const u16* Wt = (const u16*)(p.ws + OFF_WS5IN);
  u16* AP = (u16*)(p.ws + OFF_AP);
  const int lane = threadIdx.x & 63, wave = threadIdx.x >> 6, wm = wave >> 1, wn = wave & 1;
  bool pre_ = false;
  for (int it = 0, mt, nt; tile_map(it, 256, 8, mt, nt); ++it) {
    int mtn, ntn;
    const bool nxt_ = tile_map(it + 1, 256, 8, mtn, ntn);
    const int m0 = mt * 128, n0 = nt * 128;
    gemm_tile_dma<true>(XIN + (size_t)m0 * 1024, 1024, Wt + (size_t)n0 * 1024, 1024, 1024, smem, [&](f32x4 (&acc)[4][4]) {
#pragma unroll
      for (int i = 0; i < 4; ++i)
#pragma unroll
        for (int j = 0; j < 4; ++j) {
          const int row = m0 + wm * 64 + i * 16 + (lane & 15);
          const int col = n0 + wn * 64 + j * 16 + (lane >> 4) * 4;
          uint2 w; w.x = pack2(acc[i][j][0], acc[i][j][1]); w.y = pack2(acc[i][j][2], acc[i][j][3]);
          *reinterpret_cast<uint2*>(AP + ((size_t)(col >> 4) * 1024 + (row >> 5)) * 768 + (row & 31) * 16 + (col & 15)) = w;
        }
    }, nxt_ ? (XIN + (size_t)(mtn * 128) * 1024) : nullptr, nxt_ ? (Wt + (size_t)(ntn * 128) * 1024) : nullptr, pre_);
    pre_ = nxt_;
  }
}

DEVI void phase_s5_state(const Params& p, unsigned char* smem) {
  const u16* AP = (const u16*)(p.ws + OFF_AP);
  const u16* WST = (const u16*)(p.ws + OFF_WST);
  float* HLOC = (float*)(p.ws + OFF_HLOC);
  const int lane = threadIdx.x & 63, wave = threadIdx.x >> 6, wm = wave >> 1, wn = wave & 1;
  for (int tile = blockIdx.x; tile < 64 * 16; tile += gridDim.x) {
    const int g = tile >> 4, m0 = ((tile >> 1) & 7) * 128, n0 = (tile & 1) * 128;
    gemm_tile_dma(AP + ((size_t)g * 1024 + m0) * 768, 768, WST + ((size_t)g * 256 + n0) * 512, 512, 512, smem, [&](f32x4 (&acc)[4][4]) {
#pragma unroll
      for (int i = 0; i < 4; ++i)
#pragma unroll
        for (int j = 0; j < 4; ++j)
#pragma unroll
          for (int r = 0; r < 4; ++r) {
            const int row = m0 + wm * 64 + i * 16 + (lane >> 4) * 4 + r;
            const int col = n0 + wn * 64 + j * 16 + (lane & 15);
            HLOC[((size_t)g * 1024 + row) * 256 + col] = acc[i][j][r];
          }
    });
  }
}

DEVI void phase_s5_cscan(const Params& p, int s) {
  const int L = s ? 2048 : 4096;
  const int nseq = TS / L, nch = L / 32;
  u16* AP = (u16*)(p.ws + OFF_AP);
  const float* HLOC = (const float*)(p.ws + OFF_HLOC);
  const float2* POW = (const float2*)(p.ws + OFF_POW);
  const int gsz = gridDim.x * 256, gtid = blockIdx.x * 256 + threadIdx.x;
  for (int i = gtid; i < 64 * nseq * 128; i += gsz) {
    const int pp = i & 63, d = (i >> 6) & 1, g = (i >> 7) & 63, seq = i >> 13;
    const float2 e = POW[((size_t)(d * 64 + g) * 33 + 32) * 64 + pp];
    float Hr = 0.f, Hi = 0.f;
#pragma unroll 8
    for (int j = 0; j < nch; ++j) {
      const int chunk = seq * nch + (d ? (nch - 1 - j) : j);
      u16* ap = AP + ((size_t)g * 1024 + chunk) * 768 + 512 + d * 128 + pp;
      ap[0] = f2bf(Hr);
      ap[64] = f2bf(Hi);
      const float* hl = HLOC + ((size_t)g * 1024 + chunk) * 256 + d * 128 + pp;
      const float a = hl[0], b = hl[64];
      const float nHr = e.x * Hr - e.y * Hi + a;
      const float nHi = e.x * Hi + e.y * Hr + b;
      Hr = nHr; Hi = nHi;
    }
  }
}

DEVI void phase_s5_main(const Params& p, unsigned char* smem) {
  const u16* AP = (const u16*)(p.ws + OFF_AP);
  const u16* BT1 = (const u16*)(p.ws + OFF_BT1);
  u16* HB = (u16*)(p.ws + OFF_HB);
  const float* dsk = p.in[12];
  const int lane = threadIdx.x & 63, wave = threadIdx.x >> 6, wm = wave >> 1, wn = wave & 1;
  for (int tile = blockIdx.x; tile < 64 * 32; tile += gridDim.x) {
    const int g = tile >> 5, m0 = ((tile >> 2) & 7) * 128, n0 = (tile & 3) * 128;
    gemm_tile_dma(AP + ((size_t)g * 1024 + m0) * 768, 768, BT1 + ((size_t)g * 512 + n0) * 768, 768, 768, smem, [&](f32x4 (&acc)[4][4]) {
      const float dv = dsk[g * 16 + (lane & 15)];
#pragma unroll
      for (int i = 0; i < 4; ++i)
#pragma unroll
        for (int j = 0; j < 4; ++j)
#pragma unroll
          for (int r = 0; r < 4; ++r) {
            const int chunk = m0 + wm * 64 + i * 16 + (lane >> 4) * 4 + r;
            const int n = n0 + wn * 64 + j * 16 + (lane & 15);
            const float u = bf2f(AP[((size_t)g * 1024 + chunk) * 768 + n]);
            const float y = acc[i][j][r] + dv * u;
            HB[((size_t)chunk * 32 + (n >> 4)) * 1024 + g * 16 + (lane & 15)] = f2bf(gelu_(y));
          }
    });
  }
}

DEVI void phase_s5_glu(const Params& p, int s, unsigned char* smem) {
  const u16* HB = (const u16*)(p.ws + OFF_HB);
  const u16* Wt = (const u16*)(p.ws + OFF_WGLU);
  const float* Xin = p.in[s];
  u16* ZB = (u16*)(p.ws + OFF_XB);
  const int lane = threadIdx.x & 63, wave = threadIdx.x >> 6, wm = wave >> 1, wn = wave & 1;
  bool pre_ = false;
  for (int it = 0, mt, nt; tile_map(it, 256, 16, mt, nt); ++it) {
    int mtn, ntn;
    const bool nxt_ = tile_map(it + 1, 256, 16, mtn, ntn);
    const int m0 = mt * 128, n0 = nt * 128;
    gemm_tile_dma<true>(HB + (size_t)m0 * 1024, 1024, Wt + (size_t)n0 * 1024, 1024, 1024, smem, [&](f32x4 (&acc)[4][4]) {
#pragma unroll
      for (int i = 0; i < 4; ++i)
#pragma unroll
        for (int jj = 0; jj < 4; jj += 2) {
          const int row = m0 + wm * 64 + i * 16 + (lane & 15);
          const int nb = n0 + wn * 64 + jj * 16;
          const int o = (nb >> 5) * 16 + (lane >> 4) * 4;
          const size_t idx = (size_t)row * 1024 + o;
          const float4 xi = *reinterpret_cast<const float4*>(Xin + idx);
          float4 v;
          v.x = ALPHA * xi.x + acc[i][jj][0] * sigmoid_(acc[i][jj + 1][0]);
          v.y = ALPHA * xi.y + acc[i][jj][1] * sigmoid_(acc[i][jj + 1][1]);
          v.z = ALPHA * xi.z + acc[i][jj][2] * sigmoid_(acc[i][jj + 1][2]);
          v.w = ALPHA * xi.w + acc[i][jj][3] * sigmoid_(acc[i][jj + 1][3]);
          uint2 w; w.x = pack2(v.x, v.y); w.y = pack2(v.z, v.w);
          *reinterpret_cast<uint2*>(ZB + idx) = w;
        }
    }, nxt_ ? (HB + (size_t)(mtn * 128) * 1024) : nullptr, nxt_ ? (Wt + (size_t)(ntn * 128) * 1024) : nullptr, pre_);
    pre_ = nxt_;
  }
}

DEVI void phase_ln1_tables(const Params& p, int s, int layer, unsigned char* smem) {
  float* X = p.out + (size_t)s * TS * 1024;
  u16* XB = (u16*)(p.ws + OFF_XB);
  const float* gam = p.in[23] + layer * 1024;
  const float* bet = p.in[24] + layer * 1024;
  const int lane = threadIdx.x & 63, wave = threadIdx.x >> 6;
  for (int t = blockIdx.x * 4 + wave; t < TS; t += gridDim.x * 4) {
    float4 v[4];
#pragma unroll
    for (int i = 0; i < 4; ++i) {
      const uint2 w = *reinterpret_cast<const uint2*>(XB + (size_t)t * 1024 + i * 256 + lane * 4);
      v[i] = float4{bflo(w.x), bfhi(w.x), bflo(w.y), bfhi(w.y)};
    }
    float sm = 0.f;
#pragma unroll
    for (int i = 0; i < 4; ++i) sm += v[i].x + v[i].y + v[i].z + v[i].w;
#pragma unroll
    for (int m = 32; m >= 1; m >>= 1) sm += __shfl_xor(sm, m);
    const float mu = sm * (1.f / 1024.f);
    float sq = 0.f;
#pragma unroll
    for (int i = 0; i < 4; ++i) {
      const float a = v[i].x - mu, b = v[i].y - mu, c = v[i].z - mu, d = v[i].w - mu;
      sq += a * a + b * b + c * c + d * d;
    }
#pragma unroll
    for (int m = 32; m >= 1; m >>= 1) sq += __shfl_xor(sq, m);
    const float rs = rsqrtf(sq * (1.f / 1024.f) + LN_EPS);
#pragma unroll
    for (int i = 0; i < 4; ++i) {
      const int c0 = i * 256 + lane * 4;
      const float4 g4 = *reinterpret_cast<const float4*>(gam + c0);
      const float4 b4 = *reinterpret_cast<const float4*>(bet + c0);
      float4 o;
      o.x = (v[i].x - mu) * rs * g4.x + b4.x; o.y = (v[i].y - mu) * rs * g4.y + b4.y;
      o.z = (v[i].z - mu) * rs * g4.z + b4.z; o.w = (v[i].w - mu) * rs * g4.w + b4.w;
      uint2 pk; pk.x = pack2(o.x, o.y); pk.y = pack2(o.z, o.w);
      *reinterpret_cast<uint2*>(XB + (size_t)t * 1024 + c0) = pk;
    }
  }
}

DEVI void phase_tables(const Params& p, int layer, unsigned char* smem) {
  const int lane = threadIdx.x & 63, wave = threadIdx.x >> 6;
  float* SCL = (float*)(p.ws + OFF_SCL + (size_t)layer * TB_STRIDE);
  float* lds = reinterpret_cast<float*>(smem) + (threadIdx.x & 63) + (threadIdx.x >> 6) * 2048;
  int srck[32];
  {
    v16f ra, rb;
#pragma unroll
    for (int j = 0; j < 16; ++j) { ra[j] = (j < 8) ? 0.125f * j : 1.f + 0.125f * (j - 8); rb[j] = (j < 8) ? 2.f + 0.25f * j : 4.f + 0.5f * (j - 8); }
    const v6u pk = __builtin_amdgcn_cvt_scalef32_2xpk16_fp6_f32(ra, rb, 1.0f);
    const v32f dd = __builtin_amdgcn_cvt_scalef32_pk32_f32_fp6(pk, 1.0f);
#pragma unroll
    for (int k = 0; k < 32; ++k) {
      const float v = dd[k];
      const float fi = v < 1.f ? v * 8.f : (v < 2.f ? 8.f + (v - 1.f) * 8.f : (v < 4.f ? 16.f + (v - 2.f) * 4.f : 24.f + (v - 4.f) * 2.f));
      srck[k] = ((int)(fi + 0.5f)) & 31;
    }
  }
  const int ll = lane & 31, hs = lane >> 5;
  for (int r2 = blockIdx.x * 4 + wave; r2 < 16384; r2 += gridDim.x * 4) {
    const int r = r2 * 2 + hs;
    const int tab = r >> 14, row = r & 16383;
    const float4* sp = reinterpret_cast<const float4*>(p.in[29 + tab] + ((size_t)layer * 16384 + row) * 1024 + ll * 32);
    float s[32];
#pragma unroll
    for (int j = 0; j < 8; ++j) { const float4 a = sp[j]; s[4 * j] = a.x; s[4 * j + 1] = a.y; s[4 * j + 2] = a.z; s[4 * j + 3] = a.w; }
    float am = 0.f;
#pragma unroll
    for (int k = 0; k < 32; ++k) am = fmaxf(am, fabsf(s[k]));
#pragma unroll
    for (int m = 16; m >= 1; m >>= 1) am = fmaxf(am, __shfl_xor(am, m));
    const float sc = am > 0.f ? 7.5f / am : 1.f;
    const float inv = am > 0.f ? am * (1.f / 7.5f) : 1.f;
#pragma unroll
    for (int k = 0; k < 32; ++k) lds[srck[k] * 64] = s[k] * sc;
    v16f ia, ib;
#pragma unroll
    for (int j = 0; j < 16; ++j) { ia[j] = lds[j * 64]; ib[j] = lds[(16 + j) * 64]; }
    const v6u pk = __builtin_amdgcn_cvt_scalef32_2xpk16_fp6_f32(ia, ib, 1.0f);
    unsigned char* dst = p.ws + (size_t)layer * TB_STRIDE + (tab ? OFF_VB8 : OFF_UB8) + (size_t)row * 768;
    *reinterpret_cast<uint4*>(dst + ll * 16) = uint4{pk[0], pk[1], pk[2], pk[3]};
    *reinterpret_cast<uint2*>(dst + 512 + ll * 8) = uint2{pk[4], pk[5]};
    if (ll == 0) SCL[tab * 16384 + row] = inv;
  }
}

DEVI u32 enc_key(float s, int n) {
  u32 b = __float_as_uint(s);
  u32 srt = (b & 0x80000000u) ? ~b : (b | 0x80000000u);
  return (srt & ~127u) | (u32)(127 - n);
}
DEVI float dec_key(u32 key, int& n) {
  n = 127 - (int)(key & 127u);
  u32 srt = key & ~127u;
  u32 b = (srt & 0x80000000u) ? (srt & 0x7fffffffu) : ~srt;
  return __uint_as_float(b);
}

DEVI void phase_peer_q(const Params& p, int layer, unsigned char* smem) {
  const u16* XB = (const u16*)(p.ws + OFF_XB);
  const u16* Wt = (const u16*)(p.ws + OFF_WQ) + (size_t)layer * 2048 * 1024;
  const u16* SK = (const u16*)(p.ws + OFF_SK) + (size_t)layer * 2 * 128 * 128;
  u32* KEYS = (u32*)(p.ws + OFF_KEYS);
  const int tid = threadIdx.x, lane = tid & 63, wave = tid >> 6, wm = wave >> 1, wn = wave & 1;
  const int lr = lane & 15, lq = lane >> 4;
  u16* Qs = reinterpret_cast<u16*>(smem);
  u32* Sk = reinterpret_cast<u32*>(smem);
  for (int it = 0, mt, nt; tile_map(it, 256, 16, mt, nt); ++it) {
    const int m0 = mt * 128, hc = nt, n0 = hc * 128;
    const int c = hc & 1;
    gemm_tile_dma(XB + (size_t)m0 * 1024, 1024, Wt + (size_t)n0 * 1024, 1024, 1024, smem, [&](f32x4 (&acc)[4][4]) {
#pragma unroll
      for (int i = 0; i < 4; ++i)
#pragma unroll
        for (int j = 0; j < 4; ++j)
#pragma unroll
          for (int r = 0; r < 4; ++r)
            Qs[(wm * 64 + i * 16 + lq * 4 + r) * 136 + wn * 64 + j * 16 + lr] = f2bf(acc[i][j][r]);
      __syncthreads();
      f32x4 sc[4][4];
#pragma unroll
      for (int i = 0; i < 4; ++i)
#pragma unroll
        for (int j = 0; j < 4; ++j) sc[i][j] = f32x4{0.f, 0.f, 0.f, 0.f};
      const u16* skc = SK + (size_t)c * 128 * 128;
#pragma unroll
      for (int ks = 0; ks < 4; ++ks) {
        bf16x8 af[4], bfr[4];
#pragma unroll
        for (int i = 0; i < 4; ++i) af[i] = *reinterpret_cast<const bf16x8*>(Qs + (wm * 64 + i * 16 + lr) * 136 + ks * 32 + lq * 8);
#pragma unroll
        for (int j = 0; j < 4; ++j) bfr[j] = *reinterpret_cast<const bf16x8*>(skc + (size_t)(wn * 64 + j * 16 + lr) * 128 + ks * 32 + lq * 8);
#pragma unroll
        for (int i = 0; i < 4; ++i)
#pragma unroll
          for (int j = 0; j < 4; ++j) sc[i][j] = __builtin_amdgcn_mfma_f32_16x16x32_bf16(af[i], bfr[j], sc[i][j], 0, 0, 0);
      }
      __syncthreads();
#pragma unroll
      for (int i = 0; i < 4; ++i)
#pragma unroll
        for (int j = 0; j < 4; ++j)
#pragma unroll
          for (int r = 0; r < 4; ++r) {
            const int n = wn * 64 + j * 16 + lr;
            Sk[(wm * 64 + i * 16 + lq * 4 + r) * 129 + n] = enc_key(sc[i][j][r], n);
          }
      __syncthreads();
      if (tid < 128) {
        u32 top[16];
#pragma unroll
        for (int k = 0; k < 16; ++k) top[k] = 0u;
#pragma unroll 4
        for (int n = 0; n < 128; ++n) {
          u32 v = Sk[tid * 129 + n];
#pragma unroll
          for (int k = 0; k < 16; ++k) {
            const u32 hi = max(top[k], v);
            v = min(top[k], v);
            top[k] = hi;
          }
        }
        uint4* dst = reinterpret_cast<uint4*>(KEYS + ((size_t)(m0 + tid) * 16 + hc) * 16);
        dst[0] = uint4{top[0], top[1], top[2], top[3]};
        dst[1] = uint4{top[4], top[5], top[6], top[7]};
        dst[2] = uint4{top[8], top[9], top[10], top[11]};
        dst[3] = uint4{top[12], top[13], top[14], top[15]};
      }
    });
  }
}

DEVI void phase_peer_route(const Params& p, int s, int layer) {
  cvt_plain(p.in[2 + s] + (size_t)layer * TS * 256, (u16*)(p.ws + OFF_PB), (size_t)TS * 256 / 8);
  const u32* KEYS = (const u32*)(p.ws + OFF_KEYS);
  int* IDX = (int*)(p.ws + OFF_IDX);
  float* GATE = (float*)(p.ws + OFF_GATE);
  float* SU = (float*)(p.ws + OFF_SU);
  const float* SCL = (const float*)(p.ws + OFF_SCL + (size_t)layer * TB_STRIDE);
  const int gsz = gridDim.x * 256, gtid = blockIdx.x * 256 + threadIdx.x;
  for (int i = gtid; i < TS * 8; i += gsz) {
    const uint4* src = reinterpret_cast<const uint4*>(KEYS + (size_t)i * 32);
    u32 kk[32];
#pragma unroll
    for (int q = 0; q < 8; ++q) { const uint4 w = src[q]; kk[q * 4] = w.x; kk[q * 4 + 1] = w.y; kk[q * 4 + 2] = w.z; kk[q * 4 + 3] = w.w; }
    float s0[16], s1[16]; int i0[16], i1[16];
#pragma unroll
    for (int k = 0; k < 16; ++k) { s0[k] = dec_key(kk[k], i0[k]); s1[k] = dec_key(kk[16 + k], i1[k]); }
    float top[16];
#pragma unroll
    for (int k = 0; k < 16; ++k) top[k] = -3.0e38f;
#pragma unroll
    for (int k1 = 0; k1 < 16; ++k1)
#pragma unroll
      for (int k2 = 0; k2 < 16; ++k2)
        if ((k1 + 1) * (k2 + 1) <= 16) {
          float v = s0[k1] + s1[k2];
#pragma unroll
          for (int k = 0; k < 16; ++k) {
            const float hi = fmaxf(top[k], v);
            v = fminf(top[k], v);
            top[k] = hi;
          }
        }
    const float thr = top[15], mx = top[0];
    float den = 0.f;
#pragma unroll
    for (int k = 0; k < 16; ++k) den += __expf(top[k] - mx);
    const float inv = 1.f / den;
    int cnt = 0;
    int* idst = IDX + (size_t)i * 16;
    float* gdst = GATE + (size_t)i * 16;
    float* sdst = SU + (size_t)i * 16;
#pragma unroll
    for (int k1 = 0; k1 < 16; ++k1)
#pragma unroll
      for (int k2 = 0; k2 < 16; ++k2)
        if ((k1 + 1) * (k2 + 1) <= 16) {
          const float v = s0[k1] + s1[k2];
          if (v >= thr && cnt < 16) {
            const int e = i0[k1] * 128 + i1[k2];
            idst[cnt] = e;
            gdst[cnt] = __expf(v - mx) * inv * SCL[16384 + e];
            sdst[cnt] = SCL[e];
            ++cnt;
          }
        }
  }
}

DEVI f2 cvt8(u32 w, bool hi) { return hi ? __builtin_amdgcn_cvt_pk_f32_fp8((int)w, true) : __builtin_amdgcn_cvt_pk_f32_fp8((int)w, false); }

DEVI v32f ld_fp6_row(const unsigned char* base, int ei, int ll) {
  const unsigned char* r = base + (size_t)ei * 768;
  const uint4 a = *reinterpret_cast<const uint4*>(r + ll * 16);
  const uint2 b = *reinterpret_cast<const uint2*>(r + 512 + ll * 8);
  v6u pk; pk[0] = a.x; pk[1] = a.y; pk[2] = a.z; pk[3] = a.w; pk[4] = b.x; pk[5] = b.y;
  return __builtin_amdgcn_cvt_scalef32_pk32_f32_fp6(pk, 1.0f);
}

struct Raw6 { uint4 a; uint2 b; };
DEVI Raw6 ld_raw6(const unsigned char* base, int ei, int ll) {
  const unsigned char* r = base + (size_t)ei * 768;
  Raw6 o;
  o.a = *reinterpret_cast<const uint4*>(r + ll * 16);
  o.b = *reinterpret_cast<const uint2*>(r + 512 + ll * 8);
  return o;
}
DEVI v32f dec6(const Raw6& r) {
  v6u pk; pk[0] = r.a.x; pk[1] = r.a.y; pk[2] = r.a.z; pk[3] = r.a.w; pk[4] = r.b.x; pk[5] = r.b.y;
  return __builtin_amdgcn_cvt_scalef32_pk32_f32_fp6(pk, 1.0f);
}

DEVI void phase_peer_gather(const Params& p, int s, int layer) {
  float* X = p.out + (size_t)s * TS * 1024;
  u16* XB = (u16*)(p.ws + OFF_XB);
  const unsigned char* Ub = p.ws + OFF_UB8 + (size_t)layer * TB_STRIDE;
  const unsigned char* Vb = p.ws + OFF_VB8 + (size_t)layer * TB_STRIDE;
  const int* IDX = (const int*)(p.ws + OFF_IDX);
  const float* GATE = (const float*)(p.ws + OFF_GATE);
  const float* SU = (const float*)(p.ws + OFF_SU);
  const float* gam = p.in[25] + layer * 1024;
  const float* bet = p.in[26] + layer * 1024;
  const int lane = threadIdx.x & 63, wave = threadIdx.x >> 6;
  const int ll = lane & 31, hs = lane >> 5;
  const bool b4 = lane & 16, b3 = lane & 8;
  for (int t = blockIdx.x * 4 + wave; t < TS; t += gridDim.x * 4) {
    float x[32], o[32];
    {
      const uint4* xp = reinterpret_cast<const uint4*>(XB + (size_t)t * 1024 + ll * 32);
#pragma unroll
      for (int j = 0; j < 4; ++j) { const uint4 a = xp[j]; unpack8(a, x + 8 * j); }
    }
#pragma unroll
    for (int k = 0; k < 32; ++k) o[k] = 0.f;
    const int iv0 = IDX[(size_t)t * 128 + lane], iv1 = IDX[(size_t)t * 128 + 64 + lane];
    const float gv0 = GATE[(size_t)t * 128 + lane], gv1 = GATE[(size_t)t * 128 + 64 + lane];
    const float su0 = SU[(size_t)t * 128 + lane], su1 = SU[(size_t)t * 128 + 64 + lane];
    for (int e0 = 0; e0 < 128; e0 += 8) {
      const bool lo = e0 < 64;
      const int ivs = lo ? iv0 : iv1;
      const float gvs = lo ? gv0 : gv1;
      const float sus = lo ? su0 : su1;
      int ei[4];
#pragma unroll
      for (int q = 0; q < 4; ++q) {
        const int ea = __builtin_amdgcn_readlane(ivs, (e0 & 63) + 2 * q);
        const int eb = __builtin_amdgcn_readlane(ivs, (e0 & 63) + 2 * q + 1);
        ei[q] = hs ? eb : ea;
      }
      Raw6 cu[4], cv[4];
#pragma unroll
      for (int q = 0; q < 4; ++q) { cu[q] = ld_raw6(Ub, ei[q], ll); cv[q] = ld_raw6(Vb, ei[q], ll); }
      float dq[4];
#pragma unroll
      for (int q = 0; q < 4; ++q) {
        const v32f u = dec6(cu[q]);
        float d0 = 0.f, d1 = 0.f;
#pragma unroll
        for (int k = 0; k < 32; k += 2) { d0 = fmaf(u[k], x[k], d0); d1 = fmaf(u[k + 1], x[k + 1], d1); }
        dq[q] = d0 + d1;
      }
      float d2[2], d1;
#pragma unroll
      for (int k = 0; k < 2; ++k) {
        const float keep = b4 ? dq[k + 2] : dq[k], send = b4 ? dq[k] : dq[k + 2];
        d2[k] = keep + __shfl_xor(send, 16);
      }
      {
        const float keep = b3 ? d2[1] : d2[0], send = b3 ? d2[0] : d2[1];
        d1 = keep + __shfl_xor(send, 8);
      }
      d1 += __shfl_xor(d1, 4);
      d1 += __shfl_xor(d1, 2);
      d1 += __shfl_xor(d1, 1);
      const int qmine = (b4 ? 2 : 0) + (b3 ? 1 : 0);
      const int srcl = (e0 & 63) + 2 * qmine + hs;
      const float suv = __shfl(sus, srcl), gvv = __shfl(gvs, srcl);
      const float w = gvv * gelu_(d1 * suv);
#pragma unroll
      for (int q = 0; q < 4; ++q) {
        const float wq = __shfl(w, (lane & 32) | ((q >> 1) << 4) | ((q & 1) << 3));
        const v32f v = dec6(cv[q]);
#pragma unroll
        for (int k = 0; k < 32; ++k) o[k] = fmaf(wq, v[k], o[k]);
      }
    }
    float sm = 0.f;
#pragma unroll
    for (int k = 0; k < 32; ++k) { o[k] += __shfl_xor(o[k], 32); o[k] = ALPHA * x[k] + o[k]; sm += o[k]; }
#pragma unroll
    for (int m = 16; m >= 1; m >>= 1) sm += __shfl_xor(sm, m);
    const float mu = sm * (1.f / 1024.f);
    float sq = 0.f;
#pragma unroll
    for (int k = 0; k < 32; ++k) { const float dd = o[k] - mu; sq += dd * dd; }
#pragma unroll
    for (int m = 16; m >= 1; m >>= 1) sq += __shfl_xor(sq, m);
    const float rs = rsqrtf(sq * (1.f / 1024.f) + LN_EPS);
    if (hs == 0) {
      const int c0 = ll * 32;
#pragma unroll
      for (int j = 0; j < 4; ++j) {
        float r[8];
#pragma unroll
        for (int k = 0; k < 8; ++k) r[k] = (o[j * 8 + k] - mu) * rs * gam[c0 + j * 8 + k] + bet[c0 + j * 8 + k];
        float4* dp = reinterpret_cast<float4*>(X + (size_t)t * 1024 + c0 + j * 8);
        dp[0] = float4{r[0], r[1], r[2], r[3]};
        dp[1] = float4{r[4], r[5], r[6], r[7]};
        *reinterpret_cast<uint4*>(XB + (size_t)t * 1024 + c0 + j * 8) = pack8(r);
      }
    }
  }
}

DEVI void phase_ple(const Params& p, int s, int layer, unsigned char* smem) {
  float* X = p.out + (size_t)s * TS * 1024;
  const u16* XB = (const u16*)(p.ws + OFF_XB);
  const u16* PB = (const u16*)(p.ws + OFF_PB);
  u16* XB2 = (u16*)(p.ws + OFF_XB2);
  const u16* Wp = (const u16*)(p.ws + OFF_WPROJ) + (size_t)layer * 1024 * 256;
  const u16* Wg = (const u16*)(p.ws + OFF_WPG) + (size_t)layer * 1024 * 1024;
  const int lane = threadIdx.x & 63, wave = threadIdx.x >> 6, wm = wave >> 1, wn = wave & 1;
  for (int it = 0, mt, nt; tile_map(it, 256, 8, mt, nt); ++it) {
    const int m0 = mt * 128, n0 = nt * 128;
    u32 pk[4][4][2];
    gemm_tile_dma(XB + (size_t)m0 * 1024, 1024, Wg + (size_t)n0 * 1024, 1024, 1024, smem, [&](f32x4 (&acc)[4][4]) {
#pragma unroll
      for (int i = 0; i < 4; ++i)
#pragma unroll
        for (int j = 0; j < 4; ++j) {
          pk[i][j][0] = pack2(sigmoid_(acc[i][j][0]), sigmoid_(acc[i][j][1]));
          pk[i][j][1] = pack2(sigmoid_(acc[i][j][2]), sigmoid_(acc[i][j][3]));
        }
    });
    gemm_tile_dma(PB + (size_t)m0 * 256, 256, Wp + (size_t)n0 * 256, 256, 256, smem, [&](f32x4 (&acc)[4][4]) {
#pragma unroll
      for (int i = 0; i < 4; ++i)
#pragma unroll
        for (int j = 0; j < 4; ++j)
#pragma unroll
          for (int r = 0; r < 4; ++r) {
            const int row = m0 + wm * 64 + i * 16 + (lane >> 4) * 4 + r;
            const int col = n0 + wn * 64 + j * 16 + (lane & 15);
            const u32 w = pk[i][j][r >> 1];
            const float sg = (r & 1) ? bfhi(w) : bflo(w);
            const size_t idx = (size_t)row * 1024 + col;
            const float v = X[idx] + acc[i][j][r] * sg;
            X[idx] = v;
            if (layer == 0) XB2[idx] = f2bf(v);
          }
    });
  }
  if (layer == 1 && s == 0) cvt_plain(p.in[1], (u16*)(p.ws + OFF_XIN), (size_t)TS * 1024 / 8);
}

DEVI void phase_rg_in(const Params& p, int s, unsigned char* smem) {
  const u16* XB2 = (const u16*)(p.ws + OFF_XB2);
  const u16* Wt = (const u16*)(p.ws + OFF_WRGIN);
  u16* GG = (u16*)(p.ws + OFF_GG);
  u16* R = (u16*)(p.ws + OFF_R);
  const int lane = threadIdx.x & 63, wave = threadIdx.x >> 6, wm = wave >> 1, wn = wave & 1;
  bool pre_ = false;
  for (int it = 0, mt, nt; tile_map(it, 256, 16, mt, nt); ++it) {
    int mtn, ntn;
    const bool nxt_ = tile_map(it + 1, 256, 16, mtn, ntn);
    const int m0 = mt * 128, n0 = nt * 128;
    gemm_tile_dma<true>(XB2 + (size_t)m0 * 1024, 1024, Wt + (size_t)n0 * 1024, 1024, 1024, smem, [&](f32x4 (&acc)[4][4]) {
#pragma unroll
      for (int i = 0; i < 4; ++i)
#pragma unroll
        for (int j = 0; j < 4; ++j) {
          const int row = m0 + wm * 64 + i * 16 + (lane & 15);
          const int col = n0 + wn * 64 + j * 16 + (lane >> 4) * 4;
          uint2 w;
          if (n0 < 1024) {
            w.x = pack2(gelu_(acc[i][j][0]), gelu_(acc[i][j][1])); w.y = pack2(gelu_(acc[i][j][2]), gelu_(acc[i][j][3]));
            *reinterpret_cast<uint2*>(GG + (size_t)row * 1024 + col) = w;
          } else {
            w.x = pack2(acc[i][j][0], acc[i][j][1]); w.y = pack2(acc[i][j][2], acc[i][j][3]);
            *reinterpret_cast<uint2*>(R + (size_t)row * 1024 + col - 1024) = w;
          }
        }
    }, nxt_ ? (XB2 + (size_t)(mtn * 128) * 1024) : nullptr, nxt_ ? (Wt + (size_t)(ntn * 128) * 1024) : nullptr, pre_);
    pre_ = nxt_;
  }
}

DEVI void phase_rg_conv(const Params& p, int s) {
  const int L = s ? 2048 : 4096;
  const u16* R = (const u16*)(p.ws + OFF_R);
  u16* C = (u16*)(p.ws + OFF_C);
  const float* cw = p.in[15];
  const float* cb = p.in[16];
  const int gsz = gridDim.x * 256, gtid = blockIdx.x * 256 + threadIdx.x;
  for (int i = gtid; i < TS * 128; i += gsz) {
    const int t = i >> 7, cv = (i & 127) * 8;
    const int pos = t & (L - 1);
    float acc[8];
#pragma unroll
    for (int j = 0; j < 8; ++j) acc[j] = cb[cv + j];
#pragma unroll
    for (int k = 0; k < 4; ++k) {
      const int pp = pos + k - 1;
      if (pp >= 0 && pp < L) {
        float rv[8];
        unpack8(*reinterpret_cast<const uint4*>(R + (size_t)(t + k - 1) * 1024 + cv), rv);
#pragma unroll
        for (int j = 0; j < 8; ++j) acc[j] = fmaf(rv[j], cw[k * 1024 + cv + j], acc[j]);
      }
    }
    *reinterpret_cast<uint4*>(C + (size_t)i * 8) = pack8(acc);
  }
}

DEVI void phase_rg_gates(const Params& p, unsigned char* smem) {
  const u16* C = (const u16*)(p.ws + OFF_C);
  const u16* Wt = (const u16*)(p.ws + OFF_WGATES);
  u32* AB = (u32*)(p.ws + OFF_AB);
  const float* ba = p.in[18];
  const float* bx = p.in[20];
  const float* lam = p.in[21];
  const int lane = threadIdx.x & 63, wave = threadIdx.x >> 6, wm = wave >> 1, wn = wave & 1;
  for (int it = 0, mt, nt32; tile_map(it, 256, 32, mt, nt32); ++it) {
    const int m0 = mt * 128, h = nt32 >> 3, nt = nt32 & 7, n0 = nt * 128;
    gemm_tile_dma(C + (size_t)m0 * 1024 + h * 256, 1024, Wt + ((size_t)h * 1024 + n0) * 256, 256, 256, smem, [&](f32x4 (&acc)[4][4]) {
#pragma unroll
      for (int jj = 0; jj < 4; jj += 2) {
        const int nb = n0 + wn * 64 + jj * 16;
        const int d = nb >> 9;
        const int ch = h * 256 + ((nb & 511) >> 5) * 16 + (lane & 15);
        const float bav = ba[d * 1024 + ch], bxv = bx[d * 1024 + ch];
        const float sp8 = -8.f * softplus_(-lam[d * 1024 + ch]);
#pragma unroll
        for (int i = 0; i < 4; ++i)
#pragma unroll
          for (int r = 0; r < 4; ++r) {
            const int row = m0 + wm * 64 + i * 16 + (lane >> 4) * 4 + r;
            const float rg = sigmoid_(acc[i][jj][r] + bav);
            const float ig = sigmoid_(acc[i][jj + 1][r] + bxv);
            const float la = sp8 * rg;
            const float cval = bf2f(C[(size_t)row * 1024 + ch]);
            const float b = __builtin_amdgcn_sqrtf(fmaxf(1.f - __expf(2.f * la), 0.f)) * ig * cval;
            AB[((size_t)row * 2 + d) * 1024 + ch] = pack2(la, b);
            if (r == 3) __builtin_amdgcn_sched_barrier(0);
          }
      }
    });
  }
}

DEVI void phase_rg_agg(const Params& p) {
  const u32* AB = (const u32*)(p.ws + OFF_AB);
  float2* AGG = (float2*)(p.ws + OFF_AGG);
  const int gsz = gridDim.x * 256, gtid = blockIdx.x * 256 + threadIdx.x;
  for (int i = gtid; i < 1024 * 2 * 1024; i += gsz) {
    const int ch = i & 1023, d = (i >> 10) & 1, chunk = i >> 11;
    const int c0 = chunk * 32;
    float h = 0.f, LA = 0.f;
#pragma unroll 8
    for (int k = 0; k < 32; ++k) {
      const int t = d ? (c0 + 31 - k) : (c0 + k);
      const u32 w = AB[((size_t)t * 2 + d) * 1024 + ch];
      const float la = bflo(w), b = bfhi(w);
      h = __expf(la) * h + b;
      LA += la;
    }
    AGG[((size_t)d * 1024 + chunk) * 1024 + ch] = float2{LA, h};
  }
}

DEVI void phase_rg_carry(const Params& p, int s) {
  const int L = s ? 2048 : 4096;
  const int nseq = TS / L, nch = L / 32;
  const float2* AGG = (const float2*)(p.ws + OFF_AGG);
  float* CAR = (float*)(p.ws + OFF_CAR);
  const int gsz = gridDim.x * 256, gtid = blockIdx.x * 256 + threadIdx.x;
  for (int i = gtid; i < nseq * 2 * 1024; i += gsz) {
    const int ch = i & 1023, d = (i >> 10) & 1, seq = i >> 11;
    float H = 0.f;
#pragma unroll 8
    for (int k = 0; k < nch; ++k) {
      const int chunk = seq * nch + (d ? (nch - 1 - k) : k);
      const size_t idx = ((size_t)d * 1024 + chunk) * 1024 + ch;
      CAR[idx] = H;
      const float2 ag = AGG[idx];
      H = __expf(ag.x) * H + ag.y;
    }
  }
}

DEVI void phase_rg_final(const Params& p) {
  const u32* AB = (const u32*)(p.ws + OFF_AB);
  const float* CAR = (const float*)(p.ws + OFF_CAR);
  const u16* GG = (const u16*)(p.ws + OFF_GG);
  u16* Y = (u16*)(p.ws + OFF_R);
  const int gsz = gridDim.x * 256, gtid = blockIdx.x * 256 + threadIdx.x;
  for (int i = gtid; i < 1024 * 1024; i += gsz) {
    const int ch = i & 1023, chunk = i >> 10;
    const int c0 = chunk * 32;
    float hf[32];
    float h = CAR[((size_t)chunk) * 1024 + ch];
#pragma unroll
    for (int k = 0; k < 32; ++k) {
      const u32 w = AB[((size_t)(c0 + k) * 2 + 0) * 1024 + ch];
      h = __expf(bflo(w)) * h + bfhi(w);
      hf[k] = h;
    }
    h = CAR[((size_t)1024 + chunk) * 1024 + ch];
#pragma unroll
    for (int k = 31; k >= 0; --k) {
      const u32 w = AB[((size_t)(c0 + k) * 2 + 1) * 1024 + ch];
      h = __expf(bflo(w)) * h + bfhi(w);
      const size_t idx = (size_t)(c0 + k) * 1024 + ch;
      Y[idx] = f2bf((hf[k] + h) * bf2f(GG[idx]));
    }
  }
}

DEVI void phase_rg_out(const Params& p, int s, unsigned char* smem) {
  float* X = p.out + (size_t)s * TS * 1024;
  u16* ZB = (u16*)(p.ws + OFF_XB);
  const u16* Y = (const u16*)(p.ws + OFF_R);
  const u16* Wt = (const u16*)(p.ws + OFF_WRGOUT);
  const int lane = threadIdx.x & 63, wave = threadIdx.x >> 6, wm = wave >> 1, wn = wave & 1;
  bool pre_ = false;
  for (int it = 0, mt, nt; tile_map(it, 256, 8, mt, nt); ++it) {
    int mtn, ntn;
    const bool nxt_ = tile_map(it + 1, 256, 8, mtn, ntn);
    const int m0 = mt * 128, n0 = nt * 128;
    gemm_tile_dma<true>(Y + (size_t)m0 * 1024, 1024, Wt + (size_t)n0 * 1024, 1024, 1024, smem, [&](f32x4 (&acc)[4][4]) {
#pragma unroll
      for (int i = 0; i < 4; ++i)
#pragma unroll
        for (int j = 0; j < 4; ++j) {
          const int row = m0 + wm * 64 + i * 16 + (lane & 15);
          const int col = n0 + wn * 64 + j * 16 + (lane >> 4) * 4;
          float4* xp = reinterpret_cast<float4*>(X + (size_t)row * 1024 + col);
          float4 v = *xp;
          v.x = ALPHA * v.x + acc[i][j][0]; v.y = ALPHA * v.y + acc[i][j][1]; v.z = ALPHA * v.z + acc[i][j][2]; v.w = ALPHA * v.w + acc[i][j][3];
          uint2 w; w.x = pack2(v.x, v.y); w.y = pack2(v.z, v.w);
          *reinterpret_cast<uint2*>(ZB + (size_t)row * 1024 + col) = w;
        }
    }, nxt_ ? (Y + (size_t)(mtn * 128) * 1024) : nullptr, nxt_ ? (Wt + (size_t)(ntn * 128) * 1024) : nullptr, pre_);
    pre_ = nxt_;
  }
}

constexpr int NPS = 22;
constexpr int NSETUP = 3;
constexpr int NPHASE = NSETUP + 2 * NPS;

template <int PH>
DEVI void run_phase(const Params& p, unsigned char* smem) {
  if constexpr (PH == 0) {
    phase_setup(p);
  } else if constexpr (PH == 1) {
    phase_setup2(p, smem);
  } else if constexpr (PH == 2) {
    phase_setup3(p);
  } else {
    constexpr int s = (PH - NSETUP) / NPS, q = (PH - NSETUP) % NPS;
    if constexpr (q == 0) phase_s5_in(p, s, smem);
    else if constexpr (q == 1) phase_s5_state(p, smem);
    else if constexpr (q == 2) phase_s5_cscan(p, s);
    else if constexpr (q == 3) phase_s5_main(p, smem);
    else if constexpr (q == 4) phase_s5_glu(p, s, smem);
    else if constexpr (q == 5) phase_ln1_tables(p, s, 0, smem);
    else if constexpr (q == 6) phase_peer_q(p, 0, smem);
    else if constexpr (q == 7) phase_peer_route(p, s, 0);
    else if constexpr (q == 8) phase_peer_gather(p, s, 0);
    else if constexpr (q == 9) phase_ple(p, s, 0, smem);
    else if constexpr (q == 10) phase_rg_in(p, s, smem);
    else if constexpr (q == 11) phase_rg_conv(p, s);
    else if constexpr (q == 12) phase_rg_gates(p, smem);
    else if constexpr (q == 13) phase_rg_agg(p);
    else if constexpr (q == 14) phase_rg_carry(p, s);
    else if constexpr (q == 15) phase_rg_final(p);
    else if constexpr (q == 16) phase_rg_out(p, s, smem);
    else if constexpr (q == 17) phase_ln1_tables(p, s, 1, smem);
    else if constexpr (q == 18) phase_peer_q(p, 1, smem);
    else if constexpr (q == 19) phase_peer_route(p, s, 1);
    else if constexpr (q == 20) phase_peer_gather(p, s, 1);
    else if constexpr (q == 21) phase_ple(p, s, 1, smem);
  }
}

#define XB_TMO      128
#define XB_XCNT(j)  (256  + 64 * (j))
#define XB_XSUB(j)  (1280 + 64 * (j))
#define XB_XGEN(j)  (2304 + 64 * (j))
#define XB_TOP      3328
#define XB_TOPGEN   3392
#define XCD_BAR_WORDS 3456
#define XB_SPIN_CAP (1u << 18)
#define LAS __attribute__((address_space(3)))
DEVI unsigned xb_ld(unsigned* p) { return __hip_atomic_load(p, __ATOMIC_RELAXED, __HIP_MEMORY_SCOPE_AGENT); }
DEVI unsigned xb_add(unsigned* p, unsigned v) { return __hip_atomic_fetch_add(p, v, __ATOMIC_RELAXED, __HIP_MEMORY_SCOPE_AGENT); }
DEVI unsigned xb_xcc_id() { return (unsigned)__builtin_amdgcn_s_getreg((3 << 11) | 20) & 0xFu; }
#define XB_SPIN(cond, bar) do { unsigned _sp = 0; while (cond) { __builtin_amdgcn_s_sleep(1); \
    if ((++_sp & 255u) == 0u) { if (xb_ld(&(bar)[XB_TMO])) break; if (_sp > XB_SPIN_CAP) { atomicAdd(&(bar)[XB_TMO], 1u); break; } } } } while (0)
struct XcdBarrier { unsigned* bar; unsigned x; volatile LAS unsigned* st; };
DEVI XcdBarrier xcd_barrier_post(unsigned* bar, volatile LAS unsigned* st) {
  XcdBarrier b; b.bar = bar; b.x = xb_xcc_id(); b.st = st;
  if (threadIdx.x == 0) (void)xb_add(&bar[XB_XCNT(b.x)], 1u);
  return b;
}
DEVI void xcd_barrier_complete(unsigned* bar, unsigned x, unsigned& nloc, unsigned& nx) {
  const unsigned G = gridDim.x * gridDim.y * gridDim.z;
  unsigned sum, cnt, mine, sp = 0u;
  for (;;) {
    sum = 0u; cnt = 0u; mine = 0u;
#pragma unroll
    for (unsigned j = 0; j < 16; ++j) { const unsigned c = xb_ld(&bar[XB_XCNT(j)]); sum += c; cnt += (c > 0u) ? 1u : 0u; mine = (j == x) ? c : mine; }
    if (sum == G) break;
    __builtin_amdgcn_s_sleep(1);
    if ((++sp & 255u) == 0u) { if (xb_ld(&bar[XB_TMO])) break; if (sp > XB_SPIN_CAP) { atomicAdd(&bar[XB_TMO], 1u); break; } }
  }
  nloc = mine > 0u ? mine : 1u; nx = cnt > 0u ? cnt : 1u;
}
DEVI void xcd_barrier(const XcdBarrier& b) {
  asm volatile("s_waitcnt vmcnt(0)" ::: "memory");
  __syncthreads();
  if (threadIdx.x == 0) {
    unsigned* bar = b.bar;
    __builtin_amdgcn_s_waitcnt(0);
    unsigned nloc = b.st[0], nx = b.st[1];
    if (nloc == 0u) { xcd_barrier_complete(bar, b.x, nloc, nx); b.st[0] = nloc; b.st[1] = nx; }
    const unsigned old = xb_add(&bar[XB_XSUB(b.x)], 1u);
    const unsigned gen = old / nloc;
    if (old + 1u == (gen + 1u) * nloc) {
      __builtin_amdgcn_fence(__ATOMIC_RELEASE, "agent");
      asm volatile("s_waitcnt vmcnt(0)" ::: "memory");
      const unsigned og = xb_add(&bar[XB_TOP], 1u);
      const unsigned tg = og / nx;
      if (og + 1u == (tg + 1u) * nx) xb_add(&bar[XB_TOPGEN], 1u);
      else XB_SPIN(xb_ld(&bar[XB_TOPGEN]) == tg, bar);
      __builtin_amdgcn_fence(__ATOMIC_ACQUIRE, "agent");
      xb_add(&bar[XB_XGEN(b.x)], 1u);
      asm volatile("s_waitcnt vmcnt(0)" ::: "memory");
    } else {
      XB_SPIN(xb_ld(&bar[XB_XGEN(b.x)]) == gen, bar);
      __builtin_amdgcn_fence(__ATOMIC_ACQUIRE, "agent");
      asm volatile("s_waitcnt vmcnt(0)" ::: "memory");
    }
  }
  __syncthreads();
}

template <int PH>
DEVI void run_steps(const Params& p, int lo, int hi, unsigned char* smem, const XcdBarrier& xb) {
  if constexpr (PH < NPHASE) {
    if (PH >= lo && PH < hi) {
      run_phase<PH>(p, smem);
      if (PH + 1 < hi) {
        if (lo < 0) cg::this_grid().sync();
        xcd_barrier(xb);
      }
    }
    run_steps<PH + 1>(p, lo, hi, smem, xb);
  }
}

__global__ void __launch_bounds__(256, 2) mega(Params p, int ph_lo, int ph_hi) {
  extern __shared__ __attribute__((aligned(16))) unsigned char smem[];
  volatile LAS unsigned* st = (volatile LAS unsigned*)(smem + LDS_BYTES);
  if (threadIdx.x == 0) { st[0] = 0u; st[1] = 0u; }
  __syncthreads();
  const XcdBarrier xb = xcd_barrier_post((unsigned*)(p.ws + OFF_BAR), st);
  run_steps<0>(p, ph_lo, ph_hi, smem, xb);
}

extern "C" void kernel_launch(void* const* d_in, const int* in_sizes, int n_in, void* d_out, int out_size, void* d_ws,
                              size_t ws_size, hipStream_t stream) {
  static int grid = 0;
  if (grid == 0) {
    if (n_in != 33 || ws_size < WS_END) {
      fprintf(stderr, "kernel_launch: need 33 inputs and %zu bytes ws; got %d, %zu\n", (size_t)WS_END, n_in, ws_size);
      grid = -1;
      return;
    }
    int dev = 0, cus = 0, per_cu = 0;
    hipGetDevice(&dev);
    hipDeviceGetAttribute(&cus, hipDeviceAttributeMultiprocessorCount, dev);
    if (hipFuncSetAttribute((const void*)mega, hipFuncAttributeMaxDynamicSharedMemorySize, LDS_BYTES + 16) != hipSuccess) {
      fprintf(stderr, "kernel_launch: hipFuncSetAttribute failed\n");
      grid = -1;
      return;
    }
    hipOccupancyMaxActiveBlocksPerMultiprocessor(&per_cu, (const void*)mega, 256, LDS_BYTES + 16);
    if (per_cu < 1) per_cu = 1;
    if (per_cu > 2) per_cu = 2;
    grid = cus * per_cu;
    fprintf(stderr, "kernel_launch: cus %d per_cu %d grid %d\n", cus, per_cu, grid);
  }
  if (grid < 0) return;
  (void)hipMemsetAsync((unsigned char*)d_ws + OFF_BAR, 0, XCD_BAR_WORDS * sizeof(unsigned), stream);
  Params p{};
  for (int i = 0; i < 33; ++i) p.in[i] = (const float*)d_in[i];
  p.out = (float*)d_out;
  p.ws = (unsigned char*)d_ws;
#if COOP
  int lo = 0, hi = NPHASE;
  void* args[] = {&p, &lo, &hi};
  hipError_t e = hipLaunchCooperativeKernel((const void*)mega, dim3(grid), dim3(256), args, LDS_BYTES + 16, stream);
  if (e != hipSuccess) fprintf(stderr, "cooperative launch failed: %s (grid %d)\n", hipGetErrorString(e), grid);
#else
  for (int ph = 0; ph < NPHASE; ++ph) {
    hipLaunchKernelGGL(mega, dim3(grid), dim3(256), LDS_BYTES + 16, stream, p, ph, ph + 1);
  }
#endif
}
```

```cpp
#include <hip/hip_runtime.h>
#include <hip/hip_cooperative_groups.h>
#include <cstdio>
namespace cg = cooperative_groups;

#ifndef COOP
#define COOP 1
#endif

typedef unsigned short u16;
typedef unsigned int u32;
using bf16x8 = __attribute__((ext_vector_type(8))) short;
using f32x4 = __attribute__((ext_vector_type(4))) float;
typedef float f2 __attribute__((ext_vector_type(2)));
typedef float v32f __attribute__((ext_vector_type(32)));
typedef float v16f __attribute__((ext_vector_type(16)));
typedef unsigned v6u __attribute__((ext_vector_type(6)));

#define DEVI __device__ __forceinline__

constexpr int TS = 32768;
constexpr float ALPHA = 1.41421356237309515f;
constexpr float LN_EPS = 1e-5f;
constexpr size_t MBy = 1ull << 20;

constexpr size_t OFF_WS5IN = 0;
constexpr size_t OFF_WGLU = 2 * MBy;
constexpr size_t OFF_WRGIN = 6 * MBy;
constexpr size_t OFF_WGATES = 10 * MBy;
constexpr size_t OFF_WRGOUT = 12 * MBy;
constexpr size_t OFF_WQ = 14 * MBy;
constexpr size_t OFF_SK = 22 * MBy;
constexpr size_t OFF_WPROJ = 23 * MBy;
constexpr size_t OFF_WPG = 24 * MBy;
constexpr size_t OFF_UB = 28 * MBy;
constexpr size_t OFF_VB = 60 * MBy;
constexpr size_t TB_STRIDE = 26 * MBy;
constexpr size_t OFF_UB8 = OFF_UB;
constexpr size_t OFF_VB8 = OFF_UB + 12 * MBy;
constexpr size_t OFF_SCL = OFF_UB + 24 * MBy;
constexpr size_t OFF_ACT = 92 * MBy;
constexpr size_t OFF_XB = OFF_ACT;
constexpr size_t OFF_KEYS = OFF_ACT + 64 * MBy;
constexpr size_t OFF_IDX = OFF_ACT + 96 * MBy;
constexpr size_t OFF_GATE = OFF_ACT + 112 * MBy;
constexpr size_t OFF_SU = OFF_ACT + 128 * MBy;
constexpr size_t OFF_PB = OFF_ACT + 144 * MBy;
constexpr size_t OFF_XB2 = OFF_ACT + 192 * MBy;
constexpr size_t OFF_XIN = OFF_ACT + 256 * MBy;
constexpr size_t OFF_AP = OFF_ACT;
constexpr size_t OFF_HLOC = OFF_ACT + 104 * MBy;
constexpr size_t OFF_HB = OFF_ACT + 192 * MBy;
constexpr size_t OFF_GG = OFF_ACT;
constexpr size_t OFF_R = OFF_ACT + 64 * MBy;
constexpr size_t OFF_C = OFF_ACT + 128 * MBy;
constexpr size_t OFF_AB = OFF_ACT + 192 * MBy;
constexpr size_t OFF_AGG = OFF_ACT + 448 * MBy;
constexpr size_t OFF_CAR = OFF_ACT + 464 * MBy;
constexpr size_t OFF_BT1 = OFF_ACT + 472 * MBy;
constexpr size_t OFF_WST = OFF_BT1 + 48 * MBy;
constexpr size_t OFF_KTAB = OFF_WST + 16 * MBy;
constexpr size_t OFF_POW = OFF_KTAB + 4 * MBy;
constexpr size_t OFF_BBAR = OFF_POW + 3 * MBy;
constexpr size_t OFF_BAR = OFF_BBAR + 1 * MBy;
constexpr size_t WS_END = OFF_BAR + 1 * MBy;

constexpr int LDS_BYTES = 36864 + 32768;

struct Params {
  const float* in[33];
  float* out;
  unsigned char* ws;
};

DEVI u16 f2bf(float f) {
  u32 u = __float_as_uint(f);
  u += 0x7FFFu + ((u >> 16) & 1u);
  return (u16)(u >> 16);
}
DEVI float bf2f(u16 h) { return __uint_as_float(((u32)h) << 16); }
DEVI u32 pack2(float lo, float hi) { return (u32)f2bf(lo) | ((u32)f2bf(hi) << 16); }
DEVI float bflo(u32 w) { return __uint_as_float(w << 16); }
DEVI float bfhi(u32 w) { return __uint_as_float(w & 0xffff0000u); }
DEVI float sigmoid_(float x) { return __builtin_amdgcn_rcpf(1.f + __expf(-x)); }
DEVI float gelu_(float x) {
  float z = 0.7978845608028654f * (x + 0.044715f * x * x * x);
  return x * __builtin_amdgcn_rcpf(1.f + __expf(-2.f * z));
}
DEVI float softplus_(float x) { return fmaxf(x, 0.f) + log1pf(__expf(-fabsf(x))); }
DEVI void unpack8(const uint4& w, float* f) {
  f[0] = bflo(w.x); f[1] = bfhi(w.x); f[2] = bflo(w.y); f[3] = bfhi(w.y);
  f[4] = bflo(w.z); f[5] = bfhi(w.z); f[6] = bflo(w.w); f[7] = bfhi(w.w);
}
DEVI uint4 pack8(const float* f) {
  uint4 o; o.x = pack2(f[0], f[1]); o.y = pack2(f[2], f[3]); o.z = pack2(f[4], f[5]); o.w = pack2(f[6], f[7]);
  return o;
}

struct LdBF {
  const u16* base; int ld;
  typedef uint4 Raw;
  DEVI Raw load(int row, int k) const { return *reinterpret_cast<const uint4*>(base + (size_t)row * ld + k); }
  DEVI static uint4 cvt(const Raw& r) { return r; }
};
struct RawF { float4 a, b; };
struct LdF32 {
  const float* base; int ld;
  typedef RawF Raw;
  DEVI Raw load(int row, int k) const {
    const float4* q = reinterpret_cast<const float4*>(base + (size_t)row * ld + k);
    RawF r; r.a = q[0]; r.b = q[1]; return r;
  }
  DEVI static uint4 cvt(const Raw& r) {
    uint4 o; o.x = pack2(r.a.x, r.a.y); o.y = pack2(r.a.z, r.a.w); o.z = pack2(r.b.x, r.b.y); o.w = pack2(r.b.z, r.b.w);
    return o;
  }
};

template <class AL, class BL, class EP>
DEVI void gemm_tile(const AL al, const BL bl, const int K, unsigned char* smem, EP ep) {
  u16* As = reinterpret_cast<u16*>(smem);
  u16* Bs = As + 128 * 72;
  const int tid = threadIdx.x, lane = tid & 63, wave = tid >> 6, wm = wave >> 1, wn = wave & 1;
  const int lr = lane & 15, lq = lane >> 4;
  f32x4 acc[4][4];
#pragma unroll
  for (int i = 0; i < 4; ++i)
#pragma unroll
    for (int j = 0; j < 4; ++j) acc[i][j] = f32x4{0.f, 0.f, 0.f, 0.f};
  typename AL::Raw ra[4];
  typename BL::Raw rb[4];
  const int prow = tid >> 3, pk = (tid & 7) * 8;
#pragma unroll
  for (int i = 0; i < 4; ++i) { ra[i] = al.load(prow + i * 32, pk); rb[i] = bl.load(prow + i * 32, pk); }
  for (int kt = 0; kt < K; kt += 64) {
    __syncthreads();
#pragma unroll
    for (int i = 0; i < 4; ++i) {
      *reinterpret_cast<uint4*>(As + (prow + i * 32) * 72 + pk) = AL::cvt(ra[i]);
      *reinterpret_cast<uint4*>(Bs + (prow + i * 32) * 72 + pk) = BL::cvt(rb[i]);
    }
    __syncthreads();
    if (kt + 64 < K) {
#pragma unroll
      for (int i = 0; i < 4; ++i) { ra[i] = al.load(prow + i * 32, kt + 64 + pk); rb[i] = bl.load(prow + i * 32, kt + 64 + pk); }
    }
#pragma unroll
    for (int ks = 0; ks < 2; ++ks) {
      bf16x8 af[4], bfr[4];
#pragma unroll
      for (int i = 0; i < 4; ++i) af[i] = *reinterpret_cast<const bf16x8*>(As + (wm * 64 + i * 16 + lr) * 72 + ks * 32 + lq * 8);
#pragma unroll
      for (int j = 0; j < 4; ++j) bfr[j] = *reinterpret_cast<const bf16x8*>(Bs + (wn * 64 + j * 16 + lr) * 72 + ks * 32 + lq * 8);
#pragma unroll
      for (int i = 0; i < 4; ++i)
#pragma unroll
        for (int j = 0; j < 4; ++j) acc[i][j] = __builtin_amdgcn_mfma_f32_16x16x32_bf16(af[i], bfr[j], acc[i][j], 0, 0, 0);
    }
  }
  __syncthreads();
  ep(acc);
}

typedef __attribute__((address_space(3))) unsigned lds_u32;
template <bool TR = false, class EP>
DEVI void gemm_tile_dma(const u16* A, const int lda, const u16* Bt, const int ldb, const int K, unsigned char* smem, EP ep,
                        const u16* An = nullptr, const u16* Bn = nullptr, const bool pre = false) {
  const int tid = threadIdx.x, lane = tid & 63, wave = tid >> 6, wm = wave >> 1, wn = wave & 1;
  const int lr = lane & 15, lq = lane >> 4;
  f32x4 acc[4][4];
#pragma unroll
  for (int i = 0; i < 4; ++i)
#pragma unroll
    for (int j = 0; j < 4; ++j) acc[i][j] = f32x4{0.f, 0.f, 0.f, 0.f};
  const int rr = lane >> 3, qq = (lane & 7) ^ rr;
  const size_t aoff = (size_t)(wave * 32 + rr) * lda + qq * 8, boff = (size_t)(wave * 32 + rr) * ldb + qq * 8;
  const u16* ag = A + aoff;
  const u16* bg = Bt + boff;
  unsigned char* wbase = smem + wave * 4096;
#define GT_ISSUE(AP_, BP_, stage, kt)                                                                                    \
  do {                                                                                                                   \
    _Pragma("unroll") for (int j = 0; j < 4; ++j) {                                                                      \
      __builtin_amdgcn_global_load_lds((const unsigned*)((AP_) + (size_t)j * 8 * lda + (kt)),                            \
                                       (lds_u32*)(wbase + (stage) * 32768 + j * 1024), 16, 0, 0);                        \
      __builtin_amdgcn_global_load_lds((const unsigned*)((BP_) + (size_t)j * 8 * ldb + (kt)),                            \
                                       (lds_u32*)(wbase + (stage) * 32768 + 16384 + j * 1024), 16, 0, 0);                \
    }                                                                                                                    \
  } while (0)
  if (!pre) {
    __syncthreads();
    GT_ISSUE(ag, bg, 0, 0);
  }
  const int sw = lr & 7;
  int it = 0;
  for (int kt = 0; kt < K; kt += 64, ++it) {
    asm volatile("s_waitcnt vmcnt(0)" ::: "memory");
    __syncthreads();
    if (kt + 64 < K) GT_ISSUE(ag, bg, (it + 1) & 1, kt + 64);
    else if (An != nullptr) GT_ISSUE(An + aoff, Bn + boff, 0, 0);
    const unsigned char* As = smem + (it & 1) * 32768;
    const unsigned char* Bs = As + 16384;
#pragma unroll
    for (int ks = 0; ks < 2; ++ks) {
      bf16x8 af[4], bfr[4];
      const int ch = ((ks * 4 + lq) ^ sw) * 16;
#pragma unroll
      for (int i = 0; i < 4; ++i) af[i] = *reinterpret_cast<const bf16x8*>(As + (wm * 64 + i * 16 + lr) * 128 + ch);
#pragma unroll
      for (int j = 0; j < 4; ++j) bfr[j] = *reinterpret_cast<const bf16x8*>(Bs + (wn * 64 + j * 16 + lr) * 128 + ch);
      __builtin_amdgcn_s_setprio(1);
#pragma unroll
      for (int i = 0; i < 4; ++i)
#pragma unroll
        for (int j = 0; j < 4; ++j)
          acc[i][j] = TR ? __builtin_amdgcn_mfma_f32_16x16x32_bf16(bfr[j], af[i], acc[i][j], 0, 0, 0)
                         : __builtin_amdgcn_mfma_f32_16x16x32_bf16(af[i], bfr[j], acc[i][j], 0, 0, 0);
      __builtin_amdgcn_s_setprio(0);
    }
  }
#undef GT_ISSUE
  if (An == nullptr) __syncthreads();
  ep(acc);
}

DEVI bool tile_map(int it, int nmt, int nnt, int& mt, int& nt) {
  const int xcd = blockIdx.x & 7, j = blockIdx.x >> 3;
  const int per = gridDim.x >> 3;
  const int slot = it * per + j;
  const int S = (slot >> 6) * 8 + xcd;
  const int nsn = nnt >> 3, nsm = nmt >> 3;
  if (S >= nsn * nsm) return false;
  const int sm = S / nsn, sn = S - sm * nsn;
  const int w = slot & 63;
  mt = sm * 8 + (w >> 3);
  nt = sn * 8 + (w & 7);
  return true;
}

template <int PERM>
DEVI void cvt_wt(const float* W, int K, int N, u16* out, int a0, int a1) {
  const int gsz = gridDim.x * 256, gtid = blockIdx.x * 256 + threadIdx.x;
  const int total = N * (K >> 3);
  for (int i = gtid; i < total; i += gsz) {
    const int n = i % N, kv = i / N;
    float v[8];
#pragma unroll
    for (int j = 0; j < 8; ++j) v[j] = W[(size_t)(kv * 8 + j) * N + n];
    int np = n;
    if (PERM == 1) { const int g = n >> 10, o = n & 1023; np = (o >> 4) * 32 + g * 16 + (o & 15); }
    if (PERM == 2) { np = a0 * 512 + (n >> 4) * 32 + a1 * 16 + (n & 15); }
    *reinterpret_cast<uint4*>(out + (size_t)np * K + kv * 8) = pack8(v);
  }
}

DEVI void cvt_plain(const float* src, u16* dst, size_t n8) {
  const size_t gsz = (size_t)gridDim.x * 256, gtid = (size_t)blockIdx.x * 256 + threadIdx.x;
  for (size_t i = gtid; i < n8; i += gsz) {
    const float4* q = reinterpret_cast<const float4*>(src + i * 8);
    float4 a = q[0], b = q[1];
    uint4 o; o.x = pack2(a.x, a.y); o.y = pack2(a.z, a.w); o.z = pack2(b.x, b.y); o.w = pack2(b.z, b.w);
    *reinterpret_cast<uint4*>(dst + i * 8) = o;
  }
}

DEVI void phase_setup(const Params& p) {
  unsigned char* ws = p.ws;
  cvt_wt<0>(p.in[4], 1024, 1024, (u16*)(ws + OFF_WS5IN), 0, 0);
  cvt_wt<1>(p.in[13], 1024, 2048, (u16*)(ws + OFF_WGLU), 0, 0);
  cvt_wt<0>(p.in[14], 1024, 2048, (u16*)(ws + OFF_WRGIN), 0, 0);
  for (int d = 0; d < 2; ++d)
    for (int gate = 0; gate < 2; ++gate)
      for (int h = 0; h < 4; ++h)
        cvt_wt<2>((gate ? p.in[19] : p.in[17]) + (size_t)(d * 4 + h) * 65536, 256, 256,
                  (u16*)(ws + OFF_WGATES) + (size_t)h * 1024 * 256, d, gate);
  cvt_wt<0>(p.in[22], 1024, 1024, (u16*)(ws + OFF_WRGOUT), 0, 0);
  for (int l = 0; l < 2; ++l) {
    cvt_wt<0>(p.in[27] + (size_t)l * 1024 * 2048, 1024, 2048, (u16*)(ws + OFF_WQ) + (size_t)l * 2048 * 1024, 0, 0);
    cvt_wt<0>(p.in[31] + (size_t)l * 256 * 1024, 256, 1024, (u16*)(ws + OFF_WPROJ) + (size_t)l * 1024 * 256, 0, 0);
    cvt_wt<0>(p.in[32] + (size_t)l * 1024 * 1024, 1024, 1024, (u16*)(ws + OFF_WPG) + (size_t)l * 1024 * 1024, 0, 0);
  }
  cvt_plain(p.in[28], (u16*)(ws + OFF_SK), 65536 / 8);
  const int gsz = gridDim.x * 256, gtid = blockIdx.x * 256 + threadIdx.x;
  float2* POW = (float2*)(ws + OFF_POW);
  float2* BBAR = (float2*)(ws + OFF_BBAR);
  for (int i = gtid; i < 2 * 64 * 33 * 64; i += gsz) {
    const int pp = i & 63, n = (i >> 6) % 33, dg = i / (64 * 33);
    const float step = expf(p.in[7][dg]);
    const float lr_ = p.in[5][dg * 64 + pp], li_ = p.in[6][dg * 64 + pp];
    const float mag = expf((float)n * (lr_ * step)), ang = (float)n * (li_ * step);
    POW[i] = float2{mag * cosf(ang), mag * sinf(ang)};
  }
  for (int i = gtid; i < 2 * 64 * 64; i += gsz) {
    const int dg = i >> 6;
    const float step = expf(p.in[7][dg]);
    const float lr_ = p.in[5][i], li_ = p.in[6][i];
    const float mag = expf(lr_ * step), ang = li_ * step;
    const float ar = mag * cosf(ang), ai = mag * sinf(ang);
    const float den = lr_ * lr_ + li_ * li_;
    const float zr = ar - 1.f;
    const float qr = (zr * lr_ + ai * li_) / den, qi = (ai * lr_ - zr * li_) / den;
#pragma unroll
    for (int c = 0; c < 16; ++c) {
      const float br = p.in[8][(size_t)i * 16 + c], bi = p.in[9][(size_t)i * 16 + c];
      BBAR[(size_t)i * 16 + c] = float2{qr * br - qi * bi, qr * bi + qi * br};
    }
  }
}

DEVI float s5_kterm(const Params& p, const float2* POW, const float2* BBAR, int d, int g, int n, int c, int cp) {
  const int dg = d * 64 + g;
  const float* cr = p.in[10] + ((size_t)dg * 16 + c) * 64;
  const float* ci = p.in[11] + ((size_t)dg * 16 + c) * 64;
  const float2* E = POW + ((size_t)dg * 33 + n) * 64;
  const float2* BB = BBAR + (size_t)dg * 64 * 16 + cp;
  float s = 0.f;
#pragma unroll 8
  for (int pp = 0; pp < 64; ++pp) {
    const float2 e = E[pp], bb = BB[pp * 16];
    const float Cr = cr[pp], Ci = ci[pp];
    const float cer = Cr * e.x - Ci * e.y, cei = Cr * e.y + Ci * e.x;
    s += cer * bb.x - cei * bb.y;
  }
  return s;
}

DEVI void phase_tables(const Params& p, int layer, unsigned char* smem);

DEVI void phase_setup2(const Params& p, unsigned char* smem) {
  phase_tables(p, 0, smem);
  phase_tables(p, 1, smem);
  unsigned char* ws = p.ws;
  const int gsz = gridDim.x * 256, gtid = blockIdx.x * 256 + threadIdx.x;
  const float2* POW = (const float2*)(ws + OFF_POW);
  const float2* BBAR = (const float2*)(ws + OFF_BBAR);
  float* KTAB = (float*)(ws + OFF_KTAB);
  u16* WST = (u16*)(ws + OFF_WST);
  u16* BT1 = (u16*)(ws + OFF_BT1);
  for (int i = gtid; i < 64 * 63 * 256; i += gsz) {
    const int cp = i & 15, c = (i >> 4) & 15, ti = (i >> 8) % 63, g = i / (63 * 256);
    const int tau = ti - 31;
    float s = 0.f;
    if (tau >= 0) s += s5_kterm(p, POW, BBAR, 0, g, tau, c, cp);
    if (tau <= 0) s += s5_kterm(p, POW, BBAR, 1, g, -tau, c, cp);
    KTAB[i] = s;
  }
  for (int i = gtid; i < 64 * 256 * 64; i += gsz) {
    const int kv = i & 63, np = (i >> 6) & 255, g = i >> 14;
    const int d = np >> 7, ri = (np >> 6) & 1, pp = np & 63, s = kv >> 1, c0 = (kv & 1) * 8;
    const int npow = d ? s : 31 - s;
    const float2 e = POW[((size_t)(d * 64 + g) * 33 + npow) * 64 + pp];
    float v[8];
#pragma unroll
    for (int j = 0; j < 8; ++j) {
      const float2 bb = BBAR[((size_t)(d * 64 + g) * 64 + pp) * 16 + c0 + j];
      v[j] = ri ? (e.x * bb.y + e.y * bb.x) : (e.x * bb.x - e.y * bb.y);
    }
    *reinterpret_cast<uint4*>(WST + ((size_t)g * 256 + np) * 512 + kv * 8) = pack8(v);
  }
  for (int i = gtid; i < 64 * 512 * 32; i += gsz) {
    const int kv = i & 31, n = (i >> 5) & 511, g = i >> 14;
    const int t = n >> 4, c = n & 15, kk0 = kv * 8;
    const int d = kk0 >> 7, ri = (kk0 >> 6) & 1, p0 = kk0 & 63;
    const int npow = d ? 32 - t : t + 1;
    const int dg = d * 64 + g;
    float v[8];
#pragma unroll
    for (int j = 0; j < 8; ++j) {
      const int pp = p0 + j;
      const float Cr = p.in[10][((size_t)dg * 16 + c) * 64 + pp], Ci = p.in[11][((size_t)dg * 16 + c) * 64 + pp];
      const float2 e = POW[((size_t)dg * 33 + npow) * 64 + pp];
      v[j] = ri ? -(Cr * e.y + Ci * e.x) : (Cr * e.x - Ci * e.y);
    }
    *reinterpret_cast<uint4*>(BT1 + ((size_t)g * 512 + n) * 768 + 512 + kv * 8) = pack8(v);
  }
}

DEVI void phase_setup3(const Params& p) {
  cvt_plain(p.in[0], (u16*)(p.ws + OFF_XIN), (size_t)TS * 1024 / 8);
  const int gsz = gridDim.x * 256, gtid = blockIdx.x * 256 + threadIdx.x;
  const float* KTAB = (const float*)(p.ws + OFF_KTAB);
  u16* BT1 = (u16*)(p.ws + OFF_BT1);
  for (int i = gtid; i < 64 * 512 * 64; i += gsz) {
    const int kv = i & 63, n = (i >> 6) & 511, g = i >> 15;
    const int t = n >> 4, c = n & 15, s = kv >> 1, c0 = (kv & 1) * 8;
    const float* src = KTAB + (((size_t)g * 63 + (t - s + 31)) * 16 + c) * 16 + c0;
    float v[8];
#pragma unroll
    for (int j = 0; j < 8; ++j) v[j] = src[j];
    *reinterpret_cast<uint4*>(BT1 + ((size_t)g * 512 + n) * 768 + kv * 8) = pack8(v);
  }
}

DEVI void phase_s5_in(const Params& p, int s, unsigned char* smem) {
  const u16* XIN = (const u16*)(p.ws + OFF_XIN);
  const u16* Wt = (const u16*)(p.ws + OFF_WS5IN);
  u16* AP = (u16*)(p.ws + OFF_AP);
  const int lane = threadIdx.x & 63, wave = threadIdx.x >> 6, wm = wave >> 1, wn = wave & 1;
  bool pre_ = false;
  for (int it = 0, mt, nt; tile_map(it, 256, 8, mt, nt); ++it) {
    int mtn, ntn;
    const bool nxt_ = tile_map(it + 1, 256, 8, mtn, ntn);
    const int m0 = mt * 128, n0 = nt * 128;
    gemm_tile_dma<true>(XIN + (size_t)m0 * 1024, 1024, Wt + (size_t)n0 * 1024, 1024, 1024, smem, [&](f32x4 (&acc)[4][4]) {
#pragma unroll
      for (int i = 0; i < 4; ++i)
#pragma unroll
        for (int j = 0; j < 4; ++j) {
          const int row = m0 + wm * 64 + i * 16 + (lane & 15);
          const int col = n0 + wn * 64 + j * 16 + (lane >> 4) * 4;
          uint2 w; w.x = pack2(acc[i][j][0], acc[i][j][1]); w.y = pack2(acc[i][j][2], acc[i][j][3]);
          *reinterpret_cast<uint2*>(AP + ((size_t)(col >> 4) * 1024 + (row >> 5)) * 768 + (row & 31) * 16 + (col & 15)) = w;
        }
    }, nxt_ ? (XIN + (size_t)(mtn * 128) * 1024) : nullptr, nxt_ ? (Wt + (size_t)(ntn * 128) * 1024) : nullptr, pre_);
    pre_ = nxt_;
  }
}

DEVI void phase_s5_state(const Params& p, unsigned char* smem) {
  const u16* AP = (const u16*)(p.ws + OFF_AP);
  const u16* WST = (const u16*)(p.ws + OFF_WST);
  float* HLOC = (float*)(p.ws + OFF_HLOC);
  const int lane = threadIdx.x & 63, wave = threadIdx.x >> 6, wm = wave >> 1, wn = wave & 1;
  for (int tile = blockIdx.x; tile < 64 * 16; tile += gridDim.x) {
    const int g = tile >> 4, m0 = ((tile >> 1) & 7) * 128, n0 = (tile & 1) * 128;
    gemm_tile_dma(AP + ((size_t)g * 1024 + m0) * 768, 768, WST + ((size_t)g * 256 + n0) * 512, 512, 512, smem, [&](f32x4 (&acc)[4][4]) {
#pragma unroll
      for (int i = 0; i < 4; ++i)
#pragma unroll
        for (int j = 0; j < 4; ++j)
#pragma unroll
          for (int r = 0; r < 4; ++r) {
            const int row = m0 + wm * 64 + i * 16 + (lane >> 4) * 4 + r;
            const int col = n0 + wn * 64 + j * 16 + (lane & 15);
            HLOC[((size_t)g * 1024 + row) * 256 + col] = acc[i][j][r];
          }
    });
  }
}

DEVI void phase_s5_cscan(const Params& p, int s) {
  const int L = s ? 2048 : 4096;
  const int nseq = TS / L, nch = L / 32;
  u16* AP = (u16*)(p.ws + OFF_AP);
  const float* HLOC = (const float*)(p.ws + OFF_HLOC);
  const float2* POW = (const float2*)(p.ws + OFF_POW);
  const int gsz = gridDim.x * 256, gtid = blockIdx.x * 256 + threadIdx.x;
  for (int i = gtid; i < 64 * nseq * 128; i += gsz) {
    const int pp = i & 63, d = (i >> 6) & 1, g = (i >> 7) & 63, seq = i >> 13;
    const float2 e = POW[((size_t)(d * 64 + g) * 33 + 32) * 64 + pp];
    float Hr = 0.f, Hi = 0.f;
#pragma unroll 8
    for (int j = 0; j < nch; ++j) {
      const int chunk = seq * nch + (d ? (nch - 1 - j) : j);
      u16* ap = AP + ((size_t)g * 1024 + chunk) * 768 + 512 + d * 128 + pp;
      ap[0] = f2bf(Hr);
      ap[64] = f2bf(Hi);
      const float* hl = HLOC + ((size_t)g * 1024 + chunk) * 256 + d * 128 + pp;
      const float a = hl[0], b = hl[64];
      const float nHr = e.x * Hr - e.y * Hi + a;
      const float nHi = e.x * Hi + e.y * Hr + b;
      Hr = nHr; Hi = nHi;
    }
  }
}

DEVI void phase_s5_main(const Params& p, unsigned char* smem) {
  const u16* AP = (const u16*)(p.ws + OFF_AP);
  const u16* BT1 = (const u16*)(p.ws + OFF_BT1);
  u16* HB = (u16*)(p.ws + OFF_HB);
  const float* dsk = p.in[12];
  const int lane = threadIdx.x & 63, wave = threadIdx.x >> 6, wm = wave >> 1, wn = wave & 1;
  for (int tile = blockIdx.x; tile < 64 * 32; tile += gridDim.x) {
    const int g = tile >> 5, m0 = ((tile >> 2) & 7) * 128, n0 = (tile & 3) * 128;
    gemm_tile_dma(AP + ((size_t)g * 1024 + m0) * 768, 768, BT1 + ((size_t)g * 512 + n0) * 768, 768, 768, smem, [&](f32x4 (&acc)[4][4]) {
      const float dv = dsk[g * 16 + (lane & 15)];
#pragma unroll
      for (int i = 0; i < 4; ++i)
#pragma unroll
        for (int j = 0; j < 4; ++j)
#pragma unroll
          for (int r = 0; r < 4; ++r) {
            const int chunk = m0 + wm * 64 + i * 16 + (lane >> 4) * 4 + r;
            const int n = n0 + wn * 64 + j * 16 + (lane & 15);
            const float u = bf2f(AP[((size_t)g * 1024 + chunk) * 768 + n]);
            const float y = acc[i][j][r] + dv * u;
            HB[((size_t)chunk * 32 + (n >> 4)) * 1024 + g * 16 + (lane & 15)] = f2bf(gelu_(y));
          }
    });
  }
}

DEVI void phase_s5_glu(const Params& p, int s, unsigned char* smem) {
  const u16* HB = (const u16*)(p.ws + OFF_HB);
  const u16* Wt = (const u16*)(p.ws + OFF_WGLU);
  const float* Xin = p.in[s];
  u16* ZB = (u16*)(p.ws + OFF_XB);
  const int lane = threadIdx.x & 63, wave = threadIdx.x >> 6, wm = wave >> 1, wn = wave & 1;
  bool pre_ = false;
  for (int it = 0, mt, nt; tile_map(it, 256, 16, mt, nt); ++it) {
    int mtn, ntn;
    const bool nxt_ = tile_map(it + 1, 256, 16, mtn, ntn);
    const int m0 = mt * 128, n0 = nt * 128;
    gemm_tile_dma<true>(HB + (size_t)m0 * 1024, 1024, Wt + (size_t)n0 * 1024, 1024, 1024, smem, [&](f32x4 (&acc)[4][4]) {
#pragma unroll
      for (int i = 0; i < 4; ++i)
#pragma unroll
        for (int jj = 0; jj < 4; jj += 2) {
          const int row = m0 + wm * 64 + i * 16 + (lane & 15);
          const int nb = n0 + wn * 64 + jj * 16;
          const int o = (nb >> 5) * 16 + (lane >> 4) * 4;
          const size_t idx = (size_t)row * 1024 + o;
          const float4 xi = *reinterpret_cast<const float4*>(Xin + idx);
          float4 v;
          v.x = ALPHA * xi.x + acc[i][jj][0] * sigmoid_(acc[i][jj + 1][0]);
          v.y = ALPHA * xi.y + acc[i][jj][1] * sigmoid_(acc[i][jj + 1][1]);
          v.z = ALPHA * xi.z + acc[i][jj][2] * sigmoid_(acc[i][jj + 1][2]);
          v.w = ALPHA * xi.w + acc[i][jj][3] * sigmoid_(acc[i][jj + 1][3]);
          uint2 w; w.x = pack2(v.x, v.y); w.y = pack2(v.z, v.w);
          *reinterpret_cast<uint2*>(ZB + idx) = w;
        }
    }, nxt_ ? (HB + (size_t)(mtn * 128) * 1024) : nullptr, nxt_ ? (Wt + (size_t)(ntn * 128) * 1024) : nullptr, pre_);
    pre_ = nxt_;
  }
}

DEVI void phase_ln1_tables(const Params& p, int s, int layer, unsigned char* smem) {
  float* X = p.out + (size_t)s * TS * 1024;
  u16* XB = (u16*)(p.ws + OFF_XB);
  const float* gam = p.in[23] + layer * 1024;
  const float* bet = p.in[24] + layer * 1024;
  const int lane = threadIdx.x & 63, wave = threadIdx.x >> 6;
  for (int t = blockIdx.x * 4 + wave; t < TS; t += gridDim.x * 4) {
    float4 v[4];
#pragma unroll
    for (int i = 0; i < 4; ++i) {
      const uint2 w = *reinterpret_cast<const uint2*>(XB + (size_t)t * 1024 + i * 256 + lane * 4);
      v[i] = float4{bflo(w.x), bfhi(w.x), bflo(w.y), bfhi(w.y)};
    }
    float sm = 0.f;
#pragma unroll
    for (int i = 0; i < 4; ++i) sm += v[i].x + v[i].y + v[i].z + v[i].w;
#pragma unroll
    for (int m = 32; m >= 1; m >>= 1) sm += __shfl_xor(sm, m);
    const float mu = sm * (1.f / 1024.f);
    float sq = 0.f;
#pragma unroll
    for (int i = 0; i < 4; ++i) {
      const float a = v[i].x - mu, b = v[i].y - mu, c = v[i].z - mu, d = v[i].w - mu;
      sq += a * a + b * b + c * c + d * d;
    }
#pragma unroll
    for (int m = 32; m >= 1; m >>= 1) sq += __shfl_xor(sq, m);
    const float rs = rsqrtf(sq * (1.f / 1024.f) + LN_EPS);
#pragma unroll
    for (int i = 0; i < 4; ++i) {
      const int c0 = i * 256 + lane * 4;
      const float4 g4 = *reinterpret_cast<const float4*>(gam + c0);
      const float4 b4 = *reinterpret_cast<const float4*>(bet + c0);
      float4 o;
      o.x = (v[i].x - mu) * rs * g4.x + b4.x; o.y = (v[i].y - mu) * rs * g4.y + b4.y;
      o.z = (v[i].z - mu) * rs * g4.z + b4.z; o.w = (v[i].w - mu) * rs * g4.w + b4.w;
      uint2 pk; pk.x = pack2(o.x, o.y); pk.y = pack2(o.z, o.w);
      *reinterpret_cast<uint2*>(XB + (size_t)t * 1024 + c0) = pk;
    }
  }
}

DEVI void phase_tables(const Params& p, int layer, unsigned char* smem) {
  const int lane = threadIdx.x & 63, wave = threadIdx.x >> 6;
  float* SCL = (float*)(p.ws + OFF_SCL + (size_t)layer * TB_STRIDE);
  float* lds = reinterpret_cast<float*>(smem) + (threadIdx.x & 63) + (threadIdx.x >> 6) * 2048;
  int srck[32];
  {
    v16f ra, rb;
#pragma unroll
    for (int j = 0; j < 16; ++j) { ra[j] = (j < 8) ? 0.125f * j : 1.f + 0.125f * (j - 8); rb[j] = (j < 8) ? 2.f + 0.25f * j : 4.f + 0.5f * (j - 8); }
    const v6u pk = __builtin_amdgcn_cvt_scalef32_2xpk16_fp6_f32(ra, rb, 1.0f);
    const v32f dd = __builtin_amdgcn_cvt_scalef32_pk32_f32_fp6(pk, 1.0f);
#pragma unroll
    for (int k = 0; k < 32; ++k) {
      const float v = dd[k];
      const float fi = v < 1.f ? v * 8.f : (v < 2.f ? 8.f + (v - 1.f) * 8.f : (v < 4.f ? 16.f + (v - 2.f) * 4.f : 24.f + (v - 4.f) * 2.f));
      srck[k] = ((int)(fi + 0.5f)) & 31;
    }
  }
  const int ll = lane & 31, hs = lane >> 5;
  for (int r2 = blockIdx.x * 4 + wave; r2 < 16384; r2 += gridDim.x * 4) {
    const int r = r2 * 2 + hs;
    const int tab = r >> 14, row = r & 16383;
    const float4* sp = reinterpret_cast<const float4*>(p.in[29 + tab] + ((size_t)layer * 16384 + row) * 1024 + ll * 32);
    float s[32];
#pragma unroll
    for (int j = 0; j < 8; ++j) { const float4 a = sp[j]; s[4 * j] = a.x; s[4 * j + 1] = a.y; s[4 * j + 2] = a.z; s[4 * j + 3] = a.w; }
    float am = 0.f;
#pragma unroll
    for (int k = 0; k < 32; ++k) am = fmaxf(am, fabsf(s[k]));
#pragma unroll
    for (int m = 16; m >= 1; m >>= 1) am = fmaxf(am, __shfl_xor(am, m));
    const float sc = am > 0.f ? 7.5f / am : 1.f;
    const float inv = am > 0.f ? am * (1.f / 7.5f) : 1.f;
#pragma unroll
    for (int k = 0; k < 32; ++k) lds[srck[k] * 64] = s[k] * sc;
    v16f ia, ib;
#pragma unroll
    for (int j = 0; j < 16; ++j) { ia[j] = lds[j * 64]; ib[j] = lds[(16 + j) * 64]; }
    const v6u pk = __builtin_amdgcn_cvt_scalef32_2xpk16_fp6_f32(ia, ib, 1.0f);
    unsigned char* dst = p.ws + (size_t)layer * TB_STRIDE + (tab ? OFF_VB8 : OFF_UB8) + (size_t)row * 768;
    *reinterpret_cast<uint4*>(dst + ll * 16) = uint4{pk[0], pk[1], pk[2], pk[3]};
    *reinterpret_cast<uint2*>(dst + 512 + ll * 8) = uint2{pk[4], pk[5]};
    if (ll == 0) SCL[tab * 16384 + row] = inv;
  }
}

DEVI u32 enc_key(float s, int n) {
  u32 b = __float_as_uint(s);
  u32 srt = (b & 0x80000000u) ? ~b : (b | 0x80000000u);
  return (srt & ~127u) | (u32)(127 - n);
}
DEVI float dec_key(u32 key, int& n) {
  n = 127 - (int)(key & 127u);
  u32 srt = key & ~127u;
  u32 b = (srt & 0x80000000u) ? (srt & 0x7fffffffu) : ~srt;
  return __uint_as_float(b);
}

DEVI void phase_peer_q(const Params& p, int layer, unsigned char* smem) {
  const u16* XB = (const u16*)(p.ws + OFF_XB);
  const u16* Wt = (const u16*)(p.ws + OFF_WQ) + (size_t)layer * 2048 * 1024;
  const u16* SK = (const u16*)(p.ws + OFF_SK) + (size_t)layer * 2 * 128 * 128;
  u32* KEYS = (u32*)(p.ws + OFF_KEYS);
  const int tid = threadIdx.x, lane = tid & 63, wave = tid >> 6, wm = wave >> 1, wn = wave & 1;
  const int lr = lane & 15, lq = lane >> 4;
  u16* Qs = reinterpret_cast<u16*>(smem);
  u32* Sk = reinterpret_cast<u32*>(smem);
  for (int it = 0, mt, nt; tile_map(it, 256, 16, mt, nt); ++it) {
    const int m0 = mt * 128, hc = nt, n0 = hc * 128;
    const int c = hc & 1;
    gemm_tile_dma(XB + (size_t)m0 * 1024, 1024, Wt + (size_t)n0 * 1024, 1024, 1024, smem, [&](f32x4 (&acc)[4][4]) {
#pragma unroll
      for (int i = 0; i < 4; ++i)
#pragma unroll
        for (int j = 0; j < 4; ++j)
#pragma unroll
          for (int r = 0; r < 4; ++r)
            Qs[(wm * 64 + i * 16 + lq * 4 + r) * 136 + wn * 64 + j * 16 + lr] = f2bf(acc[i][j][r]);
      __syncthreads();
      f32x4 sc[4][4];
#pragma unroll
      for (int i = 0; i < 4; ++i)
#pragma unroll
        for (int j = 0; j < 4; ++j) sc[i][j] = f32x4{0.f, 0.f, 0.f, 0.f};
      const u16* skc = SK + (size_t)c * 128 * 128;
#pragma unroll
      for (int ks = 0; ks < 4; ++ks) {
        bf16x8 af[4], bfr[4];
#pragma unroll
        for (int i = 0; i < 4; ++i) af[i] = *reinterpret_cast<const bf16x8*>(Qs + (wm * 64 + i * 16 + lr) * 136 + ks * 32 + lq * 8);
#pragma unroll
        for (int j = 0; j < 4; ++j) bfr[j] = *reinterpret_cast<const bf16x8*>(skc + (size_t)(wn * 64 + j * 16 + lr) * 128 + ks * 32 + lq * 8);
#pragma unroll
        for (int i = 0; i < 4; ++i)
#pragma unroll
          for (int j = 0; j < 4; ++j) sc[i][j] = __builtin_amdgcn_mfma_f32_16x16x32_bf16(af[i], bfr[j], sc[i][j], 0, 0, 0);
      }
      __syncthreads();
#pragma unroll
      for (int i = 0; i < 4; ++i)
#pragma unroll
        for (int j = 0; j < 4; ++j)
#pragma unroll
          for (int r = 0; r < 4; ++r) {
            const int n = wn * 64 + j * 16 + lr;
            Sk[(wm * 64 + i * 16 + lq * 4 + r) * 129 + n] = enc_key(sc[i][j][r], n);
          }
      __syncthreads();
      if (tid < 128) {
        u32 top[16];
#pragma unroll
        for (int k = 0; k < 16; ++k) top[k] = 0u;
#pragma unroll 4
        for (int n = 0; n < 128; ++n) {
          u32 v = Sk[tid * 129 + n];
#pragma unroll
          for (int k = 0; k < 16; ++k) {
            const u32 hi = max(top[k], v);
            v = min(top[k], v);
            top[k] = hi;
          }
        }
        uint4* dst = reinterpret_cast<uint4*>(KEYS + ((size_t)(m0 + tid) * 16 + hc) * 16);
        dst[0] = uint4{top[0], top[1], top[2], top[3]};
        dst[1] = uint4{top[4], top[5], top[6], top[7]};
        dst[2] = uint4{top[8], top[9], top[10], top[11]};
        dst[3] = uint4{top[12], top[13], top[14], top[15]};
      }
    });
  }
}

DEVI void phase_peer_route(const Params& p, int s, int layer) {
  cvt_plain(p.in[2 + s] + (size_t)layer * TS * 256, (u16*)(p.ws + OFF_PB), (size_t)TS * 256 / 8);
  const u32* KEYS = (const u32*)(p.ws + OFF_KEYS);
  int* IDX = (int*)(p.ws + OFF_IDX);
  float* GATE = (float*)(p.ws + OFF_GATE);
  float* SU = (float*)(p.ws + OFF_SU);
  const float* SCL = (const float*)(p.ws + OFF_SCL + (size_t)layer * TB_STRIDE);
  const int gsz = gridDim.x * 256, gtid = blockIdx.x * 256 + threadIdx.x;
  for (int i = gtid; i < TS * 8; i += gsz) {
    const uint4* src = reinterpret_cast<const uint4*>(KEYS + (size_t)i * 32);
    u32 kk[32];
#pragma unroll
    for (int q = 0; q < 8; ++q) { const uint4 w = src[q]; kk[q * 4] = w.x; kk[q * 4 + 1] = w.y; kk[q * 4 + 2] = w.z; kk[q * 4 + 3] = w.w; }
    float s0[16], s1[16]; int i0[16], i1[16];
#pragma unroll
    for (int k = 0; k < 16; ++k) { s0[k] = dec_key(kk[k], i0[k]); s1[k] = dec_key(kk[16 + k], i1[k]); }
    float top[16];
#pragma unroll
    for (int k = 0; k < 16; ++k) top[k] = -3.0e38f;
#pragma unroll
    for (int k1 = 0; k1 < 16; ++k1)
#pragma unroll
      for (int k2 = 0; k2 < 16; ++k2)
        if ((k1 + 1) * (k2 + 1) <= 16) {
          float v = s0[k1] + s1[k2];
#pragma unroll
          for (int k = 0; k < 16; ++k) {
            const float hi = fmaxf(top[k], v);
            v = fminf(top[k], v);
            top[k] = hi;
          }
        }
    const float thr = top[15], mx = top[0];
    float den = 0.f;
#pragma unroll
    for (int k = 0; k < 16; ++k) den += __expf(top[k] - mx);
    const float inv = 1.f / den;
    int cnt = 0;
    int* idst = IDX + (size_t)i * 16;
    float* gdst = GATE + (size_t)i * 16;
    float* sdst = SU + (size_t)i * 16;
#pragma unroll
    for (int k1 = 0; k1 < 16; ++k1)
#pragma unroll
      for (int k2 = 0; k2 < 16; ++k2)
        if ((k1 + 1) * (k2 + 1) <= 16) {
          const float v = s0[k1] + s1[k2];
          if (v >= thr && cnt < 16) {
            const int e = i0[k1] * 128 + i1[k2];
            idst[cnt] = e;
            gdst[cnt] = __expf(v - mx) * inv * SCL[16384 + e];
            sdst[cnt] = SCL[e];
            ++cnt;
          }
        }
  }
}

DEVI f2 cvt8(u32 w, bool hi) { return hi ? __builtin_amdgcn_cvt_pk_f32_fp8((int)w, true) : __builtin_amdgcn_cvt_pk_f32_fp8((int)w, false); }

DEVI v32f ld_fp6_row(const unsigned char* base, int ei, int ll) {
  const unsigned char* r = base + (size_t)ei * 768;
  const uint4 a = *reinterpret_cast<const uint4*>(r + ll * 16);
  const uint2 b = *reinterpret_cast<const uint2*>(r + 512 + ll * 8);
  v6u pk; pk[0] = a.x; pk[1] = a.y; pk[2] = a.z; pk[3] = a.w; pk[4] = b.x; pk[5] = b.y;
  return __builtin_amdgcn_cvt_scalef32_pk32_f32_fp6(pk, 1.0f);
}

struct Raw6 { uint4 a; uint2 b; };
DEVI Raw6 ld_raw6(const unsigned char* base, int ei, int ll) {
  const unsigned char* r = base + (size_t)ei * 768;
  Raw6 o;
  o.a = *reinterpret_cast<const uint4*>(r + ll * 16);
  o.b = *reinterpret_cast<const uint2*>(r + 512 + ll * 8);
  return o;
}
DEVI v32f dec6(const Raw6& r) {
  v6u pk; pk[0] = r.a.x; pk[1] = r.a.y; pk[2] = r.a.z; pk[3] = r.a.w; pk[4] = r.b.x; pk[5] = r.b.y;
  return __builtin_amdgcn_cvt_scalef32_pk32_f32_fp6(pk, 1.0f);
}

DEVI void phase_peer_gather(const Params& p, int s, int layer) {
  float* X = p.out + (size_t)s * TS * 1024;
  u16* XB = (u16*)(p.ws + OFF_XB);
  const unsigned char* Ub = p.ws + OFF_UB8 + (size_t)layer * TB_STRIDE;
  const unsigned char* Vb = p.ws + OFF_VB8 + (size_t)layer * TB_STRIDE;
  const int* IDX = (const int*)(p.ws + OFF_IDX);
  const float* GATE = (const float*)(p.ws + OFF_GATE);
  const float* SU = (const float*)(p.ws + OFF_SU);
  const float* gam = p.in[25] + layer * 1024;
  const float* bet = p.in[26] + layer * 1024;
  const int lane = threadIdx.x & 63, wave = threadIdx.x >> 6;
  const int ll = lane & 31, hs = lane >> 5;
  const bool b4 = lane & 16, b3 = lane & 8;
  for (int t = blockIdx.x * 4 + wave; t < TS; t += gridDim.x * 4) {
    float x[32], o[32];
    {
      const uint4* xp = reinterpret_cast<const uint4*>(XB + (size_t)t * 1024 + ll * 32);
#pragma unroll
      for (int j = 0; j < 4; ++j) { const uint4 a = xp[j]; unpack8(a, x + 8 * j); }
    }
#pragma unroll
    for (int k = 0; k < 32; ++k) o[k] = 0.f;
    const int iv0 = IDX[(size_t)t * 128 + lane], iv1 = IDX[(size_t)t * 128 + 64 + lane];
    const float gv0 = GATE[(size_t)t * 128 + lane], gv1 = GATE[(size_t)t * 128 + 64 + lane];
    const float su0 = SU[(size_t)t * 128 + lane], su1 = SU[(size_t)t * 128 + 64 + lane];
    for (int e0 = 0; e0 < 128; e0 += 8) {
      const bool lo = e0 < 64;
      const int ivs = lo ? iv0 : iv1;
      const float gvs = lo ? gv0 : gv1;
      const float sus = lo ? su0 : su1;
      int ei[4];
#pragma unroll
      for (int q = 0; q < 4; ++q) {
        const int ea = __builtin_amdgcn_readlane(ivs, (e0 & 63) + 2 * q);
        const int eb = __builtin_amdgcn_readlane(ivs, (e0 & 63) + 2 * q + 1);
        ei[q] = hs ? eb : ea;
      }
      Raw6 cu[4], cv[4];
#pragma unroll
      for (int q = 0; q < 4; ++q) { cu[q] = ld_raw6(Ub, ei[q], ll); cv[q] = ld_raw6(Vb, ei[q], ll); }
      float dq[4];
#pragma unroll
      for (int q = 0; q < 4; ++q) {
        const v32f u = dec6(cu[q]);
        float d0 = 0.f, d1 = 0.f;
#pragma unroll
        for (int k = 0; k < 32; k += 2) { d0 = fmaf(u[k], x[k], d0); d1 = fmaf(u[k + 1], x[k + 1], d1); }
        dq[q] = d0 + d1;
      }
      float d2[2], d1;
#pragma unroll
      for (int k = 0; k < 2; ++k) {
        const float keep = b4 ? dq[k + 2] : dq[k], send = b4 ? dq[k] : dq[k + 2];
        d2[k] = keep + __shfl_xor(send, 16);
      }
      {
        const float keep = b3 ? d2[1] : d2[0], send = b3 ? d2[0] : d2[1];
        d1 = keep + __shfl_xor(send, 8);
      }
      d1 += __shfl_xor(d1, 4);
      d1 += __shfl_xor(d1, 2);
      d1 += __shfl_xor(d1, 1);
      const int qmine = (b4 ? 2 : 0) + (b3 ? 1 : 0);
      const int srcl = (e0 & 63) + 2 * qmine + hs;
      const float suv = __shfl(sus, srcl), gvv = __shfl(gvs, srcl);
      const float w = gvv * gelu_(d1 * suv);
#pragma unroll
      for (int q = 0; q < 4; ++q) {
        const float wq = __shfl(w, (lane & 32) | ((q >> 1) << 4) | ((q & 1) << 3));
        const v32f v = dec6(cv[q]);
#pragma unroll
        for (int k = 0; k < 32; ++k) o[k] = fmaf(wq, v[k], o[k]);
      }
    }
    float sm = 0.f;
#pragma unroll
    for (int k = 0; k < 32; ++k) { o[k] += __shfl_xor(o[k], 32); o[k] = ALPHA * x[k] + o[k]; sm += o[k]; }
#pragma unroll
    for (int m = 16; m >= 1; m >>= 1) sm += __shfl_xor(sm, m);
    const float mu = sm * (1.f / 1024.f);
    float sq = 0.f;
#pragma unroll
    for (int k = 0; k < 32; ++k) { const float dd = o[k] - mu; sq += dd * dd; }
#pragma unroll
    for (int m = 16; m >= 1; m >>= 1) sq += __shfl_xor(sq, m);
    const float rs = rsqrtf(sq * (1.f / 1024.f) + LN_EPS);
    if (hs == 0) {
      const int c0 = ll * 32;
#pragma unroll
      for (int j = 0; j < 4; ++j) {
        float r[8];
#pragma unroll
        for (int k = 0; k < 8; ++k) r[k] = (o[j * 8 + k] - mu) * rs * gam[c0 + j * 8 + k] + bet[c0 + j * 8 + k];
        *reinterpret_cast<uint4*>(XB + (size_t)t * 1024 + c0 + j * 8) = pack8(r);
      }
    }
  }
}

DEVI void phase_ple(const Params& p, int s, int layer, unsigned char* smem) {
  float* X = p.out + (size_t)s * TS * 1024;
  const u16* XB = (const u16*)(p.ws + OFF_XB);
  const u16* PB = (const u16*)(p.ws + OFF_PB);
  u16* XB2 = (u16*)(p.ws + OFF_XB2);
  const u16* Wp = (const u16*)(p.ws + OFF_WPROJ) + (size_t)layer * 1024 * 256;
  const u16* Wg = (const u16*)(p.ws + OFF_WPG) + (size_t)layer * 1024 * 1024;
  const int lane = threadIdx.x & 63, wave = threadIdx.x >> 6, wm = wave >> 1, wn = wave & 1;
  for (int it = 0, mt, nt; tile_map(it, 256, 8, mt, nt); ++it) {
    const int m0 = mt * 128, n0 = nt * 128;
    u32 pk[4][4][2];
    gemm_tile_dma(XB + (size_t)m0 * 1024, 1024, Wg + (size_t)n0 * 1024, 1024, 1024, smem, [&](f32x4 (&acc)[4][4]) {
#pragma unroll
      for (int i = 0; i < 4; ++i)
#pragma unroll
        for (int j = 0; j < 4; ++j) {
          pk[i][j][0] = pack2(sigmoid_(acc[i][j][0]), sigmoid_(acc[i][j][1]));
          pk[i][j][1] = pack2(sigmoid_(acc[i][j][2]), sigmoid_(acc[i][j][3]));
        }
    });
    gemm_tile_dma(PB + (size_t)m0 * 256, 256, Wp + (size_t)n0 * 256, 256, 256, smem, [&](f32x4 (&acc)[4][4]) {
#pragma unroll
      for (int i = 0; i < 4; ++i)
#pragma unroll
        for (int j = 0; j < 4; ++j)
#pragma unroll
          for (int r = 0; r < 4; ++r) {
            const int row = m0 + wm * 64 + i * 16 + (lane >> 4) * 4 + r;
            const int col = n0 + wn * 64 + j * 16 + (lane & 15);
            const u32 w = pk[i][j][r >> 1];
            const float sg = (r & 1) ? bfhi(w) : bflo(w);
            const size_t idx = (size_t)row * 1024 + col;
            const float v = bf2f(XB[idx]) + acc[i][j][r] * sg;
            X[idx] = v;
            if (layer == 0) XB2[idx] = f2bf(v);
          }
    });
  }
  if (layer == 1 && s == 0) cvt_plain(p.in[1], (u16*)(p.ws + OFF_XIN), (size_t)TS * 1024 / 8);
}

DEVI void phase_rg_in(const Params& p, int s, unsigned char* smem) {
  const u16* XB2 = (const u16*)(p.ws + OFF_XB2);
  const u16* Wt = (const u16*)(p.ws + OFF_WRGIN);
  u16* GG = (u16*)(p.ws + OFF_GG);
  u16* R = (u16*)(p.ws + OFF_R);
  const int lane = threadIdx.x & 63, wave = threadIdx.x >> 6, wm = wave >> 1, wn = wave & 1;
  bool pre_ = false;
  for (int it = 0, mt, nt; tile_map(it, 256, 16, mt, nt); ++it) {
    int mtn, ntn;
    const bool nxt_ = tile_map(it + 1, 256, 16, mtn, ntn);
    const int m0 = mt * 128, n0 = nt * 128;
    gemm_tile_dma<true>(XB2 + (size_t)m0 * 1024, 1024, Wt + (size_t)n0 * 1024, 1024, 1024, smem, [&](f32x4 (&acc)[4][4]) {
#pragma unroll
      for (int i = 0; i < 4; ++i)
#pragma unroll
        for (int j = 0; j < 4; ++j) {
          const int row = m0 + wm * 64 + i * 16 + (lane & 15);
          const int col = n0 + wn * 64 + j * 16 + (lane >> 4) * 4;
          uint2 w;
          if (n0 < 1024) {
            w.x = pack2(gelu_(acc[i][j][0]), gelu_(acc[i][j][1])); w.y = pack2(gelu_(acc[i][j][2]), gelu_(acc[i][j][3]));
            *reinterpret_cast<uint2*>(GG + (size_t)row * 1024 + col) = w;
          } else {
            w.x = pack2(acc[i][j][0], acc[i][j][1]); w.y = pack2(acc[i][j][2], acc[i][j][3]);
            *reinterpret_cast<uint2*>(R + (size_t)row * 1024 + col - 1024) = w;
          }
        }
    }, nxt_ ? (XB2 + (size_t)(mtn * 128) * 1024) : nullptr, nxt_ ? (Wt + (size_t)(ntn * 128) * 1024) : nullptr, pre_);
    pre_ = nxt_;
  }
}

DEVI void phase_rg_conv(const Params& p, int s) {
  const int L = s ? 2048 : 4096;
  const u16* R = (const u16*)(p.ws + OFF_R);
  u16* C = (u16*)(p.ws + OFF_C);
  const float* cw = p.in[15];
  const float* cb = p.in[16];
  const int gsz = gridDim.x * 256, gtid = blockIdx.x * 256 + threadIdx.x;
  for (int i = gtid; i < TS * 128; i += gsz) {
    const int t = i >> 7, cv = (i & 127) * 8;
    const int pos = t & (L - 1);
    float acc[8];
#pragma unroll
    for (int j = 0; j < 8; ++j) acc[j] = cb[cv + j];
#pragma unroll
    for (int k = 0; k < 4; ++k) {
      const int pp = pos + k - 1;
      if (pp >= 0 && pp < L) {
        float rv[8];
        unpack8(*reinterpret_cast<const uint4*>(R + (size_t)(t + k - 1) * 1024 + cv), rv);
#pragma unroll
        for (int j = 0; j < 8; ++j) acc[j] = fmaf(rv[j], cw[k * 1024 + cv + j], acc[j]);
      }
    }
    *reinterpret_cast<uint4*>(C + (size_t)i * 8) = pack8(acc);
  }
}

DEVI void phase_rg_gates(const Params& p, unsigned char* smem) {
  const u16* C = (const u16*)(p.ws + OFF_C);
  const u16* Wt = (const u16*)(p.ws + OFF_WGATES);
  u32* AB = (u32*)(p.ws + OFF_AB);
  const float* ba = p.in[18];
  const float* bx = p.in[20];
  const float* lam = p.in[21];
  const int lane = threadIdx.x & 63, wave = threadIdx.x >> 6, wm = wave >> 1, wn = wave & 1;
  for (int it = 0, mt, nt32; tile_map(it, 256, 32, mt, nt32); ++it) {
    const int m0 = mt * 128, h = nt32 >> 3, nt = nt32 & 7, n0 = nt * 128;
    gemm_tile_dma(C + (size_t)m0 * 1024 + h * 256, 1024, Wt + ((size_t)h * 1024 + n0) * 256, 256, 256, smem, [&](f32x4 (&acc)[4][4]) {
#pragma unroll
      for (int jj = 0; jj < 4; jj += 2) {
        const int nb = n0 + wn * 64 + jj * 16;
        const int d = nb >> 9;
        const int ch = h * 256 + ((nb & 511) >> 5) * 16 + (lane & 15);
        const float bav = ba[d * 1024 + ch], bxv = bx[d * 1024 + ch];
        const float sp8 = -8.f * softplus_(-lam[d * 1024 + ch]);
#pragma unroll
        for (int i = 0; i < 4; ++i)
#pragma unroll
          for (int r = 0; r < 4; ++r) {
            const int row = m0 + wm * 64 + i * 16 + (lane >> 4) * 4 + r;
            const float rg = sigmoid_(acc[i][jj][r] + bav);
            const float ig = sigmoid_(acc[i][jj + 1][r] + bxv);
            const float la = sp8 * rg;
            const float cval = bf2f(C[(size_t)row * 1024 + ch]);
            const float b = __builtin_amdgcn_sqrtf(fmaxf(1.f - __expf(2.f * la), 0.f)) * ig * cval;
            AB[((size_t)row * 2 + d) * 1024 + ch] = pack2(la, b);
            if (r == 3) __builtin_amdgcn_sched_barrier(0);
          }
      }
    });
  }
}

DEVI void phase_rg_agg(const Params& p) {
  const u32* AB = (const u32*)(p.ws + OFF_AB);
  float2* AGG = (float2*)(p.ws + OFF_AGG);
  const int gsz = gridDim.x * 256, gtid = blockIdx.x * 256 + threadIdx.x;
  for (int i = gtid; i < 1024 * 2 * 1024; i += gsz) {
    const int ch = i & 1023, d = (i >> 10) & 1, chunk = i >> 11;
    const int c0 = chunk * 32;
    float h = 0.f, LA = 0.f;
#pragma unroll 8
    for (int k = 0; k < 32; ++k) {
      const int t = d ? (c0 + 31 - k) : (c0 + k);
      const u32 w = AB[((size_t)t * 2 + d) * 1024 + ch];
      const float la = bflo(w), b = bfhi(w);
      h = __expf(la) * h + b;
      LA += la;
    }
    AGG[((size_t)d * 1024 + chunk) * 1024 + ch] = float2{LA, h};
  }
}

DEVI void phase_rg_carry(const Params& p, int s) {
  const int L = s ? 2048 : 4096;
  const int nseq = TS / L, nch = L / 32;
  const float2* AGG = (const float2*)(p.ws + OFF_AGG);
  float* CAR = (float*)(p.ws + OFF_CAR);
  const int gsz = gridDim.x * 256, gtid = blockIdx.x * 256 + threadIdx.x;
  for (int i = gtid; i < nseq * 2 * 1024; i += gsz) {
    const int ch = i & 1023, d = (i >> 10) & 1, seq = i >> 11;
    float H = 0.f;
#pragma unroll 8
    for (int k = 0; k < nch; ++k) {
      const int chunk = seq * nch + (d ? (nch - 1 - k) : k);
      const size_t idx = ((size_t)d * 1024 + chunk) * 1024 + ch;
      CAR[idx] = H;
      const float2 ag = AGG[idx];
      H = __expf(ag.x) * H + ag.y;
    }
  }
}

DEVI void phase_rg_final(const Params& p) {
  const u32* AB = (const u32*)(p.ws + OFF_AB);
  const float* CAR = (const float*)(p.ws + OFF_CAR);
  const u16* GG = (const u16*)(p.ws + OFF_GG);
  u16* Y = (u16*)(p.ws + OFF_R);
  const int gsz = gridDim.x * 256, gtid = blockIdx.x * 256 + threadIdx.x;
  for (int i = gtid; i < 1024 * 1024; i += gsz) {
    const int ch = i & 1023, chunk = i >> 10;
    const int c0 = chunk * 32;
    float hf[32];
    float h = CAR[((size_t)chunk) * 1024 + ch];
#pragma unroll
    for (int k = 0; k < 32; ++k) {
      const u32 w = AB[((size_t)(c0 + k) * 2 + 0) * 1024 + ch];
      h = __expf(bflo(w)) * h + bfhi(w);
      hf[k] = h;
    }
    h = CAR[((size_t)1024 + chunk) * 1024 + ch];
#pragma unroll
    for (int k = 31; k >= 0; --k) {
      const u32 w = AB[((size_t)(c0 + k) * 2 + 1) * 1024 + ch];
      h = __expf(bflo(w)) * h + bfhi(w);
      const size_t idx = (size_t)(c0 + k) * 1024 + ch;
      Y[idx] = f2bf((hf[k] + h) * bf2f(GG[idx]));
    }
  }
}

DEVI void phase_rg_out(const Params& p, int s, unsigned char* smem) {
  float* X = p.out + (size_t)s * TS * 1024;
  u16* ZB = (u16*)(p.ws + OFF_XB);
  const u16* Y = (const u16*)(p.ws + OFF_R);
  const u16* Wt = (const u16*)(p.ws + OFF_WRGOUT);
  const int lane = threadIdx.x & 63, wave = threadIdx.x >> 6, wm = wave >> 1, wn = wave & 1;
  bool pre_ = false;
  for (int it = 0, mt, nt; tile_map(it, 256, 8, mt, nt); ++it) {
    int mtn, ntn;
    const bool nxt_ = tile_map(it + 1, 256, 8, mtn, ntn);
    const int m0 = mt * 128, n0 = nt * 128;
    gemm_tile_dma<true>(Y + (size_t)m0 * 1024, 1024, Wt + (size_t)n0 * 1024, 1024, 1024, smem, [&](f32x4 (&acc)[4][4]) {
#pragma unroll
      for (int i = 0; i < 4; ++i)
#pragma unroll
        for (int j = 0; j < 4; ++j) {
          const int row = m0 + wm * 64 + i * 16 + (lane & 15);
          const int col = n0 + wn * 64 + j * 16 + (lane >> 4) * 4;
          float4* xp = reinterpret_cast<float4*>(X + (size_t)row * 1024 + col);
          float4 v = *xp;
          v.x = ALPHA * v.x + acc[i][j][0]; v.y = ALPHA * v.y + acc[i][j][1]; v.z = ALPHA * v.z + acc[i][j][2]; v.w = ALPHA * v.w + acc[i][j][3];
          uint2 w; w.x = pack2(v.x, v.y); w.y = pack2(v.z, v.w);
          *reinterpret_cast<uint2*>(ZB + (size_t)row * 1024 + col) = w;
        }
    }, nxt_ ? (Y + (size_t)(mtn * 128) * 1024) : nullptr, nxt_ ? (Wt + (size_t)(ntn * 128) * 1024) : nullptr, pre_);
    pre_ = nxt_;
  }
}

constexpr int NPS = 22;
constexpr int NSETUP = 3;
constexpr int NPHASE = NSETUP + 2 * NPS;

template <int PH>
DEVI void run_phase(const Params& p, unsigned char* smem) {
  if constexpr (PH == 0) {
    phase_setup(p);
  } else if constexpr (PH == 1) {
    phase_setup2(p, smem);
  } else if constexpr (PH == 2) {
    phase_setup3(p);
  } else {
    constexpr int s = (PH - NSETUP) / NPS, q = (PH - NSETUP) % NPS;
    if constexpr (q == 0) phase_s5_in(p, s, smem);
    else if constexpr (q == 1) phase_s5_state(p, smem);
    else if constexpr (q == 2) phase_s5_cscan(p, s);
    else if constexpr (q == 3) phase_s5_main(p, smem);
    else if constexpr (q == 4) phase_s5_glu(p, s, smem);
    else if constexpr (q == 5) phase_ln1_tables(p, s, 0, smem);
    else if constexpr (q == 6) phase_peer_q(p, 0, smem);
    else if constexpr (q == 7) phase_peer_route(p, s, 0);
    else if constexpr (q == 8) phase_peer_gather(p, s, 0);
    else if constexpr (q == 9) phase_ple(p, s, 0, smem);
    else if constexpr (q == 10) phase_rg_in(p, s, smem);
    else if constexpr (q == 11) phase_rg_conv(p, s);
    else if constexpr (q == 12) phase_rg_gates(p, smem);
    else if constexpr (q == 13) phase_rg_agg(p);
    else if constexpr (q == 14) phase_rg_carry(p, s);
    else if constexpr (q == 15) phase_rg_final(p);
    else if constexpr (q == 16) phase_rg_out(p, s, smem);
    else if constexpr (q == 17) phase_ln1_tables(p, s, 1, smem);
    else if constexpr (q == 18) phase_peer_q(p, 1, smem);
    else if constexpr (q == 19) phase_peer_route(p, s, 1);
    else if constexpr (q == 20) phase_peer_gather(p, s, 1);
    else if constexpr (q == 21) phase_ple(p, s, 1, smem);
  }
}

#define XB_TMO      128
#define XB_XCNT(j)  (256  + 64 * (j))
#define XB_XSUB(j)  (1280 + 64 * (j))
#define XB_XGEN(j)  (2304 + 64 * (j))
#define XB_TOP      3328
#define XB_TOPGEN   3392
#define XCD_BAR_WORDS 3456
#define XB_SPIN_CAP (1u << 18)
#define LAS __attribute__((address_space(3)))
DEVI unsigned xb_ld(unsigned* p) { return __hip_atomic_load(p, __ATOMIC_RELAXED, __HIP_MEMORY_SCOPE_AGENT); }
DEVI unsigned xb_add(unsigned* p, unsigned v) { return __hip_atomic_fetch_add(p, v, __ATOMIC_RELAXED, __HIP_MEMORY_SCOPE_AGENT); }
DEVI unsigned xb_xcc_id() { return (unsigned)__builtin_amdgcn_s_getreg((3 << 11) | 20) & 0xFu; }
#define XB_SPIN(cond, bar) do { unsigned _sp = 0; while (cond) { __builtin_amdgcn_s_sleep(1); \
    if ((++_sp & 255u) == 0u) { if (xb_ld(&(bar)[XB_TMO])) break; if (_sp > XB_SPIN_CAP) { atomicAdd(&(bar)[XB_TMO], 1u); break; } } } } while (0)
struct XcdBarrier { unsigned* bar; unsigned x; volatile LAS unsigned* st; };
DEVI XcdBarrier xcd_barrier_post(unsigned* bar, volatile LAS unsigned* st) {
  XcdBarrier b; b.bar = bar; b.x = xb_xcc_id(); b.st = st;
  if (threadIdx.x == 0) (void)xb_add(&bar[XB_XCNT(b.x)], 1u);
  return b;
}
DEVI void xcd_barrier_complete(unsigned* bar, unsigned x, unsigned& nloc, unsigned& nx) {
  const unsigned G = gridDim.x * gridDim.y * gridDim.z;
  unsigned sum, cnt, mine, sp = 0u;
  for (;;) {
    sum = 0u; cnt = 0u; mine = 0u;
#pragma unroll
    for (unsigned j = 0; j < 16; ++j) { const unsigned c = xb_ld(&bar[XB_XCNT(j)]); sum += c; cnt += (c > 0u) ? 1u : 0u; mine = (j == x) ? c : mine; }
    if (sum == G) break;
    __builtin_amdgcn_s_sleep(1);
    if ((++sp & 255u) == 0u) { if (xb_ld(&bar[XB_TMO])) break; if (sp > XB_SPIN_CAP) { atomicAdd(&bar[XB_TMO], 1u); break; } }
  }
  nloc = mine > 0u ? mine : 1u; nx = cnt > 0u ? cnt : 1u;
}
DEVI void xcd_barrier(const XcdBarrier& b) {
  asm volatile("s_waitcnt vmcnt(0)" ::: "memory");
  __syncthreads();
  if (threadIdx.x == 0) {
    unsigned* bar = b.bar;
    __builtin_amdgcn_s_waitcnt(0);
    unsigned nloc = b.st[0], nx = b.st[1];
    if (nloc == 0u) { xcd_barrier_complete(bar, b.x, nloc, nx); b.st[0] = nloc; b.st[1] = nx; }
    const unsigned old = xb_add(&bar[XB_XSUB(b.x)], 1u);
    const unsigned gen = old / nloc;
    if (old + 1u == (gen + 1u) * nloc) {
      __builtin_amdgcn_fence(__ATOMIC_RELEASE, "agent");
      asm volatile("s_waitcnt vmcnt(0)" ::: "memory");
      const unsigned og = xb_add(&bar[XB_TOP], 1u);
      const unsigned tg = og / nx;
      if (og + 1u == (tg + 1u) * nx) xb_add(&bar[XB_TOPGEN], 1u);
      else XB_SPIN(xb_ld(&bar[XB_TOPGEN]) == tg, bar);
      __builtin_amdgcn_fence(__ATOMIC_ACQUIRE, "agent");
      xb_add(&bar[XB_XGEN(b.x)], 1u);
      asm volatile("s_waitcnt vmcnt(0)" ::: "memory");
    } else {
      XB_SPIN(xb_ld(&bar[XB_XGEN(b.x)]) == gen, bar);
      __builtin_amdgcn_fence(__ATOMIC_ACQUIRE, "agent");
      asm volatile("s_waitcnt vmcnt(0)" ::: "memory");
    }
  }
  __syncthreads();
}

template <int PH>
DEVI void run_steps(const Params& p, int lo, int hi, unsigned char* smem, const XcdBarrier& xb) {
  if constexpr (PH < NPHASE) {
    if (PH >= lo && PH < hi) {
      run_phase<PH>(p, smem);
      if (PH + 1 < hi) {
        if (lo < 0) cg::this_grid().sync();
        xcd_barrier(xb);
      }
    }
    run_steps<PH + 1>(p, lo, hi, smem, xb);
  }
}

__global__ void __launch_bounds__(256, 2) mega(Params p, int ph_lo, int ph_hi) {
  extern __shared__ __attribute__((aligned(16))) unsigned char smem[];
  volatile LAS unsigned* st = (volatile LAS unsigned*)(smem + LDS_BYTES);
  if (threadIdx.x == 0) { st[0] = 0u; st[1] = 0u; }
  __syncthreads();
  const XcdBarrier xb = xcd_barrier_post((unsigned*)(p.ws + OFF_BAR), st);
  run_steps<0>(p, ph_lo, ph_hi, smem, xb);
}

extern "C" void kernel_launch(void* const* d_in, const int* in_sizes, int n_in, void* d_out, int out_size, void* d_ws,
                              size_t ws_size, hipStream_t stream) {
  static int grid = 0;
  if (grid == 0) {
    if (n_in != 33 || ws_size < WS_END) {
      fprintf(stderr, "kernel_launch: need 33 inputs and %zu bytes ws; got %d, %zu\n", (size_t)WS_END, n_in, ws_size);
      grid = -1;
      return;
    }
    int dev = 0, cus = 0, per_cu = 0;
    hipGetDevice(&dev);
    hipDeviceGetAttribute(&cus, hipDeviceAttributeMultiprocessorCount, dev);
    if (hipFuncSetAttribute((const void*)mega, hipFuncAttributeMaxDynamicSharedMemorySize, LDS_BYTES + 16) != hipSuccess) {
      fprintf(stderr, "kernel_launch: hipFuncSetAttribute failed\n");
      grid = -1;
      return;
    }
    hipOccupancyMaxActiveBlocksPerMultiprocessor(&per_cu, (const void*)mega, 256, LDS_BYTES + 16);
    if (per_cu < 1) per_cu = 1;
    if (per_cu > 2) per_cu = 2;
    grid = cus * per_cu;
    fprintf(stderr, "kernel_launch: cus %d per_cu %d grid %d\n", cus, per_cu, grid);
  }
  if (grid < 0) return;
  (void)hipMemsetAsync((unsigned char*)d_ws + OFF_BAR, 0, XCD_BAR_WORDS * sizeof(unsigned), stream);
  Params p{};
  for (int i = 0; i < 33; ++i) p.in[i] = (const float*)d_in[i];
  p.out = (float*)d_out;
  p.ws = (unsigned char*)d_ws;
#if COOP
  int lo = 0, hi = NPHASE;
  void* args[] = {&p, &lo, &hi};
  hipError_t e = hipLaunchCooperativeKernel((const void*)mega, dim3(grid), dim3(256), args, LDS_BYTES + 16, stream);
  if (e != hipSuccess) fprintf(stderr, "cooperative launch failed: %s (grid %d)\n", hipGetErrorString(e), grid);
#else
  for (int ph = 0; ph < NPHASE; ++ph) {
    hipLaunchKernelGGL(mega, dim3(grid), dim3(256), LDS_BYTES + 16, stream, p, ph, ph + 1);
  }
#endif
}
```

```cpp
#include <hip/hip_runtime.h>
#include <hip/hip_cooperative_groups.h>
#include <cstdio>
namespace cg = cooperative_groups;

#ifndef COOP
#define COOP 1
#endif

typedef unsigned short u16;
typedef unsigned int u32;
using bf16x8 = __attribute__((ext_vector_type(8))) short;
using f32x4 = __attribute__((ext_vector_type(4))) float;
typedef float f2 __attribute__((ext_vector_type(2)));
typedef float v32f __attribute__((ext_vector_type(32)));
typedef float v16f __attribute__((ext_vector_type(16)));
typedef unsigned v6u __attribute__((ext_vector_type(6)));

#define DEVI __device__ __forceinline__

constexpr int TS = 32768;
constexpr float ALPHA = 1.41421356237309515f;
constexpr float LN_EPS = 1e-5f;
constexpr size_t MBy = 1ull << 20;

constexpr size_t OFF_WS5IN = 0;
constexpr size_t OFF_WGLU = 2 * MBy;
constexpr size_t OFF_WRGIN = 6 * MBy;
constexpr size_t OFF_WGATES = 10 * MBy;
constexpr size_t OFF_WRGOUT = 12 * MBy;
constexpr size_t OFF_WQ = 14 * MBy;
constexpr size_t OFF_SK = 22 * MBy;
constexpr size_t OFF_WPROJ = 23 * MBy;
constexpr size_t OFF_WPG = 24 * MBy;
constexpr size_t OFF_UB = 28 * MBy;
constexpr size_t OFF_VB = 60 * MBy;
constexpr size_t TB_STRIDE = 26 * MBy;
constexpr size_t OFF_UB8 = OFF_UB;
constexpr size_t OFF_VB8 = OFF_UB + 12 * MBy;
constexpr size_t OFF_SCL = OFF_UB + 24 * MBy;
constexpr size_t OFF_ACT = 92 * MBy;
constexpr size_t OFF_XB = OFF_ACT;
constexpr size_t OFF_KEYS = OFF_ACT + 64 * MBy;
constexpr size_t OFF_IDX = OFF_ACT + 96 * MBy;
constexpr size_t OFF_GATE = OFF_ACT + 112 * MBy;
constexpr size_t OFF_SU = OFF_ACT + 128 * MBy;
constexpr size_t OFF_PB = OFF_ACT + 144 * MBy;
constexpr size_t OFF_XB2 = OFF_ACT + 192 * MBy;
constexpr size_t OFF_XIN = OFF_ACT + 256 * MBy;
constexpr size_t OFF_AP = OFF_ACT;
constexpr size_t OFF_HLOC = OFF_ACT + 104 * MBy;
constexpr size_t OFF_HB = OFF_ACT + 192 * MBy;
constexpr size_t OFF_GG = OFF_ACT;
constexpr size_t OFF_R = OFF_ACT + 64 * MBy;
constexpr size_t OFF_C = OFF_ACT + 128 * MBy;
constexpr size_t OFF_AB = OFF_ACT + 192 * MBy;
constexpr size_t OFF_AGG = OFF_ACT + 448 * MBy;
constexpr size_t OFF_CAR = OFF_ACT + 464 * MBy;
constexpr size_t OFF_BT1 = OFF_ACT + 472 * MBy;
constexpr size_t OFF_WST = OFF_BT1 + 48 * MBy;
constexpr size_t OFF_KTAB = OFF_WST + 16 * MBy;
constexpr size_t OFF_POW = OFF_KTAB + 4 * MBy;
constexpr size_t OFF_BBAR = OFF_POW + 3 * MBy;
constexpr size_t OFF_BAR = OFF_BBAR + 1 * MBy;
constexpr size_t WS_END = OFF_BAR + 1 * MBy;

constexpr int LDS_BYTES = 36864 + 32768;

struct Params {
  const float* in[33];
  float* out;
  unsigned char* ws;
};

DEVI u16 f2bf(float f) {
  u32 u = __float_as_uint(f);
  u += 0x7FFFu + ((u >> 16) & 1u);
  return (u16)(u >> 16);
}
DEVI float bf2f(u16 h) { return __uint_as_float(((u32)h) << 16); }
DEVI u32 pack2(float lo, float hi) { return (u32)f2bf(lo) | ((u32)f2bf(hi) << 16); }
DEVI float bflo(u32 w) { return __uint_as_float(w << 16); }
DEVI float bfhi(u32 w) { return __uint_as_float(w & 0xffff0000u); }
DEVI float sigmoid_(float x) { return __builtin_amdgcn_rcpf(1.f + __expf(-x)); }
DEVI float gelu_(float x) {
  float z = 0.7978845608028654f * (x + 0.044715f * x * x * x);
  return x * __builtin_amdgcn_rcpf(1.f + __expf(-2.f * z));
}
DEVI float softplus_(float x) { return fmaxf(x, 0.f) + log1pf(__expf(-fabsf(x))); }
DEVI void unpack8(const uint4& w, float* f) {
  f[0] = bflo(w.x); f[1] = bfhi(w.x); f[2] = bflo(w.y); f[3] = bfhi(w.y);
  f[4] = bflo(w.z); f[5] = bfhi(w.z); f[6] = bflo(w.w); f[7] = bfhi(w.w);
}
DEVI uint4 pack8(const float* f) {
  uint4 o; o.x = pack2(f[0], f[1]); o.y = pack2(f[2], f[3]); o.z = pack2(f[4], f[5]); o.w = pack2(f[6], f[7]);
  return o;
}

struct LdBF {
  const u16* base; int ld;
  typedef uint4 Raw;
  DEVI Raw load(int row, int k) const { return *reinterpret_cast<const uint4*>(base + (size_t)row * ld + k); }
  DEVI static uint4 cvt(const Raw& r) { return r; }
};
struct RawF { float4 a, b; };
struct LdF32 {
  const float* base; int ld;
  typedef RawF Raw;
  DEVI Raw load(int row, int k) const {
    const float4* q = reinterpret_cast<const float4*>(base + (size_t)row * ld + k);
    RawF r; r.a = q[0]; r.b = q[1]; return r;
  }
  DEVI static uint4 cvt(const Raw& r) {
    uint4 o; o.x = pack2(r.a.x, r.a.y); o.y = pack2(r.a.z, r.a.w); o.z = pack2(r.b.x, r.b.y); o.w = pack2(r.b.z, r.b.w);
    return o;
  }
};

template <class AL, class BL, class EP>
DEVI void gemm_tile(const AL al, const BL bl, const int K, unsigned char* smem, EP ep) {
  u16* As = reinterpret_cast<u16*>(smem);
  u16* Bs = As + 128 * 72;
  const int tid = threadIdx.x, lane = tid & 63, wave = tid >> 6, wm = wave >> 1, wn = wave & 1;
  const int lr = lane & 15, lq = lane >> 4;
  f32x4 acc[4][4];
#pragma unroll
  for (int i = 0; i < 4; ++i)
#pragma unroll
    for (int j = 0; j < 4; ++j) acc[i][j] = f32x4{0.f, 0.f, 0.f, 0.f};
  typename AL::Raw ra[4];
  typename BL::Raw rb[4];
  const int prow = tid >> 3, pk = (tid & 7) * 8;
#pragma unroll
  for (int i = 0; i < 4; ++i) { ra[i] = al.load(prow + i * 32, pk); rb[i] = bl.load(prow + i * 32, pk); }
  for (int kt = 0; kt < K; kt += 64) {
    __syncthreads();
#pragma unroll
    for (int i = 0; i < 4; ++i) {
      *reinterpret_cast<uint4*>(As + (prow + i * 32) * 72 + pk) = AL::cvt(ra[i]);
      *reinterpret_cast<uint4*>(Bs + (prow + i * 32) * 72 + pk) = BL::cvt(rb[i]);
    }
    __syncthreads();
    if (kt + 64 < K) {
#pragma unroll
      for (int i = 0; i < 4; ++i) { ra[i] = al.load(prow + i * 32, kt + 64 + pk); rb[i] = bl.load(prow + i * 32, kt + 64 + pk); }
    }
#pragma unroll
    for (int ks = 0; ks < 2; ++ks) {
      bf16x8 af[4], bfr[4];
#pragma unroll
      for (int i = 0; i < 4; ++i) af[i] = *reinterpret_cast<const bf16x8*>(As + (wm * 64 + i * 16 + lr) * 72 + ks * 32 + lq * 8);
#pragma unroll
      for (int j = 0; j < 4; ++j) bfr[j] = *reinterpret_cast<const bf16x8*>(Bs + (wn * 64 + j * 16 + lr) * 72 + ks * 32 + lq * 8);
#pragma unroll
      for (int i = 0; i < 4; ++i)
#pragma unroll
        for (int j = 0; j < 4; ++j) acc[i][j] = __builtin_amdgcn_mfma_f32_16x16x32_bf16(af[i], bfr[j], acc[i][j], 0, 0, 0);
    }
  }
  __syncthreads();
  ep(acc);
}

typedef __attribute__((address_space(3))) unsigned lds_u32;
template <bool TR = false, class EP>
DEVI void gemm_tile_dma(const u16* A, const int lda, const u16* Bt, const int ldb, const int K, unsigned char* smem, EP ep,
                        const u16* An = nullptr, const u16* Bn = nullptr, const bool pre = false) {
  const int tid = threadIdx.x, lane = tid & 63, wave = tid >> 6, wm = wave >> 1, wn = wave & 1;
  const int lr = lane & 15, lq = lane >> 4;
  f32x4 acc[4][4];
#pragma unroll
  for (int i = 0; i < 4; ++i)
#pragma unroll
    for (int j = 0; j < 4; ++j) acc[i][j] = f32x4{0.f, 0.f, 0.f, 0.f};
  const int rr = lane >> 3, qq = (lane & 7) ^ rr;
  const size_t aoff = (size_t)(wave * 32 + rr) * lda + qq * 8, boff = (size_t)(wave * 32 + rr) * ldb + qq * 8;
  const u16* ag = A + aoff;
  const u16* bg = Bt + boff;
  unsigned char* wbase = smem + wave * 4096;
#define GT_ISSUE(AP_, BP_, stage, kt)                                                                                    \
  do {                                                                                                                   \
    _Pragma("unroll") for (int j = 0; j < 4; ++j) {                                                                      \
      __builtin_amdgcn_global_load_lds((const unsigned*)((AP_) + (size_t)j * 8 * lda + (kt)),                            \
                                       (lds_u32*)(wbase + (stage) * 32768 + j * 1024), 16, 0, 0);                        \
      __builtin_amdgcn_global_load_lds((const unsigned*)((BP_) + (size_t)j * 8 * ldb + (kt)),                            \
                                       (lds_u32*)(wbase + (stage) * 32768 + 16384 + j * 1024), 16, 0, 0);                \
    }                                                                                                                    \
  } while (0)
  if (!pre) {
    __syncthreads();
    GT_ISSUE(ag, bg, 0, 0);
  }
  const int sw = lr & 7;
  int it = 0;
  for (int kt = 0; kt < K; kt += 64, ++it) {
    asm volatile("s_waitcnt vmcnt(0)" ::: "memory");
    __syncthreads();
    if (kt + 64 < K) GT_ISSUE(ag, bg, (it + 1) & 1, kt + 64);
    else if (An != nullptr) GT_ISSUE(An + aoff, Bn + boff, 0, 0);
    const unsigned char* As = smem + (it & 1) * 32768;
    const unsigned char* Bs = As + 16384;
#pragma unroll
    for (int ks = 0; ks < 2; ++ks) {
      bf16x8 af[4], bfr[4];
      const int ch = ((ks * 4 + lq) ^ sw) * 16;
#pragma unroll
      for (int i = 0; i < 4; ++i) af[i] = *reinterpret_cast<const bf16x8*>(As + (wm * 64 + i * 16 + lr) * 128 + ch);
#pragma unroll
      for (int j = 0; j < 4; ++j) bfr[j] = *reinterpret_cast<const bf16x8*>(Bs + (wn * 64 + j * 16 + lr) * 128 + ch);
      __builtin_amdgcn_s_setprio(1);
#pragma unroll
      for (int i = 0; i < 4; ++i)
#pragma unroll
        for (int j = 0; j < 4; ++j)
          acc[i][j] = TR ? __builtin_amdgcn_mfma_f32_16x16x32_bf16(bfr[j], af[i], acc[i][j], 0, 0, 0)
                         : __builtin_amdgcn_mfma_f32_16x16x32_bf16(af[i], bfr[j], acc[i][j], 0, 0, 0);
      __builtin_amdgcn_s_setprio(0);
    }
  }
#undef GT_ISSUE
  if (An == nullptr) __syncthreads();
  ep(acc);
}

DEVI bool tile_map(int it, int nmt, int nnt, int& mt, int& nt) {
  const int xcd = blockIdx.x & 7, j = blockIdx.x >> 3;
  const int per = gridDim.x >> 3;
  const int slot = it * per + j;
  const int S = (slot >> 6) * 8 + xcd;
  const int nsn = nnt >> 3, nsm = nmt >> 3;
  if (S >= nsn * nsm) return false;
  const int sm = S / nsn, sn = S - sm * nsn;
  const int w = slot & 63;
  mt = sm * 8 + (w >> 3);
  nt = sn * 8 + (w & 7);
  return true;
}

template <int PERM>
DEVI void cvt_wt(const float* W, int K, int N, u16* out, int a0, int a1) {
  const int gsz = gridDim.x * 256, gtid = blockIdx.x * 256 + threadIdx.x;
  const int total = N * (K >> 3);
  for (int i = gtid; i < total; i += gsz) {
    const int n = i % N, kv = i / N;
    float v[8];
#pragma unroll
    for (int j = 0; j < 8; ++j) v[j] = W[(size_t)(kv * 8 + j) * N + n];
    int np = n;
    if (PERM == 1) { const int g = n >> 10, o = n & 1023; np = (o >> 4) * 32 + g * 16 + (o & 15); }
    if (PERM == 2) { np = a0 * 512 + (n >> 4) * 32 + a1 * 16 + (n & 15); }
    *reinterpret_cast<uint4*>(out + (size_t)np * K + kv * 8) = pack8(v);
  }
}

DEVI void cvt_plain(const float* src, u16* dst, size_t n8) {
  const size_t gsz = (size_t)gridDim.x * 256, gtid = (size_t)blockIdx.x * 256 + threadIdx.x;
  for (size_t i = gtid; i < n8; i += gsz) {
    const float4* q = reinterpret_cast<const float4*>(src + i * 8);
    float4 a = q[0], b = q[1];
    uint4 o; o.x = pack2(a.x, a.y); o.y = pack2(a.z, a.w); o.z = pack2(b.x, b.y); o.w = pack2(b.z, b.w);
    *reinterpret_cast<uint4*>(dst + i * 8) = o;
  }
}

DEVI void phase_setup(const Params& p) {
  unsigned char* ws = p.ws;
  cvt_wt<0>(p.in[4], 1024, 1024, (u16*)(ws + OFF_WS5IN), 0, 0);
  cvt_wt<1>(p.in[13], 1024, 2048, (u16*)(ws + OFF_WGLU), 0, 0);
  cvt_wt<0>(p.in[14], 1024, 2048, (u16*)(ws + OFF_WRGIN), 0, 0);
  for (int d = 0; d < 2; ++d)
    for (int gate = 0; gate < 2; ++gate)
      for (int h = 0; h < 4; ++h)
        cvt_wt<2>((gate ? p.in[19] : p.in[17]) + (size_t)(d * 4 + h) * 65536, 256, 256,
                  (u16*)(ws + OFF_WGATES) + (size_t)h * 1024 * 256, d, gate);
  cvt_wt<0>(p.in[22], 1024, 1024, (u16*)(ws + OFF_WRGOUT), 0, 0);
  for (int l = 0; l < 2; ++l) {
    cvt_wt<0>(p.in[27] + (size_t)l * 1024 * 2048, 1024, 2048, (u16*)(ws + OFF_WQ) + (size_t)l * 2048 * 1024, 0, 0);
    cvt_wt<0>(p.in[31] + (size_t)l * 256 * 1024, 256, 1024, (u16*)(ws + OFF_WPROJ) + (size_t)l * 1024 * 256, 0, 0);
    cvt_wt<0>(p.in[32] + (size_t)l * 1024 * 1024, 1024, 1024, (u16*)(ws + OFF_WPG) + (size_t)l * 1024 * 1024, 0, 0);
  }
  cvt_plain(p.in[28], (u16*)(ws + OFF_SK), 65536 / 8);
  const int gsz = gridDim.x * 256, gtid = blockIdx.x * 256 + threadIdx.x;
  float2* POW = (float2*)(ws + OFF_POW);
  float2* BBAR = (float2*)(ws + OFF_BBAR);
  for (int i = gtid; i < 2 * 64 * 33 * 64; i += gsz) {
    const int pp = i & 63, n = (i >> 6) % 33, dg = i / (64 * 33);
    const float step = expf(p.in[7][dg]);
    const float lr_ = p.in[5][dg * 64 + pp], li_ = p.in[6][dg * 64 + pp];
    const float mag = expf((float)n * (lr_ * step)), ang = (float)n * (li_ * step);
    POW[i] = float2{mag * cosf(ang), mag * sinf(ang)};
  }
  for (int i = gtid; i < 2 * 64 * 64; i += gsz) {
    const int dg = i >> 6;
    const float step = expf(p.in[7][dg]);
    const float lr_ = p.in[5][i], li_ = p.in[6][i];
    const float mag = expf(lr_ * step), ang = li_ * step;
    const float ar = mag * cosf(ang), ai = mag * sinf(ang);
    const float den = lr_ * lr_ + li_ * li_;
    const float zr = ar - 1.f;
    const float qr = (zr * lr_ + ai * li_) / den, qi = (ai * lr_ - zr * li_) / den;
#pragma unroll
    for (int c = 0; c < 16; ++c) {
      const float br = p.in[8][(size_t)i * 16 + c], bi = p.in[9][(size_t)i * 16 + c];
      BBAR[(size_t)i * 16 + c] = float2{qr * br - qi * bi, qr * bi + qi * br};
    }
  }
}

DEVI float s5_kterm(const Params& p, const float2* POW, const float2* BBAR, int d, int g, int n, int c, int cp) {
  const int dg = d * 64 + g;
  const float* cr = p.in[10] + ((size_t)dg * 16 + c) * 64;
  const float* ci = p.in[11] + ((size_t)dg * 16 + c) * 64;
  const float2* E = POW + ((size_t)dg * 33 + n) * 64;
  const float2* BB = BBAR + (size_t)dg * 64 * 16 + cp;
  float s = 0.f;
#pragma unroll 8
  for (int pp = 0; pp < 64; ++pp) {
    const float2 e = E[pp], bb = BB[pp * 16];
    const float Cr = cr[pp], Ci = ci[pp];
    const float cer = Cr * e.x - Ci * e.y, cei = Cr * e.y + Ci * e.x;
    s += cer * bb.x - cei * bb.y;
  }
  return s;
}

DEVI void phase_tables(const Params& p, int layer, unsigned char* smem);

DEVI void phase_setup2(const Params& p, unsigned char* smem) {
  phase_tables(p, 0, smem);
  phase_tables(p, 1, smem);
  unsigned char* ws = p.ws;
  const int gsz = gridDim.x * 256, gtid = blockIdx.x * 256 + threadIdx.x;
  const float2* POW = (const float2*)(ws + OFF_POW);
  const float2* BBAR = (const float2*)(ws + OFF_BBAR);
  float* KTAB = (float*)(ws + OFF_KTAB);
  u16* WST = (u16*)(ws + OFF_WST);
  u16* BT1 = (u16*)(ws + OFF_BT1);
  for (int i = gtid; i < 64 * 63 * 256; i += gsz) {
    const int cp = i & 15, c = (i >> 4) & 15, ti = (i >> 8) % 63, g = i / (63 * 256);
    const int tau = ti - 31;
    float s = 0.f;
    if (tau >= 0) s += s5_kterm(p, POW, BBAR, 0, g, tau, c, cp);
    if (tau <= 0) s += s5_kterm(p, POW, BBAR, 1, g, -tau, c, cp);
    KTAB[i] = s;
  }
  for (int i = gtid; i < 64 * 256 * 64; i += gsz) {
    const int kv = i & 63, np = (i >> 6) & 255, g = i >> 14;
    const int d = np >> 7, ri = (np >> 6) & 1, pp = np & 63, s = kv >> 1, c0 = (kv & 1) * 8;
    const int npow = d ? s : 31 - s;
    const float2 e = POW[((size_t)(d * 64 + g) * 33 + npow) * 64 + pp];
    float v[8];
#pragma unroll
    for (int j = 0; j < 8; ++j) {
      const float2 bb = BBAR[((size_t)(d * 64 + g) * 64 + pp) * 16 + c0 + j];
      v[j] = ri ? (e.x * bb.y + e.y * bb.x) : (e.x * bb.x - e.y * bb.y);
    }
    *reinterpret_cast<uint4*>(WST + ((size_t)g * 256 + np) * 512 + kv * 8) = pack8(v);
  }
  for (int i = gtid; i < 64 * 512 * 32; i += gsz) {
    const int kv = i & 31, n = (i >> 5) & 511, g = i >> 14;
    const int t = n >> 4, c = n & 15, kk0 = kv * 8;
    const int d = kk0 >> 7, ri = (kk0 >> 6) & 1, p0 = kk0 & 63;
    const int npow = d ? 32 - t : t + 1;
    const int dg = d * 64 + g;
    float v[8];
#pragma unroll
    for (int j = 0; j < 8; ++j) {
      const int pp = p0 + j;
      const float Cr = p.in[10][((size_t)dg * 16 + c) * 64 + pp], Ci = p.in[11][((size_t)dg * 16 + c) * 64 + pp];
      const float2 e = POW[((size_t)dg * 33 + npow) * 64 + pp];
      v[j] = ri ? -(Cr * e.y + Ci * e.x) : (Cr * e.x - Ci * e.y);
    }
    *reinterpret_cast<uint4*>(BT1 + ((size_t)g * 512 + n) * 768 + 512 + kv * 8) = pack8(v);
  }
}

DEVI void phase_setup3(const Params& p) {
  cvt_plain(p.in[0], (u16*)(p.ws + OFF_XIN), (size_t)TS * 1024 / 8);
  const int gsz = gridDim.x * 256, gtid = blockIdx.x * 256 + threadIdx.x;
  const float* KTAB = (const float*)(p.ws + OFF_KTAB);
  u16* BT1 = (u16*)(p.ws + OFF_BT1);
  for (int i = gtid; i < 64 * 512 * 64; i += gsz) {
    const int kv = i & 63, n = (i >> 6) & 511, g = i >> 15;
    const int t = n >> 4, c = n & 15, s = kv >> 1, c0 = (kv & 1) * 8;
    const float* src = KTAB + (((size_t)g * 63 + (t - s + 31)) * 16 + c) * 16 + c0;
    float v[8];
#pragma unroll
    for (int j = 0; j < 8; ++j) v[j] = src[j];
    *reinterpret_cast<uint4*>(BT1 + ((size_t)g * 512 + n) * 768 + kv * 8) = pack8(v);
  }
}

DEVI void phase_s5_in(const Params& p, int s, unsigned char* smem) {
  const u16* XIN = (const u16*)(p.ws + OFF_XIN);
  const u16* Wt = (const u16*)(p.ws + OFF_WS5IN);
  u16* AP = (u16*)(p.ws + OFF_AP);
  const int lane = threadIdx.x & 63, wave = threadIdx.x >> 6, wm = wave >> 1, wn = wave & 1;
  bool pre_ = false;
  for (int it = 0, mt, nt; tile_map(it, 256, 8, mt, nt); ++it) {
    int mtn, ntn;
    const bool nxt_ = tile_map(it + 1, 256, 8, mtn, ntn);
    const int m0 = mt * 128, n0 = nt * 128;
    gemm_tile_dma<true>(XIN + (size_t)m0 * 1024, 1024, Wt + (size_t)n0 * 1024, 1024, 1024, smem, [&](f32x4 (&acc)[4][4]) {
#pragma unroll
      for (int i = 0; i < 4; ++i)
#pragma unroll
        for (int j = 0; j < 4; ++j) {
          const int row = m0 + wm * 64 + i * 16 + (lane & 15);
          const int col = n0 + wn * 64 + j * 16 + (lane >> 4) * 4;
          uint2 w; w.x = pack2(acc[i][j][0], acc[i][j][1]); w.y = pack2(acc[i][j][2], acc[i][j][3]);
          *reinterpret_cast<uint2*>(AP + ((size_t)(col >> 4) * 1024 + (row >> 5)) * 768 + (row & 31) * 16 + (col & 15)) = w;
        }
    }, nxt_ ? (XIN + (size_t)(mtn * 128) * 1024) : nullptr, nxt_ ? (Wt + (size_t)(ntn * 128) * 1024) : nullptr, pre_);
    pre_ = nxt_;
  }
}

DEVI void phase_s5_state(const Params& p, unsigned char* smem) {
  const u16* AP = (const u16*)(p.ws + OFF_AP);
  const u16* WST = (const u16*)(p.ws + OFF_WST);
  float* HLOC = (float*)(p.ws + OFF_HLOC);
  const int lane = threadIdx.x & 63, wave = threadIdx.x >> 6, wm = wave >> 1, wn = wave & 1;
  for (int tile = blockIdx.x; tile < 64 * 16; tile += gridDim.x) {
    const int g = tile >> 4, m0 = ((tile >> 1) & 7) * 128, n0 = (tile & 1) * 128;
    gemm_tile_dma(AP + ((size_t)g * 1024 + m0) * 768, 768, WST + ((size_t)g * 256 + n0) * 512, 512, 512, smem, [&](f32x4 (&acc)[4][4]) {
#pragma unroll
      for (int i = 0; i < 4; ++i)
#pragma unroll
        for (int j = 0; j < 4; ++j)
#pragma unroll
          for (int r = 0; r < 4; ++r) {
            const int row = m0 + wm * 64 + i * 16 + (lane >> 4) * 4 + r;
            const int col = n0 + wn * 64 + j * 16 + (lane & 15);
            HLOC[((size_t)g * 1024 + row) * 256 + col] = acc[i][j][r];
          }
    });
  }
}

DEVI void phase_s5_cscan(const Params& p, int s) {
  const int L = s ? 2048 : 4096;
  const int nseq = TS / L, nch = L / 32;
  u16* AP = (u16*)(p.ws + OFF_AP);
  const float* HLOC = (const float*)(p.ws + OFF_HLOC);
  const float2* POW = (const float2*)(p.ws + OFF_POW);
  const int gsz = gridDim.x * 256, gtid = blockIdx.x * 256 + threadIdx.x;
  for (int i = gtid; i < 64 * nseq * 128; i += gsz) {
    const int pp = i & 63, d = (i >> 6) & 1, g = (i >> 7) & 63, seq = i >> 13;
    const float2 e = POW[((size_t)(d * 64 + g) * 33 + 32) * 64 + pp];
    float Hr = 0.f, Hi = 0.f;
#pragma unroll 8
    for (int j = 0; j < nch; ++j) {
      const int chunk = seq * nch + (d ? (nch - 1 - j) : j);
      u16* ap = AP + ((size_t)g * 1024 + chunk) * 768 + 512 + d * 128 + pp;
      ap[0] = f2bf(Hr);
      ap[64] = f2bf(Hi);
      const float* hl = HLOC + ((size_t)g * 1024 + chunk) * 256 + d * 128 + pp;
      const float a = hl[0], b = hl[64];
      const float nHr = e.x * Hr - e.y * Hi + a;
      const float nHi = e.x * Hi + e.y * Hr + b;
      Hr = nHr; Hi = nHi;
    }
  }
}

DEVI void phase_s5_main(const Params& p, unsigned char* smem) {
  const u16* AP = (const u16*)(p.ws + OFF_AP);
  const u16* BT1 = (const u16*)(p.ws + OFF_BT1);
  u16* HB = (u16*)(p.ws + OFF_HB);
  const float* dsk = p.in[12];
  const int lane = threadIdx.x & 63, wave = threadIdx.x >> 6, wm = wave >> 1, wn = wave & 1;
  for (int tile = blockIdx.x; tile < 64 * 32; tile += gridDim.x) {
    const int g = tile >> 5, m0 = ((tile >> 2) & 7) * 128, n0 = (tile & 3) * 128;
    gemm_tile_dma(AP + ((size_t)g * 1024 + m0) * 768, 768, BT1 + ((size_t)g * 512 + n0) * 768, 768, 768, smem, [&](f32x4 (&acc)[4][4]) {
      const float dv = dsk[g * 16 + (lane & 15)];
#pragma unroll
      for (int i = 0; i < 4; ++i)
#pragma unroll
        for (int j = 0; j < 4; ++j)
#pragma unroll
          for (int r = 0; r < 4; ++r) {
            const int chunk = m0 + wm * 64 + i * 16 + (lane >> 4) * 4 + r;
            const int n = n0 + wn * 64 + j * 16 + (lane & 15);
            const float u = bf2f(AP[((size_t)g * 1024 + chunk) * 768 + n]);
            const float y = acc[i][j][r] + dv * u;
            HB[((size_t)chunk * 32 + (n >> 4)) * 1024 + g * 16 + (lane & 15)] = f2bf(gelu_(y));
          }
    });
  }
}

DEVI void phase_s5_glu(const Params& p, int s, unsigned char* smem) {
  const u16* HB = (const u16*)(p.ws + OFF_HB);
  const u16* Wt = (const u16*)(p.ws + OFF_WGLU);
  const float* Xin = p.in[s];
  u16* ZB = (u16*)(p.ws + OFF_XB);
  const int lane = threadIdx.x & 63, wave = threadIdx.x >> 6, wm = wave >> 1, wn = wave & 1;
  bool pre_ = false;
  for (int it = 0, mt, nt; tile_map(it, 256, 16, mt, nt); ++it) {
    int mtn, ntn;
    const bool nxt_ = tile_map(it + 1, 256, 16, mtn, ntn);
    const int m0 = mt * 128, n0 = nt * 128;
    gemm_tile_dma<true>(HB + (size_t)m0 * 1024, 1024, Wt + (size_t)n0 * 1024, 1024, 1024, smem, [&](f32x4 (&acc)[4][4]) {
#pragma unroll
      for (int i = 0; i < 4; ++i)
#pragma unroll
        for (int jj = 0; jj < 4; jj += 2) {
          const int row = m0 + wm * 64 + i * 16 + (lane & 15);
          const int nb = n0 + wn * 64 + jj * 16;
          const int o = (nb >> 5) * 16 + (lane >> 4) * 4;
          const size_t idx = (size_t)row * 1024 + o;
          const float4 xi = *reinterpret_cast<const float4*>(Xin + idx);
          float4 v;
          v.x = ALPHA * xi.x + acc[i][jj][0] * sigmoid_(acc[i][jj + 1][0]);
          v.y = ALPHA * xi.y + acc[i][jj][1] * sigmoid_(acc[i][jj + 1][1]);
          v.z = ALPHA * xi.z + acc[i][jj][2] * sigmoid_(acc[i][jj + 1][2]);
          v.w = ALPHA * xi.w + acc[i][jj][3] * sigmoid_(acc[i][jj + 1][3]);
          uint2 w; w.x = pack2(v.x, v.y); w.y = pack2(v.z, v.w);
          *reinterpret_cast<uint2*>(ZB + idx) = w;
        }
    }, nxt_ ? (HB + (size_t)(mtn * 128) * 1024) : nullptr, nxt_ ? (Wt + (size_t)(ntn * 128) * 1024) : nullptr, pre_);
    pre_ = nxt_;
  }
}

DEVI void phase_ln1_tables(const Params& p, int s, int layer, unsigned char* smem) {
  float* X = p.out + (size_t)s * TS * 1024;
  u16* XB = (u16*)(p.ws + OFF_XB);
  const float* gam = p.in[23] + layer * 1024;
  const float* bet = p.in[24] + layer * 1024;
  const int lane = threadIdx.x & 63, wave = threadIdx.x >> 6;
  for (int t = blockIdx.x * 4 + wave; t < TS; t += gridDim.x * 4) {
    float4 v[4];
#pragma unroll
    for (int i = 0; i < 4; ++i) {
      const uint2 w = *reinterpret_cast<const uint2*>(XB + (size_t)t * 1024 + i * 256 + lane * 4);
      v[i] = float4{bflo(w.x), bfhi(w.x), bflo(w.y), bfhi(w.y)};
    }
    float sm = 0.f;
#pragma unroll
    for (int i = 0; i < 4; ++i) sm += v[i].x + v[i].y + v[i].z + v[i].w;
#pragma unroll
    for (int m = 32; m >= 1; m >>= 1) sm += __shfl_xor(sm, m);
    const float mu = sm * (1.f / 1024.f);
    float sq = 0.f;
#pragma unroll
    for (int i = 0; i < 4; ++i) {
      const float a = v[i].x - mu, b = v[i].y - mu, c = v[i].z - mu, d = v[i].w - mu;
      sq += a * a + b * b + c * c + d * d;
    }
#pragma unroll
    for (int m = 32; m >= 1; m >>= 1) sq += __shfl_xor(sq, m);
    const float rs = rsqrtf(sq * (1.f / 1024.f) + LN_EPS);
#pragma unroll
    for (int i = 0; i < 4; ++i) {
      const int c0 = i * 256 + lane * 4;
      const float4 g4 = *reinterpret_cast<const float4*>(gam + c0);
      const float4 b4 = *reinterpret_cast<const float4*>(bet + c0);
      float4 o;
      o.x = (v[i].x - mu) * rs * g4.x + b4.x; o.y = (v[i].y - mu) * rs * g4.y + b4.y;
      o.z = (v[i].z - mu) * rs * g4.z + b4.z; o.w = (v[i].w - mu) * rs * g4.w + b4.w;
      uint2 pk; pk.x = pack2(o.x, o.y); pk.y = pack2(o.z, o.w);
      *reinterpret_cast<uint2*>(XB + (size_t)t * 1024 + c0) = pk;
    }
  }
}

DEVI void phase_tables(const Params& p, int layer, unsigned char* smem) {
  const int lane = threadIdx.x & 63, wave = threadIdx.x >> 6;
  float* SCL = (float*)(p.ws + OFF_SCL + (size_t)layer * TB_STRIDE);
  float* lds = reinterpret_cast<float*>(smem) + (threadIdx.x & 63) + (threadIdx.x >> 6) * 2048;
  int srck[32];
  {
    v16f ra, rb;
#pragma unroll
    for (int j = 0; j < 16; ++j) { ra[j] = (j < 8) ? 0.125f * j : 1.f + 0.125f * (j - 8); rb[j] = (j < 8) ? 2.f + 0.25f * j : 4.f + 0.5f * (j - 8); }
    const v6u pk = __builtin_amdgcn_cvt_scalef32_2xpk16_fp6_f32(ra, rb, 1.0f);
    const v32f dd = __builtin_amdgcn_cvt_scalef32_pk32_f32_fp6(pk, 1.0f);
#pragma unroll
    for (int k = 0; k < 32; ++k) {
      const float v = dd[k];
      const float fi = v < 1.f ? v * 8.f : (v < 2.f ? 8.f + (v - 1.f) * 8.f : (v < 4.f ? 16.f + (v - 2.f) * 4.f : 24.f + (v - 4.f) * 2.f));
      srck[k] = ((int)(fi + 0.5f)) & 31;
    }
  }
  const int ll = lane & 31, hs = lane >> 5;
  for (int r2 = blockIdx.x * 4 + wave; r2 < 16384; r2 += gridDim.x * 4) {
    const int r = r2 * 2 + hs;
    const int tab = r >> 14, row = r & 16383;
    const float4* sp = reinterpret_cast<const float4*>(p.in[29 + tab] + ((size_t)layer * 16384 + row) * 1024 + ll * 32);
    float s[32];
#pragma unroll
    for (int j = 0; j < 8; ++j) { const float4 a = sp[j]; s[4 * j] = a.x; s[4 * j + 1] = a.y; s[4 * j + 2] = a.z; s[4 * j + 3] = a.w; }
    float am = 0.f;
#pragma unroll
    for (int k = 0; k < 32; ++k) am = fmaxf(am, fabsf(s[k]));
#pragma unroll
    for (int m = 16; m >= 1; m >>= 1) am = fmaxf(am, __shfl_xor(am, m));
    const float sc = am > 0.f ? 7.5f / am : 1.f;
    const float inv = am > 0.f ? am * (1.f / 7.5f) : 1.f;
#pragma unroll
    for (int k = 0; k < 32; ++k) lds[srck[k] * 64] = s[k] * sc;
    v16f ia, ib;
#pragma unroll
    for (int j = 0; j < 16; ++j) { ia[j] = lds[j * 64]; ib[j] = lds[(16 + j) * 64]; }
    const v6u pk = __builtin_amdgcn_cvt_scalef32_2xpk16_fp6_f32(ia, ib, 1.0f);
    unsigned char* dst = p.ws + (size_t)layer * TB_STRIDE + (tab ? OFF_VB8 : OFF_UB8) + (size_t)row * 768;
    *reinterpret_cast<uint4*>(dst + ll * 16) = uint4{pk[0], pk[1], pk[2], pk[3]};
    *reinterpret_cast<uint2*>(dst + 512 + ll * 8) = uint2{pk[4], pk[5]};
    if (ll == 0) SCL[tab * 16384 + row] = inv;
  }
}

DEVI u32 enc_key(float s, int n) {
  u32 b = __float_as_uint(s);
  u32 srt = (b & 0x80000000u) ? ~b : (b | 0x80000000u);
  return (srt & ~127u) | (u32)(127 - n);
}
DEVI float dec_key(u32 key, int& n) {
  n = 127 - (int)(key & 127u);
  u32 srt = key & ~127u;
  u32 b = (srt & 0x80000000u) ? (srt & 0x7fffffffu) : ~srt;
  return __uint_as_float(b);
}

DEVI void phase_peer_q(const Params& p, int layer, unsigned char* smem) {
  const u16* XB = (const u16*)(p.ws + OFF_XB);
  const u16* Wt = (const u16*)(p.ws + OFF_WQ) + (size_t)layer * 2048 * 1024;
  const u16* SK = (const u16*)(p.ws + OFF_SK) + (size_t)layer * 2 * 128 * 128;
  u32* KEYS = (u32*)(p.ws + OFF_KEYS);
  const int tid = threadIdx.x, lane = tid & 63, wave = tid >> 6, wm = wave >> 1, wn = wave & 1;
  const int lr = lane & 15, lq = lane >> 4;
  u16* Qs = reinterpret_cast<u16*>(smem);
  u32* Sk = reinterpret_cast<u32*>(smem);
  for (int it = 0, mt, nt; tile_map(it, 256, 16, mt, nt); ++it) {
    const int m0 = mt * 128, hc = nt, n0 = hc * 128;
    const int c = hc & 1;
    gemm_tile_dma(XB + (size_t)m0 * 1024, 1024, Wt + (size_t)n0 * 1024, 1024, 1024, smem, [&](f32x4 (&acc)[4][4]) {
#pragma unroll
      for (int i = 0; i < 4; ++i)
#pragma unroll
        for (int j = 0; j < 4; ++j)
#pragma unroll
          for (int r = 0; r < 4; ++r)
            Qs[(wm * 64 + i * 16 + lq * 4 + r) * 136 + wn * 64 + j * 16 + lr] = f2bf(acc[i][j][r]);
      __syncthreads();
      f32x4 sc[4][4];
#pragma unroll
      for (int i = 0; i < 4; ++i)
#pragma unroll
        for (int j = 0; j < 4; ++j) sc[i][j] = f32x4{0.f, 0.f, 0.f, 0.f};
      const u16* skc = SK + (size_t)c * 128 * 128;
#pragma unroll
      for (int ks = 0; ks < 4; ++ks) {
        bf16x8 af[4], bfr[4];
#pragma unroll
        for (int i = 0; i < 4; ++i) af[i] = *reinterpret_cast<const bf16x8*>(Qs + (wm * 64 + i * 16 + lr) * 136 + ks * 32 + lq * 8);
#pragma unroll
        for (int j = 0; j < 4; ++j) bfr[j] = *reinterpret_cast<const bf16x8*>(skc + (size_t)(wn * 64 + j * 16 + lr) * 128 + ks * 32 + lq * 8);
#pragma unroll
        for (int i = 0; i < 4; ++i)
#pragma unroll
          for (int j = 0; j < 4; ++j) sc[i][j] = __builtin_amdgcn_mfma_f32_16x16x32_bf16(af[i], bfr[j], sc[i][j], 0, 0, 0);
      }
      __syncthreads();
#pragma unroll
      for (int i = 0; i < 4; ++i)
#pragma unroll
        for (int j = 0; j < 4; ++j)
#pragma unroll
          for (int r = 0; r < 4; ++r) {
            const int n = wn * 64 + j * 16 + lr;
            Sk[(wm * 64 + i * 16 + lq * 4 + r) * 129 + n] = enc_key(sc[i][j][r], n);
          }
      __syncthreads();
      if (tid < 128) {
        u32 top[16];
#pragma unroll
        for (int k = 0; k < 16; ++k) top[k] = 0u;
#pragma unroll 4
        for (int n = 0; n < 128; ++n) {
          u32 v = Sk[tid * 129 + n];
#pragma unroll
          for (int k = 0; k < 16; ++k) {
            const u32 hi = max(top[k], v);
            v = min(top[k], v);
            top[k] = hi;
          }
        }
        uint4* dst = reinterpret_cast<uint4*>(KEYS + ((size_t)(m0 + tid) * 16 + hc) * 16);
        dst[0] = uint4{top[0], top[1], top[2], top[3]};
        dst[1] = uint4{top[4], top[5], top[6], top[7]};
        dst[2] = uint4{top[8], top[9], top[10], top[11]};
        dst[3] = uint4{top[12], top[13], top[14], top[15]};
      }
    });
  }
}

DEVI void phase_peer_route(const Params& p, int s, int layer) {
  cvt_plain(p.in[2 + s] + (size_t)layer * TS * 256, (u16*)(p.ws + OFF_PB), (size_t)TS * 256 / 8);
  const u32* KEYS = (const u32*)(p.ws + OFF_KEYS);
  int* IDX = (int*)(p.ws + OFF_IDX);
  float* GATE = (float*)(p.ws + OFF_GATE);
  float* SU = (float*)(p.ws + OFF_SU);
  const float* SCL = (const float*)(p.ws + OFF_SCL + (size_t)layer * TB_STRIDE);
  const int gsz = gridDim.x * 256, gtid = blockIdx.x * 256 + threadIdx.x;
  for (int i = gtid; i < TS * 8; i += gsz) {
    const uint4* src = reinterpret_cast<const uint4*>(KEYS + (size_t)i * 32);
    u32 kk[32];
#pragma unroll
    for (int q = 0; q < 8; ++q) { const uint4 w = src[q]; kk[q * 4] = w.x; kk[q * 4 + 1] = w.y; kk[q * 4 + 2] = w.z; kk[q * 4 + 3] = w.w; }
    float s0[16], s1[16]; int i0[16], i1[16];
#pragma unroll
    for (int k = 0; k < 16; ++k) { s0[k] = dec_key(kk[k], i0[k]); s1[k] = dec_key(kk[16 + k], i1[k]); }
    float top[16];
#pragma unroll
    for (int k = 0; k < 16; ++k) top[k] = -3.0e38f;
#pragma unroll
    for (int k1 = 0; k1 < 16; ++k1)
#pragma unroll
      for (int k2 = 0; k2 < 16; ++k2)
        if ((k1 + 1) * (k2 + 1) <= 16) {
          float v = s0[k1] + s1[k2];
#pragma unroll
          for (int k = 0; k < 16; ++k) {
            const float hi = fmaxf(top[k], v);
            v = fminf(top[k], v);
            top[k] = hi;
          }
        }
    const float thr = top[15], mx = top[0];
    float den = 0.f;
#pragma unroll
    for (int k = 0; k < 16; ++k) den += __expf(top[k] - mx);
    const float inv = 1.f / den;
    int cnt = 0;
    int* idst = IDX + (size_t)i * 16;
    float* gdst = GATE + (size_t)i * 16;
    float* sdst = SU + (size_t)i * 16;
#pragma unroll
    for (int k1 = 0; k1 < 16; ++k1)
#pragma unroll
      for (int k2 = 0; k2 < 16; ++k2)
        if ((k1 + 1) * (k2 + 1) <= 16) {
          const float v = s0[k1] + s1[k2];
          if (v >= thr && cnt < 16) {
            const int e = i0[k1] * 128 + i1[k2];
            idst[cnt] = e;
            gdst[cnt] = __expf(v - mx) * inv * SCL[16384 + e];
            sdst[cnt] = SCL[e];
            ++cnt;
          }
        }
  }
}

DEVI f2 cvt8(u32 w, bool hi) { return hi ? __builtin_amdgcn_cvt_pk_f32_fp8((int)w, true) : __builtin_amdgcn_cvt_pk_f32_fp8((int)w, false); }

DEVI v32f ld_fp6_row(const unsigned char* base, int ei, int ll) {
  const unsigned char* r = base + (size_t)ei * 768;
  const uint4 a = *reinterpret_cast<const uint4*>(r + ll * 16);
  const uint2 b = *reinterpret_cast<const uint2*>(r + 512 + ll * 8);
  v6u pk; pk[0] = a.x; pk[1] = a.y; pk[2] = a.z; pk[3] = a.w; pk[4] = b.x; pk[5] = b.y;
  return __builtin_amdgcn_cvt_scalef32_pk32_f32_fp6(pk, 1.0f);
}

struct Raw6 { uint4 a; uint2 b; };
DEVI Raw6 ld_raw6(const unsigned char* base, int ei, int ll) {
  const unsigned char* r = base + (size_t)ei * 768;
  Raw6 o;
  o.a = *reinterpret_cast<const uint4*>(r + ll * 16);
  o.b = *reinterpret_cast<const uint2*>(r + 512 + ll * 8);
  return o;
}
DEVI v32f dec6(const Raw6& r) {
  v6u pk; pk[0] = r.a.x; pk[1] = r.a.y; pk[2] = r.a.z; pk[3] = r.a.w; pk[4] = r.b.x; pk[5] = r.b.y;
  return __builtin_amdgcn_cvt_scalef32_pk32_f32_fp6(pk, 1.0f);
}

DEVI void phase_peer_gather(const Params& p, int s, int layer) {
  float* X = p.out + (size_t)s * TS * 1024;
  u16* XB = (u16*)(p.ws + OFF_XB);
  const unsigned char* Ub = p.ws + OFF_UB8 + (size_t)layer * TB_STRIDE;
  const unsigned char* Vb = p.ws + OFF_VB8 + (size_t)layer * TB_STRIDE;
  const int* IDX = (const int*)(p.ws + OFF_IDX);
  const float* GATE = (const float*)(p.ws + OFF_GATE);
  const float* SU = (const float*)(p.ws + OFF_SU);
  const float* gam = p.in[25] + layer * 1024;
  const float* bet = p.in[26] + layer * 1024;
  const int lane = threadIdx.x & 63, wave = threadIdx.x >> 6;
  const int ll = lane & 31, hs = lane >> 5;
  const bool b4 = lane & 16, b3 = lane & 8;
  for (int t = blockIdx.x * 4 + wave; t < TS; t += gridDim.x * 4) {
    float x[32], o[32];
    {
      const uint4* xp = reinterpret_cast<const uint4*>(XB + (size_t)t * 1024 + ll * 32);
#pragma unroll
      for (int j = 0; j < 4; ++j) { const uint4 a = xp[j]; unpack8(a, x + 8 * j); }
    }
#pragma unroll
    for (int k = 0; k < 32; ++k) o[k] = 0.f;
    const int iv0 = IDX[(size_t)t * 128 + lane], iv1 = IDX[(size_t)t * 128 + 64 + lane];
    const float gv0 = GATE[(size_t)t * 128 + lane], gv1 = GATE[(size_t)t * 128 + 64 + lane];
    const float su0 = SU[(size_t)t * 128 + lane], su1 = SU[(size_t)t * 128 + 64 + lane];
    for (int e0 = 0; e0 < 128; e0 += 8) {
      const bool lo = e0 < 64;
      const int ivs = lo ? iv0 : iv1;
      const float gvs = lo ? gv0 : gv1;
      const float sus = lo ? su0 : su1;
      int ei[4];
#pragma unroll
      for (int q = 0; q < 4; ++q) {
        const int ea = __builtin_amdgcn_readlane(ivs, (e0 & 63) + 2 * q);
        const int eb = __builtin_amdgcn_readlane(ivs, (e0 & 63) + 2 * q + 1);
        ei[q] = hs ? eb : ea;
      }
      Raw6 cu[4], cv[4];
#pragma unroll
      for (int q = 0; q < 4; ++q) { cu[q] = ld_raw6(Ub, ei[q], ll); cv[q] = ld_raw6(Vb, ei[q], ll); }
      float dq[4];
#pragma unroll
      for (int q = 0; q < 4; ++q) {
        const v32f u = dec6(cu[q]);
        float d0 = 0.f, d1 = 0.f;
#pragma unroll
        for (int k = 0; k < 32; k += 2) { d0 = fmaf(u[k], x[k], d0); d1 = fmaf(u[k + 1], x[k + 1], d1); }
        dq[q] = d0 + d1;
      }
      float d2[2], d1;
#pragma unroll
      for (int k = 0; k < 2; ++k) {
        const float keep = b4 ? dq[k + 2] : dq[k], send = b4 ? dq[k] : dq[k + 2];
        d2[k] = keep + __shfl_xor(send, 16);
      }
      {
        const float keep = b3 ? d2[1] : d2[0], send = b3 ? d2[0] : d2[1];
        d1 = keep + __shfl_xor(send, 8);
      }
      d1 += __shfl_xor(d1, 4);
      d1 += __shfl_xor(d1, 2);
      d1 += __shfl_xor(d1, 1);
      const int qmine = (b4 ? 2 : 0) + (b3 ? 1 : 0);
      const int srcl = (e0 & 63) + 2 * qmine + hs;
      const float suv = __shfl(sus, srcl), gvv = __shfl(gvs, srcl);
      const float w = gvv * gelu_(d1 * suv);
#pragma unroll
      for (int q = 0; q < 4; ++q) {
        const float wq = __shfl(w, (lane & 32) | ((q >> 1) << 4) | ((q & 1) << 3));
        const v32f v = dec6(cv[q]);
#pragma unroll
        for (int k = 0; k < 32; ++k) o[k] = fmaf(wq, v[k], o[k]);
      }
    }
    float sm = 0.f;
#pragma unroll
    for (int k = 0; k < 32; ++k) { o[k] += __shfl_xor(o[k], 32); o[k] = ALPHA * x[k] + o[k]; sm += o[k]; }
#pragma unroll
    for (int m = 16; m >= 1; m >>= 1) sm += __shfl_xor(sm, m);
    const float mu = sm * (1.f / 1024.f);
    float sq = 0.f;
#pragma unroll
    for (int k = 0; k < 32; ++k) { const float dd = o[k] - mu; sq += dd * dd; }
#pragma unroll
    for (int m = 16; m >= 1; m >>= 1) sq += __shfl_xor(sq, m);
    const float rs = rsqrtf(sq * (1.f / 1024.f) + LN_EPS);
    if (hs == 0) {
      const int c0 = ll * 32;
#pragma unroll
      for (int j = 0; j < 4; ++j) {
        float r[8];
#pragma unroll
        for (int k = 0; k < 8; ++k) r[k] = (o[j * 8 + k] - mu) * rs * gam[c0 + j * 8 + k] + bet[c0 + j * 8 + k];
        *reinterpret_cast<uint4*>(XB + (size_t)t * 1024 + c0 + j * 8) = pack8(r);
      }
    }
  }
}

DEVI void phase_ple(const Params& p, int s, int layer, unsigned char* smem) {
  float* X = p.out + (size_t)s * TS * 1024;
  const u16* XB = (const u16*)(p.ws + OFF_XB);
  const u16* PB = (const u16*)(p.ws + OFF_PB);
  u16* XS = (u16*)(p.out + (size_t)s * TS * 1024);
  const u16* Wp = (const u16*)(p.ws + OFF_WPROJ) + (size_t)layer * 1024 * 256;
  const u16* Wg = (const u16*)(p.ws + OFF_WPG) + (size_t)layer * 1024 * 1024;
  const int lane = threadIdx.x & 63, wave = threadIdx.x >> 6, wm = wave >> 1, wn = wave & 1;
  for (int it = 0, mt, nt; tile_map(it, 256, 8, mt, nt); ++it) {
    const int m0 = mt * 128, n0 = nt * 128;
    u32 pk[4][4][2];
    gemm_tile_dma(XB + (size_t)m0 * 1024, 1024, Wg + (size_t)n0 * 1024, 1024, 1024, smem, [&](f32x4 (&acc)[4][4]) {
#pragma unroll
      for (int i = 0; i < 4; ++i)
#pragma unroll
        for (int j = 0; j < 4; ++j) {
          pk[i][j][0] = pack2(sigmoid_(acc[i][j][0]), sigmoid_(acc[i][j][1]));
          pk[i][j][1] = pack2(sigmoid_(acc[i][j][2]), sigmoid_(acc[i][j][3]));
        }
    });
    gemm_tile_dma(PB + (size_t)m0 * 256, 256, Wp + (size_t)n0 * 256, 256, 256, smem, [&](f32x4 (&acc)[4][4]) {
#pragma unroll
      for (int i = 0; i < 4; ++i)
#pragma unroll
        for (int j = 0; j < 4; ++j)
#pragma unroll
          for (int r = 0; r < 4; ++r) {
            const int row = m0 + wm * 64 + i * 16 + (lane >> 4) * 4 + r;
            const int col = n0 + wn * 64 + j * 16 + (lane & 15);
            const u32 w = pk[i][j][r >> 1];
            const float sg = (r & 1) ? bfhi(w) : bflo(w);
            const size_t idx = (size_t)row * 1024 + col;
            const float v = bf2f(XB[idx]) + acc[i][j][r] * sg;
            if (layer == 0) XS[idx] = f2bf(v); else X[idx] = v;
          }
    });
  }
  if (layer == 1 && s == 0) cvt_plain(p.in[1], (u16*)(p.ws + OFF_XIN), (size_t)TS * 1024 / 8);
}

DEVI void phase_rg_in(const Params& p, int s, unsigned char* smem) {
  const u16* XB2 = (const u16*)(p.out + (size_t)s * TS * 1024);
  const u16* Wt = (const u16*)(p.ws + OFF_WRGIN);
  u16* GG = (u16*)(p.ws + OFF_GG);
  u16* R = (u16*)(p.ws + OFF_R);
  const int lane = threadIdx.x & 63, wave = threadIdx.x >> 6, wm = wave >> 1, wn = wave & 1;
  bool pre_ = false;
  for (int it = 0, mt, nt; tile_map(it, 256, 16, mt, nt); ++it) {
    int mtn, ntn;
    const bool nxt_ = tile_map(it + 1, 256, 16, mtn, ntn);
    const int m0 = mt * 128, n0 = nt * 128;
    gemm_tile_dma<true>(XB2 + (size_t)m0 * 1024, 1024, Wt + (size_t)n0 * 1024, 1024, 1024, smem, [&](f32x4 (&acc)[4][4]) {
#pragma unroll
      for (int i = 0; i < 4; ++i)
#pragma unroll
        for (int j = 0; j < 4; ++j) {
          const int row = m0 + wm * 64 + i * 16 + (lane & 15);
          const int col = n0 + wn * 64 + j * 16 + (lane >> 4) * 4;
          uint2 w;
          if (n0 < 1024) {
            w.x = pack2(gelu_(acc[i][j][0]), gelu_(acc[i][j][1])); w.y = pack2(gelu_(acc[i][j][2]), gelu_(acc[i][j][3]));
            *reinterpret_cast<uint2*>(GG + (size_t)row * 1024 + col) = w;
          } else {
            w.x = pack2(acc[i][j][0], acc[i][j][1]); w.y = pack2(acc[i][j][2], acc[i][j][3]);
            *reinterpret_cast<uint2*>(R + (size_t)row * 1024 + col - 1024) = w;
          }
        }
    }, nxt_ ? (XB2 + (size_t)(mtn * 128) * 1024) : nullptr, nxt_ ? (Wt + (size_t)(ntn * 128) * 1024) : nullptr, pre_);
    pre_ = nxt_;
  }
}

DEVI void phase_rg_conv(const Params& p, int s) {
  const int L = s ? 2048 : 4096;
  const u16* R = (const u16*)(p.ws + OFF_R);
  u16* C = (u16*)(p.ws + OFF_C);
  const float* cw = p.in[15];
  const float* cb = p.in[16];
  const int gsz = gridDim.x * 256, gtid = blockIdx.x * 256 + threadIdx.x;
  for (int i = gtid; i < TS * 128; i += gsz) {
    const int t = i >> 7, cv = (i & 127) * 8;
    const int pos = t & (L - 1);
    float acc[8];
#pragma unroll
    for (int j = 0; j < 8; ++j) acc[j] = cb[cv + j];
#pragma unroll
    for (int k = 0; k < 4; ++k) {
      const int pp = pos + k - 1;
      if (pp >= 0 && pp < L) {
        float rv[8];
        unpack8(*reinterpret_cast<const uint4*>(R + (size_t)(t + k - 1) * 1024 + cv), rv);
#pragma unroll
        for (int j = 0; j < 8; ++j) acc[j] = fmaf(rv[j], cw[k * 1024 + cv + j], acc[j]);
      }
    }
    *reinterpret_cast<uint4*>(C + (size_t)i * 8) = pack8(acc);
  }
}

DEVI void phase_rg_gates(const Params& p, unsigned char* smem) {
  const u16* C = (const u16*)(p.ws + OFF_C);
  const u16* Wt = (const u16*)(p.ws + OFF_WGATES);
  u32* AB = (u32*)(p.ws + OFF_AB);
  const float* ba = p.in[18];
  const float* bx = p.in[20];
  const float* lam = p.in[21];
  const int lane = threadIdx.x & 63, wave = threadIdx.x >> 6, wm = wave >> 1, wn = wave & 1;
  for (int it = 0, mt, nt32; tile_map(it, 256, 32, mt, nt32); ++it) {
    const int m0 = mt * 128, h = nt32 >> 3, nt = nt32 & 7, n0 = nt * 128;
    gemm_tile_dma(C + (size_t)m0 * 1024 + h * 256, 1024, Wt + ((size_t)h * 1024 + n0) * 256, 256, 256, smem, [&](f32x4 (&acc)[4][4]) {
#pragma unroll
      for (int jj = 0; jj < 4; jj += 2) {
        const int nb = n0 + wn * 64 + jj * 16;
        const int d = nb >> 9;
        const int ch = h * 256 + ((nb & 511) >> 5) * 16 + (lane & 15);
        const float bav = ba[d * 1024 + ch], bxv = bx[d * 1024 + ch];
        const float sp8 = -8.f * softplus_(-lam[d * 1024 + ch]);
#pragma unroll
        for (int i = 0; i < 4; ++i)
#pragma unroll
          for (int r = 0; r < 4; ++r) {
            const int row = m0 + wm * 64 + i * 16 + (lane >> 4) * 4 + r;
            const float rg = sigmoid_(acc[i][jj][r] + bav);
            const float ig = sigmoid_(acc[i][jj + 1][r] + bxv);
            const float la = sp8 * rg;
            const float cval = bf2f(C[(size_t)row * 1024 + ch]);
            const float b = __builtin_amdgcn_sqrtf(fmaxf(1.f - __expf(2.f * la), 0.f)) * ig * cval;
            AB[((size_t)row * 2 + d) * 1024 + ch] = pack2(la, b);
            if (r == 3) __builtin_amdgcn_sched_barrier(0);
          }
      }
    });
  }
}

DEVI void phase_rg_agg(const Params& p) {
  const u32* AB = (const u32*)(p.ws + OFF_AB);
  float2* AGG = (float2*)(p.ws + OFF_AGG);
  const int gsz = gridDim.x * 256, gtid = blockIdx.x * 256 + threadIdx.x;
  for (int i = gtid; i < 1024 * 2 * 1024; i += gsz) {
    const int ch = i & 1023, d = (i >> 10) & 1, chunk = i >> 11;
    const int c0 = chunk * 32;
    float h = 0.f, LA = 0.f;
#pragma unroll 8
    for (int k = 0; k < 32; ++k) {
      const int t = d ? (c0 + 31 - k) : (c0 + k);
      const u32 w = AB[((size_t)t * 2 + d) * 1024 + ch];
      const float la = bflo(w), b = bfhi(w);
      h = __expf(la) * h + b;
      LA += la;
    }
    AGG[((size_t)d * 1024 + chunk) * 1024 + ch] = float2{LA, h};
  }
}

DEVI void phase_rg_carry(const Params& p, int s) {
  const int L = s ? 2048 : 4096;
  const int nseq = TS / L, nch = L / 32;
  const float2* AGG = (const float2*)(p.ws + OFF_AGG);
  float* CAR = (float*)(p.ws + OFF_CAR);
  const int gsz = gridDim.x * 256, gtid = blockIdx.x * 256 + threadIdx.x;
  for (int i = gtid; i < nseq * 2 * 1024; i += gsz) {
    const int ch = i & 1023, d = (i >> 10) & 1, seq = i >> 11;
    float H = 0.f;
#pragma unroll 8
    for (int k = 0; k < nch; ++k) {
      const int chunk = seq * nch + (d ? (nch - 1 - k) : k);
      const size_t idx = ((size_t)d * 1024 + chunk) * 1024 + ch;
      CAR[idx] = H;
      const float2 ag = AGG[idx];
      H = __expf(ag.x) * H + ag.y;
    }
  }
}

DEVI void phase_rg_final(const Params& p) {
  const u32* AB = (const u32*)(p.ws + OFF_AB);
  const float* CAR = (const float*)(p.ws + OFF_CAR);
  const u16* GG = (const u16*)(p.ws + OFF_GG);
  u16* Y = (u16*)(p.ws + OFF_R);
  const int gsz = gridDim.x * 256, gtid = blockIdx.x * 256 + threadIdx.x;
  for (int i = gtid; i < 1024 * 1024; i += gsz) {
    const int ch = i & 1023, chunk = i >> 10;
    const int c0 = chunk * 32;
    float hf[32];
    float h = CAR[((size_t)chunk) * 1024 + ch];
#pragma unroll
    for (int k = 0; k < 32; ++k) {
      const u32 w = AB[((size_t)(c0 + k) * 2 + 0) * 1024 + ch];
      h = __expf(bflo(w)) * h + bfhi(w);
      hf[k] = h;
    }
    h = CAR[((size_t)1024 + chunk) * 1024 + ch];
#pragma unroll
    for (int k = 31; k >= 0; --k) {
      const u32 w = AB[((size_t)(c0 + k) * 2 + 1) * 1024 + ch];
      h = __expf(bflo(w)) * h + bfhi(w);
      const size_t idx = (size_t)(c0 + k) * 1024 + ch;
      Y[idx] = f2bf((hf[k] + h) * bf2f(GG[idx]));
    }
  }
}

DEVI void phase_rg_out(const Params& p, int s, unsigned char* smem) {
  const u16* XS = (const u16*)(p.out + (size_t)s * TS * 1024);
  u16* ZB = (u16*)(p.ws + OFF_XB);
  const u16* Y = (const u16*)(p.ws + OFF_R);
  const u16* Wt = (const u16*)(p.ws + OFF_WRGOUT);
  const int lane = threadIdx.x & 63, wave = threadIdx.x >> 6, wm = wave >> 1, wn = wave & 1;
  bool pre_ = false;
  for (int it = 0, mt, nt; tile_map(it, 256, 8, mt, nt); ++it) {
    int mtn, ntn;
    const bool nxt_ = tile_map(it + 1, 256, 8, mtn, ntn);
    const int m0 = mt * 128, n0 = nt * 128;
    gemm_tile_dma<true>(Y + (size_t)m0 * 1024, 1024, Wt + (size_t)n0 * 1024, 1024, 1024, smem, [&](f32x4 (&acc)[4][4]) {
#pragma unroll
      for (int i = 0; i < 4; ++i)
#pragma unroll
        for (int j = 0; j < 4; ++j) {
          const int row = m0 + wm * 64 + i * 16 + (lane & 15);
          const int col = n0 + wn * 64 + j * 16 + (lane >> 4) * 4;
          const uint2 xw = *reinterpret_cast<const uint2*>(XS + (size_t)row * 1024 + col);
          float4 v = float4{bflo(xw.x), bfhi(xw.x), bflo(xw.y), bfhi(xw.y)};
          v.x = ALPHA * v.x + acc[i][j][0]; v.y = ALPHA * v.y + acc[i][j][1]; v.z = ALPHA * v.z + acc[i][j][2]; v.w = ALPHA * v.w + acc[i][j][3];
          uint2 w; w.x = pack2(v.x, v.y); w.y = pack2(v.z, v.w);
          *reinterpret_cast<uint2*>(ZB + (size_t)row * 1024 + col) = w;
        }
    }, nxt_ ? (Y + (size_t)(mtn * 128) * 1024) : nullptr, nxt_ ? (Wt + (size_t)(ntn * 128) * 1024) : nullptr, pre_);
    pre_ = nxt_;
  }
}

constexpr int NPS = 22;
constexpr int NSETUP = 3;
constexpr int NPHASE = NSETUP + 2 * NPS;

template <int PH>
DEVI void run_phase(const Params& p, unsigned char* smem) {
  if constexpr (PH == 0) {
    phase_setup(p);
  } else if constexpr (PH == 1) {
    phase_setup2(p, smem);
  } else if constexpr (PH == 2) {
    phase_setup3(p);
  } else {
    constexpr int s = (PH - NSETUP) / NPS, q = (PH - NSETUP) % NPS;
    if constexpr (q == 0) phase_s5_in(p, s, smem);
    else if constexpr (q == 1) phase_s5_state(p, smem);
    else if constexpr (q == 2) phase_s5_cscan(p, s);
    else if constexpr (q == 3) phase_s5_main(p, smem);
    else if constexpr (q == 4) phase_s5_glu(p, s, smem);
    else if constexpr (q == 5) phase_ln1_tables(p, s, 0, smem);
    else if constexpr (q == 6) phase_peer_q(p, 0, smem);
    else if constexpr (q == 7) phase_peer_route(p, s, 0);
    else if constexpr (q == 8) phase_peer_gather(p, s, 0);
    else if constexpr (q == 9) phase_ple(p, s, 0, smem);
    else if constexpr (q == 10) phase_rg_in(p, s, smem);
    else if constexpr (q == 11) phase_rg_conv(p, s);
    else if constexpr (q == 12) phase_rg_gates(p, smem);
    else if constexpr (q == 13) phase_rg_agg(p);
    else if constexpr (q == 14) phase_rg_carry(p, s);
    else if constexpr (q == 15) phase_rg_final(p);
    else if constexpr (q == 16) phase_rg_out(p, s, smem);
    else if constexpr (q == 17) phase_ln1_tables(p, s, 1, smem);
    else if constexpr (q == 18) phase_peer_q(p, 1, smem);
    else if constexpr (q == 19) phase_peer_route(p, s, 1);
    else if constexpr (q == 20) phase_peer_gather(p, s, 1);
    else if constexpr (q == 21) phase_ple(p, s, 1, smem);
  }
}

#define XB_TMO      128
#define XB_XCNT(j)  (256  + 64 * (j))
#define XB_XSUB(j)  (1280 + 64 * (j))
#define XB_XGEN(j)  (2304 + 64 * (j))
#define XB_TOP      3328
#define XB_TOPGEN   3392
#define XCD_BAR_WORDS 3456
#define XB_SPIN_CAP (1u << 18)
#define LAS __attribute__((address_space(3)))
DEVI unsigned xb_ld(unsigned* p) { return __hip_atomic_load(p, __ATOMIC_RELAXED, __HIP_MEMORY_SCOPE_AGENT); }
DEVI unsigned xb_add(unsigned* p, unsigned v) { return __hip_atomic_fetch_add(p, v, __ATOMIC_RELAXED, __HIP_MEMORY_SCOPE_AGENT); }
DEVI unsigned xb_xcc_id() { return (unsigned)__builtin_amdgcn_s_getreg((3 << 11) | 20) & 0xFu; }
#define XB_SPIN(cond, bar) do { unsigned _sp = 0; while (cond) { __builtin_amdgcn_s_sleep(1); \
    if ((++_sp & 255u) == 0u) { if (xb_ld(&(bar)[XB_TMO])) break; if (_sp > XB_SPIN_CAP) { atomicAdd(&(bar)[XB_TMO], 1u); break; } } } } while (0)
struct XcdBarrier { unsigned* bar; unsigned x; volatile LAS unsigned* st; };
DEVI XcdBarrier xcd_barrier_post(unsigned* bar, volatile LAS unsigned* st) {
  XcdBarrier b; b.bar = bar; b.x = xb_xcc_id(); b.st = st;
  if (threadIdx.x == 0) (void)xb_add(&bar[XB_XCNT(b.x)], 1u);
  return b;
}
DEVI void xcd_barrier_complete(unsigned* bar, unsigned x, unsigned& nloc, unsigned& nx) {
  const unsigned G = gridDim.x * gridDim.y * gridDim.z;
  unsigned sum, cnt, mine, sp = 0u;
  for (;;) {
    sum = 0u; cnt = 0u; mine = 0u;
#pragma unroll
    for (unsigned j = 0; j < 16; ++j) { const unsigned c = xb_ld(&bar[XB_XCNT(j)]); sum += c; cnt += (c > 0u) ? 1u : 0u; mine = (j == x) ? c : mine; }
    if (sum == G) break;
    __builtin_amdgcn_s_sleep(1);
    if ((++sp & 255u) == 0u) { if (xb_ld(&bar[XB_TMO])) break; if (sp > XB_SPIN_CAP) { atomicAdd(&bar[XB_TMO], 1u); break; } }
  }
  nloc = mine > 0u ? mine : 1u; nx = cnt > 0u ? cnt : 1u;
}
DEVI void xcd_barrier(const XcdBarrier& b) {
  asm volatile("s_waitcnt vmcnt(0)" ::: "memory");
  __syncthreads();
  if (threadIdx.x == 0) {
    unsigned* bar = b.bar;
    __builtin_amdgcn_s_waitcnt(0);
    unsigned nloc = b.st[0], nx = b.st[1];
    if (nloc == 0u) { xcd_barrier_complete(bar, b.x, nloc, nx); b.st[0] = nloc; b.st[1] = nx; }
    const unsigned old = xb_add(&bar[XB_XSUB(b.x)], 1u);
    const unsigned gen = old / nloc;
    if (old + 1u == (gen + 1u) * nloc) {
      __builtin_amdgcn_fence(__ATOMIC_RELEASE, "agent");
      asm volatile("s_waitcnt vmcnt(0)" ::: "memory");
      const unsigned og = xb_add(&bar[XB_TOP], 1u);
      const unsigned tg = og / nx;
      if (og + 1u == (tg + 1u) * nx) xb_add(&bar[XB_TOPGEN], 1u);
      else XB_SPIN(xb_ld(&bar[XB_TOPGEN]) == tg, bar);
      __builtin_amdgcn_fence(__ATOMIC_ACQUIRE, "agent");
      xb_add(&bar[XB_XGEN(b.x)], 1u);
      asm volatile("s_waitcnt vmcnt(0)" ::: "memory");
    } else {
      XB_SPIN(xb_ld(&bar[XB_XGEN(b.x)]) == gen, bar);
      __builtin_amdgcn_fence(__ATOMIC_ACQUIRE, "agent");
      asm volatile("s_waitcnt vmcnt(0)" ::: "memory");
    }
  }
  __syncthreads();
}

template <int PH>
DEVI void run_steps(const Params& p, int lo, int hi, unsigned char* smem, const XcdBarrier& xb) {
  if constexpr (PH < NPHASE) {
    if (PH >= lo && PH < hi) {
      run_phase<PH>(p, smem);
      if (PH + 1 < hi) {
        if (lo < 0) cg::this_grid().sync();
        xcd_barrier(xb);
      }
    }
    run_steps<PH + 1>(p, lo, hi, smem, xb);
  }
}

__global__ void __launch_bounds__(256, 2) mega(Params p, int ph_lo, int ph_hi) {
  extern __shared__ __attribute__((aligned(16))) unsigned char smem[];
  volatile LAS unsigned* st = (volatile LAS unsigned*)(smem + LDS_BYTES);
  if (threadIdx.x == 0) { st[0] = 0u; st[1] = 0u; }
  __syncthreads();
  const XcdBarrier xb = xcd_barrier_post((unsigned*)(p.ws + OFF_BAR), st);
  run_steps<0>(p, ph_lo, ph_hi, smem, xb);
}

extern "C" void kernel_launch(void* const* d_in, const int* in_sizes, int n_in, void* d_out, int out_size, void* d_ws,
                              size_t ws_size, hipStream_t stream) {
  static int grid = 0;
  if (grid == 0) {
    if (n_in != 33 || ws_size < WS_END) {
      fprintf(stderr, "kernel_launch: need 33 inputs and %zu bytes ws; got %d, %zu\n", (size_t)WS_END, n_in, ws_size);
      grid = -1;
      return;
    }
    int dev = 0, cus = 0, per_cu = 0;
    hipGetDevice(&dev);
    hipDeviceGetAttribute(&cus, hipDeviceAttributeMultiprocessorCount, dev);
    if (hipFuncSetAttribute((const void*)mega, hipFuncAttributeMaxDynamicSharedMemorySize, LDS_BYTES + 16) != hipSuccess) {
      fprintf(stderr, "kernel_launch: hipFuncSetAttribute failed\n");
      grid = -1;
      return;
    }
    hipOccupancyMaxActiveBlocksPerMultiprocessor(&per_cu, (const void*)mega, 256, LDS_BYTES + 16);
    if (per_cu < 1) per_cu = 1;
    if (per_cu > 2) per_cu = 2;
    grid = cus * per_cu;
    fprintf(stderr, "kernel_launch: cus %d per_cu %d grid %d\n", cus, per_cu, grid);
  }
  if (grid < 0) return;
  (void)hipMemsetAsync((unsigned char*)d_ws + OFF_BAR, 0, XCD_BAR_WORDS * sizeof(unsigned), stream);
  Params p{};
  for (int i = 0; i < 33; ++i) p.in[i] = (const float*)d_in[i];
  p.out = (float*)d_out;
  p.ws = (unsigned char*)d_ws;
#if COOP
  int lo = 0, hi = NPHASE;
  void* args[] = {&p, &lo, &hi};
  hipError_t e = hipLaunchCooperativeKernel((const void*)mega, dim3(grid), dim3(256), args, LDS_BYTES + 16, stream);
  if (e != hipSuccess) fprintf(stderr, "cooperative launch failed: %s (grid %d)\n", hipGetErrorString(e), grid);
#else
  for (int ph = 0; ph < NPHASE; ++ph) {
    hipLaunchKernelGGL(mega, dim3(grid), dim3(256), LDS_BYTES + 16, stream, p, ph, ph + 1);
  }
#endif
}
```

```cpp
#include <hip/hip_runtime.h>
#include <hip/hip_cooperative_groups.h>
#include <cstdio>
namespace cg = cooperative_groups;

#ifndef COOP
#define COOP 1
#endif

typedef unsigned short u16;
typedef unsigned int u32;
using bf16x8 = __attribute__((ext_vector_type(8))) short;
using f32x4 = __attribute__((ext_vector_type(4))) float;
typedef float f2 __attribute__((ext_vector_type(2)));
typedef float v32f __attribute__((ext_vector_type(32)));
typedef float v16f __attribute__((ext_vector_type(16)));
typedef unsigned v6u __attribute__((ext_vector_type(6)));

#define DEVI __device__ __forceinline__

constexpr int TS = 32768;
constexpr float ALPHA = 1.41421356237309515f;
constexpr float LN_EPS = 1e-5f;
constexpr size_t MBy = 1ull << 20;

constexpr size_t OFF_WS5IN = 0;
constexpr size_t OFF_WGLU = 2 * MBy;
constexpr size_t OFF_WRGIN = 6 * MBy;
constexpr size_t OFF_WGATES = 10 * MBy;
constexpr size_t OFF_WRGOUT = 12 * MBy;
constexpr size_t OFF_WQ = 14 * MBy;
constexpr size_t OFF_SK = 22 * MBy;
constexpr size_t OFF_WPROJ = 23 * MBy;
constexpr size_t OFF_WPG = 24 * MBy;
constexpr size_t OFF_UB = 28 * MBy;
constexpr size_t OFF_VB = 60 * MBy;
constexpr size_t TB_STRIDE = 26 * MBy;
constexpr size_t OFF_UB8 = OFF_UB;
constexpr size_t OFF_VB8 = OFF_UB + 12 * MBy;
constexpr size_t OFF_SCL = OFF_UB + 24 * MBy;
constexpr size_t OFF_ACT = 92 * MBy;
constexpr size_t OFF_XB = OFF_ACT;
constexpr size_t OFF_KEYS = OFF_ACT + 64 * MBy;
constexpr size_t OFF_IDX = OFF_ACT + 96 * MBy;
constexpr size_t OFF_GATE = OFF_ACT + 112 * MBy;
constexpr size_t OFF_SU = OFF_ACT + 128 * MBy;
constexpr size_t OFF_PB = OFF_ACT + 144 * MBy;
constexpr size_t OFF_XB2 = OFF_ACT + 192 * MBy;
constexpr size_t OFF_XIN = OFF_ACT + 256 * MBy;
constexpr size_t OFF_AP = OFF_ACT;
constexpr size_t OFF_HLOC = OFF_ACT + 104 * MBy;
constexpr size_t OFF_HB = OFF_ACT + 192 * MBy;
constexpr size_t OFF_GG = OFF_ACT;
constexpr size_t OFF_R = OFF_ACT + 64 * MBy;
constexpr size_t OFF_C = OFF_ACT + 128 * MBy;
constexpr size_t OFF_AB = OFF_ACT + 192 * MBy;
constexpr size_t OFF_AGG = OFF_ACT + 448 * MBy;
constexpr size_t OFF_CAR = OFF_ACT + 464 * MBy;
constexpr size_t OFF_BT1 = OFF_ACT + 472 * MBy;
constexpr size_t OFF_WST = OFF_BT1 + 48 * MBy;
constexpr size_t OFF_KTAB = OFF_WST + 16 * MBy;
constexpr size_t OFF_POW = OFF_KTAB + 4 * MBy;
constexpr size_t OFF_BBAR = OFF_POW + 3 * MBy;
constexpr size_t OFF_BAR = OFF_BBAR + 1 * MBy;
constexpr size_t WS_END = OFF_BAR + 1 * MBy;

constexpr int LDS_BYTES = 36864 + 32768;

struct Params {
  const float* in[33];
  float* out;
  unsigned char* ws;
};

DEVI u16 f2bf(float f) {
  u32 u = __float_as_uint(f);
  u += 0x7FFFu + ((u >> 16) & 1u);
  return (u16)(u >> 16);
}
DEVI float bf2f(u16 h) { return __uint_as_float(((u32)h) << 16); }
DEVI u32 pack2(float lo, float hi) { return (u32)f2bf(lo) | ((u32)f2bf(hi) << 16); }
DEVI float bflo(u32 w) { return __uint_as_float(w << 16); }
DEVI float bfhi(u32 w) { return __uint_as_float(w & 0xffff0000u); }
DEVI float sigmoid_(float x) { return __builtin_amdgcn_rcpf(1.f + __expf(-x)); }
DEVI float gelu_(float x) {
  float z = 0.7978845608028654f * (x + 0.044715f * x * x * x);
  return x * __builtin_amdgcn_rcpf(1.f + __expf(-2.f * z));
}
DEVI float softplus_(float x) { return fmaxf(x, 0.f) + log1pf(__expf(-fabsf(x))); }
DEVI void unpack8(const uint4& w, float* f) {
  f[0] = bflo(w.x); f[1] = bfhi(w.x); f[2] = bflo(w.y); f[3] = bfhi(w.y);
  f[4] = bflo(w.z); f[5] = bfhi(w.z); f[6] = bflo(w.w); f[7] = bfhi(w.w);
}
DEVI uint4 pack8(const float* f) {
  uint4 o; o.x = pack2(f[0], f[1]); o.y = pack2(f[2], f[3]); o.z = pack2(f[4], f[5]); o.w = pack2(f[6], f[7]);
  return o;
}

struct LdBF {
  const u16* base; int ld;
  typedef uint4 Raw;
  DEVI Raw load(int row, int k) const { return *reinterpret_cast<const uint4*>(base + (size_t)row * ld + k); }
  DEVI static uint4 cvt(const Raw& r) { return r; }
};
struct RawF { float4 a, b; };
struct LdF32 {
  const float* base; int ld;
  typedef RawF Raw;
  DEVI Raw load(int row, int k) const {
    const float4* q = reinterpret_cast<const float4*>(base + (size_t)row * ld + k);
    RawF r; r.a = q[0]; r.b = q[1]; return r;
  }
  DEVI static uint4 cvt(const Raw& r) {
    uint4 o; o.x = pack2(r.a.x, r.a.y); o.y = pack2(r.a.z, r.a.w); o.z = pack2(r.b.x, r.b.y); o.w = pack2(r.b.z, r.b.w);
    return o;
  }
};

template <class AL, class BL, class EP>
DEVI void gemm_tile(const AL al, const BL bl, const int K, unsigned char* smem, EP ep) {
  u16* As = reinterpret_cast<u16*>(smem);
  u16* Bs = As + 128 * 72;
  const int tid = threadIdx.x, lane = tid & 63, wave = tid >> 6, wm = wave >> 1, wn = wave & 1;
  const int lr = lane & 15, lq = lane >> 4;
  f32x4 acc[4][4];
#pragma unroll
  for (int i = 0; i < 4; ++i)
#pragma unroll
    for (int j = 0; j < 4; ++j) acc[i][j] = f32x4{0.f, 0.f, 0.f, 0.f};
  typename AL::Raw ra[4];
  typename BL::Raw rb[4];
  const int prow = tid >> 3, pk = (tid & 7) * 8;
#pragma unroll
  for (int i = 0; i < 4; ++i) { ra[i] = al.load(prow + i * 32, pk); rb[i] = bl.load(prow + i * 32, pk); }
  for (int kt = 0; kt < K; kt += 64) {
    __syncthreads();
#pragma unroll
    for (int i = 0; i < 4; ++i) {
      *reinterpret_cast<uint4*>(As + (prow + i * 32) * 72 + pk) = AL::cvt(ra[i]);
      *reinterpret_cast<uint4*>(Bs + (prow + i * 32) * 72 + pk) = BL::cvt(rb[i]);
    }
    __syncthreads();
    if (kt + 64 < K) {
#pragma unroll
      for (int i = 0; i < 4; ++i) { ra[i] = al.load(prow + i * 32, kt + 64 + pk); rb[i] = bl.load(prow + i * 32, kt + 64 + pk); }
    }
#pragma unroll
    for (int ks = 0; ks < 2; ++ks) {
      bf16x8 af[4], bfr[4];
#pragma unroll
      for (int i = 0; i < 4; ++i) af[i] = *reinterpret_cast<const bf16x8*>(As + (wm * 64 + i * 16 + lr) * 72 + ks * 32 + lq * 8);
#pragma unroll
      for (int j = 0; j < 4; ++j) bfr[j] = *reinterpret_cast<const bf16x8*>(Bs + (wn * 64 + j * 16 + lr) * 72 + ks * 32 + lq * 8);
#pragma unroll
      for (int i = 0; i < 4; ++i)
#pragma unroll
        for (int j = 0; j < 4; ++j) acc[i][j] = __builtin_amdgcn_mfma_f32_16x16x32_bf16(af[i], bfr[j], acc[i][j], 0, 0, 0);
    }
  }
  __syncthreads();
  ep(acc);
}

typedef __attribute__((address_space(3))) unsigned lds_u32;
template <bool TR = false, class EP>
DEVI void gemm_tile_dma(const u16* A, const int lda, const u16* Bt, const int ldb, const int K, unsigned char* smem, EP ep,
                        const u16* An = nullptr, const u16* Bn = nullptr, const bool pre = false) {
  const int tid = threadIdx.x, lane = tid & 63, wave = tid >> 6, wm = wave >> 1, wn = wave & 1;
  const int lr = lane & 15, lq = lane >> 4;
  f32x4 acc[4][4];
#pragma unroll
  for (int i = 0; i < 4; ++i)
#pragma unroll
    for (int j = 0; j < 4; ++j) acc[i][j] = f32x4{0.f, 0.f, 0.f, 0.f};
  const int rr = lane >> 3, qq = (lane & 7) ^ rr;
  const size_t aoff = (size_t)(wave * 32 + rr) * lda + qq * 8, boff = (size_t)(wave * 32 + rr) * ldb + qq * 8;
  const u16* ag = A + aoff;
  const u16* bg = Bt + boff;
  unsigned char* wbase = smem + wave * 4096;
#define GT_ISSUE(AP_, BP_, stage, kt)                                                                                    \
  do {                                                                                                                   \
    _Pragma("unroll") for (int j = 0; j < 4; ++j) {                                                                      \
      __builtin_amdgcn_global_load_lds((const unsigned*)((AP_) + (size_t)j * 8 * lda + (kt)),                            \
                                       (lds_u32*)(wbase + (stage) * 32768 + j * 1024), 16, 0, 0);                        \
      __builtin_amdgcn_global_load_lds((const unsigned*)((BP_) + (size_t)j * 8 * ldb + (kt)),                            \
                                       (lds_u32*)(wbase + (stage) * 32768 + 16384 + j * 1024), 16, 0, 0);                \
    }                                                                                                                    \
  } while (0)
  if (!pre) {
    __syncthreads();
    GT_ISSUE(ag, bg, 0, 0);
  }
  const int sw = lr & 7;
  int it = 0;
  for (int kt = 0; kt < K; kt += 64, ++it) {
    asm volatile("s_waitcnt vmcnt(0)" ::: "memory");
    __syncthreads();
    if (kt + 64 < K) GT_ISSUE(ag, bg, (it + 1) & 1, kt + 64);
    else if (An != nullptr) GT_ISSUE(An + aoff, Bn + boff, 0, 0);
    const unsigned char* As = smem + (it & 1) * 32768;
    const unsigned char* Bs = As + 16384;
#pragma unroll
    for (int ks = 0; ks < 2; ++ks) {
      bf16x8 af[4], bfr[4];
      const int ch = ((ks * 4 + lq) ^ sw) * 16;
#pragma unroll
      for (int i = 0; i < 4; ++i) af[i] = *reinterpret_cast<const bf16x8*>(As + (wm * 64 + i * 16 + lr) * 128 + ch);
#pragma unroll
      for (int j = 0; j < 4; ++j) bfr[j] = *reinterpret_cast<const bf16x8*>(Bs + (wn * 64 + j * 16 + lr) * 128 + ch);
      __builtin_amdgcn_s_setprio(1);
#pragma unroll
      for (int i = 0; i < 4; ++i)
#pragma unroll
        for (int j = 0; j < 4; ++j)
          acc[i][j] = TR ? __builtin_amdgcn_mfma_f32_16x16x32_bf16(bfr[j], af[i], acc[i][j], 0, 0, 0)
                         : __builtin_amdgcn_mfma_f32_16x16x32_bf16(af[i], bfr[j], acc[i][j], 0, 0, 0);
      __builtin_amdgcn_s_setprio(0);
    }
  }
#undef GT_ISSUE
  if (An == nullptr) __syncthreads();
  ep(acc);
}

DEVI bool tile_map(int it, int nmt, int nnt, int& mt, int& nt) {
  const int xcd = blockIdx.x & 7, j = blockIdx.x >> 3;
  const int per = gridDim.x >> 3;
  const int slot = it * per + j;
  const int S = (slot >> 6) * 8 + xcd;
  const int nsn = nnt >> 3, nsm = nmt >> 3;
  if (S >= nsn * nsm) return false;
  const int sm = S / nsn, sn = S - sm * nsn;
  const int w = slot & 63;
  mt = sm * 8 + (w >> 3);
  nt = sn * 8 + (w & 7);
  return true;
}

template <int PERM>
DEVI void cvt_wt(const float* W, int K, int N, u16* out, int a0, int a1) {
  const int gsz = gridDim.x * 256, gtid = blockIdx.x * 256 + threadIdx.x;
  const int total = N * (K >> 3);
  for (int i = gtid; i < total; i += gsz) {
    const int n = i % N, kv = i / N;
    float v[8];
#pragma unroll
    for (int j = 0; j < 8; ++j) v[j] = W[(size_t)(kv * 8 + j) * N + n];
    int np = n;
    if (PERM == 1) { const int g = n >> 10, o = n & 1023; np = (o >> 4) * 32 + g * 16 + (o & 15); }
    if (PERM == 2) { np = a0 * 512 + (n >> 4) * 32 + a1 * 16 + (n & 15); }
    *reinterpret_cast<uint4*>(out + (size_t)np * K + kv * 8) = pack8(v);
  }
}

DEVI void cvt_plain(const float* src, u16* dst, size_t n8) {
  const size_t gsz = (size_t)gridDim.x * 256, gtid = (size_t)blockIdx.x * 256 + threadIdx.x;
  for (size_t i = gtid; i < n8; i += gsz) {
    const float4* q = reinterpret_cast<const float4*>(src + i * 8);
    float4 a = q[0], b = q[1];
    uint4 o; o.x = pack2(a.x, a.y); o.y = pack2(a.z, a.w); o.z = pack2(b.x, b.y); o.w = pack2(b.z, b.w);
    *reinterpret_cast<uint4*>(dst + i * 8) = o;
  }
}

DEVI void phase_setup(const Params& p) {
  unsigned char* ws = p.ws;
  cvt_wt<0>(p.in[4], 1024, 1024, (u16*)(ws + OFF_WS5IN), 0, 0);
  cvt_wt<1>(p.in[13], 1024, 2048, (u16*)(ws + OFF_WGLU), 0, 0);
  cvt_wt<0>(p.in[14], 1024, 2048, (u16*)(ws + OFF_WRGIN), 0, 0);
  for (int d = 0; d < 2; ++d)
    for (int gate = 0; gate < 2; ++gate)
      for (int h = 0; h < 4; ++h)
        cvt_wt<2>((gate ? p.in[19] : p.in[17]) + (size_t)(d * 4 + h) * 65536, 256, 256,
                  (u16*)(ws + OFF_WGATES) + (size_t)h * 1024 * 256, d, gate);
  cvt_wt<0>(p.in[22], 1024, 1024, (u16*)(ws + OFF_WRGOUT), 0, 0);
  for (int l = 0; l < 2; ++l) {
    cvt_wt<0>(p.in[27] + (size_t)l * 1024 * 2048, 1024, 2048, (u16*)(ws + OFF_WQ) + (size_t)l * 2048 * 1024, 0, 0);
    cvt_wt<0>(p.in[31] + (size_t)l * 256 * 1024, 256, 1024, (u16*)(ws + OFF_WPROJ) + (size_t)l * 1024 * 256, 0, 0);
    cvt_wt<0>(p.in[32] + (size_t)l * 1024 * 1024, 1024, 1024, (u16*)(ws + OFF_WPG) + (size_t)l * 1024 * 1024, 0, 0);
  }
  cvt_plain(p.in[28], (u16*)(ws + OFF_SK), 65536 / 8);
  const int gsz = gridDim.x * 256, gtid = blockIdx.x * 256 + threadIdx.x;
  float2* POW = (float2*)(ws + OFF_POW);
  float2* BBAR = (float2*)(ws + OFF_BBAR);
  for (int i = gtid; i < 2 * 64 * 33 * 64; i += gsz) {
    const int pp = i & 63, n = (i >> 6) % 33, dg = i / (64 * 33);
    const float step = expf(p.in[7][dg]);
    const float lr_ = p.in[5][dg * 64 + pp], li_ = p.in[6][dg * 64 + pp];
    const float mag = expf((float)n * (lr_ * step)), ang = (float)n * (li_ * step);
    POW[i] = float2{mag * cosf(ang), mag * sinf(ang)};
  }
  for (int i = gtid; i < 2 * 64 * 64; i += gsz) {
    const int dg = i >> 6;
    const float step = expf(p.in[7][dg]);
    const float lr_ = p.in[5][i], li_ = p.in[6][i];
    const float mag = expf(lr_ * step), ang = li_ * step;
    const float ar = mag * cosf(ang), ai = mag * sinf(ang);
    const float den = lr_ * lr_ + li_ * li_;
    const float zr = ar - 1.f;
    const float qr = (zr * lr_ + ai * li_) / den, qi = (ai * lr_ - zr * li_) / den;
#pragma unroll
    for (int c = 0; c < 16; ++c) {
      const float br = p.in[8][(size_t)i * 16 + c], bi = p.in[9][(size_t)i * 16 + c];
      BBAR[(size_t)i * 16 + c] = float2{qr * br - qi * bi, qr * bi + qi * br};
    }
  }
}

DEVI float s5_kterm(const Params& p, const float2* POW, const float2* BBAR, int d, int g, int n, int c, int cp) {
  const int dg = d * 64 + g;
  const float* cr = p.in[10] + ((size_t)dg * 16 + c) * 64;
  const float* ci = p.in[11] + ((size_t)dg * 16 + c) * 64;
  const float2* E = POW + ((size_t)dg * 33 + n) * 64;
  const float2* BB = BBAR + (size_t)dg * 64 * 16 + cp;
  float s = 0.f;
#pragma unroll 8
  for (int pp = 0; pp < 64; ++pp) {
    const float2 e = E[pp], bb = BB[pp * 16];
    const float Cr = cr[pp], Ci = ci[pp];
    const float cer = Cr * e.x - Ci * e.y, cei = Cr * e.y + Ci * e.x;
    s += cer * bb.x - cei * bb.y;
  }
  return s;
}

DEVI void phase_tables(const Params& p, int layer, unsigned char* smem);

DEVI void phase_setup2(const Params& p, unsigned char* smem) {
  phase_tables(p, 0, smem);
  phase_tables(p, 1, smem);
  unsigned char* ws = p.ws;
  const int gsz = gridDim.x * 256, gtid = blockIdx.x * 256 + threadIdx.x;
  const float2* POW = (const float2*)(ws + OFF_POW);
  const float2* BBAR = (const float2*)(ws + OFF_BBAR);
  float* KTAB = (float*)(ws + OFF_KTAB);
  u16* WST = (u16*)(ws + OFF_WST);
  u16* BT1 = (u16*)(ws + OFF_BT1);
  for (int i = gtid; i < 64 * 63 * 256; i += gsz) {
    const int cp = i & 15, c = (i >> 4) & 15, ti = (i >> 8) % 63, g = i / (63 * 256);
    const int tau = ti - 31;
    float s = 0.f;
    if (tau >= 0) s += s5_kterm(p, POW, BBAR, 0, g, tau, c, cp);
    if (tau <= 0) s += s5_kterm(p, POW, BBAR, 1, g, -tau, c, cp);
    KTAB[i] = s;
  }
  for (int i = gtid; i < 64 * 256 * 64; i += gsz) {
    const int kv = i & 63, np = (i >> 6) & 255, g = i >> 14;
    const int d = np >> 7, ri = (np >> 6) & 1, pp = np & 63, s = kv >> 1, c0 = (kv & 1) * 8;
    const int npow = d ? s : 31 - s;
    const float2 e = POW[((size_t)(d * 64 + g) * 33 + npow) * 64 + pp];
    float v[8];
#pragma unroll
    for (int j = 0; j < 8; ++j) {
      const float2 bb = BBAR[((size_t)(d * 64 + g) * 64 + pp) * 16 + c0 + j];
      v[j] = ri ? (e.x * bb.y + e.y * bb.x) : (e.x * bb.x - e.y * bb.y);
    }
    *reinterpret_cast<uint4*>(WST + ((size_t)g * 256 + np) * 512 + kv * 8) = pack8(v);
  }
  for (int i = gtid; i < 64 * 512 * 32; i += gsz) {
    const int kv = i & 31, n = (i >> 5) & 511, g = i >> 14;
    const int t = n >> 4, c = n & 15, kk0 = kv * 8;
    const int d = kk0 >> 7, ri = (kk0 >> 6) & 1, p0 = kk0 & 63;
    const int npow = d ? 32 - t : t + 1;
    const int dg = d * 64 + g;
    float v[8];
#pragma unroll
    for (int j = 0; j < 8; ++j) {
      const int pp = p0 + j;
      const float Cr = p.in[10][((size_t)dg * 16 + c) * 64 + pp], Ci = p.in[11][((size_t)dg * 16 + c) * 64 + pp];
      const float2 e = POW[((size_t)dg * 33 + npow) * 64 + pp];
      v[j] = ri ? -(Cr * e.y + Ci * e.x) : (Cr * e.x - Ci * e.y);
    }
    *reinterpret_cast<uint4*>(BT1 + ((size_t)g * 512 + n) * 768 + 512 + kv * 8) = pack8(v);
  }
}

DEVI void phase_setup3(const Params& p) {
  cvt_plain(p.in[0], (u16*)(p.ws + OFF_XIN), (size_t)TS * 1024 / 8);
  const int gsz = gridDim.x * 256, gtid = blockIdx.x * 256 + threadIdx.x;
  const float* KTAB = (const float*)(p.ws + OFF_KTAB);
  u16* BT1 = (u16*)(p.ws + OFF_BT1);
  for (int i = gtid; i < 64 * 512 * 64; i += gsz) {
    const int kv = i & 63, n = (i >> 6) & 511, g = i >> 15;
    const int t = n >> 4, c = n & 15, s = kv >> 1, c0 = (kv & 1) * 8;
    const float* src = KTAB + (((size_t)g * 63 + (t - s + 31)) * 16 + c) * 16 + c0;
    float v[8];
#pragma unroll
    for (int j = 0; j < 8; ++j) v[j] = src[j];
    *reinterpret_cast<uint4*>(BT1 + ((size_t)g * 512 + n) * 768 + kv * 8) = pack8(v);
  }
}

DEVI void phase_s5_in(const Params& p, int s, unsigned char* smem) {
  const u16* XIN = (const u16*)(p.ws + OFF_XIN);
  const u16* Wt = (const u16*)(p.ws + OFF_WS5IN);
  u16* AP = (u16*)(p.ws + OFF_AP);
  const int lane = threadIdx.x & 63, wave = threadIdx.x >> 6, wm = wave >> 1, wn = wave & 1;
  bool pre_ = false;
  for (int it = 0, mt, nt; tile_map(it, 256, 8, mt, nt); ++it) {
    int mtn, ntn;
    const bool nxt_ = tile_map(it + 1, 256, 8, mtn, ntn);
    const int m0 = mt * 128, n0 = nt * 128;
    gemm_tile_dma<true>(XIN + (size_t)m0 * 1024, 1024, Wt + (size_t)n0 * 1024, 1024, 1024, smem, [&](f32x4 (&acc)[4][4]) {
#pragma unroll
      for (int i = 0; i < 4; ++i)
#pragma unroll
        for (int j = 0; j < 4; ++j) {
          const int row = m0 + wm * 64 + i * 16 + (lane & 15);
          const int col = n0 + wn * 64 + j * 16 + (lane >> 4) * 4;
          uint2 w; w.x = pack2(acc[i][j][0], acc[i][j][1]); w.y = pack2(acc[i][j][2], acc[i][j][3]);
          *reinterpret_cast<uint2*>(AP + ((size_t)(col >> 4) * 1024 + (row >> 5)) * 768 + (row & 31) * 16 + (col & 15)) = w;
        }
    }, nxt_ ? (XIN + (size_t)(mtn * 128) * 1024) : nullptr, nxt_ ? (Wt + (size_t)(ntn * 128) * 1024) : nullptr, pre_);
    pre_ = nxt_;
  }
}

DEVI void phase_s5_state(const Params& p, unsigned char* smem) {
  const u16* AP = (const u16*)(p.ws + OFF_AP);
  const u16* WST = (const u16*)(p.ws + OFF_WST);
  float* HLOC = (float*)(p.ws + OFF_HLOC);
  const int lane = threadIdx.x & 63, wave = threadIdx.x >> 6, wm = wave >> 1, wn = wave & 1;
  for (int tile = blockIdx.x; tile < 64 * 16; tile += gridDim.x) {
    const int g = tile >> 4, m0 = ((tile >> 1) & 7) * 128, n0 = (tile & 1) * 128;
    gemm_tile_dma(AP + ((size_t)g * 1024 + m0) * 768, 768, WST + ((size_t)g * 256 + n0) * 512, 512, 512, smem, [&](f32x4 (&acc)[4][4]) {
#pragma unroll
      for (int i = 0; i < 4; ++i)
#pragma unroll
        for (int j = 0; j < 4; ++j)
#pragma unroll
          for (int r = 0; r < 4; ++r) {
            const int row = m0 + wm * 64 + i * 16 + (lane >> 4) * 4 + r;
            const int col = n0 + wn * 64 + j * 16 + (lane & 15);
            HLOC[((size_t)g * 1024 + row) * 256 + col] = acc[i][j][r];
          }
    });
  }
}

DEVI void phase_s5_cscan(const Params& p, int s) {
  const int L = s ? 2048 : 4096;
  const int nseq = TS / L, nch = L / 32;
  u16* AP = (u16*)(p.ws + OFF_AP);
  const float* HLOC = (const float*)(p.ws + OFF_HLOC);
  const float2* POW = (const float2*)(p.ws + OFF_POW);
  const int gsz = gridDim.x * 256, gtid = blockIdx.x * 256 + threadIdx.x;
  for (int i = gtid; i < 64 * nseq * 128; i += gsz) {
    const int pp = i & 63, d = (i >> 6) & 1, g = (i >> 7) & 63, seq = i >> 13;
    const float2 e = POW[((size_t)(d * 64 + g) * 33 + 32) * 64 + pp];
    float Hr = 0.f, Hi = 0.f;
#pragma unroll 8
    for (int j = 0; j < nch; ++j) {
      const int chunk = seq * nch + (d ? (nch - 1 - j) : j);
      u16* ap = AP + ((size_t)g * 1024 + chunk) * 768 + 512 + d * 128 + pp;
      ap[0] = f2bf(Hr);
      ap[64] = f2bf(Hi);
      const float* hl = HLOC + ((size_t)g * 1024 + chunk) * 256 + d * 128 + pp;
      const float a = hl[0], b = hl[64];
      const float nHr = e.x * Hr - e.y * Hi + a;
      const float nHi = e.x * Hi + e.y * Hr + b;
      Hr = nHr; Hi = nHi;
    }
  }
}

DEVI void phase_s5_main(const Params& p, unsigned char* smem) {
  const u16* AP = (const u16*)(p.ws + OFF_AP);
  const u16* BT1 = (const u16*)(p.ws + OFF_BT1);
  u16* HB = (u16*)(p.ws + OFF_HB);
  const float* dsk = p.in[12];
  const int lane = threadIdx.x & 63, wave = threadIdx.x >> 6, wm = wave >> 1, wn = wave & 1;
  for (int tile = blockIdx.x; tile < 64 * 32; tile += gridDim.x) {
    const int g = tile >> 5, m0 = ((tile >> 2) & 7) * 128, n0 = (tile & 3) * 128;
    gemm_tile_dma(AP + ((size_t)g * 1024 + m0) * 768, 768, BT1 + ((size_t)g * 512 + n0) * 768, 768, 768, smem, [&](f32x4 (&acc)[4][4]) {
      const float dv = dsk[g * 16 + (lane & 15)];
#pragma unroll
      for (int i = 0; i < 4; ++i)
#pragma unroll
        for (int j = 0; j < 4; ++j)
#pragma unroll
          for (int r = 0; r < 4; ++r) {
            const int chunk = m0 + wm * 64 + i * 16 + (lane >> 4) * 4 + r;
            const int n = n0 + wn * 64 + j * 16 + (lane & 15);
            const float u = bf2f(AP[((size_t)g * 1024 + chunk) * 768 + n]);
            const float y = acc[i][j][r] + dv * u;
            HB[((size_t)chunk * 32 + (n >> 4)) * 1024 + g * 16 + (lane & 15)] = f2bf(gelu_(y));
          }
    });
  }
}

DEVI void phase_s5_glu(const Params& p, int s, unsigned char* smem) {
  const u16* HB = (const u16*)(p.ws + OFF_HB);
  const u16* Wt = (const u16*)(p.ws + OFF_WGLU);
  const u16* XINB = (const u16*)(p.ws + OFF_XIN);
  u16* ZB = (u16*)(p.ws + OFF_XB);
  const int lane = threadIdx.x & 63, wave = threadIdx.x >> 6, wm = wave >> 1, wn = wave & 1;
  bool pre_ = false;
  for (int it = 0, mt, nt; tile_map(it, 256, 16, mt, nt); ++it) {
    int mtn, ntn;
    const bool nxt_ = tile_map(it + 1, 256, 16, mtn, ntn);
    const int m0 = mt * 128, n0 = nt * 128;
    gemm_tile_dma<true>(HB + (size_t)m0 * 1024, 1024, Wt + (size_t)n0 * 1024, 1024, 1024, smem, [&](f32x4 (&acc)[4][4]) {
#pragma unroll
      for (int i = 0; i < 4; ++i)
#pragma unroll
        for (int jj = 0; jj < 4; jj += 2) {
          const int row = m0 + wm * 64 + i * 16 + (lane & 15);
          const int nb = n0 + wn * 64 + jj * 16;
          const int o = (nb >> 5) * 16 + (lane >> 4) * 4;
          const size_t idx = (size_t)row * 1024 + o;
          const uint2 xw = *reinterpret_cast<const uint2*>(XINB + idx);
          const float4 xi = float4{bflo(xw.x), bfhi(xw.x), bflo(xw.y), bfhi(xw.y)};
          float4 v;
          v.x = ALPHA * xi.x + acc[i][jj][0] * sigmoid_(acc[i][jj + 1][0]);
          v.y = ALPHA * xi.y + acc[i][jj][1] * sigmoid_(acc[i][jj + 1][1]);
          v.z = ALPHA * xi.z + acc[i][jj][2] * sigmoid_(acc[i][jj + 1][2]);
          v.w = ALPHA * xi.w + acc[i][jj][3] * sigmoid_(acc[i][jj + 1][3]);
          uint2 w; w.x = pack2(v.x, v.y); w.y = pack2(v.z, v.w);
          *reinterpret_cast<uint2*>(ZB + idx) = w;
        }
    }, nxt_ ? (HB + (size_t)(mtn * 128) * 1024) : nullptr, nxt_ ? (Wt + (size_t)(ntn * 128) * 1024) : nullptr, pre_);
    pre_ = nxt_;
  }
}

DEVI void phase_ln1_tables(const Params& p, int s, int layer, unsigned char* smem) {
  float* X = p.out + (size_t)s * TS * 1024;
  u16* XB = (u16*)(p.ws + OFF_XB);
  const float* gam = p.in[23] + layer * 1024;
  const float* bet = p.in[24] + layer * 1024;
  const int lane = threadIdx.x & 63, wave = threadIdx.x >> 6;
  for (int t = blockIdx.x * 4 + wave; t < TS; t += gridDim.x * 4) {
    float4 v[4];
#pragma unroll
    for (int i = 0; i < 4; ++i) {
      const uint2 w = *reinterpret_cast<const uint2*>(XB + (size_t)t * 1024 + i * 256 + lane * 4);
      v[i] = float4{bflo(w.x), bfhi(w.x), bflo(w.y), bfhi(w.y)};
    }
    float sm = 0.f;
#pragma unroll
    for (int i = 0; i < 4; ++i) sm += v[i].x + v[i].y + v[i].z + v[i].w;
#pragma unroll
    for (int m = 32; m >= 1; m >>= 1) sm += __shfl_xor(sm, m);
    const float mu = sm * (1.f / 1024.f);
    float sq = 0.f;
#pragma unroll
    for (int i = 0; i < 4; ++i) {
      const float a = v[i].x - mu, b = v[i].y - mu, c = v[i].z - mu, d = v[i].w - mu;
      sq += a * a + b * b + c * c + d * d;
    }
#pragma unroll
    for (int m = 32; m >= 1; m >>= 1) sq += __shfl_xor(sq, m);
    const float rs = rsqrtf(sq * (1.f / 1024.f) + LN_EPS);
#pragma unroll
    for (int i = 0; i < 4; ++i) {
      const int c0 = i * 256 + lane * 4;
      const float4 g4 = *reinterpret_cast<const float4*>(gam + c0);
      const float4 b4 = *reinterpret_cast<const float4*>(bet + c0);
      float4 o;
      o.x = (v[i].x - mu) * rs * g4.x + b4.x; o.y = (v[i].y - mu) * rs * g4.y + b4.y;
      o.z = (v[i].z - mu) * rs * g4.z + b4.z; o.w = (v[i].w - mu) * rs * g4.w + b4.w;
      uint2 pk; pk.x = pack2(o.x, o.y); pk.y = pack2(o.z, o.w);
      *reinterpret_cast<uint2*>(XB + (size_t)t * 1024 + c0) = pk;
    }
  }
}

DEVI void phase_tables(const Params& p, int layer, unsigned char* smem) {
  const int lane = threadIdx.x & 63, wave = threadIdx.x >> 6;
  float* SCL = (float*)(p.ws + OFF_SCL + (size_t)layer * TB_STRIDE);
  float* lds = reinterpret_cast<float*>(smem) + (threadIdx.x & 63) + (threadIdx.x >> 6) * 2048;
  int srck[32];
  {
    v16f ra, rb;
#pragma unroll
    for (int j = 0; j < 16; ++j) { ra[j] = (j < 8) ? 0.125f * j : 1.f + 0.125f * (j - 8); rb[j] = (j < 8) ? 2.f + 0.25f * j : 4.f + 0.5f * (j - 8); }
    const v6u pk = __builtin_amdgcn_cvt_scalef32_2xpk16_fp6_f32(ra, rb, 1.0f);
    const v32f dd = __builtin_amdgcn_cvt_scalef32_pk32_f32_fp6(pk, 1.0f);
#pragma unroll
    for (int k = 0; k < 32; ++k) {
      const float v = dd[k];
      const float fi = v < 1.f ? v * 8.f : (v < 2.f ? 8.f + (v - 1.f) * 8.f : (v < 4.f ? 16.f + (v - 2.f) * 4.f : 24.f + (v - 4.f) * 2.f));
      srck[k] = ((int)(fi + 0.5f)) & 31;
    }
  }
  const int ll = lane & 31, hs = lane >> 5;
  for (int r2 = blockIdx.x * 4 + wave; r2 < 16384; r2 += gridDim.x * 4) {
    const int r = r2 * 2 + hs;
    const int tab = r >> 14, row = r & 16383;
    const float4* sp = reinterpret_cast<const float4*>(p.in[29 + tab] + ((size_t)layer * 16384 + row) * 1024 + ll * 32);
    float s[32];
#pragma unroll
    for (int j = 0; j < 8; ++j) { const float4 a = sp[j]; s[4 * j] = a.x; s[4 * j + 1] = a.y; s[4 * j + 2] = a.z; s[4 * j + 3] = a.w; }
    float am = 0.f;
#pragma unroll
    for (int k = 0; k < 32; ++k) am = fmaxf(am, fabsf(s[k]));
#pragma unroll
    for (int m = 16; m >= 1; m >>= 1) am = fmaxf(am, __shfl_xor(am, m));
    const float sc = am > 0.f ? 7.5f / am : 1.f;
    const float inv = am > 0.f ? am * (1.f / 7.5f) : 1.f;
#pragma unroll
    for (int k = 0; k < 32; ++k) lds[srck[k] * 64] = s[k] * sc;
    v16f ia, ib;
#pragma unroll
    for (int j = 0; j < 16; ++j) { ia[j] = lds[j * 64]; ib[j] = lds[(16 + j) * 64]; }
    const v6u pk = __builtin_amdgcn_cvt_scalef32_2xpk16_fp6_f32(ia, ib, 1.0f);
    unsigned char* dst = p.ws + (size_t)layer * TB_STRIDE + (tab ? OFF_VB8 : OFF_UB8) + (size_t)row * 768;
    *reinterpret_cast<uint4*>(dst + ll * 16) = uint4{pk[0], pk[1], pk[2], pk[3]};
    *reinterpret_cast<uint2*>(dst + 512 + ll * 8) = uint2{pk[4], pk[5]};
    if (ll == 0) SCL[tab * 16384 + row] = inv;
  }
}

DEVI u32 enc_key(float s, int n) {
  u32 b = __float_as_uint(s);
  u32 srt = (b & 0x80000000u) ? ~b : (b | 0x80000000u);
  return (srt & ~127u) | (u32)(127 - n);
}
DEVI float dec_key(u32 key, int& n) {
  n = 127 - (int)(key & 127u);
  u32 srt = key & ~127u;
  u32 b = (srt & 0x80000000u) ? (srt & 0x7fffffffu) : ~srt;
  return __uint_as_float(b);
}

DEVI void phase_peer_q(const Params& p, int layer, unsigned char* smem) {
  const u16* XB = (const u16*)(p.ws + OFF_XB);
  const u16* Wt = (const u16*)(p.ws + OFF_WQ) + (size_t)layer * 2048 * 1024;
  const u16* SK = (const u16*)(p.ws + OFF_SK) + (size_t)layer * 2 * 128 * 128;
  u32* KEYS = (u32*)(p.ws + OFF_KEYS);
  const int tid = threadIdx.x, lane = tid & 63, wave = tid >> 6, wm = wave >> 1, wn = wave & 1;
  const int lr = lane & 15, lq = lane >> 4;
  u16* Qs = reinterpret_cast<u16*>(smem);
  u32* Sk = reinterpret_cast<u32*>(smem);
  for (int it = 0, mt, nt; tile_map(it, 256, 16, mt, nt); ++it) {
    const int m0 = mt * 128, hc = nt, n0 = hc * 128;
    const int c = hc & 1;
    gemm_tile_dma(XB + (size_t)m0 * 1024, 1024, Wt + (size_t)n0 * 1024, 1024, 1024, smem, [&](f32x4 (&acc)[4][4]) {
#pragma unroll
      for (int i = 0; i < 4; ++i)
#pragma unroll
        for (int j = 0; j < 4; ++j)
#pragma unroll
          for (int r = 0; r < 4; ++r)
            Qs[(wm * 64 + i * 16 + lq * 4 + r) * 136 + wn * 64 + j * 16 + lr] = f2bf(acc[i][j][r]);
      __syncthreads();
      f32x4 sc[4][4];
#pragma unroll
      for (int i = 0; i < 4; ++i)
#pragma unroll
        for (int j = 0; j < 4; ++j) sc[i][j] = f32x4{0.f, 0.f, 0.f, 0.f};
      const u16* skc = SK + (size_t)c * 128 * 128;
#pragma unroll
      for (int ks = 0; ks < 4; ++ks) {
        bf16x8 af[4], bfr[4];
#pragma unroll
        for (int i = 0; i < 4; ++i) af[i] = *reinterpret_cast<const bf16x8*>(Qs + (wm * 64 + i * 16 + lr) * 136 + ks * 32 + lq * 8);
#pragma unroll
        for (int j = 0; j < 4; ++j) bfr[j] = *reinterpret_cast<const bf16x8*>(skc + (size_t)(wn * 64 + j * 16 + lr) * 128 + ks * 32 + lq * 8);
#pragma unroll
        for (int i = 0; i < 4; ++i)
#pragma unroll
          for (int j = 0; j < 4; ++j) sc[i][j] = __builtin_amdgcn_mfma_f32_16x16x32_bf16(af[i], bfr[j], sc[i][j], 0, 0, 0);
      }
      __syncthreads();
#pragma unroll
      for (int i = 0; i < 4; ++i)
#pragma unroll
        for (int j = 0; j < 4; ++j)
#pragma unroll
          for (int r = 0; r < 4; ++r) {
            const int n = wn * 64 + j * 16 + lr;
            Sk[(wm * 64 + i * 16 + lq * 4 + r) * 129 + n] = enc_key(sc[i][j][r], n);
          }
      __syncthreads();
      if (tid < 128) {
        u32 top[16];
#pragma unroll
        for (int k = 0; k < 16; ++k) top[k] = 0u;
#pragma unroll 4
        for (int n = 0; n < 128; ++n) {
          u32 v = Sk[tid * 129 + n];
#pragma unroll
          for (int k = 0; k < 16; ++k) {
            const u32 hi = max(top[k], v);
            v = min(top[k], v);
            top[k] = hi;
          }
        }
        uint4* dst = reinterpret_cast<uint4*>(KEYS + ((size_t)(m0 + tid) * 16 + hc) * 16);
        dst[0] = uint4{top[0], top[1], top[2], top[3]};
        dst[1] = uint4{top[4], top[5], top[6], top[7]};
        dst[2] = uint4{top[8], top[9], top[10], top[11]};
        dst[3] = uint4{top[12], top[13], top[14], top[15]};
      }
    });
  }
}

DEVI void phase_peer_route(const Params& p, int s, int layer) {
  cvt_plain(p.in[2 + s] + (size_t)layer * TS * 256, (u16*)(p.ws + OFF_PB), (size_t)TS * 256 / 8);
  const u32* KEYS = (const u32*)(p.ws + OFF_KEYS);
  int* IDX = (int*)(p.ws + OFF_IDX);
  float* GATE = (float*)(p.ws + OFF_GATE);
  float* SU = (float*)(p.ws + OFF_SU);
  const float* SCL = (const float*)(p.ws + OFF_SCL + (size_t)layer * TB_STRIDE);
  const int gsz = gridDim.x * 256, gtid = blockIdx.x * 256 + threadIdx.x;
  for (int i = gtid; i < TS * 8; i += gsz) {
    const uint4* src = reinterpret_cast<const uint4*>(KEYS + (size_t)i * 32);
    u32 kk[32];
#pragma unroll
    for (int q = 0; q < 8; ++q) { const uint4 w = src[q]; kk[q * 4] = w.x; kk[q * 4 + 1] = w.y; kk[q * 4 + 2] = w.z; kk[q * 4 + 3] = w.w; }
    float s0[16], s1[16]; int i0[16], i1[16];
#pragma unroll
    for (int k = 0; k < 16; ++k) { s0[k] = dec_key(kk[k], i0[k]); s1[k] = dec_key(kk[16 + k], i1[k]); }
    float top[16];
#pragma unroll
    for (int k = 0; k < 16; ++k) top[k] = -3.0e38f;
#pragma unroll
    for (int k1 = 0; k1 < 16; ++k1)
#pragma unroll
      for (int k2 = 0; k2 < 16; ++k2)
        if ((k1 + 1) * (k2 + 1) <= 16) {
          float v = s0[k1] + s1[k2];
#pragma unroll
          for (int k = 0; k < 16; ++k) {
            const float hi = fmaxf(top[k], v);
            v = fminf(top[k], v);
            top[k] = hi;
          }
        }
    const float thr = top[15], mx = top[0];
    float den = 0.f;
#pragma unroll
    for (int k = 0; k < 16; ++k) den += __expf(top[k] - mx);
    const float inv = 1.f / den;
    int cnt = 0;
    int* idst = IDX + (size_t)i * 16;
    float* gdst = GATE + (size_t)i * 16;
    float* sdst = SU + (size_t)i * 16;
#pragma unroll
    for (int k1 = 0; k1 < 16; ++k1)
#pragma unroll
      for (int k2 = 0; k2 < 16; ++k2)
        if ((k1 + 1) * (k2 + 1) <= 16) {
          const float v = s0[k1] + s1[k2];
          if (v >= thr && cnt < 16) {
            const int e = i0[k1] * 128 + i1[k2];
            idst[cnt] = e;
            gdst[cnt] = __expf(v - mx) * inv * SCL[16384 + e];
            sdst[cnt] = SCL[e];
            ++cnt;
          }
        }
  }
}

DEVI f2 cvt8(u32 w, bool hi) { return hi ? __builtin_amdgcn_cvt_pk_f32_fp8((int)w, true) : __builtin_amdgcn_cvt_pk_f32_fp8((int)w, false); }

DEVI v32f ld_fp6_row(const unsigned char* base, int ei, int ll) {
  const unsigned char* r = base + (size_t)ei * 768;
  const uint4 a = *reinterpret_cast<const uint4*>(r + ll * 16);
  const uint2 b = *reinterpret_cast<const uint2*>(r + 512 + ll * 8);
  v6u pk; pk[0] = a.x; pk[1] = a.y; pk[2] = a.z; pk[3] = a.w; pk[4] = b.x; pk[5] = b.y;
  return __builtin_amdgcn_cvt_scalef32_pk32_f32_fp6(pk, 1.0f);
}

struct Raw6 { uint4 a; uint2 b; };
DEVI Raw6 ld_raw6(const unsigned char* base, int ei, int ll) {
  const unsigned char* r = base + (size_t)ei * 768;
  Raw6 o;
  o.a = *reinterpret_cast<const uint4*>(r + ll * 16);
  o.b = *reinterpret_cast<const uint2*>(r + 512 + ll * 8);
  return o;
}
DEVI v32f dec6(const Raw6& r) {
  v6u pk; pk[0] = r.a.x; pk[1] = r.a.y; pk[2] = r.a.z; pk[3] = r.a.w; pk[4] = r.b.x; pk[5] = r.b.y;
  return __builtin_amdgcn_cvt_scalef32_pk32_f32_fp6(pk, 1.0f);
}

DEVI void phase_peer_gather(const Params& p, int s, int layer) {
  float* X = p.out + (size_t)s * TS * 1024;
  u16* XB = (u16*)(p.ws + OFF_XB);
  const unsigned char* Ub = p.ws + OFF_UB8 + (size_t)layer * TB_STRIDE;
  const unsigned char* Vb = p.ws + OFF_VB8 + (size_t)layer * TB_STRIDE;
  const int* IDX = (const int*)(p.ws + OFF_IDX);
  const float* GATE = (const float*)(p.ws + OFF_GATE);
  const float* SU = (const float*)(p.ws + OFF_SU);
  const float* gam = p.in[25] + layer * 1024;
  const float* bet = p.in[26] + layer * 1024;
  const int lane = threadIdx.x & 63, wave = threadIdx.x >> 6;
  const int ll = lane & 31, hs = lane >> 5;
  const bool b4 = lane & 16, b3 = lane & 8;
  for (int t = blockIdx.x * 4 + wave; t < TS; t += gridDim.x * 4) {
    float x[32], o[32];
    {
      const uint4* xp = reinterpret_cast<const uint4*>(XB + (size_t)t * 1024 + ll * 32);
#pragma unroll
      for (int j = 0; j < 4; ++j) { const uint4 a = xp[j]; unpack8(a, x + 8 * j); }
    }
#pragma unroll
    for (int k = 0; k < 32; ++k) o[k] = 0.f;
    const int iv0 = IDX[(size_t)t * 128 + lane], iv1 = IDX[(size_t)t * 128 + 64 + lane];
    const float gv0 = GATE[(size_t)t * 128 + lane], gv1 = GATE[(size_t)t * 128 + 64 + lane];
    const float su0 = SU[(size_t)t * 128 + lane], su1 = SU[(size_t)t * 128 + 64 + lane];
    for (int e0 = 0; e0 < 128; e0 += 8) {
      const bool lo = e0 < 64;
      const int ivs = lo ? iv0 : iv1;
      const float gvs = lo ? gv0 : gv1;
      const float sus = lo ? su0 : su1;
      int ei[4];
#pragma unroll
      for (int q = 0; q < 4; ++q) {
        const int ea = __builtin_amdgcn_readlane(ivs, (e0 & 63) + 2 * q);
        const int eb = __builtin_amdgcn_readlane(ivs, (e0 & 63) + 2 * q + 1);
        ei[q] = hs ? eb : ea;
      }
      Raw6 cu[4], cv[4];
#pragma unroll
      for (int q = 0; q < 4; ++q) { cu[q] = ld_raw6(Ub, ei[q], ll); cv[q] = ld_raw6(Vb, ei[q], ll); }
      float dq[4];
#pragma unroll
      for (int q = 0; q < 4; ++q) {
        const v32f u = dec6(cu[q]);
        float d0 = 0.f, d1 = 0.f;
#pragma unroll
        for (int k = 0; k < 32; k += 2) { d0 = fmaf(u[k], x[k], d0); d1 = fmaf(u[k + 1], x[k + 1], d1); }
        dq[q] = d0 + d1;
      }
      float d2[2], d1;
#pragma unroll
      for (int k = 0; k < 2; ++k) {
        const float keep = b4 ? dq[k + 2] : dq[k], send = b4 ? dq[k] : dq[k + 2];
        d2[k] = keep + __shfl_xor(send, 16);
      }
      {
        const float keep = b3 ? d2[1] : d2[0], send = b3 ? d2[0] : d2[1];
        d1 = keep + __shfl_xor(send, 8);
      }
      d1 += __shfl_xor(d1, 4);
      d1 += __shfl_xor(d1, 2);
      d1 += __shfl_xor(d1, 1);
      const int qmine = (b4 ? 2 : 0) + (b3 ? 1 : 0);
      const int srcl = (e0 & 63) + 2 * qmine + hs;
      const float suv = __shfl(sus, srcl), gvv = __shfl(gvs, srcl);
      const float w = gvv * gelu_(d1 * suv);
#pragma unroll
      for (int q = 0; q < 4; ++q) {
        const float wq = __shfl(w, (lane & 32) | ((q >> 1) << 4) | ((q & 1) << 3));
        const v32f v = dec6(cv[q]);
#pragma unroll
        for (int k = 0; k < 32; ++k) o[k] = fmaf(wq, v[k], o[k]);
      }
    }
    float sm = 0.f;
#pragma unroll
    for (int k = 0; k < 32; ++k) { o[k] += __shfl_xor(o[k], 32); o[k] = ALPHA * x[k] + o[k]; sm += o[k]; }
#pragma unroll
    for (int m = 16; m >= 1; m >>= 1) sm += __shfl_xor(sm, m);
    const float mu = sm * (1.f / 1024.f);
    float sq = 0.f;
#pragma unroll
    for (int k = 0; k < 32; ++k) { const float dd = o[k] - mu; sq += dd * dd; }
#pragma unroll
    for (int m = 16; m >= 1; m >>= 1) sq += __shfl_xor(sq, m);
    const float rs = rsqrtf(sq * (1.f / 1024.f) + LN_EPS);
    if (hs == 0) {
      const int c0 = ll * 32;
#pragma unroll
      for (int j = 0; j < 4; ++j) {
        float r[8];
#pragma unroll
        for (int k = 0; k < 8; ++k) r[k] = (o[j * 8 + k] - mu) * rs * gam[c0 + j * 8 + k] + bet[c0 + j * 8 + k];
        *reinterpret_cast<uint4*>(XB + (size_t)t * 1024 + c0 + j * 8) = pack8(r);
      }
    }
  }
}

DEVI void phase_ple(const Params& p, int s, int layer, unsigned char* smem) {
  float* X = p.out + (size_t)s * TS * 1024;
  const u16* XB = (const u16*)(p.ws + OFF_XB);
  const u16* PB = (const u16*)(p.ws + OFF_PB);
  u16* XS = (u16*)(p.out + (size_t)s * TS * 1024);
  const u16* Wp = (const u16*)(p.ws + OFF_WPROJ) + (size_t)layer * 1024 * 256;
  const u16* Wg = (const u16*)(p.ws + OFF_WPG) + (size_t)layer * 1024 * 1024;
  const int lane = threadIdx.x & 63, wave = threadIdx.x >> 6, wm = wave >> 1, wn = wave & 1;
  for (int it = 0, mt, nt; tile_map(it, 256, 8, mt, nt); ++it) {
    const int m0 = mt * 128, n0 = nt * 128;
    u32 pk[4][4][2];
    gemm_tile_dma(XB + (size_t)m0 * 1024, 1024, Wg + (size_t)n0 * 1024, 1024, 1024, smem, [&](f32x4 (&acc)[4][4]) {
#pragma unroll
      for (int i = 0; i < 4; ++i)
#pragma unroll
        for (int j = 0; j < 4; ++j) {
          pk[i][j][0] = pack2(sigmoid_(acc[i][j][0]), sigmoid_(acc[i][j][1]));
          pk[i][j][1] = pack2(sigmoid_(acc[i][j][2]), sigmoid_(acc[i][j][3]));
        }
    });
    gemm_tile_dma(PB + (size_t)m0 * 256, 256, Wp + (size_t)n0 * 256, 256, 256, smem, [&](f32x4 (&acc)[4][4]) {
#pragma unroll
      for (int i = 0; i < 4; ++i)
#pragma unroll
        for (int j = 0; j < 4; ++j)
#pragma unroll
          for (int r = 0; r < 4; ++r) {
            const int row = m0 + wm * 64 + i * 16 + (lane >> 4) * 4 + r;
            const int col = n0 + wn * 64 + j * 16 + (lane & 15);
            const u32 w = pk[i][j][r >> 1];
            const float sg = (r & 1) ? bfhi(w) : bflo(w);
            const size_t idx = (size_t)row * 1024 + col;
            const float v = bf2f(XB[idx]) + acc[i][j][r] * sg;
            if (layer == 0) XS[idx] = f2bf(v); else X[idx] = v;
          }
    });
  }
  if (layer == 1 && s == 0) cvt_plain(p.in[1], (u16*)(p.ws + OFF_XIN), (size_t)TS * 1024 / 8);
}

DEVI void phase_rg_in(const Params& p, int s, unsigned char* smem) {
  const u16* XB2 = (const u16*)(p.out + (size_t)s * TS * 1024);
  const u16* Wt = (const u16*)(p.ws + OFF_WRGIN);
  u16* GG = (u16*)(p.ws + OFF_GG);
  u16* R = (u16*)(p.ws + OFF_R);
  const int lane = threadIdx.x & 63, wave = threadIdx.x >> 6, wm = wave >> 1, wn = wave & 1;
  bool pre_ = false;
  for (int it = 0, mt, nt; tile_map(it, 256, 16, mt, nt); ++it) {
    int mtn, ntn;
    const bool nxt_ = tile_map(it + 1, 256, 16, mtn, ntn);
    const int m0 = mt * 128, n0 = nt * 128;
    gemm_tile_dma<true>(XB2 + (size_t)m0 * 1024, 1024, Wt + (size_t)n0 * 1024, 1024, 1024, smem, [&](f32x4 (&acc)[4][4]) {
#pragma unroll
      for (int i = 0; i < 4; ++i)
#pragma unroll
        for (int j = 0; j < 4; ++j) {
          const int row = m0 + wm * 64 + i * 16 + (lane & 15);
          const int col = n0 + wn * 64 + j * 16 + (lane >> 4) * 4;
          uint2 w;
          if (n0 < 1024) {
            w.x = pack2(gelu_(acc[i][j][0]), gelu_(acc[i][j][1])); w.y = pack2(gelu_(acc[i][j][2]), gelu_(acc[i][j][3]));
            *reinterpret_cast<uint2*>(GG + (size_t)row * 1024 + col) = w;
          } else {
            w.x = pack2(acc[i][j][0], acc[i][j][1]); w.y = pack2(acc[i][j][2], acc[i][j][3]);
            *reinterpret_cast<uint2*>(R + (size_t)row * 1024 + col - 1024) = w;
          }
        }
    }, nxt_ ? (XB2 + (size_t)(mtn * 128) * 1024) : nullptr, nxt_ ? (Wt + (size_t)(ntn * 128) * 1024) : nullptr, pre_);
    pre_ = nxt_;
  }
}

DEVI void phase_rg_conv(const Params& p, int s) {
  const int L = s ? 2048 : 4096;
  const u16* R = (const u16*)(p.ws + OFF_R);
  u16* C = (u16*)(p.ws + OFF_C);
  const float* cw = p.in[15];
  const float* cb = p.in[16];
  const int gsz = gridDim.x * 256, gtid = blockIdx.x * 256 + threadIdx.x;
  for (int i = gtid; i < TS * 128; i += gsz) {
    const int t = i >> 7, cv = (i & 127) * 8;
    const int pos = t & (L - 1);
    float acc[8];
#pragma unroll
    for (int j = 0; j < 8; ++j) acc[j] = cb[cv + j];
#pragma unroll
    for (int k = 0; k < 4; ++k) {
      const int pp = pos + k - 1;
      if (pp >= 0 && pp < L) {
        float rv[8];
        unpack8(*reinterpret_cast<const uint4*>(R + (size_t)(t + k - 1) * 1024 + cv), rv);
#pragma unroll
        for (int j = 0; j < 8; ++j) acc[j] = fmaf(rv[j], cw[k * 1024 + cv + j], acc[j]);
      }
    }
    *reinterpret_cast<uint4*>(C + (size_t)i * 8) = pack8(acc);
  }
}

DEVI void phase_rg_gates(const Params& p, unsigned char* smem) {
  const u16* C = (const u16*)(p.ws + OFF_C);
  const u16* Wt = (const u16*)(p.ws + OFF_WGATES);
  u32* AB = (u32*)(p.ws + OFF_AB);
  const float* ba = p.in[18];
  const float* bx = p.in[20];
  const float* lam = p.in[21];
  const int lane = threadIdx.x & 63, wave = threadIdx.x >> 6, wm = wave >> 1, wn = wave & 1;
  for (int it = 0, mt, nt32; tile_map(it, 256, 32, mt, nt32); ++it) {
    const int m0 = mt * 128, h = nt32 >> 3, nt = nt32 & 7, n0 = nt * 128;
    gemm_tile_dma(C + (size_t)m0 * 1024 + h * 256, 1024, Wt + ((size_t)h * 1024 + n0) * 256, 256, 256, smem, [&](f32x4 (&acc)[4][4]) {
#pragma unroll
      for (int jj = 0; jj < 4; jj += 2) {
        const int nb = n0 + wn * 64 + jj * 16;
        const int d = nb >> 9;
        const int ch = h * 256 + ((nb & 511) >> 5) * 16 + (lane & 15);
        const float bav = ba[d * 1024 + ch], bxv = bx[d * 1024 + ch];
        const float sp8 = -8.f * softplus_(-lam[d * 1024 + ch]);
#pragma unroll
        for (int i = 0; i < 4; ++i)
#pragma unroll
          for (int r = 0; r < 4; ++r) {
            const int row = m0 + wm * 64 + i * 16 + (lane >> 4) * 4 + r;
            const float rg = sigmoid_(acc[i][jj][r] + bav);
            const float ig = sigmoid_(acc[i][jj + 1][r] + bxv);
            const float la = sp8 * rg;
            const float cval = bf2f(C[(size_t)row * 1024 + ch]);
            const float b = __builtin_amdgcn_sqrtf(fmaxf(1.f - __expf(2.f * la), 0.f)) * ig * cval;
            AB[((size_t)row * 2 + d) * 1024 + ch] = pack2(la, b);
            if (r == 3) __builtin_amdgcn_sched_barrier(0);
          }
      }
    });
  }
}

DEVI void phase_rg_agg(const Params& p) {
  const u32* AB = (const u32*)(p.ws + OFF_AB);
  float2* AGG = (float2*)(p.ws + OFF_AGG);
  const int gsz = gridDim.x * 256, gtid = blockIdx.x * 256 + threadIdx.x;
  for (int i = gtid; i < 1024 * 2 * 1024; i += gsz) {
    const int ch = i & 1023, d = (i >> 10) & 1, chunk = i >> 11;
    const int c0 = chunk * 32;
    float h = 0.f, LA = 0.f;
#pragma unroll 8
    for (int k = 0; k < 32; ++k) {
      const int t = d ? (c0 + 31 - k) : (c0 + k);
      const u32 w = AB[((size_t)t * 2 + d) * 1024 + ch];
      const float la = bflo(w), b = bfhi(w);
      h = __expf(la) * h + b;
      LA += la;
    }
    AGG[((size_t)d * 1024 + chunk) * 1024 + ch] = float2{LA, h};
  }
}

DEVI void phase_rg_carry(const Params& p, int s) {
  const int L = s ? 2048 : 4096;
  const int nseq = TS / L, nch = L / 32;
  const float2* AGG = (const float2*)(p.ws + OFF_AGG);
  float* CAR = (float*)(p.ws + OFF_CAR);
  const int gsz = gridDim.x * 256, gtid = blockIdx.x * 256 + threadIdx.x;
  for (int i = gtid; i < nseq * 2 * 1024; i += gsz) {
    const int ch = i & 1023, d = (i >> 10) & 1, seq = i >> 11;
    float H = 0.f;
#pragma unroll 8
    for (int k = 0; k < nch; ++k) {
      const int chunk = seq * nch + (d ? (nch - 1 - k) : k);
      const size_t idx = ((size_t)d * 1024 + chunk) * 1024 + ch;
      CAR[idx] = H;
      const float2 ag = AGG[idx];
      H = __expf(ag.x) * H + ag.y;
    }
  }
}

DEVI void phase_rg_final(const Params& p) {
  const u32* AB = (const u32*)(p.ws + OFF_AB);
  const float* CAR = (const float*)(p.ws + OFF_CAR);
  const u16* GG = (const u16*)(p.ws + OFF_GG);
  u16* Y = (u16*)(p.ws + OFF_R);
  const int gsz = gridDim.x * 256, gtid = blockIdx.x * 256 + threadIdx.x;
  for (int i = gtid; i < 1024 * 1024; i += gsz) {
    const int ch = i & 1023, chunk = i >> 10;
    const int c0 = chunk * 32;
    float hf[32];
    float h = CAR[((size_t)chunk) * 1024 + ch];
#pragma unroll
    for (int k = 0; k < 32; ++k) {
      const u32 w = AB[((size_t)(c0 + k) * 2 + 0) * 1024 + ch];
      h = __expf(bflo(w)) * h + bfhi(w);
      hf[k] = h;
    }
    h = CAR[((size_t)1024 + chunk) * 1024 + ch];
#pragma unroll
    for (int k = 31; k >= 0; --k) {
      const u32 w = AB[((size_t)(c0 + k) * 2 + 1) * 1024 + ch];
      h = __expf(bflo(w)) * h + bfhi(w);
      const size_t idx = (size_t)(c0 + k) * 1024 + ch;
      Y[idx] = f2bf((hf[k] + h) * bf2f(GG[idx]));
    }
  }
}

DEVI void phase_rg_out(const Params& p, int s, unsigned char* smem) {
  const u16* XS = (const u16*)(p.out + (size_t)s * TS * 1024);
  u16* ZB = (u16*)(p.ws + OFF_XB);
  const u16* Y = (const u16*)(p.ws + OFF_R);
  const u16* Wt = (const u16*)(p.ws + OFF_WRGOUT);
  const int lane = threadIdx.x & 63, wave = threadIdx.x >> 6, wm = wave >> 1, wn = wave & 1;
  bool pre_ = false;
  for (int it = 0, mt, nt; tile_map(it, 256, 8, mt, nt); ++it) {
    int mtn, ntn;
    const bool nxt_ = tile_map(it + 1, 256, 8, mtn, ntn);
    const int m0 = mt * 128, n0 = nt * 128;
    gemm_tile_dma<true>(Y + (size_t)m0 * 1024, 1024, Wt + (size_t)n0 * 1024, 1024, 1024, smem, [&](f32x4 (&acc)[4][4]) {
#pragma unroll
      for (int i = 0; i < 4; ++i)
#pragma unroll
        for (int j = 0; j < 4; ++j) {
          const int row = m0 + wm * 64 + i * 16 + (lane & 15);
          const int col = n0 + wn * 64 + j * 16 + (lane >> 4) * 4;
          const uint2 xw = *reinterpret_cast<const uint2*>(XS + (size_t)row * 1024 + col);
          float4 v = float4{bflo(xw.x), bfhi(xw.x), bflo(xw.y), bfhi(xw.y)};
          v.x = ALPHA * v.x + acc[i][j][0]; v.y = ALPHA * v.y + acc[i][j][1]; v.z = ALPHA * v.z + acc[i][j][2]; v.w = ALPHA * v.w + acc[i][j][3];
          uint2 w; w.x = pack2(v.x, v.y); w.y = pack2(v.z, v.w);
          *reinterpret_cast<uint2*>(ZB + (size_t)row * 1024 + col) = w;
        }
    }, nxt_ ? (Y + (size_t)(mtn * 128) * 1024) : nullptr, nxt_ ? (Wt + (size_t)(ntn * 128) * 1024) : nullptr, pre_);
    pre_ = nxt_;
  }
}

constexpr int NPS = 22;
constexpr int NSETUP = 3;
constexpr int NPHASE = NSETUP + 2 * NPS;

template <int PH>
DEVI void run_phase(const Params& p, unsigned char* smem) {
  if constexpr (PH == 0) {
    phase_setup(p);
  } else if constexpr (PH == 1) {
    phase_setup2(p, smem);
  } else if constexpr (PH == 2) {
    phase_setup3(p);
  } else {
    constexpr int s = (PH - NSETUP) / NPS, q = (PH - NSETUP) % NPS;
    if constexpr (q == 0) phase_s5_in(p, s, smem);
    else if constexpr (q == 1) phase_s5_state(p, smem);
    else if constexpr (q == 2) phase_s5_cscan(p, s);
    else if constexpr (q == 3) phase_s5_main(p, smem);
    else if constexpr (q == 4) phase_s5_glu(p, s, smem);
    else if constexpr (q == 5) phase_ln1_tables(p, s, 0, smem);
    else if constexpr (q == 6) phase_peer_q(p, 0, smem);
    else if constexpr (q == 7) phase_peer_route(p, s, 0);
    else if constexpr (q == 8) phase_peer_gather(p, s, 0);
    else if constexpr (q == 9) phase_ple(p, s, 0, smem);
    else if constexpr (q == 10) phase_rg_in(p, s, smem);
    else if constexpr (q == 11) phase_rg_conv(p, s);
    else if constexpr (q == 12) phase_rg_gates(p, smem);
    else if constexpr (q == 13) phase_rg_agg(p);
    else if constexpr (q == 14) phase_rg_carry(p, s);
    else if constexpr (q == 15) phase_rg_final(p);
    else if constexpr (q == 16) phase_rg_out(p, s, smem);
    else if constexpr (q == 17) phase_ln1_tables(p, s, 1, smem);
    else if constexpr (q == 18) phase_peer_q(p, 1, smem);
    else if constexpr (q == 19) phase_peer_route(p, s, 1);
    else if constexpr (q == 20) phase_peer_gather(p, s, 1);
    else if constexpr (q == 21) phase_ple(p, s, 1, smem);
  }
}

#define XB_TMO      128
#define XB_XCNT(j)  (256  + 64 * (j))
#define XB_XSUB(j)  (1280 + 64 * (j))
#define XB_XGEN(j)  (2304 + 64 * (j))
#define XB_TOP      3328
#define XB_TOPGEN   3392
#define XCD_BAR_WORDS 3456
#define XB_SPIN_CAP (1u << 18)
#define LAS __attribute__((address_space(3)))
DEVI unsigned xb_ld(unsigned* p) { return __hip_atomic_load(p, __ATOMIC_RELAXED, __HIP_MEMORY_SCOPE_AGENT); }
DEVI unsigned xb_add(unsigned* p, unsigned v) { return __hip_atomic_fetch_add(p, v, __ATOMIC_RELAXED, __HIP_MEMORY_SCOPE_AGENT); }
DEVI unsigned xb_xcc_id() { return (unsigned)__builtin_amdgcn_s_getreg((3 << 11) | 20) & 0xFu; }
#define XB_SPIN(cond, bar) do { unsigned _sp = 0; while (cond) { __builtin_amdgcn_s_sleep(1); \
    if ((++_sp & 255u) == 0u) { if (xb_ld(&(bar)[XB_TMO])) break; if (_sp > XB_SPIN_CAP) { atomicAdd(&(bar)[XB_TMO], 1u); break; } } } } while (0)
struct XcdBarrier { unsigned* bar; unsigned x; volatile LAS unsigned* st; };
DEVI XcdBarrier xcd_barrier_post(unsigned* bar, volatile LAS unsigned* st) {
  XcdBarrier b; b.bar = bar; b.x = xb_xcc_id(); b.st = st;
  if (threadIdx.x == 0) (void)xb_add(&bar[XB_XCNT(b.x)], 1u);
  return b;
}
DEVI void xcd_barrier_complete(unsigned* bar, unsigned x, unsigned& nloc, unsigned& nx) {
  const unsigned G = gridDim.x * gridDim.y * gridDim.z;
  unsigned sum, cnt, mine, sp = 0u;
  for (;;) {
    sum = 0u; cnt = 0u; mine = 0u;
#pragma unroll
    for (unsigned j = 0; j < 16; ++j) { const unsigned c = xb_ld(&bar[XB_XCNT(j)]); sum += c; cnt += (c > 0u) ? 1u : 0u; mine = (j == x) ? c : mine; }
    if (sum == G) break;
    __builtin_amdgcn_s_sleep(1);
    if ((++sp & 255u) == 0u) { if (xb_ld(&bar[XB_TMO])) break; if (sp > XB_SPIN_CAP) { atomicAdd(&bar[XB_TMO], 1u); break; } }
  }
  nloc = mine > 0u ? mine : 1u; nx = cnt > 0u ? cnt : 1u;
}
DEVI void xcd_barrier(const XcdBarrier& b) {
  asm volatile("s_waitcnt vmcnt(0)" ::: "memory");
  __syncthreads();
  if (threadIdx.x == 0) {
    unsigned* bar = b.bar;
    __builtin_amdgcn_s_waitcnt(0);
    unsigned nloc = b.st[0], nx = b.st[1];
    if (nloc == 0u) { xcd_barrier_complete(bar, b.x, nloc, nx); b.st[0] = nloc; b.st[1] = nx; }
    const unsigned old = xb_add(&bar[XB_XSUB(b.x)], 1u);
    const unsigned gen = old / nloc;
    if (old + 1u == (gen + 1u) * nloc) {
      __builtin_amdgcn_fence(__ATOMIC_RELEASE, "agent");
      asm volatile("s_waitcnt vmcnt(0)" ::: "memory");
      const unsigned og = xb_add(&bar[XB_TOP], 1u);
      const unsigned tg = og / nx;
      if (og + 1u == (tg + 1u) * nx) xb_add(&bar[XB_TOPGEN], 1u);
      else XB_SPIN(xb_ld(&bar[XB_TOPGEN]) == tg, bar);
      __builtin_amdgcn_fence(__ATOMIC_ACQUIRE, "agent");
      xb_add(&bar[XB_XGEN(b.x)], 1u);
      asm volatile("s_waitcnt vmcnt(0)" ::: "memory");
    } else {
      XB_SPIN(xb_ld(&bar[XB_XGEN(b.x)]) == gen, bar);
      __builtin_amdgcn_fence(__ATOMIC_ACQUIRE, "agent");
      asm volatile("s_waitcnt vmcnt(0)" ::: "memory");
    }
  }
  __syncthreads();
}

template <int PH>
DEVI void run_steps(const Params& p, int lo, int hi, unsigned char* smem, const XcdBarrier& xb) {
  if constexpr (PH < NPHASE) {
    if (PH >= lo && PH < hi) {
      run_phase<PH>(p, smem);
      if (PH + 1 < hi) {
        if (lo < 0) cg::this_grid().sync();
        xcd_barrier(xb);
      }
    }
    run_steps<PH + 1>(p, lo, hi, smem, xb);
  }
}

__global__ void __launch_bounds__(256, 2) mega(Params p, int ph_lo, int ph_hi) {
  extern __shared__ __attribute__((aligned(16))) unsigned char smem[];
  volatile LAS unsigned* st = (volatile LAS unsigned*)(smem + LDS_BYTES);
  if (threadIdx.x == 0) { st[0] = 0u; st[1] = 0u; }
  __syncthreads();
  const XcdBarrier xb = xcd_barrier_post((unsigned*)(p.ws + OFF_BAR), st);
  run_steps<0>(p, ph_lo, ph_hi, smem, xb);
}

extern "C" void kernel_launch(void* const* d_in, const int* in_sizes, int n_in, void* d_out, int out_size, void* d_ws,
                              size_t ws_size, hipStream_t stream) {
  static int grid = 0;
  if (grid == 0) {
    if (n_in != 33 || ws_size < WS_END) {
      fprintf(stderr, "kernel_launch: need 33 inputs and %zu bytes ws; got %d, %zu\n", (size_t)WS_END, n_in, ws_size);
      grid = -1;
      return;
    }
    int dev = 0, cus = 0, per_cu = 0;
    hipGetDevice(&dev);
    hipDeviceGetAttribute(&cus, hipDeviceAttributeMultiprocessorCount, dev);
    if (hipFuncSetAttribute((const void*)mega, hipFuncAttributeMaxDynamicSharedMemorySize, LDS_BYTES + 16) != hipSuccess) {
      fprintf(stderr, "kernel_launch: hipFuncSetAttribute failed\n");
      grid = -1;
      return;
    }
    hipOccupancyMaxActiveBlocksPerMultiprocessor(&per_cu, (const void*)mega, 256, LDS_BYTES + 16);
    if (per_cu < 1) per_cu = 1;
    if (per_cu > 2) per_cu = 2;
    grid = cus * per_cu;
    fprintf(stderr, "kernel_launch: cus %d per_cu %d grid %d\n", cus, per_cu, grid);
  }
  if (grid < 0) return;
  (void)hipMemsetAsync((unsigned char*)d_ws + OFF_BAR, 0, XCD_BAR_WORDS * sizeof(unsigned), stream);
  Params p{};
  for (int i = 0; i < 33; ++i) p.in[i] = (const float*)d_in[i];
  p.out = (float*)d_out;
  p.ws = (unsigned char*)d_ws;
#if COOP
  int lo = 0, hi = NPHASE;
  void* args[] = {&p, &lo, &hi};
  hipError_t e = hipLaunchCooperativeKernel((const void*)mega, dim3(grid), dim3(256), args, LDS_BYTES + 16, stream);
  if (e != hipSuccess) fprintf(stderr, "cooperative launch failed: %s (grid %d)\n", hipGetErrorString(e), grid);
#else
  for (int ph = 0; ph < NPHASE; ++ph) {
    hipLaunchKernelGGL(mega, dim3(grid), dim3(256), LDS_BYTES + 16, stream, p, ph, ph + 1);
  }
#endif
}
```
